# Optimizing an MI355X kernel written in HIP

```python
import jax
import jax.numpy as jnp
from jax import lax
import numpy as np

D_MODEL = 1024
BATCH = 4
SEQ = 8192
DEPTH = 4


HEAD_DIM = 64
N_MIX_HEADS = D_MODEL // HEAD_DIM
HEADS_A = (3 * N_MIX_HEADS) // 8
HEADS_B = (3 * N_MIX_HEADS) // 8
HEADS_C = N_MIX_HEADS - HEADS_A - HEADS_B
Q_LORA = D_MODEL // 4
KV_LORA = D_MODEL // 8
QK_NOPE = HEAD_DIM
QK_ROPE = HEAD_DIM // 2
V_DIM_A = HEAD_DIM
DILATED_PAIRS = ((128, 1), (512, 4), (2048, 16))
GRID_W = 64
NA_ROWS = 8
NA_COLS = 16
NA_QCOLS = 16
NA_KCOLS = 2 * NA_COLS
D_FF = 4 * D_MODEL
ROPE_THETA = 10000.0
Q_BLOCK = 128
NORM_EPS = 1e-6
NEG_INF = -1e30

COLS_A = Q_LORA + KV_LORA + QK_ROPE
COLS_B = 3 * HEADS_B * HEAD_DIM
COLS_C = 3 * HEADS_C * HEAD_DIM
IN_COLS = COLS_A + COLS_B + COLS_C
WIDTH_A = HEADS_A * V_DIM_A
WIDTH_B = HEADS_B * HEAD_DIM
WIDTH_C = HEADS_C * HEAD_DIM
MIX_WIDTH = WIDTH_A + WIDTH_B + WIDTH_C

kernel_name = "hybrid_mla_dilated_natten_encoder"


def rms_norm(x, g):
    xf = x.astype(jnp.float32)
    y = xf * lax.rsqrt(jnp.mean(xf * xf, axis=-1, keepdims=True) + NORM_EPS)
    return (y * g.astype(jnp.float32)).astype(x.dtype)


def rope(x, pos):
    half = x.shape[-1] // 2
    inv_freq = ROPE_THETA ** (-jnp.arange(half, dtype=jnp.float32) / half)
    ang = pos[:, None] * inv_freq[None, :]
    cos = jnp.cos(ang)[None, :, None, :]
    sin = jnp.sin(ang)[None, :, None, :]
    x1 = x[..., :half].astype(jnp.float32)
    x2 = x[..., half:].astype(jnp.float32)
    return jnp.concatenate([x1 * cos - x2 * sin, x1 * sin + x2 * cos], axis=-1).astype(x.dtype)


def dense_attention(q, k, v):
    b, s, h, dq = q.shape
    scale = dq ** -0.5
    qb = q.reshape(b, s // Q_BLOCK, Q_BLOCK, h, dq).transpose(1, 0, 2, 3, 4)

    def one_block(q_blk):
        sc = jnp.einsum('bqhd,bkhd->bhqk', q_blk, k, preferred_element_type=jnp.float32) * scale
        p = jax.nn.softmax(sc, axis=-1)
        return jnp.einsum('bhqk,bkhd->bqhd', p.astype(v.dtype), v)

    o = lax.map(one_block, qb)
    return o.transpose(1, 0, 2, 3, 4).reshape(b, s, h, v.shape[-1])


def banded_attention(q, k, v, half):
    bq, n, h, d = q.shape
    blk = half
    nb = -(-n // blk)
    n_pad = nb * blk
    qp = jnp.pad(q, ((0, 0), (0, n_pad - n), (0, 0), (0, 0))).reshape(bq, nb, blk, h, d)
    pad_kv = ((0, 0), (blk, n_pad - n + blk), (0, 0), (0, 0))
    kp = jnp.pad(k, pad_kv).reshape(bq, nb + 2, blk, h, d)
    vp = jnp.pad(v, pad_kv).reshape(bq, nb + 2, blk, h, d)
    kw = jnp.concatenate([kp[:, :-2], kp[:, 1:-1], kp[:, 2:]], axis=2)
    vw = jnp.concatenate([vp[:, :-2], vp[:, 1:-1], vp[:, 2:]], axis=2)
    q_idx = jnp.arange(n_pad).reshape(nb, blk)
    k_idx = jnp.arange(nb)[:, None] * blk - blk + jnp.arange(3 * blk)[None, :]
    mask = ((jnp.abs(q_idx[:, :, None] - k_idx[:, None, :]) <= half)
            & (k_idx[:, None, :] >= 0) & (k_idx[:, None, :] < n))
    sc = jnp.einsum('bnqhd,bnkhd->bnhqk', qp, kw, preferred_element_type=jnp.float32) * (d ** -0.5)
    sc = jnp.where(mask[None, :, None], sc, NEG_INF)
    m = jnp.max(sc, axis=-1, keepdims=True)
    p = jnp.exp(sc - m)
    den = jnp.sum(p, axis=-1)
    o = jnp.einsum('bnhqk,bnkhd->bnqhd', p.astype(v.dtype), vw).astype(jnp.float32)
    o = o / den.transpose(0, 1, 3, 2)[..., None]
    lse = (m[..., 0] + jnp.log(den)).transpose(0, 1, 3, 2)
    o = o.reshape(bq, n_pad, h, d)[:, :n]
    lse = lse.reshape(bq, n_pad, h)[:, :n]
    return o, lse


def dilated_sliding_attention(q, k, v):
    b, s, h, d = q.shape
    outs, lses = [], []
    for window, dil in DILATED_PAIRS:
        n = s // dil
        qc = q.reshape(b, n, dil, h, d).transpose(0, 2, 1, 3, 4).reshape(b * dil, n, h, d)
        kc = k.reshape(b, n, dil, h, d).transpose(0, 2, 1, 3, 4).reshape(b * dil, n, h, d)
        vc = v.reshape(b, n, dil, h, d).transpose(0, 2, 1, 3, 4).reshape(b * dil, n, h, d)
        o, lse = banded_attention(qc, kc, vc, window // (2 * dil))
        outs.append(o.reshape(b, dil, n, h, d).transpose(0, 2, 1, 3, 4).reshape(b, s, h, d))
        lses.append(lse.reshape(b, dil, n, h).transpose(0, 2, 1, 3).reshape(b, s, h))
    w = jax.nn.softmax(jnp.stack(lses, axis=-1), axis=-1)
    o = jnp.sum(jnp.stack(outs, axis=-1) * w[:, :, :, None, :], axis=-1)
    return o.astype(q.dtype)


def neighbourhood_attention(q, k, v, rpb):
    b, s, h, d = q.shape
    rows = s // GRID_W
    kr_win = min(NA_ROWS, rows)
    q_rows = kr_win
    k_rows = min(2 * kr_win, rows)
    nrb = -(-rows // q_rows)
    rows_pad = nrb * q_rows
    ncb = GRID_W // NA_QCOLS
    qg = jnp.pad(q.reshape(b, rows, GRID_W, h, d), ((0, 0), (0, rows_pad - rows), (0, 0), (0, 0), (0, 0)))
    qg = qg.reshape(b, nrb, q_rows, ncb, NA_QCOLS, h, d).transpose(0, 1, 3, 2, 4, 5, 6)
    r_q = jnp.arange(rows_pad).reshape(nrb, q_rows)
    r_start = jnp.clip(r_q - kr_win // 2, 0, rows - kr_win)
    c_q = jnp.arange(GRID_W).reshape(ncb, NA_QCOLS)
    c_start = jnp.clip(c_q - NA_COLS // 2, 0, GRID_W - NA_COLS)
    kr_idx = (jnp.clip(jnp.arange(nrb) * q_rows - kr_win // 2, 0, rows - k_rows)[:, None]
              + jnp.arange(k_rows)[None, :])
    kc_idx = (jnp.clip(jnp.arange(ncb) * NA_QCOLS - NA_COLS // 2, 0, GRID_W - NA_KCOLS)[:, None]
              + jnp.arange(NA_KCOLS)[None, :])
    kgrid = k.reshape(b, rows, GRID_W, h, d)
    vgrid = v.reshape(b, rows, GRID_W, h, d)
    ri = kr_idx[:, None, :, None]
    ci = kc_idx[None, :, None, :]
    kg = kgrid[:, ri, ci]
    vg = vgrid[:, ri, ci]
    row_ok = (kr_idx[:, None, :] >= r_start[:, :, None]) & (kr_idx[:, None, :] < r_start[:, :, None] + kr_win)
    col_ok = (kc_idx[:, None, :] >= c_start[:, :, None]) & (kc_idx[:, None, :] < c_start[:, :, None] + NA_COLS)
    dr = jnp.clip(kr_idx[:, None, :] - r_q[:, :, None], -(NA_ROWS - 1), NA_ROWS - 1) + (NA_ROWS - 1)
    dc = jnp.clip(kc_idx[:, None, :] - c_q[:, :, None], -(NA_COLS - 1), NA_COLS - 1) + (NA_COLS - 1)
    bias = rpb[:, dr[:, None, :, None, :, None], dc[None, :, None, :, None, :]]
    mask = row_ok[:, None, :, None, :, None] & col_ok[None, :, None, :, None, :]
    sc = jnp.einsum('bnmiphd,bnmjqhd->bnmhipjq', qg, kg, preferred_element_type=jnp.float32) * (d ** -0.5)
    sc = sc + bias.transpose(1, 2, 0, 3, 4, 5, 6).astype(jnp.float32)[None]
    sc = jnp.where(mask[:, :, None][None], sc, NEG_INF)
    shp = sc.shape
    p = jax.nn.softmax(sc.reshape(shp[:-2] + (k_rows * NA_KCOLS,)), axis=-1).reshape(shp)
    o = jnp.einsum('bnmhipjq,bnmjqhd->bnmiphd', p.astype(v.dtype), vg)
    o = o.transpose(0, 1, 3, 2, 4, 5, 6).reshape(b, rows_pad, GRID_W, h, d)[:, :rows]
    return o.reshape(b, s, h, d)


def setup_inputs(seed: int = 0) -> dict:
    key = jax.random.key(seed)
    ks = jax.random.split(key, 16)

    def normal(k, shape, scale):
        return jax.random.normal(k, shape, dtype=jnp.float32) * scale

    def gain(k, shape):
        return 1.0 + 0.02 * jax.random.normal(k, shape, dtype=jnp.float32)

    return {
        "x": normal(ks[0], (BATCH, SEQ, D_MODEL), 1.0),
        "g_mix": gain(ks[1], (DEPTH, D_MODEL)),
        "w_in": normal(ks[2], (DEPTH, D_MODEL, IN_COLS), D_MODEL ** -0.5),
        "q_norm": gain(ks[3], (DEPTH, Q_LORA)),
        "w_uq": normal(ks[4], (DEPTH, Q_LORA, HEADS_A * (QK_NOPE + QK_ROPE)), Q_LORA ** -0.5),
        "kv_norm": gain(ks[5], (DEPTH, KV_LORA)),
        "w_ukv": normal(ks[6], (DEPTH, KV_LORA, HEADS_A * (QK_NOPE + V_DIM_A)), KV_LORA ** -0.5),
        "rpb": normal(ks[7], (DEPTH, HEADS_C, 2 * NA_ROWS - 1, 2 * NA_COLS - 1), 0.1),
        "out_norm_a": gain(ks[8], (DEPTH, WIDTH_A)),
        "out_norm_b": gain(ks[9], (DEPTH, WIDTH_B)),
        "out_norm_c": gain(ks[10], (DEPTH, WIDTH_C)),
        "w_out": normal(ks[11], (DEPTH, MIX_WIDTH, D_MODEL), MIX_WIDTH ** -0.5),
        "g_mlp": gain(ks[12], (DEPTH, D_MODEL)),
        "w_mlp_in": normal(ks[13], (DEPTH, D_MODEL, D_FF), D_MODEL ** -0.5),
        "w_mlp_out": normal(ks[14], (DEPTH, D_FF, D_MODEL), D_FF ** -0.5),
        "g_final": gain(ks[15], (D_MODEL,)),
    }


def reference(x, g_mix, w_in, q_norm, w_uq, kv_norm, w_ukv, rpb, out_norm_a, out_norm_b, out_norm_c,
              w_out, g_mlp, w_mlp_in, w_mlp_out, g_final):
    b, s, _ = x.shape
    pos = jnp.arange(s, dtype=jnp.float32)
    for l in range(DEPTH):
        h = rms_norm(x, g_mix[l])
        proj = h @ w_in[l]
        p_a = proj[..., :COLS_A]
        p_b = proj[..., COLS_A:COLS_A + COLS_B]
        p_c = proj[..., COLS_A + COLS_B:]
        c_q = p_a[..., :Q_LORA]
        c_kv = p_a[..., Q_LORA:Q_LORA + KV_LORA]
        k_pe = p_a[..., Q_LORA + KV_LORA:]
        qa = (rms_norm(c_q, q_norm[l]) @ w_uq[l]).reshape(b, s, HEADS_A, QK_NOPE + QK_ROPE)
        kva = (rms_norm(c_kv, kv_norm[l]) @ w_ukv[l]).reshape(b, s, HEADS_A, QK_NOPE + V_DIM_A)
        k_pe = jnp.broadcast_to(rope(k_pe[:, :, None, :], pos), (b, s, HEADS_A, QK_ROPE))
        qa = jnp.concatenate([qa[..., :QK_NOPE], rope(qa[..., QK_NOPE:], pos)], axis=-1)
        ka = jnp.concatenate([kva[..., :QK_NOPE], k_pe], axis=-1)
        o_a = dense_attention(qa, ka, kva[..., QK_NOPE:])
        pb = p_b.reshape(b, s, 3, HEADS_B, HEAD_DIM)
        o_b = dilated_sliding_attention(rope(pb[:, :, 0], pos), rope(pb[:, :, 1], pos), pb[:, :, 2])
        pc = p_c.reshape(b, s, 3, HEADS_C, HEAD_DIM)
        o_c = neighbourhood_attention(pc[:, :, 0], pc[:, :, 1], pc[:, :, 2], rpb[l])
        mixed = jnp.concatenate([
            rms_norm(o_a.reshape(b, s, WIDTH_A), out_norm_a[l]),
            rms_norm(o_b.reshape(b, s, WIDTH_B), out_norm_b[l]),
            rms_norm(o_c.reshape(b, s, WIDTH_C), out_norm_c[l]),
        ], axis=-1)
        x = x + mixed @ w_out[l]
        h2 = rms_norm(x, g_mlp[l])
        x = x + jnp.square(jax.nn.relu(h2 @ w_mlp_in[l])) @ w_mlp_out[l]
    return rms_norm(x, g_final)
```

```cpp
#include <hip/hip_runtime.h>
#include <hip/hip_cooperative_groups.h>
#include <cstdio>
#include <cmath>
#include <cstring>
namespace cg = cooperative_groups;

#ifndef ONE_LAUNCH
#define ONE_LAUNCH 1
#endif

#define DI __device__ __forceinline__
typedef unsigned short bf16_t;
typedef short bf16x8 __attribute__((ext_vector_type(8)));
typedef short s16x4 __attribute__((ext_vector_type(4)));
typedef float f32x16 __attribute__((ext_vector_type(16)));
typedef float f32x2 __attribute__((ext_vector_type(2)));
typedef float f32x4 __attribute__((ext_vector_type(4)));
typedef __bf16 bf2_t __attribute__((ext_vector_type(2)));
typedef unsigned u32x4 __attribute__((ext_vector_type(4)));
typedef unsigned u32x2 __attribute__((ext_vector_type(2)));
typedef __attribute__((address_space(3))) s16x4 lds_s16x4;

constexpr int SEQ = 8192, NB = 4, NTOK = NB * SEQ, DM = 1024, NLAYER = 4;
constexpr int N_IN_PAD = 2432, N_UQ_PAD = 640, N_UKV = 768, DFF = 4096;

constexpr size_t SZ_XB = (size_t)NTOK * DM * 2;
constexpr size_t SZ_WIN = (size_t)N_IN_PAD * 1024 * 2, SZ_WUQ = (size_t)N_UQ_PAD * 256 * 2, SZ_WUKV = (size_t)N_UKV * 128 * 2,
                 SZ_WOUT = (size_t)1024 * 1024 * 2, SZ_W1 = (size_t)DFF * 1024 * 2, SZ_W2 = (size_t)1024 * DFF * 2;
constexpr size_t LW_WIN = 0, LW_WUQ = LW_WIN + SZ_WIN, LW_WUKV = LW_WUQ + SZ_WUQ, LW_WOUT = LW_WUKV + SZ_WUKV, LW_W1 = LW_WOUT + SZ_WOUT,
                 LW_W2 = LW_W1 + SZ_W1, LW_SIZE = LW_W2 + SZ_W2;
constexpr size_t OFF_XB = 0, OFF_W = OFF_XB + SZ_XB, OFF_TAB = OFF_W + NLAYER * LW_SIZE;
constexpr size_t OFF_COS32 = OFF_TAB, OFF_SIN32 = OFF_COS32 + (size_t)SEQ * 32 * 4, OFF_COS16 = OFF_SIN32 + (size_t)SEQ * 32 * 4,
                 OFF_SIN16 = OFF_COS16 + (size_t)SEQ * 16 * 4, OFF_ATT = OFF_SIN16 + (size_t)SEQ * 16 * 4;
constexpr size_t SZ_T384 = (size_t)NTOK * 384 * 2, SZ_QA = (size_t)NB * 6 * SEQ * 96 * 2, SZ_H6 = (size_t)NB * 6 * SEQ * 64 * 2,
                 SZ_H4 = (size_t)NB * 4 * SEQ * 64 * 2;
constexpr size_t OFF_CQKV = OFF_ATT;
constexpr size_t OFF_OA = OFF_CQKV;
constexpr size_t OFF_QA = OFF_CQKV + SZ_T384, OFF_KA = OFF_QA + SZ_QA, OFF_VA = OFF_KA + SZ_QA;
constexpr size_t OFF_QB = OFF_VA + SZ_H6, OFF_KB = OFF_QB + SZ_H6, OFF_VB = OFF_KB + SZ_H6;
constexpr size_t OFF_QC = OFF_VB + SZ_H6, OFF_KC = OFF_QC + SZ_H4, OFF_VC = OFF_KC + SZ_H4;
constexpr size_t OFF_OB = OFF_VC + SZ_H4, OFF_LSEB = OFF_OB + 3 * SZ_T384, OFF_OC = OFF_LSEB + (size_t)3 * NTOK * 6 * 4;
constexpr size_t OFF_END = OFF_OC + (size_t)NTOK * 256 * 2;
constexpr size_t OFF_MIXED = OFF_QA;
constexpr size_t OFF_HID = OFF_ATT;
static_assert(OFF_HID + (size_t)NTOK * DFF * 2 <= OFF_END, "hid fits");
static_assert(OFF_MIXED + (size_t)NTOK * DM * 2 <= OFF_VA, "mixed fits");

struct Params {
  const float *x, *g_mix, *w_in, *q_norm, *w_uq, *kv_norm, *w_ukv, *rpb, *on_a, *on_b, *on_c, *w_out, *g_mlp, *w_mlp_in, *w_mlp_out, *g_final;
  float* out; char* ws;
  float qscaleA, qscaleB;
};
__shared__ __attribute__((aligned(16))) char g_smem[37376];
#define NI __device__ __forceinline__
DI const Params& kparams() { return *(const Params*)__builtin_amdgcn_kernarg_segment_ptr(); }

DI unsigned cvtpk(float lo, float hi) { f32x2 v = {lo, hi}; bf2_t b = __builtin_convertvector(v, bf2_t); return __builtin_bit_cast(unsigned, b); }
DI bf16_t f2bf(float x) { return (bf16_t)(cvtpk(x, 0.f) & 0xffffu); }
DI float bf2f(unsigned h) { return __uint_as_float(h << 16); }
DI int crow(int i, int h) { return (i & 3) + 8 * (i >> 2) + 4 * h; }
#define MFMA32(a, b, c) __builtin_amdgcn_mfma_f32_32x32x16_bf16((a), (b), (c), 0, 0, 0)
DI float fdot2bf(unsigned a, float c) { bf2_t v = __builtin_bit_cast(bf2_t, a); return __builtin_amdgcn_fdot2_f32_bf16(v, v, c, false); }
DI float swap_max(float v) { auto rr = __builtin_amdgcn_permlane32_swap(__float_as_uint(v), __float_as_uint(v), false, false); return fmaxf(__uint_as_float(rr[0]), __uint_as_float(rr[1])); }
DI float swap_sum(float v) { auto rr = __builtin_amdgcn_permlane32_swap(__float_as_uint(v), __float_as_uint(v), false, false); return __uint_as_float(rr[0]) + __uint_as_float(rr[1]); }

constexpr int SMEM_BYTES = 37376;
DI int otid() { int t = threadIdx.x; asm volatile("" : "+v"(t)); return t; }
DI int obid() { int t = blockIdx.x; asm volatile("" : "+s"(t)); return t; }

template <bool NORM, class Epi>
DI void gemm_tile(const bf16_t* __restrict__ A, int lda, const bf16_t* __restrict__ Bt, int ldb, int K, int m0, int n0, char* smem, const Epi& epi, const int tid) {
  const int lane = tid & 63, w = tid >> 6, wm = w >> 1, wn = w & 1, r32 = lane & 31, hi = lane >> 5;
  char* As = smem; char* Bs = smem + 18432; float* rstd_s = (float*)(smem + 36864);
  const int srow = tid >> 3, skc = tid & 7;
  const bf16_t* Ap = A + (size_t)(m0 + srow) * lda + skc * 8;
  const bf16_t* Bp = Bt + (size_t)(n0 + srow) * ldb + skc * 8;
  u32x4 ra[4], rb[4];
  f32x16 acc[2][2];
#pragma unroll
  for (int mi = 0; mi < 2; ++mi)
#pragma unroll
    for (int nj = 0; nj < 2; ++nj)
#pragma unroll
      for (int i = 0; i < 16; ++i) acc[mi][nj][i] = 0.f;
  float ssq[4];
#pragma unroll
  for (int i = 0; i < 4; ++i) ssq[i] = 0.f;
  const int nk = K >> 6;
#pragma unroll
  for (int i = 0; i < 4; ++i) ra[i] = *(const u32x4*)(Ap + (size_t)(32 * i) * lda);
#pragma unroll
  for (int i = 0; i < 4; ++i) rb[i] = *(const u32x4*)(Bp + (size_t)(32 * i) * ldb);
  const char* a_base = As + (wm * 64 + r32) * 144 + hi * 16;
  const char* b_base = Bs + (wn * 64 + r32) * 144 + hi * 16;
  for (int kt = 0; kt < nk; ++kt) {
    __syncthreads();
#pragma unroll
    for (int i = 0; i < 4; ++i) *(u32x4*)(As + (srow + 32 * i) * 144 + skc * 16) = ra[i];
#pragma unroll
    for (int i = 0; i < 4; ++i) *(u32x4*)(Bs + (srow + 32 * i) * 144 + skc * 16) = rb[i];
    if (NORM) {
#pragma unroll
      for (int i = 0; i < 4; ++i)
#pragma unroll
        for (int j = 0; j < 4; ++j) ssq[i] = fdot2bf(ra[i][j], ssq[i]);
    }
    __syncthreads();
    if (kt + 1 < nk) {
      const int ko = (kt + 1) * 64;
#pragma unroll
      for (int i = 0; i < 4; ++i) ra[i] = *(const u32x4*)(Ap + (size_t)(32 * i) * lda + ko);
#pragma unroll
      for (int i = 0; i < 4; ++i) rb[i] = *(const u32x4*)(Bp + (size_t)(32 * i) * ldb + ko);
    }
#pragma unroll
    for (int ks = 0; ks < 4; ++ks) {
      bf16x8 af[2], bfr[2];
#pragma unroll
      for (int mi = 0; mi < 2; ++mi) af[mi] = *(const bf16x8*)(a_base + mi * 4608 + ks * 32);
#pragma unroll
      for (int nj = 0; nj < 2; ++nj) bfr[nj] = *(const bf16x8*)(b_base + nj * 4608 + ks * 32);
#pragma unroll
      for (int mi = 0; mi < 2; ++mi)
#pragma unroll
        for (int nj = 0; nj < 2; ++nj) acc[mi][nj] = MFMA32(af[mi], bfr[nj], acc[mi][nj]);
    }
  }
  if (NORM) {
    const float invK = 1.f / (float)K;
#pragma unroll
    for (int i = 0; i < 4; ++i) {
      float v = ssq[i];
      v += __shfl_xor(v, 1); v += __shfl_xor(v, 2); v += __shfl_xor(v, 4);
      if (skc == 0) rstd_s[srow + 32 * i] = rsqrtf(v * invK + 1e-6f);
    }
    __syncthreads();
  }
  epi(acc, m0, wm * 64, n0 + wn * 64, lane, rstd_s);
}

struct EpiG1 {
  bf16_t *cqkv, *KA, *qB, *qC; const float *cos32, *sin32, *cos16, *sin16; float qs;
  DI void operator()(f32x16 (&acc)[2][2], int m0, int lr0, int col0, int lane, const float* rstd_s) const {
    const int c = lane & 31, h = lane >> 5, cb = col0 >> 6;
    if (cb >= 37) return;
#pragma unroll
    for (int mi = 0; mi < 2; ++mi)
#pragma unroll
      for (int i = 0; i < 16; ++i) {
        const int lr = lr0 + mi * 32 + crow(i, h), tok = m0 + lr, b = tok >> 13, s = tok & 8191;
        const float rs = rstd_s[lr];
        float v0 = acc[mi][0][i] * rs, v1 = acc[mi][1][i] * rs;
        if (cb < 6) {
          bf16_t* d = cqkv + (size_t)tok * 384 + cb * 64 + c; d[0] = f2bf(v0); d[32] = f2bf(v1);
        } else if (cb == 6) {
          if (c < 16) {
            const float cs = cos16[s * 16 + c], sn = sin16[s * 16 + c];
            const bf16_t o1 = f2bf(v0 * cs - v1 * sn), o2 = f2bf(v0 * sn + v1 * cs);
#pragma unroll
            for (int hd = 0; hd < 6; ++hd) { bf16_t* d = KA + ((size_t)(b * 6 + hd) * SEQ + s) * 96 + 64 + c; d[0] = o1; d[16] = o2; }
          }
        } else if (cb < 25) {
          const int idx = cb - 7, which = idx / 6, hd = idx - which * 6;
          if (which < 2) {
            const float cs = cos32[s * 32 + c], sn = sin32[s * 32 + c];
            const float o1 = v0 * cs - v1 * sn, o2 = v0 * sn + v1 * cs; v0 = o1; v1 = o2;
            if (which == 0) { v0 *= qs; v1 *= qs; }
          }
          bf16_t* d = qB + (size_t)which * (SZ_H6 / 2) + ((size_t)(b * 6 + hd) * SEQ + s) * 64 + c;
          d[0] = f2bf(v0); d[32] = f2bf(v1);
        } else {
          const int idx = cb - 25, which = idx >> 2, hd = idx & 3;
          if (which == 0) { v0 *= qs; v1 *= qs; }
          bf16_t* d = qC + (size_t)which * (SZ_H4 / 2) + ((size_t)(b * 4 + hd) * SEQ + s) * 64 + c;
          d[0] = f2bf(v0); d[32] = f2bf(v1);
        }
      }
  }
};
struct EpiUQ {
  bf16_t* QA; const float *cos16, *sin16; float qs;
  DI void operator()(f32x16 (&acc)[2][2], int m0, int lr0, int col0, int lane, const float* rstd_s) const {
    const int c = lane & 31, h = lane >> 5, cb = col0 >> 6;
    if (cb >= 9) return;
#pragma unroll
    for (int mi = 0; mi < 2; ++mi)
#pragma unroll
      for (int i = 0; i < 16; ++i) {
        const int lr = lr0 + mi * 32 + crow(i, h), tok = m0 + lr, b = tok >> 13, s = tok & 8191;
        const float rs = rstd_s[lr] * qs;
        const float v0 = acc[mi][0][i] * rs, v1 = acc[mi][1][i] * rs;
        if (cb < 6) {
          bf16_t* d = QA + ((size_t)(b * 6 + cb) * SEQ + s) * 96 + c; d[0] = f2bf(v0); d[32] = f2bf(v1);
        } else {
          const int hd = 2 * (cb - 6) + (c >> 4), fi = c & 15;
          const float cs = cos16[s * 16 + fi], sn = sin16[s * 16 + fi];
          bf16_t* d = QA + ((size_t)(b * 6 + hd) * SEQ + s) * 96 + 64 + fi;
          d[0] = f2bf(v0 * cs - v1 * sn); d[16] = f2bf(v0 * sn + v1 * cs);
        }
      }
  }
};
struct EpiUKV {
  bf16_t *KA, *VA;
  DI void operator()(f32x16 (&acc)[2][2], int m0, int lr0, int col0, int lane, const float* rstd_s) const {
    const int c = lane & 31, h = lane >> 5, cb = col0 >> 6, hd = cb >> 1, isv = cb & 1;
#pragma unroll
    for (int mi = 0; mi < 2; ++mi)
#pragma unroll
      for (int i = 0; i < 16; ++i) {
        const int lr = lr0 + mi * 32 + crow(i, h), tok = m0 + lr, b = tok >> 13, s = tok & 8191;
        const float rs = rstd_s[lr];
        const float v0 = acc[mi][0][i] * rs, v1 = acc[mi][1][i] * rs;
        bf16_t* d = isv ? VA + ((size_t)(b * 6 + hd) * SEQ + s) * 64 + c : KA + ((size_t)(b * 6 + hd) * SEQ + s) * 96 + c;
        d[0] = f2bf(v0); d[32] = f2bf(v1);
      }
  }
};
struct EpiRes {
  const float* xold; float* xf; bf16_t* xb;
  DI void operator()(f32x16 (&acc)[2][2], int m0, int lr0, int col0, int lane, const float*) const {
    const int c = lane & 31, h = lane >> 5;
#pragma unroll
    for (int mi = 0; mi < 2; ++mi)
#pragma unroll
      for (int i = 0; i < 16; ++i) {
        const size_t o = (size_t)(m0 + lr0 + mi * 32 + crow(i, h)) * DM + col0 + c;
        const float v0 = xold[o] + acc[mi][0][i], v1 = xold[o + 32] + acc[mi][1][i];
        xf[o] = v0; xf[o + 32] = v1; xb[o] = f2bf(v0); xb[o + 32] = f2bf(v1);
      }
  }
};
struct EpiMlp1 {
  bf16_t* hid;
  DI void operator()(f32x16 (&acc)[2][2], int m0, int lr0, int col0, int lane, const float* rstd_s) const {
    const int c = lane & 31, h = lane >> 5;
#pragma unroll
    for (int mi = 0; mi < 2; ++mi)
#pragma unroll
      for (int i = 0; i < 16; ++i) {
        const int lr = lr0 + mi * 32 + crow(i, h);
        const float rs = rstd_s[lr];
        const float v0 = fmaxf(acc[mi][0][i] * rs, 0.f), v1 = fmaxf(acc[mi][1][i] * rs, 0.f);
        bf16_t* d = hid + (size_t)(m0 + lr) * DFF + col0 + c; d[0] = f2bf(v0 * v0); d[32] = f2bf(v1 * v1);
      }
  }
};

struct AttnItem {
  const bf16_t *Q, *K, *V;
  int q0;
  int n0, dil, res, N;
  int nrb, ncb, kr0, kc0;
  bf16_t* out; int ldo;
  float* lse;
  const float* rpb;
};

template <int DQ, int MODE>
DI void attn_block(const AttnItem& it, char* smem, const int tid) {
  constexpr int CPR = DQ / 8, KST = DQ * 2 + 16, KCH = (64 * CPR) / 256, NT = MODE == 0 ? SEQ / 64 : MODE == 1 ? 4 : 8;
  const int lane = tid & 63, w = tid >> 6, r32 = lane & 31, hi = lane >> 5;
  char* Ks = smem; char* Vs = smem + 64 * KST; float* bias_s = (float*)(smem + 64 * KST + 8192);
  const int qi = w * 32 + r32;
  int qpos;
  if (MODE == 0) qpos = it.q0 + qi;
  else if (MODE == 1) qpos = (it.n0 + qi) * it.dil + it.res;
  else qpos = (8 * it.nrb + (qi >> 4)) * 64 + 16 * it.ncb + (qi & 15);
  __syncthreads();
  if (MODE == 2) { for (int i = tid; i < 465; i += 256) bias_s[i] = it.rpb[i] * 1.4426950408889634f; }
  bf16x8 qr[DQ / 16];
#pragma unroll
  for (int d0 = 0; d0 < DQ / 16; ++d0) qr[d0] = *(const bf16x8*)(it.Q + (size_t)qpos * DQ + d0 * 16 + hi * 8);
  f32x16 o[2];
#pragma unroll
  for (int i = 0; i < 16; ++i) { o[0][i] = 0.f; o[1][i] = 0.f; }
  float m_run = -1e30f, l_run = 0.f;
  u32x4 rk[KCH], rv[2];
  auto kpos = [&](int t, int row) -> int {
    if (MODE == 0) return t * 64 + row;
    if (MODE == 1) { int n = it.n0 - 64 + 64 * t + row; n = n < 0 ? 0 : (n > it.N - 1 ? it.N - 1 : n); return n * it.dil + it.res; }
    return (it.kr0 + 2 * t + (row >> 5)) * 64 + it.kc0 + (row & 31);
  };
  auto load = [&](int t) {
#pragma unroll
    for (int i = 0; i < KCH; ++i) { const int c = tid + 256 * i, row = c / CPR, kc = c - row * CPR; rk[i] = *(const u32x4*)(it.K + (size_t)kpos(t, row) * DQ + kc * 8); }
#pragma unroll
    for (int i = 0; i < 2; ++i) { const int c = tid + 256 * i, row = c >> 3, kc = c & 7; rv[i] = *(const u32x4*)(it.V + (size_t)kpos(t, row) * 64 + kc * 8); }
  };
  const int vrd = ((lane >> 5) * 4 + ((lane & 15) >> 2)) * 64 + ((lane >> 4) & 1) * 32 + (lane & 3) * 8;
  load(0);
  for (int t = 0; t < NT; ++t) {
    __syncthreads();
#pragma unroll
    for (int i = 0; i < KCH; ++i) { const int c = tid + 256 * i, row = c / CPR, kc = c - row * CPR; *(u32x4*)(Ks + row * KST + kc * 16) = rk[i]; }
#pragma unroll
    for (int i = 0; i < 2; ++i) { const int c = tid + 256 * i, row = c >> 3, kc = c & 7; *(u32x4*)(Vs + (kc >> 2) * 4096 + row * 64 + (kc & 3) * 16) = rv[i]; }
    __syncthreads();
    if (t + 1 < NT) load(t + 1);
    bool skip = false;
    if (MODE == 1) skip = (w < 2) ? (t == 3) : (t == 0);
    if (MODE == 2) {
      const int rq_lo = 8 * it.nrb + 2 * w, rq_hi = rq_lo + 1;
      const int rs_lo = min(max(rq_lo - 4, 0), 120), rs_hi = min(max(rq_hi - 4, 0), 120) + 7;
      const int kr = it.kr0 + 2 * t;
      skip = (kr + 1 < rs_lo) || (kr > rs_hi);
    }
    if (skip) continue;
    f32x16 p0, p1;
#pragma unroll
    for (int i = 0; i < 16; ++i) { p0[i] = 0.f; p1[i] = 0.f; }
#pragma unroll
    for (int d0 = 0; d0 < DQ / 16; ++d0) {
      const bf16x8 k0 = *(const bf16x8*)(Ks + r32 * KST + d0 * 32 + hi * 16);
      const bf16x8 k1 = *(const bf16x8*)(Ks + (32 + r32) * KST + d0 * 32 + hi * 16);
      p0 = MFMA32(k0, qr[d0], p0); p1 = MFMA32(k1, qr[d0], p1);
    }
    if (MODE == 1) {
      const int nq = it.n0 + qi, kb = it.n0 - 64 + 64 * t;
#pragma unroll
      for (int i = 0; i < 16; ++i) {
        const int nk = kb + crow(i, hi), nk2 = nk + 32;
        const int d1 = nq - nk, d2 = nq - nk2;
        const bool ok1 = (d1 <= 64) && (d1 >= -64) && (nk >= 0) && (nk < it.N);
        const bool ok2 = (d2 <= 64) && (d2 >= -64) && (nk2 >= 0) && (nk2 < it.N);
        p0[i] = ok1 ? p0[i] : -INFINITY; p1[i] = ok2 ? p1[i] : -INFINITY;
      }
    }
    if (MODE == 2) {
      const int rq = 8 * it.nrb + (qi >> 4), cq = 16 * it.ncb + (qi & 15);
      const int rs_ = min(max(rq - 4, 0), 120), cs_ = min(max(cq - 8, 0), 48);
      const int kr = it.kr0 + 2 * t;
      const bool okr0 = (kr >= rs_) && (kr < rs_ + 8), okr1 = (kr + 1 >= rs_) && (kr + 1 < rs_ + 8);
      const int bi0 = (kr - rq + 7) * 31 - cq + 15;
#pragma unroll
      for (int i = 0; i < 16; ++i) {
        const int kc = it.kc0 + crow(i, hi);
        const bool okc = (kc >= cs_) && (kc < cs_ + 16);
        const bool ok0 = okc && okr0, ok1 = okc && okr1;
        const float b0 = bias_s[ok0 ? bi0 + kc : 0], b1 = bias_s[ok1 ? bi0 + 31 + kc : 0];
        p0[i] = ok0 ? p0[i] + b0 : -INFINITY; p1[i] = ok1 ? p1[i] + b1 : -INFINITY;
      }
    }
    float pmax = p0[0];
#pragma unroll
    for (int i = 1; i < 16; ++i) pmax = fmaxf(pmax, p0[i]);
#pragma unroll
    for (int i = 0; i < 16; ++i) pmax = fmaxf(pmax, p1[i]);
    pmax = swap_max(pmax);
    const float mn = fmaxf(m_run, pmax);
    const float alpha = __builtin_amdgcn_exp2f(m_run - mn);
    m_run = mn;
    float ps = 0.f;
#pragma unroll
    for (int i = 0; i < 16; ++i) { p0[i] = __builtin_amdgcn_exp2f(p0[i] - mn); ps += p0[i]; }
#pragma unroll
    for (int i = 0; i < 16; ++i) { p1[i] = __builtin_amdgcn_exp2f(p1[i] - mn); ps += p1[i]; }
    ps = swap_sum(ps);
    l_run = l_run * alpha + ps;
#pragma unroll
    for (int i = 0; i < 16; ++i) { o[0][i] *= alpha; o[1][i] *= alpha; }
    bf16x8 pb[4];
#pragma unroll
    for (int s = 0; s < 2; ++s) {
      u32x4 a = {cvtpk(p0[8 * s], p0[8 * s + 1]), cvtpk(p0[8 * s + 2], p0[8 * s + 3]), cvtpk(p0[8 * s + 4], p0[8 * s + 5]), cvtpk(p0[8 * s + 6], p0[8 * s + 7])};
      u32x4 b = {cvtpk(p1[8 * s], p1[8 * s + 1]), cvtpk(p1[8 * s + 2], p1[8 * s + 3]), cvtpk(p1[8 * s + 4], p1[8 * s + 5]), cvtpk(p1[8 * s + 6], p1[8 * s + 7])};
      pb[s] = __builtin_bit_cast(bf16x8, a); pb[2 + s] = __builtin_bit_cast(bf16x8, b);
    }
#pragma unroll
    for (int db = 0; db < 2; ++db)
#pragma unroll
      for (int s = 0; s < 4; ++s) {
        const s16x4 lo = __builtin_amdgcn_ds_read_tr16_b64_v4i16((lds_s16x4*)(Vs + db * 4096 + (16 * s) * 64 + vrd));
        const s16x4 hh = __builtin_amdgcn_ds_read_tr16_b64_v4i16((lds_s16x4*)(Vs + db * 4096 + (16 * s + 8) * 64 + vrd));
        const bf16x8 a = {lo[0], lo[1], lo[2], lo[3], hh[0], hh[1], hh[2], hh[3]};
        o[db] = MFMA32(a, pb[s], o[db]);
      }
  }
  const float inv = 1.f / l_run;
  const int bq = qpos;
  bf16_t* orow = it.out + (size_t)bq * it.ldo;
#pragma unroll
  for (int db = 0; db < 2; ++db)
#pragma unroll
    for (int g = 0; g < 4; ++g) {
      u32x2 v = {cvtpk(o[db][4 * g] * inv, o[db][4 * g + 1] * inv), cvtpk(o[db][4 * g + 2] * inv, o[db][4 * g + 3] * inv)};
      *(u32x2*)(orow + db * 32 + 8 * g + 4 * hi) = v;
    }
  if (MODE == 1) { if (hi == 0) it.lse[(size_t)bq * 6] = m_run + __builtin_amdgcn_logf(l_run); }
}

DI float gain_of(const Params& p, int kind, int l, int k) {
  switch (kind) {
    case 0: return p.g_mix[l * 1024 + k];
    case 1: return p.q_norm[l * 256 + k];
    case 2: return p.kv_norm[l * 128 + k];
    case 3: return k < 384 ? p.on_a[l * 384 + k] : (k < 768 ? p.on_b[l * 384 + k - 384] : p.on_c[l * 256 + k - 768]);
    case 4: return p.g_mlp[l * 1024 + k];
    default: return 1.f;
  }
}
DI int map_col(int kind, int n) {
  if (kind == 0) {
    if (n < 384) return n;
    if (n < 448) { const int wv = n - 384, c = wv & 31, sub = wv >> 5; return c < 16 ? 384 + sub * 16 + c : -1; }
    if (n < 1600) return 416 + (n - 448);
    if (n < 2368) return 1568 + (n - 1600);
    return -1;
  }
  if (kind == 1) {
    if (n < 384) return (n >> 6) * 96 + (n & 63);
    if (n < 576) { const int wv = n - 384, g = wv >> 6, wi = wv & 63, sub = wi >> 5, c = wi & 31, hd = 2 * g + (c >> 4), fi = c & 15; return hd * 96 + 64 + sub * 16 + fi; }
    return -1;
  }
  return n;
}
DI void wtile(const Params& p, const float* src, int Nsrc, bf16_t* dst, int K, int kt, int nt, int kind, int l, char* smem, const int tid) {
  float* tile = (float*)smem;
  const int lane = tid & 63, wv = tid >> 6;
  __syncthreads();
  const int n = nt * 64 + lane, sc = map_col(kind, n);
#pragma unroll 4
  for (int r = 0; r < 16; ++r) {
    const int kl = r * 4 + wv, k = kt * 64 + kl;
    float v = 0.f;
    if (sc >= 0) v = src[(size_t)k * Nsrc + sc] * gain_of(p, kind, l, k);
    tile[kl * 65 + lane] = v;
  }
  __syncthreads();
#pragma unroll 4
  for (int r = 0; r < 16; ++r) {
    const int nl = r * 4 + wv;
    dst[(size_t)(nt * 64 + nl) * K + kt * 64 + lane] = f2bf(tile[lane * 65 + nl]);
  }
}

NI void phase_prep() {
  const Params& p = kparams(); char* smem = g_smem; const int tid = otid(), bid = obid();
  char* ws = p.ws;
  constexpr int T_WIN = (N_IN_PAD / 64) * 16, T_WUQ = (N_UQ_PAD / 64) * 4, T_WUKV = (N_UKV / 64) * 2, T_WOUT = 16 * 16, T_W1 = 64 * 16, T_W2 = 16 * 64;
  constexpr int T_L = T_WIN + T_WUQ + T_WUKV + T_WOUT + T_W1 + T_W2;
  for (int j = bid; j < NLAYER * T_L; j += gridDim.x) {
    const int l = j / T_L; int r = j - l * T_L;
    char* lw = ws + OFF_W + (size_t)l * LW_SIZE;
    if (r < T_WIN) { wtile(p, p.w_in + (size_t)l * 1024 * 2336, 2336, (bf16_t*)(lw + LW_WIN), 1024, r & 15, r >> 4, 0, l, smem, tid); continue; }
    r -= T_WIN;
    if (r < T_WUQ) { wtile(p, p.w_uq + (size_t)l * 256 * 576, 576, (bf16_t*)(lw + LW_WUQ), 256, r & 3, r >> 2, 1, l, smem, tid); continue; }
    r -= T_WUQ;
    if (r < T_WUKV) { wtile(p, p.w_ukv + (size_t)l * 128 * 768, 768, (bf16_t*)(lw + LW_WUKV), 128, r & 1, r >> 1, 2, l, smem, tid); continue; }
    r -= T_WUKV;
    if (r < T_WOUT) { wtile(p, p.w_out + (size_t)l * 1024 * 1024, 1024, (bf16_t*)(lw + LW_WOUT), 1024, r & 15, r >> 4, 3, l, smem, tid); continue; }
    r -= T_WOUT;
    if (r < T_W1) { wtile(p, p.w_mlp_in + (size_t)l * 1024 * 4096, 4096, (bf16_t*)(lw + LW_W1), 1024, r & 15, r >> 4, 4, l, smem, tid); continue; }
    r -= T_W1;
    wtile(p, p.w_mlp_out + (size_t)l * 4096 * 1024, 1024, (bf16_t*)(lw + LW_W2), 4096, r & 63, r >> 6, 5, l, smem, tid);
  }
  const size_t gtid = (size_t)bid * 256 + tid, gsz = (size_t)gridDim.x * 256;
  bf16_t* xb = (bf16_t*)(ws + OFF_XB);
  for (size_t i = gtid; i < (size_t)NTOK * DM / 8; i += gsz) {
    const f32x4 a = *(const f32x4*)(p.x + i * 8), b = *(const f32x4*)(p.x + i * 8 + 4);
    u32x4 o = {cvtpk(a[0], a[1]), cvtpk(a[2], a[3]), cvtpk(b[0], b[1]), cvtpk(b[2], b[3])};
    *(u32x4*)(xb + i * 8) = o;
  }
  float* c32 = (float*)(ws + OFF_COS32); float* s32 = (float*)(ws + OFF_SIN32); float* c16 = (float*)(ws + OFF_COS16); float* s16 = (float*)(ws + OFF_SIN16);
  for (size_t i = gtid; i < (size_t)SEQ * 48; i += gsz) {
    int pos, fi; float invf; float *cd, *sd;
    if (i < (size_t)SEQ * 32) { pos = (int)(i >> 5); fi = (int)(i & 31); invf = __builtin_amdgcn_exp2f(-(float)fi * (13.287712379549449f / 32.f)); cd = c32 + i; sd = s32 + i; }
    else { const size_t j = i - (size_t)SEQ * 32; pos = (int)(j >> 4); fi = (int)(j & 15); invf = __builtin_amdgcn_exp2f(-(float)fi * (13.287712379549449f / 16.f)); cd = c16 + j; sd = s16 + j; }
    const float ang = (float)pos * invf;
    const double rev = (double)ang * 0.15915494309189535;
    const float fr = (float)(rev - rint(rev));
    *cd = __builtin_amdgcn_cosf(fr); *sd = __builtin_amdgcn_sinf(fr);
  }
}

NI void phase_g1(int l_) {
  const Params& p = kparams(); char* smem = g_smem; const int l = __builtin_amdgcn_readfirstlane(l_); const int tid = otid(), bid = obid(); (void)tid; (void)bid;
  char* ws = p.ws;
  EpiG1 e;
  e.cqkv = (bf16_t*)(ws + OFF_CQKV); e.KA = (bf16_t*)(ws + OFF_KA); e.qB = (bf16_t*)(ws + OFF_QB); e.qC = (bf16_t*)(ws + OFF_QC);
  e.cos32 = (const float*)(ws + OFF_COS32); e.sin32 = (const float*)(ws + OFF_SIN32); e.cos16 = (const float*)(ws + OFF_COS16); e.sin16 = (const float*)(ws + OFF_SIN16);
  e.qs = p.qscaleB;
  const bf16_t* A = (const bf16_t*)(ws + OFF_XB);
  const bf16_t* Bt = (const bf16_t*)(ws + OFF_W + (size_t)l * LW_SIZE + LW_WIN);
  constexpr int NNT = N_IN_PAD / 128;
  for (int t = bid; t < (NTOK / 128) * NNT; t += gridDim.x) {
    const int mt = t / NNT, nt = t - mt * NNT;
    gemm_tile<true>(A, 1024, Bt, 1024, 1024, mt * 128, nt * 128, smem, e, tid);
  }
}
NI void phase_g2(int l_) {
  const Params& p = kparams(); char* smem = g_smem; const int l = __builtin_amdgcn_readfirstlane(l_); const int tid = otid(), bid = obid(); (void)tid; (void)bid;
  char* ws = p.ws;
  const bf16_t* A = (const bf16_t*)(ws + OFF_CQKV);
  EpiUQ eq; eq.QA = (bf16_t*)(ws + OFF_QA); eq.cos16 = (const float*)(ws + OFF_COS16); eq.sin16 = (const float*)(ws + OFF_SIN16); eq.qs = p.qscaleA;
  EpiUKV ek; ek.KA = (bf16_t*)(ws + OFF_KA); ek.VA = (bf16_t*)(ws + OFF_VA);
  const bf16_t* Wq = (const bf16_t*)(ws + OFF_W + (size_t)l * LW_SIZE + LW_WUQ);
  const bf16_t* Wkv = (const bf16_t*)(ws + OFF_W + (size_t)l * LW_SIZE + LW_WUKV);
  constexpr int TQ = (NTOK / 128) * 5, TKV = (NTOK / 128) * 6;
  for (int t = bid; t < TQ; t += gridDim.x) { const int mt = t / 5, nt = t - mt * 5; gemm_tile<true>(A, 384, Wq, 256, 256, mt * 128, nt * 128, smem, eq, tid); }
  for (int u = bid; u < TKV; u += gridDim.x) { const int mt = u / 6, nt = u - mt * 6; gemm_tile<true>(A + 256, 384, Wkv, 128, 128, mt * 128, nt * 128, smem, ek, tid); }
}
NI void phase_attn(int l_) {
  const Params& p = kparams(); char* smem = g_smem; const int l = __builtin_amdgcn_readfirstlane(l_); const int tid = otid(), bid = obid(); (void)tid; (void)bid;
  char* ws = p.ws;
  constexpr int NA = 1536, NBI = 4608, NC = 1024;
  for (int i = bid; i < NA; i += gridDim.x) {
    AttnItem it{};
    const int bh = ((i >> 3) >> 6) * 8 + (i & 7), qb = (i >> 3) & 63, b = bh / 6, h = bh - b * 6;
    it.Q = (const bf16_t*)(ws + OFF_QA) + (size_t)bh * SEQ * 96; it.K = (const bf16_t*)(ws + OFF_KA) + (size_t)bh * SEQ * 96; it.V = (const bf16_t*)(ws + OFF_VA) + (size_t)bh * SEQ * 64;
    it.q0 = qb * 128; it.out = (bf16_t*)(ws + OFF_OA) + (size_t)b * SEQ * 384 + h * 64; it.ldo = 384;
    attn_block<96, 0>(it, smem, tid);
  }
  for (int i = bid; i < NBI; i += gridDim.x) {
    AttnItem it{};
    const int g = ((i >> 3) >> 6) * 8 + (i & 7), c = (i >> 3) & 63, br = g / 24, bh = g - br * 24, b = bh / 6, h = bh - b * 6;
    const int dil = br == 0 ? 1 : (br == 1 ? 4 : 16), cpr = 64 / dil;
    it.Q = (const bf16_t*)(ws + OFF_QB) + (size_t)bh * SEQ * 64; it.K = (const bf16_t*)(ws + OFF_KB) + (size_t)bh * SEQ * 64; it.V = (const bf16_t*)(ws + OFF_VB) + (size_t)bh * SEQ * 64;
    it.dil = dil; it.res = c / cpr; it.n0 = (c - it.res * cpr) * 128; it.N = SEQ / dil;
    it.out = (bf16_t*)(ws + OFF_OB) + (size_t)br * NTOK * 384 + (size_t)b * SEQ * 384 + h * 64; it.ldo = 384;
    it.lse = (float*)(ws + OFF_LSEB) + (size_t)br * NTOK * 6 + (size_t)b * SEQ * 6 + h;
    attn_block<64, 1>(it, smem, tid);
  }
  for (int i = bid; i < NC; i += gridDim.x) {
    AttnItem it{};
    const int bh = ((i >> 3) >> 6) * 8 + (i & 7), blk = (i >> 3) & 63, b = bh >> 2, h = bh & 3;
    it.Q = (const bf16_t*)(ws + OFF_QC) + (size_t)bh * SEQ * 64; it.K = (const bf16_t*)(ws + OFF_KC) + (size_t)bh * SEQ * 64; it.V = (const bf16_t*)(ws + OFF_VC) + (size_t)bh * SEQ * 64;
    it.nrb = blk >> 2; it.ncb = blk & 3;
    it.kr0 = min(max(8 * it.nrb - 4, 0), 112); it.kc0 = min(max(16 * it.ncb - 8, 0), 32);
    it.out = (bf16_t*)(ws + OFF_OC) + (size_t)b * SEQ * 256 + h * 64; it.ldo = 256;
    it.rpb = p.rpb + ((size_t)l * 4 + h) * 465;
    attn_block<64, 2>(it, smem, tid);
  }
}
DI float wave_sum(float v) {
  v += __shfl_xor(v, 32); v += __shfl_xor(v, 16); v += __shfl_xor(v, 8); v += __shfl_xor(v, 4); v += __shfl_xor(v, 2); v += __shfl_xor(v, 1); return v;
}
NI void phase_mix() {
  const Params& p = kparams(); const int tid = otid(), bid = obid();
  char* ws = p.ws;
  const int lane = tid & 63, gw = bid * 4 + (tid >> 6), nw = gridDim.x * 4;
  const bf16_t* oA = (const bf16_t*)(ws + OFF_OA); const bf16_t* oB = (const bf16_t*)(ws + OFF_OB); const bf16_t* oC = (const bf16_t*)(ws + OFF_OC);
  const float* lse = (const float*)(ws + OFF_LSEB);
  bf16_t* mixed = (bf16_t*)(ws + OFF_MIXED);
  for (int tok = gw; tok < NTOK; tok += nw) {
    float v[16];
    if (lane < 24 || lane >= 48) {
      const bf16_t* src = lane < 24 ? oA + (size_t)tok * 384 + lane * 16 : oC + (size_t)tok * 256 + (lane - 48) * 16;
      const u32x4 a = *(const u32x4*)src, b = *(const u32x4*)(src + 8);
#pragma unroll
      for (int j = 0; j < 4; ++j) { v[2 * j] = bf2f(a[j] & 0xffffu); v[2 * j + 1] = bf2f(a[j] >> 16); v[8 + 2 * j] = bf2f(b[j] & 0xffffu); v[8 + 2 * j + 1] = bf2f(b[j] >> 16); }
    } else {
      const int col = (lane - 24) * 16, hd = col >> 6;
      const float l0 = lse[(size_t)tok * 6 + hd], l1 = lse[(size_t)NTOK * 6 + (size_t)tok * 6 + hd], l2 = lse[(size_t)2 * NTOK * 6 + (size_t)tok * 6 + hd];
      const float mx = fmaxf(l0, fmaxf(l1, l2));
      float w0 = __builtin_amdgcn_exp2f(l0 - mx), w1 = __builtin_amdgcn_exp2f(l1 - mx), w2 = __builtin_amdgcn_exp2f(l2 - mx);
      const float wi = 1.f / (w0 + w1 + w2); w0 *= wi; w1 *= wi; w2 *= wi;
#pragma unroll
      for (int j = 0; j < 16; ++j) v[j] = 0.f;
#pragma unroll
      for (int br = 0; br < 3; ++br) {
        const float wb = br == 0 ? w0 : (br == 1 ? w1 : w2);
        const bf16_t* src = oB + (size_t)br * NTOK * 384 + (size_t)tok * 384 + col;
        const u32x4 a = *(const u32x4*)src, b = *(const u32x4*)(src + 8);
#pragma unroll
        for (int j = 0; j < 4; ++j) { v[2 * j] += wb * bf2f(a[j] & 0xffffu); v[2 * j + 1] += wb * bf2f(a[j] >> 16); v[8 + 2 * j] += wb * bf2f(b[j] & 0xffffu); v[8 + 2 * j + 1] += wb * bf2f(b[j] >> 16); }
      }
    }
    float ss = 0.f;
#pragma unroll
    for (int j = 0; j < 16; ++j) ss += v[j] * v[j];
    const float sa = wave_sum(lane < 24 ? ss : 0.f), sb = wave_sum((lane >= 24 && lane < 48) ? ss : 0.f), sc = wave_sum(lane >= 48 ? ss : 0.f);
    const float rs = lane < 24 ? rsqrtf(sa * (1.f / 384.f) + 1e-6f) : (lane < 48 ? rsqrtf(sb * (1.f / 384.f) + 1e-6f) : rsqrtf(sc * (1.f / 256.f) + 1e-6f));
    u32x4 oa, ob;
#pragma unroll
    for (int j = 0; j < 4; ++j) { oa[j] = cvtpk(v[2 * j] * rs, v[2 * j + 1] * rs); ob[j] = cvtpk(v[8 + 2 * j] * rs, v[8 + 2 * j + 1] * rs); }
    bf16_t* dst = mixed + (size_t)tok * 1024 + lane * 16;
    *(u32x4*)dst = oa; *(u32x4*)(dst + 8) = ob;
  }
}
NI void phase_wout(int l_) {
  const Params& p = kparams(); char* smem = g_smem; const int l = __builtin_amdgcn_readfirstlane(l_); const int tid = otid(), bid = obid(); (void)tid; (void)bid;
  char* ws = p.ws;
  EpiRes e; e.xold = (l == 0) ? p.x : p.out; e.xf = p.out; e.xb = (bf16_t*)(ws + OFF_XB);
  const bf16_t* A = (const bf16_t*)(ws + OFF_MIXED);
  const bf16_t* Bt = (const bf16_t*)(ws + OFF_W + (size_t)l * LW_SIZE + LW_WOUT);
  for (int t = bid; t < (NTOK / 128) * 8; t += gridDim.x) { const int mt = t >> 3, nt = t & 7; gemm_tile<false>(A, 1024, Bt, 1024, 1024, mt * 128, nt * 128, smem, e, tid); }
}
NI void phase_mlp1(int l_) {
  const Params& p = kparams(); char* smem = g_smem; const int l = __builtin_amdgcn_readfirstlane(l_); const int tid = otid(), bid = obid(); (void)tid; (void)bid;
  char* ws = p.ws;
  EpiMlp1 e; e.hid = (bf16_t*)(ws + OFF_HID);
  const bf16_t* A = (const bf16_t*)(ws + OFF_XB);
  const bf16_t* Bt = (const bf16_t*)(ws + OFF_W + (size_t)l * LW_SIZE + LW_W1);
  for (int t = bid; t < (NTOK / 128) * 32; t += gridDim.x) { const int mt = t >> 5, nt = t & 31; gemm_tile<true>(A, 1024, Bt, 1024, 1024, mt * 128, nt * 128, smem, e, tid); }
}
NI void phase_mlp2(int l_) {
  const Params& p = kparams(); char* smem = g_smem; const int l = __builtin_amdgcn_readfirstlane(l_); const int tid = otid(), bid = obid(); (void)tid; (void)bid;
  char* ws = p.ws;
  EpiRes e; e.xold = p.out; e.xf = p.out; e.xb = (bf16_t*)(ws + OFF_XB);
  const bf16_t* A = (const bf16_t*)(ws + OFF_HID);
  const bf16_t* Bt = (const bf16_t*)(ws + OFF_W + (size_t)l * LW_SIZE + LW_W2);
  for (int t = bid; t < (NTOK / 128) * 8; t += gridDim.x) { const int mt = t >> 3, nt = t & 7; gemm_tile<false>(A, DFF, Bt, DFF, DFF, mt * 128, nt * 128, smem, e, tid); }
}
NI void phase_final() {
  const Params& p = kparams(); const int tid = otid(), bid = obid();
  const int lane = tid & 63, gw = bid * 4 + (tid >> 6), nw = gridDim.x * 4;
  for (int tok = gw; tok < NTOK; tok += nw) {
    float* row = p.out + (size_t)tok * DM;
    f32x4 v[4]; float ss = 0.f;
#pragma unroll
    for (int j = 0; j < 4; ++j) { v[j] = *(const f32x4*)(row + j * 256 + lane * 4); ss += v[j][0] * v[j][0] + v[j][1] * v[j][1] + v[j][2] * v[j][2] + v[j][3] * v[j][3]; }
    ss = wave_sum(ss);
    const float rs = rsqrtf(ss * (1.f / 1024.f) + 1e-6f);
#pragma unroll
    for (int j = 0; j < 4; ++j) { const f32x4 g = *(const f32x4*)(p.g_final + j * 256 + lane * 4); f32x4 o = {v[j][0] * rs * g[0], v[j][1] * rs * g[1], v[j][2] * rs * g[2], v[j][3] * rs * g[3]}; *(f32x4*)(row + j * 256 + lane * 4) = o; }
  }
}

constexpr int NPHASE = 2 + 7 * NLAYER;
DI void run_phase(int ph) {
  if (ph == 0) { phase_prep(); return; }
  if (ph == NPHASE - 1) { phase_final(); return; }
  const int l = (ph - 1) / 7, st = (ph - 1) - l * 7;
  switch (st) {
    case 0: phase_g1(l); break;
    case 1: phase_g2(l); break;
    case 2: phase_attn(l); break;
    case 3: phase_mix(); break;
    case 4: phase_wout(l); break;
    case 5: phase_mlp1(l); break;
    default: phase_mlp2(l); break;
  }
}

__global__ void __launch_bounds__(256, 2) mega(Params p, int ph_lo, int ph_hi) {
  cg::grid_group grid = cg::this_grid();
  for (int ph = ph_lo; ph < ph_hi; ++ph) {
    run_phase(ph);
    if (ph + 1 < ph_hi) grid.sync();
  }
}

extern "C" void kernel_launch(void* const* d_in, const int* in_sizes, int n_in, void* d_out, int out_size, void* d_ws, size_t ws_size, hipStream_t stream) {
  static int grid_blocks = 0;
  if (!grid_blocks) {
    int dev = 0, cus = 0, per_cu = 0;
    (void)hipGetDevice(&dev);
    (void)hipDeviceGetAttribute(&cus, hipDeviceAttributeMultiprocessorCount, dev);
    (void)hipOccupancyMaxActiveBlocksPerMultiprocessor(&per_cu, mega, 256, 0);
    if (per_cu > 2) per_cu = 2;
    grid_blocks = cus * per_cu;
    if (ws_size < OFF_END) fprintf(stderr, "kernel_launch: workspace too small: %zu < %zu\n", ws_size, (size_t)OFF_END);
  }
  Params p;
  memset(&p, 0, sizeof(p));
  p.x = (const float*)d_in[0]; p.g_mix = (const float*)d_in[1]; p.w_in = (const float*)d_in[2]; p.q_norm = (const float*)d_in[3];
  p.w_uq = (const float*)d_in[4]; p.kv_norm = (const float*)d_in[5]; p.w_ukv = (const float*)d_in[6]; p.rpb = (const float*)d_in[7];
  p.on_a = (const float*)d_in[8]; p.on_b = (const float*)d_in[9]; p.on_c = (const float*)d_in[10]; p.w_out = (const float*)d_in[11];
  p.g_mlp = (const float*)d_in[12]; p.w_mlp_in = (const float*)d_in[13]; p.w_mlp_out = (const float*)d_in[14]; p.g_final = (const float*)d_in[15];
  p.out = (float*)d_out; p.ws = (char*)d_ws;
  p.qscaleA = (float)(1.4426950408889634 / std::sqrt(96.0));
  p.qscaleB = (float)(1.4426950408889634 * 0.125);
#if ONE_LAUNCH
  int lo = 0, hi = NPHASE;
  void* args[] = {&p, &lo, &hi};
  hipError_t e = hipLaunchCooperativeKernel((void*)mega, dim3(grid_blocks), dim3(256), args, 0, stream);
  if (e != hipSuccess) fprintf(stderr, "cooperative launch failed: %s (grid %d)\n", hipGetErrorString(e), grid_blocks);
#else
  for (int ph = 0; ph < NPHASE; ++ph) hipLaunchKernelGGL(mega, dim3(grid_blocks), dim3(256), 0, stream, p, ph, ph + 1);
#endif
}
```

```cpp
#include <hip/hip_runtime.h>
#include <hip/hip_cooperative_groups.h>
#include <cstdio>
#include <cmath>
#include <cstring>
namespace cg = cooperative_groups;

#ifndef ONE_LAUNCH
#define ONE_LAUNCH 1
#endif

#define DI __device__ __forceinline__
typedef unsigned short bf16_t;
typedef short bf16x8 __attribute__((ext_vector_type(8)));
typedef short s16x4 __attribute__((ext_vector_type(4)));
typedef float f32x16 __attribute__((ext_vector_type(16)));
typedef float f32x2 __attribute__((ext_vector_type(2)));
typedef float f32x4 __attribute__((ext_vector_type(4)));
typedef __bf16 bf2_t __attribute__((ext_vector_type(2)));
typedef unsigned u32x4 __attribute__((ext_vector_type(4)));
typedef unsigned u32x2 __attribute__((ext_vector_type(2)));
typedef __attribute__((address_space(3))) s16x4 lds_s16x4;

constexpr int SEQ = 8192, NB = 4, NTOK = NB * SEQ, DM = 1024, NLAYER = 4;
constexpr int N_IN_PAD = 2560, N_UQ_PAD = 768, N_UKV = 768, DFF = 4096;
constexpr int NTHR = 512;

constexpr size_t SZ_XB = (size_t)NTOK * DM * 2;
constexpr size_t SZ_WIN = (size_t)N_IN_PAD * 1024 * 2, SZ_WUQ = (size_t)N_UQ_PAD * 256 * 2, SZ_WUKV = (size_t)N_UKV * 128 * 2,
                 SZ_WOUT = (size_t)1024 * 1024 * 2, SZ_W1 = (size_t)DFF * 1024 * 2, SZ_W2 = (size_t)1024 * DFF * 2;
constexpr size_t LW_WIN = 0, LW_WUQ = LW_WIN + SZ_WIN, LW_WUKV = LW_WUQ + SZ_WUQ, LW_WOUT = LW_WUKV + SZ_WUKV, LW_W1 = LW_WOUT + SZ_WOUT,
                 LW_W2 = LW_W1 + SZ_W1, LW_SIZE = LW_W2 + SZ_W2;
constexpr size_t OFF_XB = 0, OFF_W = OFF_XB + SZ_XB, OFF_TAB = OFF_W + NLAYER * LW_SIZE;
constexpr size_t OFF_COS32 = OFF_TAB, OFF_SIN32 = OFF_COS32 + (size_t)SEQ * 32 * 4, OFF_COS16 = OFF_SIN32 + (size_t)SEQ * 32 * 4,
                 OFF_SIN16 = OFF_COS16 + (size_t)SEQ * 16 * 4, OFF_ATT = OFF_SIN16 + (size_t)SEQ * 16 * 4;
constexpr size_t SZ_T384 = (size_t)NTOK * 384 * 2, SZ_QA = (size_t)NB * 6 * SEQ * 96 * 2, SZ_H6 = (size_t)NB * 6 * SEQ * 64 * 2,
                 SZ_H4 = (size_t)NB * 4 * SEQ * 64 * 2;
constexpr size_t OFF_CQKV = OFF_ATT;
constexpr size_t OFF_OA = OFF_CQKV;
constexpr size_t OFF_QA = OFF_CQKV + SZ_T384, OFF_KA = OFF_QA + SZ_QA, OFF_VA = OFF_KA + SZ_QA;
constexpr size_t OFF_QB = OFF_VA + SZ_H6, OFF_KB = OFF_QB + SZ_H6, OFF_VB = OFF_KB + SZ_H6;
constexpr size_t OFF_QC = OFF_VB + SZ_H6, OFF_KC = OFF_QC + SZ_H4, OFF_VC = OFF_KC + SZ_H4;
constexpr size_t OFF_OB = OFF_VC + SZ_H4, OFF_LSEB = OFF_OB + 3 * SZ_T384, OFF_OC = OFF_LSEB + (size_t)3 * NTOK * 6 * 4;
constexpr size_t OFF_SSQ = OFF_OC + (size_t)NTOK * 256 * 2;
constexpr size_t OFF_PX1 = OFF_SSQ, OFF_PX2 = OFF_PX1 + (size_t)NTOK * 16 * 4, OFF_PQ = OFF_PX2 + (size_t)NTOK * 16 * 4, OFF_PKV = OFF_PQ + (size_t)NTOK * 4 * 4;
constexpr size_t OFF_END = OFF_PKV + (size_t)NTOK * 2 * 4;
constexpr size_t OFF_MIXED = OFF_QA;
constexpr size_t OFF_HID = OFF_ATT;
static_assert(OFF_HID + (size_t)NTOK * DFF * 2 <= OFF_SSQ, "hid fits");
static_assert(OFF_MIXED + (size_t)NTOK * DM * 2 <= OFF_VA, "mixed fits");

struct Params {
  const float *x, *g_mix, *w_in, *q_norm, *w_uq, *kv_norm, *w_ukv, *rpb, *on_a, *on_b, *on_c, *w_out, *g_mlp, *w_mlp_in, *w_mlp_out, *g_final;
  float* out; char* ws;
  float qscaleA, qscaleB;
};
__shared__ __attribute__((aligned(1024))) char g_smem[131072];
#define NI __device__ __forceinline__
DI const Params& kparams() { return *(const Params*)__builtin_amdgcn_kernarg_segment_ptr(); }

DI unsigned cvtpk(float lo, float hi) { f32x2 v = {lo, hi}; bf2_t b = __builtin_convertvector(v, bf2_t); return __builtin_bit_cast(unsigned, b); }
DI bf16_t f2bf(float x) { return (bf16_t)(cvtpk(x, 0.f) & 0xffffu); }
DI float bf2f(unsigned h) { return __uint_as_float(h << 16); }
DI int crow(int i, int h) { return (i & 3) + 8 * (i >> 2) + 4 * h; }
#define MFMA32(a, b, c) __builtin_amdgcn_mfma_f32_32x32x16_bf16((a), (b), (c), 0, 0, 0)
DI float fdot2bf(unsigned a, float c) { bf2_t v = __builtin_bit_cast(bf2_t, a); return __builtin_amdgcn_fdot2_f32_bf16(v, v, c, false); }
DI float swap_max(float v) { auto rr = __builtin_amdgcn_permlane32_swap(__float_as_uint(v), __float_as_uint(v), false, false); return fmaxf(__uint_as_float(rr[0]), __uint_as_float(rr[1])); }
DI float swap_sum(float v) { auto rr = __builtin_amdgcn_permlane32_swap(__float_as_uint(v), __float_as_uint(v), false, false); return __uint_as_float(rr[0]) + __uint_as_float(rr[1]); }

constexpr int ATT_LDS = 24576;
DI int otid() { int t = threadIdx.x; asm volatile("" : "+v"(t)); return t; }
DI int obid() { int t = blockIdx.x; asm volatile("" : "+s"(t)); return t; }

template <int NSLOT, class Epi>
DI void gemm_tile(const bf16_t* __restrict__ A, int lda, const bf16_t* __restrict__ Bt, int ldb, int K, int m0, int n0, const Epi& epi, const int tid, const float* pin) {
  const int lane = tid & 63, w = tid >> 6, wm = w >> 2, wn = w & 3, r32 = lane & 31, hi = lane >> 5;
  char* smem = g_smem;
  const int lrow = lane >> 3;
  const int c0 = (lane & 7) ^ (lane >> 4), c1 = (lane & 7) ^ ((lane >> 4) | 4);
  const char* Ab = (const char*)(A + (size_t)m0 * lda);
  const char* Bb = (const char*)(Bt + (size_t)n0 * ldb);
  const unsigned oa0 = (unsigned)(((w * 32 + lrow) * lda + c0 * 8) * 2), oa1 = (unsigned)(((w * 32 + lrow) * lda + c1 * 8) * 2);
  const unsigned ob0 = (unsigned)(((w * 32 + lrow) * ldb + c0 * 8) * 2), ob1 = (unsigned)(((w * 32 + lrow) * ldb + c1 * 8) * 2);
  const int dma_off = (w * 32) * 128 + lane * 16;
  f32x16 acc[4][2];
#pragma unroll
  for (int mi = 0; mi < 4; ++mi)
#pragma unroll
    for (int nj = 0; nj < 2; ++nj)
#pragma unroll
      for (int i = 0; i < 16; ++i) acc[mi][nj][i] = 0.f;
  const int nk = K >> 6;
  const int sw = (r32 >> 1) & 7, sh = sw >> 1, lo16 = 16 * (hi ^ (sw & 1));
  const int a_off = (wm * 128 + r32) * 128 + lo16;
  const int b_off = 32768 + (wn * 64 + r32) * 128 + lo16;
  __syncthreads();
  {
    char* sa = smem + dma_off;
#pragma unroll
    for (int j = 0; j < 4; ++j) {
      __builtin_amdgcn_global_load_lds((const unsigned*)(Ab + (size_t)(j * 8 * lda) * 2 + ((j & 1) ? oa1 : oa0)), (unsigned*)(sa + j * 1024), 16, 0, 0);
      __builtin_amdgcn_global_load_lds((const unsigned*)(Bb + (size_t)(j * 8 * ldb) * 2 + ((j & 1) ? ob1 : ob0)), (unsigned*)(sa + 32768 + j * 1024), 16, 0, 0);
    }
  }
  for (int kt = 0; kt < nk; ++kt) {
    __syncthreads();
    if (kt + 1 < nk) {
      char* sa = smem + ((kt + 1) & 1) * 65536 + dma_off;
      const int k0 = (kt + 1) * 64;
#pragma unroll
      for (int j = 0; j < 4; ++j) {
        __builtin_amdgcn_global_load_lds((const unsigned*)(Ab + (size_t)(j * 8 * lda + k0) * 2 + ((j & 1) ? oa1 : oa0)), (unsigned*)(sa + j * 1024), 16, 0, 0);
        __builtin_amdgcn_global_load_lds((const unsigned*)(Bb + (size_t)(j * 8 * ldb + k0) * 2 + ((j & 1) ? ob1 : ob0)), (unsigned*)(sa + 32768 + j * 1024), 16, 0, 0);
      }
    }
    const char* sb = smem + (kt & 1) * 65536;
#pragma unroll
    for (int ks = 0; ks < 4; ++ks) {
      const int koff = 32 * (ks ^ sh);
      bf16x8 af[4], bfr[2];
#pragma unroll
      for (int mi = 0; mi < 4; ++mi) af[mi] = *(const bf16x8*)(sb + a_off + mi * 4096 + koff);
#pragma unroll
      for (int nj = 0; nj < 2; ++nj) bfr[nj] = *(const bf16x8*)(sb + b_off + nj * 4096 + koff);
#pragma unroll
      for (int mi = 0; mi < 4; ++mi)
#pragma unroll
        for (int nj = 0; nj < 2; ++nj) acc[mi][nj] = MFMA32(af[mi], bfr[nj], acc[mi][nj]);
    }
  }
  float* rstd_s = (float*)smem;
  if (NSLOT > 0) {
    __syncthreads();
    if (tid < 256) {
      const float* pr = pin + (size_t)(m0 + tid) * NSLOT;
      float sacc = 0.f;
      if (NSLOT >= 4) {
#pragma unroll
        for (int q = 0; q < NSLOT / 4; ++q) { const f32x4 v = *(const f32x4*)(pr + 4 * q); sacc += (v[0] + v[1]) + (v[2] + v[3]); }
      } else {
#pragma unroll
        for (int q = 0; q < NSLOT; ++q) sacc += pr[q];
      }
      rstd_s[tid] = rsqrtf(sacc / (float)K + 1e-6f);
    }
    __syncthreads();
  }
  int lane2 = lane, w2 = w; asm volatile("" : "+v"(lane2), "+v"(w2));
  epi(acc, m0, (w2 >> 2) * 128, n0 + (w2 & 3) * 64, lane2, rstd_s);
}
DI void row_ssq_put(float v, float* dst, int lane) {
  v += __shfl_xor(v, 1); v += __shfl_xor(v, 2); v += __shfl_xor(v, 4); v += __shfl_xor(v, 8); v += __shfl_xor(v, 16);
  if ((lane & 31) == 0) *dst = v;
}

struct EpiG1 {
  bf16_t *cqkv, *KA, *qB, *qC; const float *cos32, *sin32, *cos16, *sin16; float qs; float *pq, *pkv;
  DI void operator()(f32x16 (&acc)[4][2], int m0, int lr0, int col0, int lane, const float* rstd_s) const {
    const int c = lane & 31, h = lane >> 5, cb = col0 >> 6;
    if (cb >= 37) return;
#define G1_ROW const int lr = lr0 + mi * 32 + crow(i, h), tok = m0 + lr, b = tok >> 13, s = tok & 8191; (void)b; (void)s; \
               const float rs = rstd_s[lr]; float v0 = acc[mi][0][i] * rs, v1 = acc[mi][1][i] * rs;
    if (cb < 6) {
#pragma unroll
      for (int mi = 0; mi < 4; ++mi)
#pragma unroll
        for (int i = 0; i < 16; ++i) {
        if ((i & 3) == 0) __builtin_amdgcn_sched_barrier(0);
          G1_ROW
          bf16_t* d = cqkv + (size_t)tok * 384 + cb * 64 + c; d[0] = f2bf(v0); d[32] = f2bf(v1);
          row_ssq_put(v0 * v0 + v1 * v1, cb < 4 ? pq + (size_t)tok * 4 + cb : pkv + (size_t)tok * 2 + (cb - 4), lane);
        }
    } else if (cb == 6) {
#pragma unroll
      for (int mi = 0; mi < 4; ++mi)
#pragma unroll
        for (int i = 0; i < 16; ++i) {
        if ((i & 3) == 0) __builtin_amdgcn_sched_barrier(0);
          G1_ROW
          if (c < 16) {
            const float cs = cos16[s * 16 + c], sn = sin16[s * 16 + c];
            const bf16_t o1 = f2bf(v0 * cs - v1 * sn), o2 = f2bf(v0 * sn + v1 * cs);
#pragma unroll
            for (int hd = 0; hd < 6; ++hd) { bf16_t* d = KA + ((size_t)(b * 6 + hd) * SEQ + s) * 96 + 64 + c; d[0] = o1; d[16] = o2; }
          }
        }
    } else if (cb < 25) {
      const int idx = cb - 7, which = idx / 6, hd = idx - which * 6;
      bf16_t* base = qB + (size_t)which * (SZ_H6 / 2) + (size_t)hd * SEQ * 64 + c;
      const float sc = which == 0 ? qs : 1.f;
      if (which < 2) {
#pragma unroll
        for (int mi = 0; mi < 4; ++mi)
#pragma unroll
          for (int i = 0; i < 16; ++i) {
        if ((i & 3) == 0) __builtin_amdgcn_sched_barrier(0);
            G1_ROW
            const float cs = cos32[s * 32 + c] * sc, sn = sin32[s * 32 + c] * sc;
            bf16_t* d = base + ((size_t)(b * 6) * SEQ + s) * 64;
            d[0] = f2bf(v0 * cs - v1 * sn); d[32] = f2bf(v0 * sn + v1 * cs);
          }
      } else {
#pragma unroll
        for (int mi = 0; mi < 4; ++mi)
#pragma unroll
          for (int i = 0; i < 16; ++i) {
        if ((i & 3) == 0) __builtin_amdgcn_sched_barrier(0);
            G1_ROW
            bf16_t* d = base + ((size_t)(b * 6) * SEQ + s) * 64;
            d[0] = f2bf(v0); d[32] = f2bf(v1);
          }
      }
    } else {
      const int idx = cb - 25, which = idx >> 2, hd = idx & 3;
      bf16_t* base = qC + (size_t)which * (SZ_H4 / 2) + (size_t)hd * SEQ * 64 + c;
      const float sc = which == 0 ? qs : 1.f;
#pragma unroll
      for (int mi = 0; mi < 4; ++mi)
#pragma unroll
        for (int i = 0; i < 16; ++i) {
        if ((i & 3) == 0) __builtin_amdgcn_sched_barrier(0);
          G1_ROW
          bf16_t* d = base + ((size_t)(b * 4) * SEQ + s) * 64;
          d[0] = f2bf(v0 * sc); d[32] = f2bf(v1 * sc);
        }
    }
#undef G1_ROW
  }
};
struct EpiUQ {
  bf16_t* QA; const float *cos16, *sin16; float qs;
  DI void operator()(f32x16 (&acc)[4][2], int m0, int lr0, int col0, int lane, const float* rstd_s) const {
    const int c = lane & 31, h = lane >> 5, cb = col0 >> 6;
    if (cb >= 9) return;
#pragma unroll
    for (int mi = 0; mi < 4; ++mi)
#pragma unroll
      for (int i = 0; i < 16; ++i) {
        if ((i & 3) == 0) __builtin_amdgcn_sched_barrier(0);
        const int lr = lr0 + mi * 32 + crow(i, h), tok = m0 + lr, b = tok >> 13, s = tok & 8191;
        const float rs = rstd_s[lr] * qs;
        const float v0 = acc[mi][0][i] * rs, v1 = acc[mi][1][i] * rs;
        if (cb < 6) {
          bf16_t* d = QA + ((size_t)(b * 6 + cb) * SEQ + s) * 96 + c; d[0] = f2bf(v0); d[32] = f2bf(v1);
        } else {
          const int hd = 2 * (cb - 6) + (c >> 4), fi = c & 15;
          const float cs = cos16[s * 16 + fi], sn = sin16[s * 16 + fi];
          bf16_t* d = QA + ((size_t)(b * 6 + hd) * SEQ + s) * 96 + 64 + fi;
          d[0] = f2bf(v0 * cs - v1 * sn); d[16] = f2bf(v0 * sn + v1 * cs);
        }
      }
  }
};
struct EpiUKV {
  bf16_t *KA, *VA;
  DI void operator()(f32x16 (&acc)[4][2], int m0, int lr0, int col0, int lane, const float* rstd_s) const {
    const int c = lane & 31, h = lane >> 5, cb = col0 >> 6, hd = cb >> 1, isv = cb & 1;
#pragma unroll
    for (int mi = 0; mi < 4; ++mi)
#pragma unroll
      for (int i = 0; i < 16; ++i) {
        if ((i & 3) == 0) __builtin_amdgcn_sched_barrier(0);
        const int lr = lr0 + mi * 32 + crow(i, h), tok = m0 + lr, b = tok >> 13, s = tok & 8191;
        const float rs = rstd_s[lr];
        const float v0 = acc[mi][0][i] * rs, v1 = acc[mi][1][i] * rs;
        bf16_t* d = isv ? VA + ((size_t)(b * 6 + hd) * SEQ + s) * 64 + c : KA + ((size_t)(b * 6 + hd) * SEQ + s) * 96 + c;
        d[0] = f2bf(v0); d[32] = f2bf(v1);
      }
  }
};
struct EpiRes {
  const float* xold; float* xf; bf16_t* xb; float* pout;
  DI void operator()(f32x16 (&acc)[4][2], int m0, int lr0, int col0, int lane, const float* rstd_s) const {
    const int c = lane & 31, h = lane >> 5;
#pragma unroll
    for (int mi = 0; mi < 4; ++mi)
#pragma unroll
      for (int i = 0; i < 16; ++i) {
        if ((i & 3) == 0) __builtin_amdgcn_sched_barrier(0);
        const int row = m0 + lr0 + mi * 32 + crow(i, h);
        const size_t o = (size_t)row * DM + col0 + c;
        const float v0 = xold[o] + acc[mi][0][i], v1 = xold[o + 32] + acc[mi][1][i];
        xf[o] = v0; xf[o + 32] = v1; xb[o] = f2bf(v0); xb[o + 32] = f2bf(v1);
        row_ssq_put(v0 * v0 + v1 * v1, pout + (size_t)row * 16 + (col0 >> 6), lane);
      }
  }
};
struct EpiMlp1 {
  bf16_t* hid;
  DI void operator()(f32x16 (&acc)[4][2], int m0, int lr0, int col0, int lane, const float* rstd_s) const {
    const int c = lane & 31, h = lane >> 5;
#pragma unroll
    for (int mi = 0; mi < 4; ++mi)
#pragma unroll
      for (int i = 0; i < 16; ++i) {
        if ((i & 3) == 0) __builtin_amdgcn_sched_barrier(0);
        const int lr = lr0 + mi * 32 + crow(i, h);
        const float rs = rstd_s[lr];
        const float v0 = fmaxf(acc[mi][0][i] * rs, 0.f), v1 = fmaxf(acc[mi][1][i] * rs, 0.f);
        bf16_t* d = hid + (size_t)(m0 + lr) * DFF + col0 + c; d[0] = f2bf(v0 * v0); d[32] = f2bf(v1 * v1);
      }
  }
};

struct AttnItem {
  const bf16_t *Q, *K, *V;
  int q0;
  int n0, dil, res, N;
  int nrb, ncb, kr0, kc0;
  bf16_t* out; int ldo;
  float* lse;
  const float* rpb;
};

template <int DQ, int MODE>
DI void attn_block(const AttnItem& it, char* smem, const int tid) {
  constexpr int CPR = DQ / 8, KST = DQ * 2 + 16, KCH = (64 * CPR) / 256, NT = MODE == 0 ? SEQ / 64 : MODE == 1 ? 4 : 8;
  const int lane = tid & 63, w = tid >> 6, r32 = lane & 31, hi = lane >> 5;
  char* Ks = smem; char* Vs = smem + 64 * KST; float* bias_s = (float*)(smem + 64 * KST + 8192);
  const int qi = w * 32 + r32;
  int qpos;
  if (MODE == 0) qpos = it.q0 + qi;
  else if (MODE == 1) qpos = (it.n0 + qi) * it.dil + it.res;
  else qpos = (8 * it.nrb + (qi >> 4)) * 64 + 16 * it.ncb + (qi & 15);
  __syncthreads();
  if (MODE == 2) { for (int i = tid; i < 465; i += 256) bias_s[i] = it.rpb[i] * 1.4426950408889634f; }
  bf16x8 qr[DQ / 16];
#pragma unroll
  for (int d0 = 0; d0 < DQ / 16; ++d0) qr[d0] = *(const bf16x8*)(it.Q + (size_t)qpos * DQ + d0 * 16 + hi * 8);
  f32x16 o[2];
#pragma unroll
  for (int i = 0; i < 16; ++i) { o[0][i] = 0.f; o[1][i] = 0.f; }
  float m_run = -1e30f, l_run = 0.f;
  u32x4 rk[KCH], rv[2];
  auto kpos = [&](int t, int row) -> int {
    if (MODE == 0) return t * 64 + row;
    if (MODE == 1) { int n = it.n0 - 64 + 64 * t + row; n = n < 0 ? 0 : (n > it.N - 1 ? it.N - 1 : n); return n * it.dil + it.res; }
    return (it.kr0 + 2 * t + (row >> 5)) * 64 + it.kc0 + (row & 31);
  };
  auto load = [&](int t) {
#pragma unroll
    for (int i = 0; i < KCH; ++i) { const int c = tid + 256 * i, row = c / CPR, kc = c - row * CPR; rk[i] = *(const u32x4*)(it.K + (size_t)kpos(t, row) * DQ + kc * 8); }
#pragma unroll
    for (int i = 0; i < 2; ++i) { const int c = tid + 256 * i, row = c >> 3, kc = c & 7; rv[i] = *(const u32x4*)(it.V + (size_t)kpos(t, row) * 64 + kc * 8); }
  };
  const int vrd = ((lane >> 5) * 4 + ((lane & 15) >> 2)) * 64 + ((lane >> 4) & 1) * 32 + (lane & 3) * 8;
  load(0);
  for (int t = 0; t < NT; ++t) {
    __syncthreads();
#pragma unroll
    for (int i = 0; i < KCH; ++i) { const int c = tid + 256 * i, row = c / CPR, kc = c - row * CPR; *(u32x4*)(Ks + row * KST + kc * 16) = rk[i]; }
#pragma unroll
    for (int i = 0; i < 2; ++i) { const int c = tid + 256 * i, row = c >> 3, kc = c & 7; *(u32x4*)(Vs + (kc >> 2) * 4096 + row * 64 + (kc & 3) * 16) = rv[i]; }
    __syncthreads();
    if (t + 1 < NT) load(t + 1);
    bool skip = false;
    if (MODE == 1) skip = (w < 2) ? (t == 3) : (t == 0);
    if (MODE == 2) {
      const int rq_lo = 8 * it.nrb + 2 * w, rq_hi = rq_lo + 1;
      const int rs_lo = min(max(rq_lo - 4, 0), 120), rs_hi = min(max(rq_hi - 4, 0), 120) + 7;
      const int kr = it.kr0 + 2 * t;
      skip = (kr + 1 < rs_lo) || (kr > rs_hi);
    }
    if (skip) continue;
    f32x16 p0, p1;
#pragma unroll
    for (int i = 0; i < 16; ++i) { p0[i] = 0.f; p1[i] = 0.f; }
#pragma unroll
    for (int d0 = 0; d0 < DQ / 16; ++d0) {
      const bf16x8 k0 = *(const bf16x8*)(Ks + r32 * KST + d0 * 32 + hi * 16);
      const bf16x8 k1 = *(const bf16x8*)(Ks + (32 + r32) * KST + d0 * 32 + hi * 16);
      p0 = MFMA32(k0, qr[d0], p0); p1 = MFMA32(k1, qr[d0], p1);
    }
    if (MODE == 1) {
      const int nq = it.n0 + qi, kb = it.n0 - 64 + 64 * t;
#pragma unroll
      for (int i = 0; i < 16; ++i) {
        const int nk = kb + crow(i, hi), nk2 = nk + 32;
        const int d1 = nq - nk, d2 = nq - nk2;
        const bool ok1 = (d1 <= 64) && (d1 >= -64) && (nk >= 0) && (nk < it.N);
        const bool ok2 = (d2 <= 64) && (d2 >= -64) && (nk2 >= 0) && (nk2 < it.N);
        p0[i] = ok1 ? p0[i] : -INFINITY; p1[i] = ok2 ? p1[i] : -INFINITY;
      }
    }
    if (MODE == 2) {
      const int rq = 8 * it.nrb + (qi >> 4), cq = 16 * it.ncb + (qi & 15);
      const int rs_ = min(max(rq - 4, 0), 120), cs_ = min(max(cq - 8, 0), 48);
      const int kr = it.kr0 + 2 * t;
      const bool okr0 = (kr >= rs_) && (kr < rs_ + 8), okr1 = (kr + 1 >= rs_) && (kr + 1 < rs_ + 8);
      const int bi0 = (kr - rq + 7) * 31 - cq + 15;
#pragma unroll
      for (int i = 0; i < 16; ++i) {
        const int kc = it.kc0 + crow(i, hi);
        const bool okc = (kc >= cs_) && (kc < cs_ + 16);
        const bool ok0 = okc && okr0, ok1 = okc && okr1;
        const float b0 = bias_s[ok0 ? bi0 + kc : 0], b1 = bias_s[ok1 ? bi0 + 31 + kc : 0];
        p0[i] = ok0 ? p0[i] + b0 : -INFINITY; p1[i] = ok1 ? p1[i] + b1 : -INFINITY;
      }
    }
    float pmax = p0[0];
#pragma unroll
    for (int i = 1; i < 16; ++i) pmax = fmaxf(pmax, p0[i]);
#pragma unroll
    for (int i = 0; i < 16; ++i) pmax = fmaxf(pmax, p1[i]);
    pmax = swap_max(pmax);
    const float mn = fmaxf(m_run, pmax);
    const float alpha = __builtin_amdgcn_exp2f(m_run - mn);
    m_run = mn;
    float ps = 0.f;
#pragma unroll
    for (int i = 0; i < 16; ++i) { p0[i] = __builtin_amdgcn_exp2f(p0[i] - mn); ps += p0[i]; }
#pragma unroll
    for (int i = 0; i < 16; ++i) { p1[i] = __builtin_amdgcn_exp2f(p1[i] - mn); ps += p1[i]; }
    ps = swap_sum(ps);
    l_run = l_run * alpha + ps;
#pragma unroll
    for (int i = 0; i < 16; ++i) { o[0][i] *= alpha; o[1][i] *= alpha; }
    bf16x8 pb[4];
#pragma unroll
    for (int s = 0; s < 2; ++s) {
      u32x4 a = {cvtpk(p0[8 * s], p0[8 * s + 1]), cvtpk(p0[8 * s + 2], p0[8 * s + 3]), cvtpk(p0[8 * s + 4], p0[8 * s + 5]), cvtpk(p0[8 * s + 6], p0[8 * s + 7])};
      u32x4 b = {cvtpk(p1[8 * s], p1[8 * s + 1]), cvtpk(p1[8 * s + 2], p1[8 * s + 3]), cvtpk(p1[8 * s + 4], p1[8 * s + 5]), cvtpk(p1[8 * s + 6], p1[8 * s + 7])};
      pb[s] = __builtin_bit_cast(bf16x8, a); pb[2 + s] = __builtin_bit_cast(bf16x8, b);
    }
#pragma unroll
    for (int db = 0; db < 2; ++db)
#pragma unroll
      for (int s = 0; s < 4; ++s) {
        const s16x4 lo = __builtin_amdgcn_ds_read_tr16_b64_v4i16((lds_s16x4*)(Vs + db * 4096 + (16 * s) * 64 + vrd));
        const s16x4 hh = __builtin_amdgcn_ds_read_tr16_b64_v4i16((lds_s16x4*)(Vs + db * 4096 + (16 * s + 8) * 64 + vrd));
        const bf16x8 a = {lo[0], lo[1], lo[2], lo[3], hh[0], hh[1], hh[2], hh[3]};
        o[db] = MFMA32(a, pb[s], o[db]);
      }
  }
  const float inv = 1.f / l_run;
  const int bq = qpos;
  bf16_t* orow = it.out + (size_t)bq * it.ldo;
#pragma unroll
  for (int db = 0; db < 2; ++db)
#pragma unroll
    for (int g = 0; g < 4; ++g) {
      u32x2 v = {cvtpk(o[db][4 * g] * inv, o[db][4 * g + 1] * inv), cvtpk(o[db][4 * g + 2] * inv, o[db][4 * g + 3] * inv)};
      *(u32x2*)(orow + db * 32 + 8 * g + 4 * hi) = v;
    }
  if (MODE == 1) { if (hi == 0) it.lse[(size_t)bq * 6] = m_run + __builtin_amdgcn_logf(l_run); }
}

DI float wave_sum(float v) {
  v += __shfl_xor(v, 32); v += __shfl_xor(v, 16); v += __shfl_xor(v, 8); v += __shfl_xor(v, 4); v += __shfl_xor(v, 2); v += __shfl_xor(v, 1); return v;
}
DI float gain_of(const Params& p, int kind, int l, int k) {
  switch (kind) {
    case 0: return p.g_mix[l * 1024 + k];
    case 1: return p.q_norm[l * 256 + k];
    case 2: return p.kv_norm[l * 128 + k];
    case 3: return k < 384 ? p.on_a[l * 384 + k] : (k < 768 ? p.on_b[l * 384 + k - 384] : p.on_c[l * 256 + k - 768]);
    case 4: return p.g_mlp[l * 1024 + k];
    default: return 1.f;
  }
}
DI int map_col(int kind, int n) {
  if (kind == 0) {
    if (n < 384) return n;
    if (n < 448) { const int wv = n - 384, c = wv & 31, sub = wv >> 5; return c < 16 ? 384 + sub * 16 + c : -1; }
    if (n < 1600) return 416 + (n - 448);
    if (n < 2368) return 1568 + (n - 1600);
    return -1;
  }
  if (kind == 1) {
    if (n < 384) return (n >> 6) * 96 + (n & 63);
    if (n < 576) { const int wv = n - 384, g = wv >> 6, wi = wv & 63, sub = wi >> 5, c = wi & 31, hd = 2 * g + (c >> 4), fi = c & 15; return hd * 96 + 64 + sub * 16 + fi; }
    return -1;
  }
  return n;
}
DI void wtile(const Params& p, const float* src, int Nsrc, bf16_t* dst, int K, int kt, int nt, int kind, int l, char* smem, const int tid) {
  float* tile = (float*)smem;
  const int lane = tid & 63, wv = tid >> 6;
  __syncthreads();
  const int n = nt * 64 + lane, sc = map_col(kind, n);
#pragma unroll 4
  for (int r = 0; r < 8; ++r) {
    const int kl = r * 8 + wv, k = kt * 64 + kl;
    float v = 0.f;
    if (sc >= 0) v = src[(size_t)k * Nsrc + sc] * gain_of(p, kind, l, k);
    tile[kl * 65 + lane] = v;
  }
  __syncthreads();
#pragma unroll 4
  for (int r = 0; r < 8; ++r) {
    const int nl = r * 8 + wv;
    dst[(size_t)(nt * 64 + nl) * K + kt * 64 + lane] = f2bf(tile[lane * 65 + nl]);
  }
}

NI void phase_prep() {
  const Params& p = kparams(); char* smem = g_smem; const int tid = otid(), bid = obid();
  char* ws = p.ws;
  constexpr int T_WIN = (N_IN_PAD / 64) * 16, T_WUQ = (N_UQ_PAD / 64) * 4, T_WUKV = (N_UKV / 64) * 2, T_WOUT = 16 * 16, T_W1 = 64 * 16, T_W2 = 16 * 64;
  constexpr int T_L = T_WIN + T_WUQ + T_WUKV + T_WOUT + T_W1 + T_W2;
  for (int j = bid; j < NLAYER * T_L; j += gridDim.x) {
    const int l = j / T_L; int r = j - l * T_L;
    char* lw = ws + OFF_W + (size_t)l * LW_SIZE;
    if (r < T_WIN) { wtile(p, p.w_in + (size_t)l * 1024 * 2336, 2336, (bf16_t*)(lw + LW_WIN), 1024, r & 15, r >> 4, 0, l, smem, tid); continue; }
    r -= T_WIN;
    if (r < T_WUQ) { wtile(p, p.w_uq + (size_t)l * 256 * 576, 576, (bf16_t*)(lw + LW_WUQ), 256, r & 3, r >> 2, 1, l, smem, tid); continue; }
    r -= T_WUQ;
    if (r < T_WUKV) { wtile(p, p.w_ukv + (size_t)l * 128 * 768, 768, (bf16_t*)(lw + LW_WUKV), 128, r & 1, r >> 1, 2, l, smem, tid); continue; }
    r -= T_WUKV;
    if (r < T_WOUT) { wtile(p, p.w_out + (size_t)l * 1024 * 1024, 1024, (bf16_t*)(lw + LW_WOUT), 1024, r & 15, r >> 4, 3, l, smem, tid); continue; }
    r -= T_WOUT;
    if (r < T_W1) { wtile(p, p.w_mlp_in + (size_t)l * 1024 * 4096, 4096, (bf16_t*)(lw + LW_W1), 1024, r & 15, r >> 4, 4, l, smem, tid); continue; }
    r -= T_W1;
    wtile(p, p.w_mlp_out + (size_t)l * 4096 * 1024, 1024, (bf16_t*)(lw + LW_W2), 4096, r & 63, r >> 6, 5, l, smem, tid);
  }
  const size_t gtid = (size_t)bid * NTHR + tid, gsz = (size_t)gridDim.x * NTHR;
  bf16_t* xb = (bf16_t*)(ws + OFF_XB);
  {
    const int lane = tid & 63, gw = bid * (NTHR / 64) + (tid >> 6), nw = gridDim.x * (NTHR / 64);
    float* px1 = (float*)(ws + OFF_PX1);
    for (int row = gw; row < NTOK; row += nw) {
      float ss = 0.f;
#pragma unroll
      for (int j = 0; j < 4; ++j) {
        const f32x4 a = *(const f32x4*)(p.x + (size_t)row * DM + j * 256 + lane * 4);
        ss += a[0] * a[0] + a[1] * a[1] + a[2] * a[2] + a[3] * a[3];
        u32x2 o = {cvtpk(a[0], a[1]), cvtpk(a[2], a[3])};
        *(u32x2*)(xb + (size_t)row * DM + j * 256 + lane * 4) = o;
      }
      ss = wave_sum(ss);
      if (lane < 16) px1[(size_t)row * 16 + lane] = lane == 0 ? ss : 0.f;
    }
  }
  float* c32 = (float*)(ws + OFF_COS32); float* s32 = (float*)(ws + OFF_SIN32); float* c16 = (float*)(ws + OFF_COS16); float* s16 = (float*)(ws + OFF_SIN16);
  for (size_t i = gtid; i < (size_t)SEQ * 48; i += gsz) {
    int pos, fi; float invf; float *cd, *sd;
    if (i < (size_t)SEQ * 32) { pos = (int)(i >> 5); fi = (int)(i & 31); invf = __builtin_amdgcn_exp2f(-(float)fi * (13.287712379549449f / 32.f)); cd = c32 + i; sd = s32 + i; }
    else { const size_t j = i - (size_t)SEQ * 32; pos = (int)(j >> 4); fi = (int)(j & 15); invf = __builtin_amdgcn_exp2f(-(float)fi * (13.287712379549449f / 16.f)); cd = c16 + j; sd = s16 + j; }
    const float ang = (float)pos * invf;
    const double rev = (double)ang * 0.15915494309189535;
    const float fr = (float)(rev - rint(rev));
    *cd = __builtin_amdgcn_cosf(fr); *sd = __builtin_amdgcn_sinf(fr);
  }
}

NI void phase_g1(int l_) {
  const Params& p = kparams(); char* smem = g_smem; const int l = __builtin_amdgcn_readfirstlane(l_); const int tid = otid(), bid = obid(); (void)tid; (void)bid;
  char* ws = p.ws;
  EpiG1 e;
  e.cqkv = (bf16_t*)(ws + OFF_CQKV); e.KA = (bf16_t*)(ws + OFF_KA); e.qB = (bf16_t*)(ws + OFF_QB); e.qC = (bf16_t*)(ws + OFF_QC);
  e.cos32 = (const float*)(ws + OFF_COS32); e.sin32 = (const float*)(ws + OFF_SIN32); e.cos16 = (const float*)(ws + OFF_COS16); e.sin16 = (const float*)(ws + OFF_SIN16);
  e.qs = p.qscaleB; e.pq = (float*)(ws + OFF_PQ); e.pkv = (float*)(ws + OFF_PKV);
  const bf16_t* A = (const bf16_t*)(ws + OFF_XB);
  const bf16_t* Bt = (const bf16_t*)(ws + OFF_W + (size_t)l * LW_SIZE + LW_WIN);
  constexpr int NNT = N_IN_PAD / 256;
  for (int t = bid; t < (NTOK / 256) * NNT; t += gridDim.x) {
    const int mt = t / NNT, nt = t - mt * NNT;
    gemm_tile<16>(A, 1024, Bt, 1024, 1024, mt * 256, nt * 256, e, tid, (const float*)(ws + OFF_PX1));
  }
}
NI void phase_g2(int l_) {
  const Params& p = kparams(); char* smem = g_smem; const int l = __builtin_amdgcn_readfirstlane(l_); const int tid = otid(), bid = obid(); (void)tid; (void)bid;
  char* ws = p.ws;
  const bf16_t* A = (const bf16_t*)(ws + OFF_CQKV);
  EpiUQ eq; eq.QA = (bf16_t*)(ws + OFF_QA); eq.cos16 = (const float*)(ws + OFF_COS16); eq.sin16 = (const float*)(ws + OFF_SIN16); eq.qs = p.qscaleA;
  EpiUKV ek; ek.KA = (bf16_t*)(ws + OFF_KA); ek.VA = (bf16_t*)(ws + OFF_VA);
  const bf16_t* Wq = (const bf16_t*)(ws + OFF_W + (size_t)l * LW_SIZE + LW_WUQ);
  const bf16_t* Wkv = (const bf16_t*)(ws + OFF_W + (size_t)l * LW_SIZE + LW_WUKV);
  constexpr int TQ = (NTOK / 256) * 3, TKV = (NTOK / 256) * 3;
  for (int t = bid; t < TQ; t += gridDim.x) { const int mt = t / 3, nt = t - mt * 3; gemm_tile<4>(A, 384, Wq, 256, 256, mt * 256, nt * 256, eq, tid, (const float*)(ws + OFF_PQ)); }
  for (int u = bid; u < TKV; u += gridDim.x) { const int mt = u / 3, nt = u - mt * 3; gemm_tile<2>(A + 256, 384, Wkv, 128, 128, mt * 256, nt * 256, ek, tid, (const float*)(ws + OFF_PKV)); }
}
NI void phase_attn(int l_) {
  const Params& p = kparams(); char* smem = g_smem; const int l = __builtin_amdgcn_readfirstlane(l_); const int tid = otid(), bid = obid(); (void)tid; (void)bid;
  char* ws = p.ws;
  constexpr int NA = 1536, NBI = 4608, NC = 1024;
  const int grp = tid >> 8, t256 = tid & 255; char* gsm = smem + grp * ATT_LDS;
  for (int i0 = bid * 2; i0 < NA; i0 += gridDim.x * 2) {
    AttnItem it{};
    const int i = i0 + grp, xcd = (i >> 1) & 7, j = ((i >> 4) << 1) | (i & 1);
    const int bh = (j >> 6) * 8 + xcd, qb = j & 63, b = bh / 6, h = bh - b * 6;
    it.Q = (const bf16_t*)(ws + OFF_QA) + (size_t)bh * SEQ * 96; it.K = (const bf16_t*)(ws + OFF_KA) + (size_t)bh * SEQ * 96; it.V = (const bf16_t*)(ws + OFF_VA) + (size_t)bh * SEQ * 64;
    it.q0 = qb * 128; it.out = (bf16_t*)(ws + OFF_OA) + (size_t)b * SEQ * 384 + h * 64; it.ldo = 384;
    attn_block<96, 0>(it, gsm, t256);
  }
  for (int i0 = bid * 2; i0 < NBI; i0 += gridDim.x * 2) {
    AttnItem it{};
    const int i = i0 + grp, xcd = (i >> 1) & 7, j = ((i >> 4) << 1) | (i & 1);
    const int g = (j >> 6) * 8 + xcd, c = j & 63, br = g / 24, bh = g - br * 24, b = bh / 6, h = bh - b * 6;
    const int dil = br == 0 ? 1 : (br == 1 ? 4 : 16), cpr = 64 / dil;
    it.Q = (const bf16_t*)(ws + OFF_QB) + (size_t)bh * SEQ * 64; it.K = (const bf16_t*)(ws + OFF_KB) + (size_t)bh * SEQ * 64; it.V = (const bf16_t*)(ws + OFF_VB) + (size_t)bh * SEQ * 64;
    it.dil = dil; it.res = c / cpr; it.n0 = (c - it.res * cpr) * 128; it.N = SEQ / dil;
    it.out = (bf16_t*)(ws + OFF_OB) + (size_t)br * NTOK * 384 + (size_t)b * SEQ * 384 + h * 64; it.ldo = 384;
    it.lse = (float*)(ws + OFF_LSEB) + (size_t)br * NTOK * 6 + (size_t)b * SEQ * 6 + h;
    attn_block<64, 1>(it, gsm, t256);
  }
  for (int i0 = bid * 2; i0 < NC; i0 += gridDim.x * 2) {
    AttnItem it{};
    const int i = i0 + grp, xcd = (i >> 1) & 7, j = ((i >> 4) << 1) | (i & 1);
    const int bh = (j >> 6) * 8 + xcd, blk = j & 63, b = bh >> 2, h = bh & 3;
    it.Q = (const bf16_t*)(ws + OFF_QC) + (size_t)bh * SEQ * 64; it.K = (const bf16_t*)(ws + OFF_KC) + (size_t)bh * SEQ * 64; it.V = (const bf16_t*)(ws + OFF_VC) + (size_t)bh * SEQ * 64;
    it.nrb = blk >> 2; it.ncb = blk & 3;
    it.kr0 = min(max(8 * it.nrb - 4, 0), 112); it.kc0 = min(max(16 * it.ncb - 8, 0), 32);
    it.out = (bf16_t*)(ws + OFF_OC) + (size_t)b * SEQ * 256 + h * 64; it.ldo = 256;
    it.rpb = p.rpb + ((size_t)l * 4 + h) * 465;
    attn_block<64, 2>(it, gsm, t256);
  }
}
NI void phase_mix() {
  const Params& p = kparams(); const int tid = otid(), bid = obid();
  char* ws = p.ws;
  const int lane = tid & 63, gw = bid * (NTHR / 64) + (tid >> 6), nw = gridDim.x * (NTHR / 64);
  const bf16_t* oA = (const bf16_t*)(ws + OFF_OA); const bf16_t* oB = (const bf16_t*)(ws + OFF_OB); const bf16_t* oC = (const bf16_t*)(ws + OFF_OC);
  const float* lse = (const float*)(ws + OFF_LSEB);
  bf16_t* mixed = (bf16_t*)(ws + OFF_MIXED);
  for (int tok = gw; tok < NTOK; tok += nw) {
    float v[16];
    if (lane < 24 || lane >= 48) {
      const bf16_t* src = lane < 24 ? oA + (size_t)tok * 384 + lane * 16 : oC + (size_t)tok * 256 + (lane - 48) * 16;
      const u32x4 a = *(const u32x4*)src, b = *(const u32x4*)(src + 8);
#pragma unroll
      for (int j = 0; j < 4; ++j) { v[2 * j] = bf2f(a[j] & 0xffffu); v[2 * j + 1] = bf2f(a[j] >> 16); v[8 + 2 * j] = bf2f(b[j] & 0xffffu); v[8 + 2 * j + 1] = bf2f(b[j] >> 16); }
    } else {
      const int col = (lane - 24) * 16, hd = col >> 6;
      const float l0 = lse[(size_t)tok * 6 + hd], l1 = lse[(size_t)NTOK * 6 + (size_t)tok * 6 + hd], l2 = lse[(size_t)2 * NTOK * 6 + (size_t)tok * 6 + hd];
      const float mx = fmaxf(l0, fmaxf(l1, l2));
      float w0 = __builtin_amdgcn_exp2f(l0 - mx), w1 = __builtin_amdgcn_exp2f(l1 - mx), w2 = __builtin_amdgcn_exp2f(l2 - mx);
      const float wi = 1.f / (w0 + w1 + w2); w0 *= wi; w1 *= wi; w2 *= wi;
#pragma unroll
      for (int j = 0; j < 16; ++j) v[j] = 0.f;
#pragma unroll
      for (int br = 0; br < 3; ++br) {
        const float wb = br == 0 ? w0 : (br == 1 ? w1 : w2);
        const bf16_t* src = oB + (size_t)br * NTOK * 384 + (size_t)tok * 384 + col;
        const u32x4 a = *(const u32x4*)src, b = *(const u32x4*)(src + 8);
#pragma unroll
        for (int j = 0; j < 4; ++j) { v[2 * j] += wb * bf2f(a[j] & 0xffffu); v[2 * j + 1] += wb * bf2f(a[j] >> 16); v[8 + 2 * j] += wb * bf2f(b[j] & 0xffffu); v[8 + 2 * j + 1] += wb * bf2f(b[j] >> 16); }
      }
    }
    float ss = 0.f;
#pragma unroll
    for (int j = 0; j < 16; ++j) ss += v[j] * v[j];
    const float sa = wave_sum(lane < 24 ? ss : 0.f), sb = wave_sum((lane >= 24 && lane < 48) ? ss : 0.f), sc = wave_sum(lane >= 48 ? ss : 0.f);
    const float rs = lane < 24 ? rsqrtf(sa * (1.f / 384.f) + 1e-6f) : (lane < 48 ? rsqrtf(sb * (1.f / 384.f) + 1e-6f) : rsqrtf(sc * (1.f / 256.f) + 1e-6f));
    u32x4 oa, ob;
#pragma unroll
    for (int j = 0; j < 4; ++j) { oa[j] = cvtpk(v[2 * j] * rs, v[2 * j + 1] * rs); ob[j] = cvtpk(v[8 + 2 * j] * rs, v[8 + 2 * j + 1] * rs); }
    bf16_t* dst = mixed + (size_t)tok * 1024 + lane * 16;
    *(u32x4*)dst = oa; *(u32x4*)(dst + 8) = ob;
  }
}
NI void phase_wout(int l_) {
  const Params& p = kparams(); char* smem = g_smem; const int l = __builtin_amdgcn_readfirstlane(l_); const int tid = otid(), bid = obid(); (void)tid; (void)bid;
  char* ws = p.ws;
  EpiRes e; e.xold = (l == 0) ? p.x : p.out; e.xf = p.out; e.xb = (bf16_t*)(ws + OFF_XB); e.pout = (float*)(ws + OFF_PX2);
  const bf16_t* A = (const bf16_t*)(ws + OFF_MIXED);
  const bf16_t* Bt = (const bf16_t*)(ws + OFF_W + (size_t)l * LW_SIZE + LW_WOUT);
  for (int t = bid; t < (NTOK / 256) * 4; t += gridDim.x) { const int mt = t >> 2, nt = t & 3; gemm_tile<0>(A, 1024, Bt, 1024, 1024, mt * 256, nt * 256, e, tid, nullptr); }
}
NI void phase_mlp1(int l_) {
  const Params& p = kparams(); char* smem = g_smem; const int l = __builtin_amdgcn_readfirstlane(l_); const int tid = otid(), bid = obid(); (void)tid; (void)bid;
  char* ws = p.ws;
  EpiMlp1 e; e.hid = (bf16_t*)(ws + OFF_HID);
  const bf16_t* A = (const bf16_t*)(ws + OFF_XB);
  const bf16_t* Bt = (const bf16_t*)(ws + OFF_W + (size_t)l * LW_SIZE + LW_W1);
  for (int t = bid; t < (NTOK / 256) * 16; t += gridDim.x) { const int mt = t >> 4, nt = t & 15; gemm_tile<16>(A, 1024, Bt, 1024, 1024, mt * 256, nt * 256, e, tid, (const float*)(ws + OFF_PX2)); }
}
NI void phase_mlp2(int l_) {
  const Params& p = kparams(); char* smem = g_smem; const int l = __builtin_amdgcn_readfirstlane(l_); const int tid = otid(), bid = obid(); (void)tid; (void)bid;
  char* ws = p.ws;
  EpiRes e; e.xold = p.out; e.xf = p.out; e.xb = (bf16_t*)(ws + OFF_XB); e.pout = (float*)(ws + OFF_PX1);
  const bf16_t* A = (const bf16_t*)(ws + OFF_HID);
  const bf16_t* Bt = (const bf16_t*)(ws + OFF_W + (size_t)l * LW_SIZE + LW_W2);
  for (int t = bid; t < (NTOK / 256) * 4; t += gridDim.x) { const int mt = t >> 2, nt = t & 3; gemm_tile<0>(A, DFF, Bt, DFF, DFF, mt * 256, nt * 256, e, tid, nullptr); }
}
NI void phase_final() {
  const Params& p = kparams(); const int tid = otid(), bid = obid();
  const int lane = tid & 63, gw = bid * (NTHR / 64) + (tid >> 6), nw = gridDim.x * (NTHR / 64);
  for (int tok = gw; tok < NTOK; tok += nw) {
    float* row = p.out + (size_t)tok * DM;
    f32x4 v[4]; float ss = 0.f;
#pragma unroll
    for (int j = 0; j < 4; ++j) { v[j] = *(const f32x4*)(row + j * 256 + lane * 4); ss += v[j][0] * v[j][0] + v[j][1] * v[j][1] + v[j][2] * v[j][2] + v[j][3] * v[j][3]; }
    ss = wave_sum(ss);
    const float rs = rsqrtf(ss * (1.f / 1024.f) + 1e-6f);
#pragma unroll
    for (int j = 0; j < 4; ++j) { const f32x4 g = *(const f32x4*)(p.g_final + j * 256 + lane * 4); f32x4 o = {v[j][0] * rs * g[0], v[j][1] * rs * g[1], v[j][2] * rs * g[2], v[j][3] * rs * g[3]}; *(f32x4*)(row + j * 256 + lane * 4) = o; }
  }
}

constexpr int NPHASE = 2 + 7 * NLAYER;
DI void run_phase(int ph) {
  if (ph == 0) { phase_prep(); return; }
  if (ph == NPHASE - 1) { phase_final(); return; }
  const int l = (ph - 1) / 7, st = (ph - 1) - l * 7;
  switch (st) {
    case 0: phase_g1(l); break;
    case 1: phase_g2(l); break;
    case 2: phase_attn(l); break;
    case 3: phase_mix(); break;
    case 4: phase_wout(l); break;
    case 5: phase_mlp1(l); break;
    default: phase_mlp2(l); break;
  }
}

__global__ void __launch_bounds__(512) mega(Params p, int ph_lo, int ph_hi) {
  cg::grid_group grid = cg::this_grid();
  for (int ph = ph_lo; ph < ph_hi; ++ph) {
    run_phase(ph);
    if (ph + 1 < ph_hi) grid.sync();
  }
}

extern "C" void kernel_launch(void* const* d_in, const int* in_sizes, int n_in, void* d_out, int out_size, void* d_ws, size_t ws_size, hipStream_t stream) {
  static int grid_blocks = 0;
  if (!grid_blocks) {
    int dev = 0, cus = 0, per_cu = 0;
    (void)hipGetDevice(&dev);
    (void)hipDeviceGetAttribute(&cus, hipDeviceAttributeMultiprocessorCount, dev);
    (void)hipOccupancyMaxActiveBlocksPerMultiprocessor(&per_cu, mega, NTHR, 0);
    if (per_cu > 1) per_cu = 1;
    grid_blocks = cus * per_cu;
    if (ws_size < OFF_END) fprintf(stderr, "kernel_launch: workspace too small: %zu < %zu\n", ws_size, (size_t)OFF_END);
  }
  Params p;
  memset(&p, 0, sizeof(p));
  p.x = (const float*)d_in[0]; p.g_mix = (const float*)d_in[1]; p.w_in = (const float*)d_in[2]; p.q_norm = (const float*)d_in[3];
  p.w_uq = (const float*)d_in[4]; p.kv_norm = (const float*)d_in[5]; p.w_ukv = (const float*)d_in[6]; p.rpb = (const float*)d_in[7];
  p.on_a = (const float*)d_in[8]; p.on_b = (const float*)d_in[9]; p.on_c = (const float*)d_in[10]; p.w_out = (const float*)d_in[11];
  p.g_mlp = (const float*)d_in[12]; p.w_mlp_in = (const float*)d_in[13]; p.w_mlp_out = (const float*)d_in[14]; p.g_final = (const float*)d_in[15];
  p.out = (float*)d_out; p.ws = (char*)d_ws;
  p.qscaleA = (float)(1.4426950408889634 / std::sqrt(96.0));
  p.qscaleB = (float)(1.4426950408889634 * 0.125);
#if ONE_LAUNCH
  int lo = 0, hi = NPHASE;
  void* args[] = {&p, &lo, &hi};
  hipError_t e = hipLaunchCooperativeKernel((void*)mega, dim3(grid_blocks), dim3(NTHR), args, 0, stream);
  if (e != hipSuccess) fprintf(stderr, "cooperative launch failed: %s (grid %d)\n", hipGetErrorString(e), grid_blocks);
#else
  for (int ph = 0; ph < NPHASE; ++ph) hipLaunchKernelGGL(mega, dim3(grid_blocks), dim3(NTHR), 0, stream, p, ph, ph + 1);
#endif
}
```

```cpp
#include <hip/hip_runtime.h>
#include <hip/hip_cooperative_groups.h>
#include <cstdio>
#include <cmath>
#include <cstring>
namespace cg = cooperative_groups;

#ifndef ONE_LAUNCH
#define ONE_LAUNCH 1
#endif

#define DI __device__ __forceinline__
typedef unsigned short bf16_t;
typedef short bf16x8 __attribute__((ext_vector_type(8)));
typedef short s16x4 __attribute__((ext_vector_type(4)));
typedef float f32x16 __attribute__((ext_vector_type(16)));
typedef float f32x2 __attribute__((ext_vector_type(2)));
typedef float f32x4 __attribute__((ext_vector_type(4)));
typedef __bf16 bf2_t __attribute__((ext_vector_type(2)));
typedef unsigned u32x4 __attribute__((ext_vector_type(4)));
typedef unsigned u32x2 __attribute__((ext_vector_type(2)));
typedef __attribute__((address_space(3))) s16x4 lds_s16x4;

constexpr int SEQ = 8192, NB = 4, NTOK = NB * SEQ, DM = 1024, NLAYER = 4;
constexpr int N_IN_PAD = 2560, N_UQ_PAD = 768, N_UKV = 768, DFF = 4096;
constexpr int NTHR = 512;

constexpr size_t SZ_XB = (size_t)NTOK * DM * 2;
constexpr size_t SZ_WIN = (size_t)N_IN_PAD * 1024 * 2, SZ_WUQ = (size_t)N_UQ_PAD * 256 * 2, SZ_WUKV = (size_t)N_UKV * 128 * 2,
                 SZ_WOUT = (size_t)1024 * 1024 * 2, SZ_W1 = (size_t)DFF * 1024 * 2, SZ_W2 = (size_t)1024 * DFF * 2;
constexpr size_t LW_WIN = 0, LW_WUQ = LW_WIN + SZ_WIN, LW_WUKV = LW_WUQ + SZ_WUQ, LW_WOUT = LW_WUKV + SZ_WUKV, LW_W1 = LW_WOUT + SZ_WOUT,
                 LW_W2 = LW_W1 + SZ_W1, LW_SIZE = LW_W2 + SZ_W2;
constexpr size_t OFF_XB = 0, OFF_W = OFF_XB + SZ_XB, OFF_TAB = OFF_W + NLAYER * LW_SIZE;
constexpr size_t OFF_COS32 = OFF_TAB, OFF_SIN32 = OFF_COS32 + (size_t)SEQ * 32 * 4, OFF_COS16 = OFF_SIN32 + (size_t)SEQ * 32 * 4,
                 OFF_SIN16 = OFF_COS16 + (size_t)SEQ * 16 * 4, OFF_ATT = OFF_SIN16 + (size_t)SEQ * 16 * 4;
constexpr size_t SZ_T384 = (size_t)NTOK * 384 * 2, SZ_QA = (size_t)NB * 6 * SEQ * 96 * 2, SZ_H6 = (size_t)NB * 6 * SEQ * 64 * 2,
                 SZ_H4 = (size_t)NB * 4 * SEQ * 64 * 2;
constexpr size_t OFF_CQKV = OFF_ATT;
constexpr size_t OFF_OA = OFF_CQKV;
constexpr size_t OFF_QA = OFF_CQKV + SZ_T384, OFF_KA = OFF_QA + SZ_QA, OFF_VA = OFF_KA + SZ_QA;
constexpr size_t OFF_QB = OFF_VA + SZ_H6, OFF_KB = OFF_QB + SZ_H6, OFF_VB = OFF_KB + SZ_H6;
constexpr size_t OFF_QC = OFF_VB + SZ_H6, OFF_KC = OFF_QC + SZ_H4, OFF_VC = OFF_KC + SZ_H4;
constexpr size_t OFF_OB = OFF_VC + SZ_H4, OFF_LSEB = OFF_OB + 3 * SZ_T384, OFF_OC = OFF_LSEB + (size_t)3 * NTOK * 6 * 4;
constexpr size_t OFF_SSQ = OFF_OC + (size_t)NTOK * 256 * 2;
constexpr size_t OFF_PX1 = OFF_SSQ, OFF_PX2 = OFF_PX1 + (size_t)NTOK * 16 * 4, OFF_PQ = OFF_PX2 + (size_t)NTOK * 16 * 4, OFF_PKV = OFF_PQ + (size_t)NTOK * 4 * 4;
constexpr size_t OFF_END = OFF_PKV + (size_t)NTOK * 2 * 4;
constexpr size_t OFF_MIXED = OFF_QA;
constexpr size_t OFF_HID = OFF_ATT;
static_assert(OFF_HID + (size_t)NTOK * DFF * 2 <= OFF_SSQ, "hid fits");
static_assert(OFF_MIXED + (size_t)NTOK * DM * 2 <= OFF_VA, "mixed fits");

struct Params {
  const float *x, *g_mix, *w_in, *q_norm, *w_uq, *kv_norm, *w_ukv, *rpb, *on_a, *on_b, *on_c, *w_out, *g_mlp, *w_mlp_in, *w_mlp_out, *g_final;
  float* out; char* ws;
  float qscaleA, qscaleB;
};
__shared__ __attribute__((aligned(1024))) char g_smem[131072];
#define NI __device__ __forceinline__
DI const Params& kparams() { return *(const Params*)__builtin_amdgcn_kernarg_segment_ptr(); }

DI unsigned cvtpk(float lo, float hi) { f32x2 v = {lo, hi}; bf2_t b = __builtin_convertvector(v, bf2_t); return __builtin_bit_cast(unsigned, b); }
DI bf16_t f2bf(float x) { return (bf16_t)(cvtpk(x, 0.f) & 0xffffu); }
DI float bf2f(unsigned h) { return __uint_as_float(h << 16); }
DI int crow(int i, int h) { return (i & 3) + 8 * (i >> 2) + 4 * h; }
#define MFMA32(a, b, c) __builtin_amdgcn_mfma_f32_32x32x16_bf16((a), (b), (c), 0, 0, 0)
DI float fdot2bf(unsigned a, float c) { bf2_t v = __builtin_bit_cast(bf2_t, a); return __builtin_amdgcn_fdot2_f32_bf16(v, v, c, false); }
DI float swap_max(float v) { auto rr = __builtin_amdgcn_permlane32_swap(__float_as_uint(v), __float_as_uint(v), false, false); return fmaxf(__uint_as_float(rr[0]), __uint_as_float(rr[1])); }
DI float swap_sum(float v) { auto rr = __builtin_amdgcn_permlane32_swap(__float_as_uint(v), __float_as_uint(v), false, false); return __uint_as_float(rr[0]) + __uint_as_float(rr[1]); }

constexpr int ATT_LDS = 24576;
#define FOR_TILES(NN, MT, NT, BODY) { const bool xm_ = gridDim.x == 256; const int st_ = xm_ ? (bid >> 3) : bid, sp_ = xm_ ? 32 : (int)gridDim.x, cn_ = xm_ ? 16 * (NN) : (NTOK / 256) * (NN); \
  for (int j_ = st_; j_ < cn_; j_ += sp_) { int MT = j_ / (NN); const int NT = j_ - MT * (NN); if (xm_) MT += (bid & 7) * 16; BODY } }
DI int otid() { int t = threadIdx.x; asm volatile("" : "+v"(t)); return t; }
DI int obid() { int t = blockIdx.x; asm volatile("" : "+s"(t)); return t; }

template <int NSLOT, class Epi>
DI void gemm_tile(const bf16_t* __restrict__ A, int lda, const bf16_t* __restrict__ Bt, int ldb, int K, int m0, int n0, const Epi& epi, const int tid, const float* pin) {
  const int lane = tid & 63, w = tid >> 6, wm = w >> 2, wn = w & 3, r32 = lane & 31, hi = lane >> 5;
  char* smem = g_smem;
  const int lrow = lane >> 3;
  const int c0 = (lane & 7) ^ (lane >> 4), c1 = (lane & 7) ^ ((lane >> 4) | 4);
  const char* Ab = (const char*)(A + (size_t)m0 * lda);
  const char* Bb = (const char*)(Bt + (size_t)n0 * ldb);
  const unsigned oa0 = (unsigned)(((w * 32 + lrow) * lda + c0 * 8) * 2), oa1 = (unsigned)(((w * 32 + lrow) * lda + c1 * 8) * 2);
  const unsigned ob0 = (unsigned)(((w * 32 + lrow) * ldb + c0 * 8) * 2), ob1 = (unsigned)(((w * 32 + lrow) * ldb + c1 * 8) * 2);
  const int dma_off = (w * 32) * 128 + lane * 16;
  f32x16 acc[4][2];
#pragma unroll
  for (int mi = 0; mi < 4; ++mi)
#pragma unroll
    for (int nj = 0; nj < 2; ++nj)
#pragma unroll
      for (int i = 0; i < 16; ++i) acc[mi][nj][i] = 0.f;
  const int nk = K >> 6;
  const int sw = (r32 >> 1) & 7, sh = sw >> 1, lo16 = 16 * (hi ^ (sw & 1));
  const int a_off = (wm * 128 + r32) * 128 + lo16;
  const int b_off = 32768 + (wn * 64 + r32) * 128 + lo16;
  __syncthreads();
  {
    char* sa = smem + dma_off;
#pragma unroll
    for (int j = 0; j < 4; ++j) {
      __builtin_amdgcn_global_load_lds((const unsigned*)(Ab + (size_t)(j * 8 * lda) * 2 + ((j & 1) ? oa1 : oa0)), (unsigned*)(sa + j * 1024), 16, 0, 0);
      __builtin_amdgcn_global_load_lds((const unsigned*)(Bb + (size_t)(j * 8 * ldb) * 2 + ((j & 1) ? ob1 : ob0)), (unsigned*)(sa + 32768 + j * 1024), 16, 0, 0);
    }
  }
  for (int kt = 0; kt < nk; ++kt) {
    __syncthreads();
    if (kt + 1 < nk) {
      char* sa = smem + ((kt + 1) & 1) * 65536 + dma_off;
      const int k0 = (kt + 1) * 64;
#pragma unroll
      for (int j = 0; j < 4; ++j) {
        __builtin_amdgcn_global_load_lds((const unsigned*)(Ab + (size_t)(j * 8 * lda + k0) * 2 + ((j & 1) ? oa1 : oa0)), (unsigned*)(sa + j * 1024), 16, 0, 0);
        __builtin_amdgcn_global_load_lds((const unsigned*)(Bb + (size_t)(j * 8 * ldb + k0) * 2 + ((j & 1) ? ob1 : ob0)), (unsigned*)(sa + 32768 + j * 1024), 16, 0, 0);
      }
    }
    const char* sb = smem + (kt & 1) * 65536;
#pragma unroll
    for (int ks = 0; ks < 4; ++ks) {
      const int koff = 32 * (ks ^ sh);
      bf16x8 af[4], bfr[2];
#pragma unroll
      for (int mi = 0; mi < 4; ++mi) af[mi] = *(const bf16x8*)(sb + a_off + mi * 4096 + koff);
#pragma unroll
      for (int nj = 0; nj < 2; ++nj) bfr[nj] = *(const bf16x8*)(sb + b_off + nj * 4096 + koff);
#pragma unroll
      for (int mi = 0; mi < 4; ++mi)
#pragma unroll
        for (int nj = 0; nj < 2; ++nj) acc[mi][nj] = MFMA32(af[mi], bfr[nj], acc[mi][nj]);
    }
  }
  float* rstd_s = (float*)smem;
  if (NSLOT > 0) {
    __syncthreads();
    if (tid < 256) {
      const float* pr = pin + (size_t)(m0 + tid) * NSLOT;
      float sacc = 0.f;
      if (NSLOT >= 4) {
#pragma unroll
        for (int q = 0; q < NSLOT / 4; ++q) { const f32x4 v = *(const f32x4*)(pr + 4 * q); sacc += (v[0] + v[1]) + (v[2] + v[3]); }
      } else {
#pragma unroll
        for (int q = 0; q < NSLOT; ++q) sacc += pr[q];
      }
      rstd_s[tid] = rsqrtf(sacc / (float)K + 1e-6f);
    }
    __syncthreads();
  }
  int lane2 = lane, w2 = w; asm volatile("" : "+v"(lane2), "+v"(w2));
  epi(acc, m0, (w2 >> 2) * 128, n0 + (w2 & 3) * 64, lane2, rstd_s);
}
DI void row_ssq_put(float v, float* dst, int lane) {
  v += __shfl_xor(v, 1); v += __shfl_xor(v, 2); v += __shfl_xor(v, 4); v += __shfl_xor(v, 8); v += __shfl_xor(v, 16);
  if ((lane & 31) == 0) *dst = v;
}

struct EpiG1 {
  bf16_t *cqkv, *KA, *qB, *qC; const float *cos32, *sin32, *cos16, *sin16; float qs; float *pq, *pkv;
  DI void operator()(f32x16 (&acc)[4][2], int m0, int lr0, int col0, int lane, const float* rstd_s) const {
    const int c = lane & 31, h = lane >> 5, cb = col0 >> 6;
    if (cb >= 37) return;
#define G1_ROW const int lr = lr0 + mi * 32 + crow(i, h), tok = m0 + lr, b = tok >> 13, s = tok & 8191; (void)b; (void)s; \
               const float rs = rstd_s[lr]; float v0 = acc[mi][0][i] * rs, v1 = acc[mi][1][i] * rs;
    if (cb < 6) {
#pragma unroll
      for (int mi = 0; mi < 4; ++mi)
#pragma unroll
        for (int i = 0; i < 16; ++i) {
        if ((i & 3) == 0) __builtin_amdgcn_sched_barrier(0);
          G1_ROW
          bf16_t* d = cqkv + (size_t)tok * 384 + cb * 64 + c; d[0] = f2bf(v0); d[32] = f2bf(v1);
          row_ssq_put(v0 * v0 + v1 * v1, cb < 4 ? pq + (size_t)tok * 4 + cb : pkv + (size_t)tok * 2 + (cb - 4), lane);
        }
    } else if (cb == 6) {
#pragma unroll
      for (int mi = 0; mi < 4; ++mi)
#pragma unroll
        for (int i = 0; i < 16; ++i) {
        if ((i & 3) == 0) __builtin_amdgcn_sched_barrier(0);
          G1_ROW
          if (c < 16) {
            const float cs = cos16[s * 16 + c], sn = sin16[s * 16 + c];
            const bf16_t o1 = f2bf(v0 * cs - v1 * sn), o2 = f2bf(v0 * sn + v1 * cs);
#pragma unroll
            for (int hd = 0; hd < 6; ++hd) { bf16_t* d = KA + ((size_t)(b * 6 + hd) * SEQ + s) * 96 + 64 + c; d[0] = o1; d[16] = o2; }
          }
        }
    } else if (cb < 25) {
      const int idx = cb - 7, which = idx / 6, hd = idx - which * 6;
      bf16_t* base = qB + (size_t)which * (SZ_H6 / 2) + (size_t)hd * SEQ * 64 + c;
      const float sc = which == 0 ? qs : 1.f;
      if (which < 2) {
#pragma unroll
        for (int mi = 0; mi < 4; ++mi)
#pragma unroll
          for (int i = 0; i < 16; ++i) {
        if ((i & 3) == 0) __builtin_amdgcn_sched_barrier(0);
            G1_ROW
            const float cs = cos32[s * 32 + c] * sc, sn = sin32[s * 32 + c] * sc;
            bf16_t* d = base + ((size_t)(b * 6) * SEQ + s) * 64;
            d[0] = f2bf(v0 * cs - v1 * sn); d[32] = f2bf(v0 * sn + v1 * cs);
          }
      } else {
#pragma unroll
        for (int mi = 0; mi < 4; ++mi)
#pragma unroll
          for (int i = 0; i < 16; ++i) {
        if ((i & 3) == 0) __builtin_amdgcn_sched_barrier(0);
            G1_ROW
            bf16_t* d = base + ((size_t)(b * 6) * SEQ + s) * 64;
            d[0] = f2bf(v0); d[32] = f2bf(v1);
          }
      }
    } else {
      const int idx = cb - 25, which = idx >> 2, hd = idx & 3;
      bf16_t* base = qC + (size_t)which * (SZ_H4 / 2) + (size_t)hd * SEQ * 64 + c;
      const float sc = which == 0 ? qs : 1.f;
#pragma unroll
      for (int mi = 0; mi < 4; ++mi)
#pragma unroll
        for (int i = 0; i < 16; ++i) {
        if ((i & 3) == 0) __builtin_amdgcn_sched_barrier(0);
          G1_ROW
          bf16_t* d = base + ((size_t)(b * 4) * SEQ + s) * 64;
          d[0] = f2bf(v0 * sc); d[32] = f2bf(v1 * sc);
        }
    }
#undef G1_ROW
  }
};
struct EpiUQ {
  bf16_t* QA; const float *cos16, *sin16; float qs;
  DI void operator()(f32x16 (&acc)[4][2], int m0, int lr0, int col0, int lane, const float* rstd_s) const {
    const int c = lane & 31, h = lane >> 5, cb = col0 >> 6;
    if (cb >= 9) return;
#pragma unroll
    for (int mi = 0; mi < 4; ++mi)
#pragma unroll
      for (int i = 0; i < 16; ++i) {
        if ((i & 3) == 0) __builtin_amdgcn_sched_barrier(0);
        const int lr = lr0 + mi * 32 + crow(i, h), tok = m0 + lr, b = tok >> 13, s = tok & 8191;
        const float rs = rstd_s[lr] * qs;
        const float v0 = acc[mi][0][i] * rs, v1 = acc[mi][1][i] * rs;
        if (cb < 6) {
          bf16_t* d = QA + ((size_t)(b * 6 + cb) * SEQ + s) * 96 + c; d[0] = f2bf(v0); d[32] = f2bf(v1);
        } else {
          const int hd = 2 * (cb - 6) + (c >> 4), fi = c & 15;
          const float cs = cos16[s * 16 + fi], sn = sin16[s * 16 + fi];
          bf16_t* d = QA + ((size_t)(b * 6 + hd) * SEQ + s) * 96 + 64 + fi;
          d[0] = f2bf(v0 * cs - v1 * sn); d[16] = f2bf(v0 * sn + v1 * cs);
        }
      }
  }
};
struct EpiUKV {
  bf16_t *KA, *VA;
  DI void operator()(f32x16 (&acc)[4][2], int m0, int lr0, int col0, int lane, const float* rstd_s) const {
    const int c = lane & 31, h = lane >> 5, cb = col0 >> 6, hd = cb >> 1, isv = cb & 1;
#pragma unroll
    for (int mi = 0; mi < 4; ++mi)
#pragma unroll
      for (int i = 0; i < 16; ++i) {
        if ((i & 3) == 0) __builtin_amdgcn_sched_barrier(0);
        const int lr = lr0 + mi * 32 + crow(i, h), tok = m0 + lr, b = tok >> 13, s = tok & 8191;
        const float rs = rstd_s[lr];
        const float v0 = acc[mi][0][i] * rs, v1 = acc[mi][1][i] * rs;
        bf16_t* d = isv ? VA + ((size_t)(b * 6 + hd) * SEQ + s) * 64 + c : KA + ((size_t)(b * 6 + hd) * SEQ + s) * 96 + c;
        d[0] = f2bf(v0); d[32] = f2bf(v1);
      }
  }
};
struct EpiRes {
  const float* xold; float* xf; bf16_t* xb; float* pout;
  DI void operator()(f32x16 (&acc)[4][2], int m0, int lr0, int col0, int lane, const float* rstd_s) const {
    const int c = lane & 31, h = lane >> 5;
#pragma unroll
    for (int mi = 0; mi < 4; ++mi)
#pragma unroll
      for (int i = 0; i < 16; ++i) {
        if ((i & 3) == 0) __builtin_amdgcn_sched_barrier(0);
        const int row = m0 + lr0 + mi * 32 + crow(i, h);
        const size_t o = (size_t)row * DM + col0 + c;
        const float v0 = xold[o] + acc[mi][0][i], v1 = xold[o + 32] + acc[mi][1][i];
        xf[o] = v0; xf[o + 32] = v1; xb[o] = f2bf(v0); xb[o + 32] = f2bf(v1);
        row_ssq_put(v0 * v0 + v1 * v1, pout + (size_t)row * 16 + (col0 >> 6), lane);
      }
  }
};
struct EpiMlp1 {
  bf16_t* hid;
  DI void operator()(f32x16 (&acc)[4][2], int m0, int lr0, int col0, int lane, const float* rstd_s) const {
    const int c = lane & 31, h = lane >> 5;
#pragma unroll
    for (int mi = 0; mi < 4; ++mi)
#pragma unroll
      for (int i = 0; i < 16; ++i) {
        if ((i & 3) == 0) __builtin_amdgcn_sched_barrier(0);
        const int lr = lr0 + mi * 32 + crow(i, h);
        const float rs = rstd_s[lr];
        const float v0 = fmaxf(acc[mi][0][i] * rs, 0.f), v1 = fmaxf(acc[mi][1][i] * rs, 0.f);
        bf16_t* d = hid + (size_t)(m0 + lr) * DFF + col0 + c; d[0] = f2bf(v0 * v0); d[32] = f2bf(v1 * v1);
      }
  }
};

struct AttnItem {
  const bf16_t *Q, *K, *V;
  int q0;
  int n0, dil, res, N;
  int nrb, ncb, kr0, kc0;
  bf16_t* out; int ldo;
  float* lse;
  const float* rpb;
};

template <int DQ, int MODE>
DI void attn_block(const AttnItem& it, char* smem, const int tid) {
  constexpr int CPR = DQ / 8, KST = DQ * 2 + 16, KCH = (64 * CPR) / 256, NT = MODE == 0 ? SEQ / 64 : MODE == 1 ? 4 : 8;
  const int lane = tid & 63, w = tid >> 6, r32 = lane & 31, hi = lane >> 5;
  char* Ks = smem; char* Vs = smem + 64 * KST; float* bias_s = (float*)(smem + 64 * KST + 8192);
  const int qi = w * 32 + r32;
  int qpos;
  if (MODE == 0) qpos = it.q0 + qi;
  else if (MODE == 1) qpos = (it.n0 + qi) * it.dil + it.res;
  else qpos = (8 * it.nrb + (qi >> 4)) * 64 + 16 * it.ncb + (qi & 15);
  __syncthreads();
  if (MODE == 2) { for (int i = tid; i < 465; i += 256) bias_s[i] = it.rpb[i] * 1.4426950408889634f; }
  bf16x8 qr[DQ / 16];
#pragma unroll
  for (int d0 = 0; d0 < DQ / 16; ++d0) qr[d0] = *(const bf16x8*)(it.Q + (size_t)qpos * DQ + d0 * 16 + hi * 8);
  f32x16 o[2];
#pragma unroll
  for (int i = 0; i < 16; ++i) { o[0][i] = 0.f; o[1][i] = 0.f; }
  float m_run = -1e30f, l_run = 0.f;
  u32x4 rk[KCH], rv[2];
  auto kpos = [&](int t, int row) -> int {
    if (MODE == 0) return t * 64 + row;
    if (MODE == 1) { int n = it.n0 - 64 + 64 * t + row; n = n < 0 ? 0 : (n > it.N - 1 ? it.N - 1 : n); return n * it.dil + it.res; }
    return (it.kr0 + 2 * t + (row >> 5)) * 64 + it.kc0 + (row & 31);
  };
  auto load = [&](int t) {
#pragma unroll
    for (int i = 0; i < KCH; ++i) { const int c = tid + 256 * i, row = c / CPR, kc = c - row * CPR; rk[i] = *(const u32x4*)(it.K + (size_t)kpos(t, row) * DQ + kc * 8); }
#pragma unroll
    for (int i = 0; i < 2; ++i) { const int c = tid + 256 * i, row = c >> 3, kc = c & 7; rv[i] = *(const u32x4*)(it.V + (size_t)kpos(t, row) * 64 + kc * 8); }
  };
  const int vrd = ((lane >> 5) * 4 + ((lane & 15) >> 2)) * 64 + ((lane >> 4) & 1) * 32 + (lane & 3) * 8;
  load(0);
  for (int t = 0; t < NT; ++t) {
    __syncthreads();
#pragma unroll
    for (int i = 0; i < KCH; ++i) { const int c = tid + 256 * i, row = c / CPR, kc = c - row * CPR; *(u32x4*)(Ks + row * KST + kc * 16) = rk[i]; }
#pragma unroll
    for (int i = 0; i < 2; ++i) { const int c = tid + 256 * i, row = c >> 3, kc = c & 7; *(u32x4*)(Vs + (kc >> 2) * 4096 + row * 64 + (kc & 3) * 16) = rv[i]; }
    __syncthreads();
    if (t + 1 < NT) load(t + 1);
    bool skip = false;
    if (MODE == 1) skip = (w < 2) ? (t == 3) : (t == 0);
    if (MODE == 2) {
      const int rq_lo = 8 * it.nrb + 2 * w, rq_hi = rq_lo + 1;
      const int rs_lo = min(max(rq_lo - 4, 0), 120), rs_hi = min(max(rq_hi - 4, 0), 120) + 7;
      const int kr = it.kr0 + 2 * t;
      skip = (kr + 1 < rs_lo) || (kr > rs_hi);
    }
    if (skip) continue;
    f32x16 p0, p1;
#pragma unroll
    for (int i = 0; i < 16; ++i) { p0[i] = 0.f; p1[i] = 0.f; }
#pragma unroll
    for (int d0 = 0; d0 < DQ / 16; ++d0) {
      const bf16x8 k0 = *(const bf16x8*)(Ks + r32 * KST + d0 * 32 + hi * 16);
      const bf16x8 k1 = *(const bf16x8*)(Ks + (32 + r32) * KST + d0 * 32 + hi * 16);
      p0 = MFMA32(k0, qr[d0], p0); p1 = MFMA32(k1, qr[d0], p1);
    }
    if (MODE == 1) {
      const int nq = it.n0 + qi, kb = it.n0 - 64 + 64 * t;
#pragma unroll
      for (int i = 0; i < 16; ++i) {
        const int nk = kb + crow(i, hi), nk2 = nk + 32;
        const int d1 = nq - nk, d2 = nq - nk2;
        const bool ok1 = (d1 <= 64) && (d1 >= -64) && (nk >= 0) && (nk < it.N);
        const bool ok2 = (d2 <= 64) && (d2 >= -64) && (nk2 >= 0) && (nk2 < it.N);
        p0[i] = ok1 ? p0[i] : -INFINITY; p1[i] = ok2 ? p1[i] : -INFINITY;
      }
    }
    if (MODE == 2) {
      const int rq = 8 * it.nrb + (qi >> 4), cq = 16 * it.ncb + (qi & 15);
      const int rs_ = min(max(rq - 4, 0), 120), cs_ = min(max(cq - 8, 0), 48);
      const int kr = it.kr0 + 2 * t;
      const bool okr0 = (kr >= rs_) && (kr < rs_ + 8), okr1 = (kr + 1 >= rs_) && (kr + 1 < rs_ + 8);
      const int bi0 = (kr - rq + 7) * 31 - cq + 15;
#pragma unroll
      for (int i = 0; i < 16; ++i) {
        const int kc = it.kc0 + crow(i, hi);
        const bool okc = (kc >= cs_) && (kc < cs_ + 16);
        const bool ok0 = okc && okr0, ok1 = okc && okr1;
        const float b0 = bias_s[ok0 ? bi0 + kc : 0], b1 = bias_s[ok1 ? bi0 + 31 + kc : 0];
        p0[i] = ok0 ? p0[i] + b0 : -INFINITY; p1[i] = ok1 ? p1[i] + b1 : -INFINITY;
      }
    }
    float pmax = p0[0];
#pragma unroll
    for (int i = 1; i < 16; ++i) pmax = fmaxf(pmax, p0[i]);
#pragma unroll
    for (int i = 0; i < 16; ++i) pmax = fmaxf(pmax, p1[i]);
    pmax = swap_max(pmax);
    const float mn = fmaxf(m_run, pmax);
    const float alpha = __builtin_amdgcn_exp2f(m_run - mn);
    m_run = mn;
    float ps = 0.f;
#pragma unroll
    for (int i = 0; i < 16; ++i) { p0[i] = __builtin_amdgcn_exp2f(p0[i] - mn); ps += p0[i]; }
#pragma unroll
    for (int i = 0; i < 16; ++i) { p1[i] = __builtin_amdgcn_exp2f(p1[i] - mn); ps += p1[i]; }
    ps = swap_sum(ps);
    l_run = l_run * alpha + ps;
#pragma unroll
    for (int i = 0; i < 16; ++i) { o[0][i] *= alpha; o[1][i] *= alpha; }
    bf16x8 pb[4];
#pragma unroll
    for (int s = 0; s < 2; ++s) {
      u32x4 a = {cvtpk(p0[8 * s], p0[8 * s + 1]), cvtpk(p0[8 * s + 2], p0[8 * s + 3]), cvtpk(p0[8 * s + 4], p0[8 * s + 5]), cvtpk(p0[8 * s + 6], p0[8 * s + 7])};
      u32x4 b = {cvtpk(p1[8 * s], p1[8 * s + 1]), cvtpk(p1[8 * s + 2], p1[8 * s + 3]), cvtpk(p1[8 * s + 4], p1[8 * s + 5]), cvtpk(p1[8 * s + 6], p1[8 * s + 7])};
      pb[s] = __builtin_bit_cast(bf16x8, a); pb[2 + s] = __builtin_bit_cast(bf16x8, b);
    }
#pragma unroll
    for (int db = 0; db < 2; ++db)
#pragma unroll
      for (int s = 0; s < 4; ++s) {
        const s16x4 lo = __builtin_amdgcn_ds_read_tr16_b64_v4i16((lds_s16x4*)(Vs + db * 4096 + (16 * s) * 64 + vrd));
        const s16x4 hh = __builtin_amdgcn_ds_read_tr16_b64_v4i16((lds_s16x4*)(Vs + db * 4096 + (16 * s + 8) * 64 + vrd));
        const bf16x8 a = {lo[0], lo[1], lo[2], lo[3], hh[0], hh[1], hh[2], hh[3]};
        o[db] = MFMA32(a, pb[s], o[db]);
      }
  }
  const float inv = 1.f / l_run;
  const int bq = qpos;
  bf16_t* orow = it.out + (size_t)bq * it.ldo;
#pragma unroll
  for (int db = 0; db < 2; ++db)
#pragma unroll
    for (int g = 0; g < 4; ++g) {
      u32x2 v = {cvtpk(o[db][4 * g] * inv, o[db][4 * g + 1] * inv), cvtpk(o[db][4 * g + 2] * inv, o[db][4 * g + 3] * inv)};
      *(u32x2*)(orow + db * 32 + 8 * g + 4 * hi) = v;
    }
  if (MODE == 1) { if (hi == 0) it.lse[(size_t)bq * 6] = m_run + __builtin_amdgcn_logf(l_run); }
}

DI float wave_sum(float v) {
  v += __shfl_xor(v, 32); v += __shfl_xor(v, 16); v += __shfl_xor(v, 8); v += __shfl_xor(v, 4); v += __shfl_xor(v, 2); v += __shfl_xor(v, 1); return v;
}
DI float gain_of(const Params& p, int kind, int l, int k) {
  switch (kind) {
    case 0: return p.g_mix[l * 1024 + k];
    case 1: return p.q_norm[l * 256 + k];
    case 2: return p.kv_norm[l * 128 + k];
    case 3: return k < 384 ? p.on_a[l * 384 + k] : (k < 768 ? p.on_b[l * 384 + k - 384] : p.on_c[l * 256 + k - 768]);
    case 4: return p.g_mlp[l * 1024 + k];
    default: return 1.f;
  }
}
DI int map_col(int kind, int n) {
  if (kind == 0) {
    if (n < 384) return n;
    if (n < 448) { const int wv = n - 384, c = wv & 31, sub = wv >> 5; return c < 16 ? 384 + sub * 16 + c : -1; }
    if (n < 1600) return 416 + (n - 448);
    if (n < 2368) return 1568 + (n - 1600);
    return -1;
  }
  if (kind == 1) {
    if (n < 384) return (n >> 6) * 96 + (n & 63);
    if (n < 576) { const int wv = n - 384, g = wv >> 6, wi = wv & 63, sub = wi >> 5, c = wi & 31, hd = 2 * g + (c >> 4), fi = c & 15; return hd * 96 + 64 + sub * 16 + fi; }
    return -1;
  }
  return n;
}
DI void wtile(const Params& p, const float* src, int Nsrc, bf16_t* dst, int K, int kt, int nt, int kind, int l, char* smem, const int tid) {
  float* tile = (float*)smem;
  const int lane = tid & 63, wv = tid >> 6;
  __syncthreads();
  const int n = nt * 64 + lane, sc = map_col(kind, n);
#pragma unroll 4
  for (int r = 0; r < 8; ++r) {
    const int kl = r * 8 + wv, k = kt * 64 + kl;
    float v = 0.f;
    if (sc >= 0) v = src[(size_t)k * Nsrc + sc] * gain_of(p, kind, l, k);
    tile[kl * 65 + lane] = v;
  }
  __syncthreads();
#pragma unroll 4
  for (int r = 0; r < 8; ++r) {
    const int nl = r * 8 + wv;
    dst[(size_t)(nt * 64 + nl) * K + kt * 64 + lane] = f2bf(tile[lane * 65 + nl]);
  }
}

NI void phase_prep() {
  const Params& p = kparams(); char* smem = g_smem; const int tid = otid(), bid = obid();
  char* ws = p.ws;
  constexpr int T_WIN = (N_IN_PAD / 64) * 16, T_WUQ = (N_UQ_PAD / 64) * 4, T_WUKV = (N_UKV / 64) * 2, T_WOUT = 16 * 16, T_W1 = 64 * 16, T_W2 = 16 * 64;
  constexpr int T_L = T_WIN + T_WUQ + T_WUKV + T_WOUT + T_W1 + T_W2;
  for (int j = bid; j < NLAYER * T_L; j += gridDim.x) {
    const int l = j / T_L; int r = j - l * T_L;
    char* lw = ws + OFF_W + (size_t)l * LW_SIZE;
    if (r < T_WIN) { wtile(p, p.w_in + (size_t)l * 1024 * 2336, 2336, (bf16_t*)(lw + LW_WIN), 1024, r & 15, r >> 4, 0, l, smem, tid); continue; }
    r -= T_WIN;
    if (r < T_WUQ) { wtile(p, p.w_uq + (size_t)l * 256 * 576, 576, (bf16_t*)(lw + LW_WUQ), 256, r & 3, r >> 2, 1, l, smem, tid); continue; }
    r -= T_WUQ;
    if (r < T_WUKV) { wtile(p, p.w_ukv + (size_t)l * 128 * 768, 768, (bf16_t*)(lw + LW_WUKV), 128, r & 1, r >> 1, 2, l, smem, tid); continue; }
    r -= T_WUKV;
    if (r < T_WOUT) { wtile(p, p.w_out + (size_t)l * 1024 * 1024, 1024, (bf16_t*)(lw + LW_WOUT), 1024, r & 15, r >> 4, 3, l, smem, tid); continue; }
    r -= T_WOUT;
    if (r < T_W1) { wtile(p, p.w_mlp_in + (size_t)l * 1024 * 4096, 4096, (bf16_t*)(lw + LW_W1), 1024, r & 15, r >> 4, 4, l, smem, tid); continue; }
    r -= T_W1;
    wtile(p, p.w_mlp_out + (size_t)l * 4096 * 1024, 1024, (bf16_t*)(lw + LW_W2), 4096, r & 63, r >> 6, 5, l, smem, tid);
  }
  const size_t gtid = (size_t)bid * NTHR + tid, gsz = (size_t)gridDim.x * NTHR;
  bf16_t* xb = (bf16_t*)(ws + OFF_XB);
  {
    const int lane = tid & 63, gw = bid * (NTHR / 64) + (tid >> 6), nw = gridDim.x * (NTHR / 64);
    float* px1 = (float*)(ws + OFF_PX1);
    for (int row = gw; row < NTOK; row += nw) {
      float ss = 0.f;
#pragma unroll
      for (int j = 0; j < 4; ++j) {
        const f32x4 a = *(const f32x4*)(p.x + (size_t)row * DM + j * 256 + lane * 4);
        ss += a[0] * a[0] + a[1] * a[1] + a[2] * a[2] + a[3] * a[3];
        u32x2 o = {cvtpk(a[0], a[1]), cvtpk(a[2], a[3])};
        *(u32x2*)(xb + (size_t)row * DM + j * 256 + lane * 4) = o;
      }
      ss = wave_sum(ss);
      if (lane < 16) px1[(size_t)row * 16 + lane] = lane == 0 ? ss : 0.f;
    }
  }
  float* c32 = (float*)(ws + OFF_COS32); float* s32 = (float*)(ws + OFF_SIN32); float* c16 = (float*)(ws + OFF_COS16); float* s16 = (float*)(ws + OFF_SIN16);
  for (size_t i = gtid; i < (size_t)SEQ * 48; i += gsz) {
    int pos, fi; float invf; float *cd, *sd;
    if (i < (size_t)SEQ * 32) { pos = (int)(i >> 5); fi = (int)(i & 31); invf = __builtin_amdgcn_exp2f(-(float)fi * (13.287712379549449f / 32.f)); cd = c32 + i; sd = s32 + i; }
    else { const size_t j = i - (size_t)SEQ * 32; pos = (int)(j >> 4); fi = (int)(j & 15); invf = __builtin_amdgcn_exp2f(-(float)fi * (13.287712379549449f / 16.f)); cd = c16 + j; sd = s16 + j; }
    const float ang = (float)pos * invf;
    const double rev = (double)ang * 0.15915494309189535;
    const float fr = (float)(rev - rint(rev));
    *cd = __builtin_amdgcn_cosf(fr); *sd = __builtin_amdgcn_sinf(fr);
  }
}

NI void phase_g1(int l_) {
  const Params& p = kparams(); char* smem = g_smem; const int l = __builtin_amdgcn_readfirstlane(l_); const int tid = otid(), bid = obid(); (void)tid; (void)bid;
  char* ws = p.ws;
  EpiG1 e;
  e.cqkv = (bf16_t*)(ws + OFF_CQKV); e.KA = (bf16_t*)(ws + OFF_KA); e.qB = (bf16_t*)(ws + OFF_QB); e.qC = (bf16_t*)(ws + OFF_QC);
  e.cos32 = (const float*)(ws + OFF_COS32); e.sin32 = (const float*)(ws + OFF_SIN32); e.cos16 = (const float*)(ws + OFF_COS16); e.sin16 = (const float*)(ws + OFF_SIN16);
  e.qs = p.qscaleB; e.pq = (float*)(ws + OFF_PQ); e.pkv = (float*)(ws + OFF_PKV);
  const bf16_t* A = (const bf16_t*)(ws + OFF_XB);
  const bf16_t* Bt = (const bf16_t*)(ws + OFF_W + (size_t)l * LW_SIZE + LW_WIN);
  constexpr int NNT = N_IN_PAD / 256;
  FOR_TILES(NNT, mt, nt, gemm_tile<16>(A, 1024, Bt, 1024, 1024, mt * 256, nt * 256, e, tid, (const float*)(ws + OFF_PX1));)
}
NI void phase_g2(int l_) {
  const Params& p = kparams(); char* smem = g_smem; const int l = __builtin_amdgcn_readfirstlane(l_); const int tid = otid(), bid = obid(); (void)tid; (void)bid;
  char* ws = p.ws;
  const bf16_t* A = (const bf16_t*)(ws + OFF_CQKV);
  EpiUQ eq; eq.QA = (bf16_t*)(ws + OFF_QA); eq.cos16 = (const float*)(ws + OFF_COS16); eq.sin16 = (const float*)(ws + OFF_SIN16); eq.qs = p.qscaleA;
  EpiUKV ek; ek.KA = (bf16_t*)(ws + OFF_KA); ek.VA = (bf16_t*)(ws + OFF_VA);
  const bf16_t* Wq = (const bf16_t*)(ws + OFF_W + (size_t)l * LW_SIZE + LW_WUQ);
  const bf16_t* Wkv = (const bf16_t*)(ws + OFF_W + (size_t)l * LW_SIZE + LW_WUKV);
  FOR_TILES(3, mt, nt, gemm_tile<4>(A, 384, Wq, 256, 256, mt * 256, nt * 256, eq, tid, (const float*)(ws + OFF_PQ));)
  FOR_TILES(3, mt, nt, gemm_tile<2>(A + 256, 384, Wkv, 128, 128, mt * 256, nt * 256, ek, tid, (const float*)(ws + OFF_PKV));)
}
NI void phase_attn(int l_) {
  const Params& p = kparams(); char* smem = g_smem; const int l = __builtin_amdgcn_readfirstlane(l_); const int tid = otid(), bid = obid(); (void)tid; (void)bid;
  char* ws = p.ws;
  constexpr int NA = 1536, NBI = 4608, NC = 1024;
  const int grp = tid >> 8, t256 = tid & 255; char* gsm = smem + grp * ATT_LDS;
  for (int i0 = bid * 2; i0 < NA; i0 += gridDim.x * 2) {
    AttnItem it{};
    const int i = i0 + grp, xcd = (i >> 1) & 7, j = ((i >> 4) << 1) | (i & 1);
    const int bh = (j >> 6) * 8 + xcd, qb = j & 63, b = bh / 6, h = bh - b * 6;
    it.Q = (const bf16_t*)(ws + OFF_QA) + (size_t)bh * SEQ * 96; it.K = (const bf16_t*)(ws + OFF_KA) + (size_t)bh * SEQ * 96; it.V = (const bf16_t*)(ws + OFF_VA) + (size_t)bh * SEQ * 64;
    it.q0 = qb * 128; it.out = (bf16_t*)(ws + OFF_OA) + (size_t)b * SEQ * 384 + h * 64; it.ldo = 384;
    attn_block<96, 0>(it, gsm, t256);
  }
  for (int i0 = bid * 2; i0 < NBI; i0 += gridDim.x * 2) {
    AttnItem it{};
    const int i = i0 + grp, xcd = (i >> 1) & 7, j = ((i >> 4) << 1) | (i & 1);
    const int g = (j >> 6) * 8 + xcd, c = j & 63, br = g / 24, bh = g - br * 24, b = bh / 6, h = bh - b * 6;
    const int dil = br == 0 ? 1 : (br == 1 ? 4 : 16), cpr = 64 / dil;
    it.Q = (const bf16_t*)(ws + OFF_QB) + (size_t)bh * SEQ * 64; it.K = (const bf16_t*)(ws + OFF_KB) + (size_t)bh * SEQ * 64; it.V = (const bf16_t*)(ws + OFF_VB) + (size_t)bh * SEQ * 64;
    it.dil = dil; it.res = c / cpr; it.n0 = (c - it.res * cpr) * 128; it.N = SEQ / dil;
    it.out = (bf16_t*)(ws + OFF_OB) + (size_t)br * NTOK * 384 + (size_t)b * SEQ * 384 + h * 64; it.ldo = 384;
    it.lse = (float*)(ws + OFF_LSEB) + (size_t)br * NTOK * 6 + (size_t)b * SEQ * 6 + h;
    attn_block<64, 1>(it, gsm, t256);
  }
  for (int i0 = bid * 2; i0 < NC; i0 += gridDim.x * 2) {
    AttnItem it{};
    const int i = i0 + grp, xcd = (i >> 1) & 7, j = ((i >> 4) << 1) | (i & 1);
    const int bh = (j >> 6) * 8 + xcd, blk = j & 63, b = bh >> 2, h = bh & 3;
    it.Q = (const bf16_t*)(ws + OFF_QC) + (size_t)bh * SEQ * 64; it.K = (const bf16_t*)(ws + OFF_KC) + (size_t)bh * SEQ * 64; it.V = (const bf16_t*)(ws + OFF_VC) + (size_t)bh * SEQ * 64;
    it.nrb = blk >> 2; it.ncb = blk & 3;
    it.kr0 = min(max(8 * it.nrb - 4, 0), 112); it.kc0 = min(max(16 * it.ncb - 8, 0), 32);
    it.out = (bf16_t*)(ws + OFF_OC) + (size_t)b * SEQ * 256 + h * 64; it.ldo = 256;
    it.rpb = p.rpb + ((size_t)l * 4 + h) * 465;
    attn_block<64, 2>(it, gsm, t256);
  }
}
NI void phase_mix() {
  const Params& p = kparams(); const int tid = otid(), bid = obid();
  char* ws = p.ws;
  const int lane = tid & 63, gw = bid * (NTHR / 64) + (tid >> 6), nw = gridDim.x * (NTHR / 64);
  const bf16_t* oA = (const bf16_t*)(ws + OFF_OA); const bf16_t* oB = (const bf16_t*)(ws + OFF_OB); const bf16_t* oC = (const bf16_t*)(ws + OFF_OC);
  const float* lse = (const float*)(ws + OFF_LSEB);
  bf16_t* mixed = (bf16_t*)(ws + OFF_MIXED);
  for (int tok = gw; tok < NTOK; tok += nw) {
    float v[16];
    if (lane < 24 || lane >= 48) {
      const bf16_t* src = lane < 24 ? oA + (size_t)tok * 384 + lane * 16 : oC + (size_t)tok * 256 + (lane - 48) * 16;
      const u32x4 a = *(const u32x4*)src, b = *(const u32x4*)(src + 8);
#pragma unroll
      for (int j = 0; j < 4; ++j) { v[2 * j] = bf2f(a[j] & 0xffffu); v[2 * j + 1] = bf2f(a[j] >> 16); v[8 + 2 * j] = bf2f(b[j] & 0xffffu); v[8 + 2 * j + 1] = bf2f(b[j] >> 16); }
    } else {
      const int col = (lane - 24) * 16, hd = col >> 6;
      const float l0 = lse[(size_t)tok * 6 + hd], l1 = lse[(size_t)NTOK * 6 + (size_t)tok * 6 + hd], l2 = lse[(size_t)2 * NTOK * 6 + (size_t)tok * 6 + hd];
      const float mx = fmaxf(l0, fmaxf(l1, l2));
      float w0 = __builtin_amdgcn_exp2f(l0 - mx), w1 = __builtin_amdgcn_exp2f(l1 - mx), w2 = __builtin_amdgcn_exp2f(l2 - mx);
      const float wi = 1.f / (w0 + w1 + w2); w0 *= wi; w1 *= wi; w2 *= wi;
#pragma unroll
      for (int j = 0; j < 16; ++j) v[j] = 0.f;
#pragma unroll
      for (int br = 0; br < 3; ++br) {
        const float wb = br == 0 ? w0 : (br == 1 ? w1 : w2);
        const bf16_t* src = oB + (size_t)br * NTOK * 384 + (size_t)tok * 384 + col;
        const u32x4 a = *(const u32x4*)src, b = *(const u32x4*)(src + 8);
#pragma unroll
        for (int j = 0; j < 4; ++j) { v[2 * j] += wb * bf2f(a[j] & 0xffffu); v[2 * j + 1] += wb * bf2f(a[j] >> 16); v[8 + 2 * j] += wb * bf2f(b[j] & 0xffffu); v[8 + 2 * j + 1] += wb * bf2f(b[j] >> 16); }
      }
    }
    float ss = 0.f;
#pragma unroll
    for (int j = 0; j < 16; ++j) ss += v[j] * v[j];
    const float sa = wave_sum(lane < 24 ? ss : 0.f), sb = wave_sum((lane >= 24 && lane < 48) ? ss : 0.f), sc = wave_sum(lane >= 48 ? ss : 0.f);
    const float rs = lane < 24 ? rsqrtf(sa * (1.f / 384.f) + 1e-6f) : (lane < 48 ? rsqrtf(sb * (1.f / 384.f) + 1e-6f) : rsqrtf(sc * (1.f / 256.f) + 1e-6f));
    u32x4 oa, ob;
#pragma unroll
    for (int j = 0; j < 4; ++j) { oa[j] = cvtpk(v[2 * j] * rs, v[2 * j + 1] * rs); ob[j] = cvtpk(v[8 + 2 * j] * rs, v[8 + 2 * j + 1] * rs); }
    bf16_t* dst = mixed + (size_t)tok * 1024 + lane * 16;
    *(u32x4*)dst = oa; *(u32x4*)(dst + 8) = ob;
  }
}
NI void phase_wout(int l_) {
  const Params& p = kparams(); char* smem = g_smem; const int l = __builtin_amdgcn_readfirstlane(l_); const int tid = otid(), bid = obid(); (void)tid; (void)bid;
  char* ws = p.ws;
  EpiRes e; e.xold = (l == 0) ? p.x : p.out; e.xf = p.out; e.xb = (bf16_t*)(ws + OFF_XB); e.pout = (float*)(ws + OFF_PX2);
  const bf16_t* A = (const bf16_t*)(ws + OFF_MIXED);
  const bf16_t* Bt = (const bf16_t*)(ws + OFF_W + (size_t)l * LW_SIZE + LW_WOUT);
  FOR_TILES(4, mt, nt, gemm_tile<0>(A, 1024, Bt, 1024, 1024, mt * 256, nt * 256, e, tid, nullptr);)
}
NI void phase_mlp1(int l_) {
  const Params& p = kparams(); char* smem = g_smem; const int l = __builtin_amdgcn_readfirstlane(l_); const int tid = otid(), bid = obid(); (void)tid; (void)bid;
  char* ws = p.ws;
  EpiMlp1 e; e.hid = (bf16_t*)(ws + OFF_HID);
  const bf16_t* A = (const bf16_t*)(ws + OFF_XB);
  const bf16_t* Bt = (const bf16_t*)(ws + OFF_W + (size_t)l * LW_SIZE + LW_W1);
  FOR_TILES(16, mt, nt, gemm_tile<16>(A, 1024, Bt, 1024, 1024, mt * 256, nt * 256, e, tid, (const float*)(ws + OFF_PX2));)
}
NI void phase_mlp2(int l_) {
  const Params& p = kparams(); char* smem = g_smem; const int l = __builtin_amdgcn_readfirstlane(l_); const int tid = otid(), bid = obid(); (void)tid; (void)bid;
  char* ws = p.ws;
  EpiRes e; e.xold = p.out; e.xf = p.out; e.xb = (bf16_t*)(ws + OFF_XB); e.pout = (float*)(ws + OFF_PX1);
  const bf16_t* A = (const bf16_t*)(ws + OFF_HID);
  const bf16_t* Bt = (const bf16_t*)(ws + OFF_W + (size_t)l * LW_SIZE + LW_W2);
  FOR_TILES(4, mt, nt, gemm_tile<0>(A, DFF, Bt, DFF, DFF, mt * 256, nt * 256, e, tid, nullptr);)
}
NI void phase_final() {
  const Params& p = kparams(); const int tid = otid(), bid = obid();
  const int lane = tid & 63, gw = bid * (NTHR / 64) + (tid >> 6), nw = gridDim.x * (NTHR / 64);
  for (int tok = gw; tok < NTOK; tok += nw) {
    float* row = p.out + (size_t)tok * DM;
    f32x4 v[4]; float ss = 0.f;
#pragma unroll
    for (int j = 0; j < 4; ++j) { v[j] = *(const f32x4*)(row + j * 256 + lane * 4); ss += v[j][0] * v[j][0] + v[j][1] * v[j][1] + v[j][2] * v[j][2] + v[j][3] * v[j][3]; }
    ss = wave_sum(ss);
    const float rs = rsqrtf(ss * (1.f / 1024.f) + 1e-6f);
#pragma unroll
    for (int j = 0; j < 4; ++j) { const f32x4 g = *(const f32x4*)(p.g_final + j * 256 + lane * 4); f32x4 o = {v[j][0] * rs * g[0], v[j][1] * rs * g[1], v[j][2] * rs * g[2], v[j][3] * rs * g[3]}; *(f32x4*)(row + j * 256 + lane * 4) = o; }
  }
}

constexpr int NPHASE = 2 + 7 * NLAYER;
DI void run_phase(int ph) {
  if (ph == 0) { phase_prep(); return; }
  if (ph == NPHASE - 1) { phase_final(); return; }
  const int l = (ph - 1) / 7, st = (ph - 1) - l * 7;
  switch (st) {
    case 0: phase_g1(l); break;
    case 1: phase_g2(l); break;
    case 2: phase_attn(l); break;
    case 3: phase_mix(); break;
    case 4: phase_wout(l); break;
    case 5: phase_mlp1(l); break;
    default: phase_mlp2(l); break;
  }
}

__global__ void __launch_bounds__(512) mega(Params p, int ph_lo, int ph_hi) {
  cg::grid_group grid = cg::this_grid();
  for (int ph = ph_lo; ph < ph_hi; ++ph) {
    run_phase(ph);
    if (ph + 1 < ph_hi) grid.sync();
  }
}

extern "C" void kernel_launch(void* const* d_in, const int* in_sizes, int n_in, void* d_out, int out_size, void* d_ws, size_t ws_size, hipStream_t stream) {
  static int grid_blocks = 0;
  if (!grid_blocks) {
    int dev = 0, cus = 0, per_cu = 0;
    (void)hipGetDevice(&dev);
    (void)hipDeviceGetAttribute(&cus, hipDeviceAttributeMultiprocessorCount, dev);
    (void)hipOccupancyMaxActiveBlocksPerMultiprocessor(&per_cu, mega, NTHR, 0);
    if (per_cu > 1) per_cu = 1;
    grid_blocks = cus * per_cu;
    if (ws_size < OFF_END) fprintf(stderr, "kernel_launch: workspace too small: %zu < %zu\n", ws_size, (size_t)OFF_END);
  }
  Params p;
  memset(&p, 0, sizeof(p));
  p.x = (const float*)d_in[0]; p.g_mix = (const float*)d_in[1]; p.w_in = (const float*)d_in[2]; p.q_norm = (const float*)d_in[3];
  p.w_uq = (const float*)d_in[4]; p.kv_norm = (const float*)d_in[5]; p.w_ukv = (const float*)d_in[6]; p.rpb = (const float*)d_in[7];
  p.on_a = (const float*)d_in[8]; p.on_b = (const float*)d_in[9]; p.on_c = (const float*)d_in[10]; p.w_out = (const float*)d_in[11];
  p.g_mlp = (const float*)d_in[12]; p.w_mlp_in = (const float*)d_in[13]; p.w_mlp_out = (const float*)d_in[14]; p.g_final = (const float*)d_in[15];
  p.out = (float*)d_out; p.ws = (char*)d_ws;
  p.qscaleA = (float)(1.4426950408889634 / std::sqrt(96.0));
  p.qscaleB = (float)(1.4426950408889634 * 0.125);
#if ONE_LAUNCH
  int lo = 0, hi = NPHASE;
  void* args[] = {&p, &lo, &hi};
  hipError_t e = hipLaunchCooperativeKernel((void*)mega, dim3(grid_blocks), dim3(NTHR), args, 0, stream);
  if (e != hipSuccess) fprintf(stderr, "cooperative launch failed: %s (grid %d)\n", hipGetErrorString(e), grid_blocks);
#else
  for (int ph = 0; ph < NPHASE; ++ph) hipLaunchKernelGGL(mega, dim3(grid_blocks), dim3(NTHR), 0, stream, p, ph, ph + 1);
#endif
}
```

```cpp
#include <hip/hip_runtime.h>
#include <hip/hip_cooperative_groups.h>
#include <cstdio>
#include <cmath>
#include <cstring>
namespace cg = cooperative_groups;

#ifndef ONE_LAUNCH
#define ONE_LAUNCH 1
#endif

#define DI __device__ __forceinline__
typedef unsigned short bf16_t;
typedef short bf16x8 __attribute__((ext_vector_type(8)));
typedef short s16x4 __attribute__((ext_vector_type(4)));
typedef float f32x16 __attribute__((ext_vector_type(16)));
typedef float f32x2 __attribute__((ext_vector_type(2)));
typedef float f32x4 __attribute__((ext_vector_type(4)));
typedef __bf16 bf2_t __attribute__((ext_vector_type(2)));
typedef unsigned u32x4 __attribute__((ext_vector_type(4)));
typedef unsigned u32x2 __attribute__((ext_vector_type(2)));
typedef __attribute__((address_space(3))) s16x4 lds_s16x4;

constexpr int SEQ = 8192, NB = 4, NTOK = NB * SEQ, DM = 1024, NLAYER = 4;
constexpr int N_IN_PAD = 2560, N_UQ_PAD = 768, N_UKV = 768, DFF = 4096;
constexpr int NTHR = 512;

constexpr size_t SZ_XB = (size_t)NTOK * DM * 2;
constexpr size_t SZ_WIN = (size_t)N_IN_PAD * 1024 * 2, SZ_WUQ = (size_t)N_UQ_PAD * 256 * 2, SZ_WUKV = (size_t)N_UKV * 128 * 2,
                 SZ_WOUT = (size_t)1024 * 1024 * 2, SZ_W1 = (size_t)DFF * 1024 * 2, SZ_W2 = (size_t)1024 * DFF * 2;
constexpr size_t LW_WIN = 0, LW_WUQ = LW_WIN + SZ_WIN, LW_WUKV = LW_WUQ + SZ_WUQ, LW_WOUT = LW_WUKV + SZ_WUKV, LW_W1 = LW_WOUT + SZ_WOUT,
                 LW_W2 = LW_W1 + SZ_W1, LW_SIZE = LW_W2 + SZ_W2;
constexpr size_t OFF_XB = 0, OFF_W = OFF_XB + SZ_XB, OFF_TAB = OFF_W + NLAYER * LW_SIZE;
constexpr size_t OFF_COS32 = OFF_TAB, OFF_SIN32 = OFF_COS32 + (size_t)SEQ * 32 * 4, OFF_COS16 = OFF_SIN32 + (size_t)SEQ * 32 * 4,
                 OFF_SIN16 = OFF_COS16 + (size_t)SEQ * 16 * 4, OFF_ATT = OFF_SIN16 + (size_t)SEQ * 16 * 4;
constexpr size_t SZ_T384 = (size_t)NTOK * 384 * 2, SZ_QA = (size_t)NB * 6 * SEQ * 96 * 2, SZ_H6 = (size_t)NB * 6 * SEQ * 64 * 2,
                 SZ_H4 = (size_t)NB * 4 * SEQ * 64 * 2;
constexpr size_t OFF_CQKV = OFF_ATT;
constexpr size_t OFF_OA = OFF_CQKV;
constexpr size_t OFF_QA = OFF_CQKV + SZ_T384, OFF_KA = OFF_QA + SZ_QA, OFF_VA = OFF_KA + SZ_QA;
constexpr size_t OFF_QB = OFF_VA + SZ_H6, OFF_KB = OFF_QB + SZ_H6, OFF_VB = OFF_KB + SZ_H6;
constexpr size_t OFF_QC = OFF_VB + SZ_H6, OFF_KC = OFF_QC + SZ_H4, OFF_VC = OFF_KC + SZ_H4;
constexpr size_t OFF_OB = OFF_VC + SZ_H4, OFF_LSEB = OFF_OB + 3 * SZ_T384, OFF_OC = OFF_LSEB + (size_t)3 * NTOK * 6 * 4;
constexpr size_t OFF_SSQ = OFF_OC + (size_t)NTOK * 256 * 2;
constexpr size_t OFF_PX1 = OFF_SSQ, OFF_PX2 = OFF_PX1 + (size_t)NTOK * 16 * 4, OFF_PQ = OFF_PX2 + (size_t)NTOK * 16 * 4, OFF_PKV = OFF_PQ + (size_t)NTOK * 4 * 4;
constexpr size_t OFF_END = OFF_PKV + (size_t)NTOK * 2 * 4;
constexpr size_t OFF_MIXED = OFF_QA;
constexpr size_t OFF_HID = OFF_ATT;
static_assert(OFF_HID + (size_t)NTOK * DFF * 2 <= OFF_SSQ, "hid fits");
static_assert(OFF_MIXED + (size_t)NTOK * DM * 2 <= OFF_VA, "mixed fits");

struct Params {
  const float *x, *g_mix, *w_in, *q_norm, *w_uq, *kv_norm, *w_ukv, *rpb, *on_a, *on_b, *on_c, *w_out, *g_mlp, *w_mlp_in, *w_mlp_out, *g_final;
  float* out; char* ws;
  float qscaleA, qscaleB;
};
__shared__ __attribute__((aligned(1024))) char g_smem[131072];
#define NI __device__ __forceinline__
DI const Params& kparams() { return *(const Params*)__builtin_amdgcn_kernarg_segment_ptr(); }

DI unsigned cvtpk(float lo, float hi) { f32x2 v = {lo, hi}; bf2_t b = __builtin_convertvector(v, bf2_t); return __builtin_bit_cast(unsigned, b); }
DI bf16_t f2bf(float x) { return (bf16_t)(cvtpk(x, 0.f) & 0xffffu); }
DI float bf2f(unsigned h) { return __uint_as_float(h << 16); }
DI int crow(int i, int h) { return (i & 3) + 8 * (i >> 2) + 4 * h; }
#define MFMA32(a, b, c) __builtin_amdgcn_mfma_f32_32x32x16_bf16((a), (b), (c), 0, 0, 0)
DI float fdot2bf(unsigned a, float c) { bf2_t v = __builtin_bit_cast(bf2_t, a); return __builtin_amdgcn_fdot2_f32_bf16(v, v, c, false); }
DI float swap_max(float v) { auto rr = __builtin_amdgcn_permlane32_swap(__float_as_uint(v), __float_as_uint(v), false, false); return fmaxf(__uint_as_float(rr[0]), __uint_as_float(rr[1])); }
DI float swap_sum(float v) { auto rr = __builtin_amdgcn_permlane32_swap(__float_as_uint(v), __float_as_uint(v), false, false); return __uint_as_float(rr[0]) + __uint_as_float(rr[1]); }

constexpr int ATT_LDS = 45056;
#define FOR_TILES(NN, MT, NT, BODY) { const bool xm_ = gridDim.x == 256; const int st_ = xm_ ? (bid >> 3) : bid, sp_ = xm_ ? 32 : (int)gridDim.x, cn_ = xm_ ? 16 * (NN) : (NTOK / 256) * (NN); \
  for (int j_ = st_; j_ < cn_; j_ += sp_) { int MT = j_ / (NN); const int NT = j_ - MT * (NN); if (xm_) MT += (bid & 7) * 16; BODY } }
DI int otid() { int t = threadIdx.x; asm volatile("" : "+v"(t)); return t; }
DI int obid() { int t = blockIdx.x; asm volatile("" : "+s"(t)); return t; }

template <int NSLOT, class Epi>
DI void gemm_tile(const bf16_t* __restrict__ A, int lda, const bf16_t* __restrict__ Bt, int ldb, int K, int m0, int n0, const Epi& epi, const int tid, const float* pin) {
  const int lane = tid & 63, w = tid >> 6, wm = w >> 2, wn = w & 3, r32 = lane & 31, hi = lane >> 5;
  char* smem = g_smem;
  const int lrow = lane >> 3;
  const int c0 = (lane & 7) ^ (lane >> 4), c1 = (lane & 7) ^ ((lane >> 4) | 4);
  const char* Ab = (const char*)(A + (size_t)m0 * lda);
  const char* Bb = (const char*)(Bt + (size_t)n0 * ldb);
  const unsigned oa0 = (unsigned)(((w * 32 + lrow) * lda + c0 * 8) * 2), oa1 = (unsigned)(((w * 32 + lrow) * lda + c1 * 8) * 2);
  const unsigned ob0 = (unsigned)(((w * 32 + lrow) * ldb + c0 * 8) * 2), ob1 = (unsigned)(((w * 32 + lrow) * ldb + c1 * 8) * 2);
  const int dma_off = (w * 32) * 128 + lane * 16;
  f32x16 acc[4][2];
#pragma unroll
  for (int mi = 0; mi < 4; ++mi)
#pragma unroll
    for (int nj = 0; nj < 2; ++nj)
#pragma unroll
      for (int i = 0; i < 16; ++i) acc[mi][nj][i] = 0.f;
  const int nk = K >> 6;
  const int sw = (r32 >> 1) & 7, sh = sw >> 1, lo16 = 16 * (hi ^ (sw & 1));
  const int a_off = (wm * 128 + r32) * 128 + lo16;
  const int b_off = 32768 + (wn * 64 + r32) * 128 + lo16;
  __syncthreads();
  {
    char* sa = smem + dma_off;
#pragma unroll
    for (int j = 0; j < 4; ++j) {
      __builtin_amdgcn_global_load_lds((const unsigned*)(Ab + (size_t)(j * 8 * lda) * 2 + ((j & 1) ? oa1 : oa0)), (unsigned*)(sa + j * 1024), 16, 0, 0);
      __builtin_amdgcn_global_load_lds((const unsigned*)(Bb + (size_t)(j * 8 * ldb) * 2 + ((j & 1) ? ob1 : ob0)), (unsigned*)(sa + 32768 + j * 1024), 16, 0, 0);
    }
  }
  for (int kt = 0; kt < nk; ++kt) {
    __syncthreads();
    if (kt + 1 < nk) {
      char* sa = smem + ((kt + 1) & 1) * 65536 + dma_off;
      const int k0 = (kt + 1) * 64;
#pragma unroll
      for (int j = 0; j < 4; ++j) {
        __builtin_amdgcn_global_load_lds((const unsigned*)(Ab + (size_t)(j * 8 * lda + k0) * 2 + ((j & 1) ? oa1 : oa0)), (unsigned*)(sa + j * 1024), 16, 0, 0);
        __builtin_amdgcn_global_load_lds((const unsigned*)(Bb + (size_t)(j * 8 * ldb + k0) * 2 + ((j & 1) ? ob1 : ob0)), (unsigned*)(sa + 32768 + j * 1024), 16, 0, 0);
      }
    }
    const char* sb = smem + (kt & 1) * 65536;
#pragma unroll
    for (int ks = 0; ks < 4; ++ks) {
      const int koff = 32 * (ks ^ sh);
      bf16x8 af[4], bfr[2];
#pragma unroll
      for (int mi = 0; mi < 4; ++mi) af[mi] = *(const bf16x8*)(sb + a_off + mi * 4096 + koff);
#pragma unroll
      for (int nj = 0; nj < 2; ++nj) bfr[nj] = *(const bf16x8*)(sb + b_off + nj * 4096 + koff);
#pragma unroll
      for (int mi = 0; mi < 4; ++mi)
#pragma unroll
        for (int nj = 0; nj < 2; ++nj) acc[mi][nj] = MFMA32(af[mi], bfr[nj], acc[mi][nj]);
    }
  }
  float* rstd_s = (float*)smem;
  if (NSLOT > 0) {
    __syncthreads();
    if (tid < 256) {
      const float* pr = pin + (size_t)(m0 + tid) * NSLOT;
      float sacc = 0.f;
      if (NSLOT >= 4) {
#pragma unroll
        for (int q = 0; q < NSLOT / 4; ++q) { const f32x4 v = *(const f32x4*)(pr + 4 * q); sacc += (v[0] + v[1]) + (v[2] + v[3]); }
      } else {
#pragma unroll
        for (int q = 0; q < NSLOT; ++q) sacc += pr[q];
      }
      rstd_s[tid] = rsqrtf(sacc / (float)K + 1e-6f);
    }
    __syncthreads();
  }
  int lane2 = lane, w2 = w; asm volatile("" : "+v"(lane2), "+v"(w2));
  epi(acc, m0, (w2 >> 2) * 128, n0 + (w2 & 3) * 64, lane2, rstd_s);
}
DI void row_ssq_put(float v, float* dst, int lane) {
  v += __shfl_xor(v, 1); v += __shfl_xor(v, 2); v += __shfl_xor(v, 4); v += __shfl_xor(v, 8); v += __shfl_xor(v, 16);
  if ((lane & 31) == 0) *dst = v;
}

struct EpiG1 {
  bf16_t *cqkv, *KA, *qB, *qC; const float *cos32, *sin32, *cos16, *sin16; float qs; float *pq, *pkv;
  DI void operator()(f32x16 (&acc)[4][2], int m0, int lr0, int col0, int lane, const float* rstd_s) const {
    const int c = lane & 31, h = lane >> 5, cb = col0 >> 6;
    if (cb >= 37) return;
#define G1_ROW const int lr = lr0 + mi * 32 + crow(i, h), tok = m0 + lr, b = tok >> 13, s = tok & 8191; (void)b; (void)s; \
               const float rs = rstd_s[lr]; float v0 = acc[mi][0][i] * rs, v1 = acc[mi][1][i] * rs;
    if (cb < 6) {
#pragma unroll
      for (int mi = 0; mi < 4; ++mi)
#pragma unroll
        for (int i = 0; i < 16; ++i) {
        if ((i & 3) == 0) __builtin_amdgcn_sched_barrier(0);
          G1_ROW
          bf16_t* d = cqkv + (size_t)tok * 384 + cb * 64 + c; d[0] = f2bf(v0); d[32] = f2bf(v1);
          row_ssq_put(v0 * v0 + v1 * v1, cb < 4 ? pq + (size_t)tok * 4 + cb : pkv + (size_t)tok * 2 + (cb - 4), lane);
        }
    } else if (cb == 6) {
#pragma unroll
      for (int mi = 0; mi < 4; ++mi)
#pragma unroll
        for (int i = 0; i < 16; ++i) {
        if ((i & 3) == 0) __builtin_amdgcn_sched_barrier(0);
          G1_ROW
          if (c < 16) {
            const float cs = cos16[s * 16 + c], sn = sin16[s * 16 + c];
            const bf16_t o1 = f2bf(v0 * cs - v1 * sn), o2 = f2bf(v0 * sn + v1 * cs);
#pragma unroll
            for (int hd = 0; hd < 6; ++hd) { bf16_t* d = KA + ((size_t)(b * 6 + hd) * SEQ + s) * 96 + 64 + c; d[0] = o1; d[16] = o2; }
          }
        }
    } else if (cb < 25) {
      const int idx = cb - 7, which = idx / 6, hd = idx - which * 6;
      bf16_t* base = qB + (size_t)which * (SZ_H6 / 2) + (size_t)hd * SEQ * 64 + c;
      const float sc = which == 0 ? qs : 1.f;
      if (which < 2) {
#pragma unroll
        for (int mi = 0; mi < 4; ++mi)
#pragma unroll
          for (int i = 0; i < 16; ++i) {
        if ((i & 3) == 0) __builtin_amdgcn_sched_barrier(0);
            G1_ROW
            const float cs = cos32[s * 32 + c] * sc, sn = sin32[s * 32 + c] * sc;
            bf16_t* d = base + ((size_t)(b * 6) * SEQ + s) * 64;
            d[0] = f2bf(v0 * cs - v1 * sn); d[32] = f2bf(v0 * sn + v1 * cs);
          }
      } else {
#pragma unroll
        for (int mi = 0; mi < 4; ++mi)
#pragma unroll
          for (int i = 0; i < 16; ++i) {
        if ((i & 3) == 0) __builtin_amdgcn_sched_barrier(0);
            G1_ROW
            bf16_t* d = base + ((size_t)(b * 6) * SEQ + s) * 64;
            d[0] = f2bf(v0); d[32] = f2bf(v1);
          }
      }
    } else {
      const int idx = cb - 25, which = idx >> 2, hd = idx & 3;
      bf16_t* base = qC + (size_t)which * (SZ_H4 / 2) + (size_t)hd * SEQ * 64 + c;
      const float sc = which == 0 ? qs : 1.f;
#pragma unroll
      for (int mi = 0; mi < 4; ++mi)
#pragma unroll
        for (int i = 0; i < 16; ++i) {
        if ((i & 3) == 0) __builtin_amdgcn_sched_barrier(0);
          G1_ROW
          bf16_t* d = base + ((size_t)(b * 4) * SEQ + s) * 64;
          d[0] = f2bf(v0 * sc); d[32] = f2bf(v1 * sc);
        }
    }
#undef G1_ROW
  }
};
struct EpiUQ {
  bf16_t* QA; const float *cos16, *sin16; float qs;
  DI void operator()(f32x16 (&acc)[4][2], int m0, int lr0, int col0, int lane, const float* rstd_s) const {
    const int c = lane & 31, h = lane >> 5, cb = col0 >> 6;
    if (cb >= 9) return;
#pragma unroll
    for (int mi = 0; mi < 4; ++mi)
#pragma unroll
      for (int i = 0; i < 16; ++i) {
        if ((i & 3) == 0) __builtin_amdgcn_sched_barrier(0);
        const int lr = lr0 + mi * 32 + crow(i, h), tok = m0 + lr, b = tok >> 13, s = tok & 8191;
        const float rs = rstd_s[lr] * qs;
        const float v0 = acc[mi][0][i] * rs, v1 = acc[mi][1][i] * rs;
        if (cb < 6) {
          bf16_t* d = QA + ((size_t)(b * 6 + cb) * SEQ + s) * 96 + c; d[0] = f2bf(v0); d[32] = f2bf(v1);
        } else {
          const int hd = 2 * (cb - 6) + (c >> 4), fi = c & 15;
          const float cs = cos16[s * 16 + fi], sn = sin16[s * 16 + fi];
          bf16_t* d = QA + ((size_t)(b * 6 + hd) * SEQ + s) * 96 + 64 + fi;
          d[0] = f2bf(v0 * cs - v1 * sn); d[16] = f2bf(v0 * sn + v1 * cs);
        }
      }
  }
};
struct EpiUKV {
  bf16_t *KA, *VA;
  DI void operator()(f32x16 (&acc)[4][2], int m0, int lr0, int col0, int lane, const float* rstd_s) const {
    const int c = lane & 31, h = lane >> 5, cb = col0 >> 6, hd = cb >> 1, isv = cb & 1;
#pragma unroll
    for (int mi = 0; mi < 4; ++mi)
#pragma unroll
      for (int i = 0; i < 16; ++i) {
        if ((i & 3) == 0) __builtin_amdgcn_sched_barrier(0);
        const int lr = lr0 + mi * 32 + crow(i, h), tok = m0 + lr, b = tok >> 13, s = tok & 8191;
        const float rs = rstd_s[lr];
        const float v0 = acc[mi][0][i] * rs, v1 = acc[mi][1][i] * rs;
        bf16_t* d = isv ? VA + ((size_t)(b * 6 + hd) * SEQ + s) * 64 + c : KA + ((size_t)(b * 6 + hd) * SEQ + s) * 96 + c;
        d[0] = f2bf(v0); d[32] = f2bf(v1);
      }
  }
};
struct EpiRes {
  const float* xold; float* xf; bf16_t* xb; float* pout;
  DI void operator()(f32x16 (&acc)[4][2], int m0, int lr0, int col0, int lane, const float* rstd_s) const {
    const int c = lane & 31, h = lane >> 5;
#pragma unroll
    for (int mi = 0; mi < 4; ++mi)
#pragma unroll
      for (int i = 0; i < 16; ++i) {
        if ((i & 3) == 0) __builtin_amdgcn_sched_barrier(0);
        const int row = m0 + lr0 + mi * 32 + crow(i, h);
        const size_t o = (size_t)row * DM + col0 + c;
        const float v0 = xold[o] + acc[mi][0][i], v1 = xold[o + 32] + acc[mi][1][i];
        xf[o] = v0; xf[o + 32] = v1; xb[o] = f2bf(v0); xb[o + 32] = f2bf(v1);
        row_ssq_put(v0 * v0 + v1 * v1, pout + (size_t)row * 16 + (col0 >> 6), lane);
      }
  }
};
struct EpiMlp1 {
  bf16_t* hid;
  DI void operator()(f32x16 (&acc)[4][2], int m0, int lr0, int col0, int lane, const float* rstd_s) const {
    const int c = lane & 31, h = lane >> 5;
#pragma unroll
    for (int mi = 0; mi < 4; ++mi)
#pragma unroll
      for (int i = 0; i < 16; ++i) {
        if ((i & 3) == 0) __builtin_amdgcn_sched_barrier(0);
        const int lr = lr0 + mi * 32 + crow(i, h);
        const float rs = rstd_s[lr];
        const float v0 = fmaxf(acc[mi][0][i] * rs, 0.f), v1 = fmaxf(acc[mi][1][i] * rs, 0.f);
        bf16_t* d = hid + (size_t)(m0 + lr) * DFF + col0 + c; d[0] = f2bf(v0 * v0); d[32] = f2bf(v1 * v1);
      }
  }
};

struct AttnItem {
  const bf16_t *Q, *K, *V;
  int q0;
  int n0, dil, res, N;
  int nrb, ncb, kr0, kc0;
  bf16_t* out; int ldo;
  float* lse;
  const float* rpb;
};

template <int DQ, int MODE>
DI void attn_block(const AttnItem& it, char* smem, const int tid) {
  constexpr int CPR = DQ / 8, KST = DQ * 2 + 16, KCH = (64 * CPR) / 256, NT = MODE == 0 ? SEQ / 64 : MODE == 1 ? 4 : 8;
  const int lane = tid & 63, w = tid >> 6, r32 = lane & 31, hi = lane >> 5;
  char* Ks = smem; char* Vs = smem + 64 * KST; float* bias_s = (float*)(smem + 64 * KST + 8192);
  const int qi = w * 32 + r32;
  int qpos;
  if (MODE == 0) qpos = it.q0 + qi;
  else if (MODE == 1) qpos = (it.n0 + qi) * it.dil + it.res;
  else qpos = (8 * it.nrb + (qi >> 4)) * 64 + 16 * it.ncb + (qi & 15);
  __syncthreads();
  if (MODE == 2) { for (int i = tid; i < 465; i += 256) bias_s[i] = it.rpb[i] * 1.4426950408889634f; }
  bf16x8 qr[DQ / 16];
#pragma unroll
  for (int d0 = 0; d0 < DQ / 16; ++d0) qr[d0] = *(const bf16x8*)(it.Q + (size_t)qpos * DQ + d0 * 16 + hi * 8);
  f32x16 o[2];
#pragma unroll
  for (int i = 0; i < 16; ++i) { o[0][i] = 0.f; o[1][i] = 0.f; }
  float m_run = -1e30f, l_run = 0.f;
  u32x4 rk[KCH], rv[2];
  auto kpos = [&](int t, int row) -> int {
    if (MODE == 0) return t * 64 + row;
    if (MODE == 1) { int n = it.n0 - 64 + 64 * t + row; n = n < 0 ? 0 : (n > it.N - 1 ? it.N - 1 : n); return n * it.dil + it.res; }
    return (it.kr0 + 2 * t + (row >> 5)) * 64 + it.kc0 + (row & 31);
  };
  auto load = [&](int t) {
#pragma unroll
    for (int i = 0; i < KCH; ++i) { const int c = tid + 256 * i, row = c / CPR, kc = c - row * CPR; rk[i] = *(const u32x4*)(it.K + (size_t)kpos(t, row) * DQ + kc * 8); }
#pragma unroll
    for (int i = 0; i < 2; ++i) { const int c = tid + 256 * i, row = c >> 3, kc = c & 7; rv[i] = *(const u32x4*)(it.V + (size_t)kpos(t, row) * 64 + kc * 8); }
  };
  const int vrd = ((lane >> 5) * 4 + ((lane & 15) >> 2)) * 64 + ((lane >> 4) & 1) * 32 + (lane & 3) * 8;
  load(0);
  for (int t = 0; t < NT; ++t) {
    __syncthreads();
#pragma unroll
    for (int i = 0; i < KCH; ++i) { const int c = tid + 256 * i, row = c / CPR, kc = c - row * CPR; *(u32x4*)(Ks + row * KST + kc * 16) = rk[i]; }
#pragma unroll
    for (int i = 0; i < 2; ++i) { const int c = tid + 256 * i, row = c >> 3, kc = c & 7; *(u32x4*)(Vs + (kc >> 2) * 4096 + row * 64 + (kc & 3) * 16) = rv[i]; }
    __syncthreads();
    if (t + 1 < NT) load(t + 1);
    bool skip = false;
    if (MODE == 1) skip = (w < 2) ? (t == 3) : (t == 0);
    if (MODE == 2) {
      const int rq_lo = 8 * it.nrb + 2 * w, rq_hi = rq_lo + 1;
      const int rs_lo = min(max(rq_lo - 4, 0), 120), rs_hi = min(max(rq_hi - 4, 0), 120) + 7;
      const int kr = it.kr0 + 2 * t;
      skip = (kr + 1 < rs_lo) || (kr > rs_hi);
    }
    if (skip) continue;
    f32x16 p0, p1;
#pragma unroll
    for (int i = 0; i < 16; ++i) { p0[i] = 0.f; p1[i] = 0.f; }
#pragma unroll
    for (int d0 = 0; d0 < DQ / 16; ++d0) {
      const bf16x8 k0 = *(const bf16x8*)(Ks + r32 * KST + d0 * 32 + hi * 16);
      const bf16x8 k1 = *(const bf16x8*)(Ks + (32 + r32) * KST + d0 * 32 + hi * 16);
      p0 = MFMA32(k0, qr[d0], p0); p1 = MFMA32(k1, qr[d0], p1);
    }
    if (MODE == 1) {
      const int nq = it.n0 + qi, kb = it.n0 - 64 + 64 * t;
#pragma unroll
      for (int i = 0; i < 16; ++i) {
        const int nk = kb + crow(i, hi), nk2 = nk + 32;
        const int d1 = nq - nk, d2 = nq - nk2;
        const bool ok1 = (d1 <= 64) && (d1 >= -64) && (nk >= 0) && (nk < it.N);
        const bool ok2 = (d2 <= 64) && (d2 >= -64) && (nk2 >= 0) && (nk2 < it.N);
        p0[i] = ok1 ? p0[i] : -INFINITY; p1[i] = ok2 ? p1[i] : -INFINITY;
      }
    }
    if (MODE == 2) {
      const int rq = 8 * it.nrb + (qi >> 4), cq = 16 * it.ncb + (qi & 15);
      const int rs_ = min(max(rq - 4, 0), 120), cs_ = min(max(cq - 8, 0), 48);
      const int kr = it.kr0 + 2 * t;
      const bool okr0 = (kr >= rs_) && (kr < rs_ + 8), okr1 = (kr + 1 >= rs_) && (kr + 1 < rs_ + 8);
      const int bi0 = (kr - rq + 7) * 31 - cq + 15;
#pragma unroll
      for (int i = 0; i < 16; ++i) {
        const int kc = it.kc0 + crow(i, hi);
        const bool okc = (kc >= cs_) && (kc < cs_ + 16);
        const bool ok0 = okc && okr0, ok1 = okc && okr1;
        const float b0 = bias_s[ok0 ? bi0 + kc : 0], b1 = bias_s[ok1 ? bi0 + 31 + kc : 0];
        p0[i] = ok0 ? p0[i] + b0 : -INFINITY; p1[i] = ok1 ? p1[i] + b1 : -INFINITY;
      }
    }
    float pmax = p0[0];
#pragma unroll
    for (int i = 1; i < 16; ++i) pmax = fmaxf(pmax, p0[i]);
#pragma unroll
    for (int i = 0; i < 16; ++i) pmax = fmaxf(pmax, p1[i]);
    pmax = swap_max(pmax);
    const float mn = fmaxf(m_run, pmax);
    const float alpha = __builtin_amdgcn_exp2f(m_run - mn);
    m_run = mn;
    float ps = 0.f;
#pragma unroll
    for (int i = 0; i < 16; ++i) { p0[i] = __builtin_amdgcn_exp2f(p0[i] - mn); ps += p0[i]; }
#pragma unroll
    for (int i = 0; i < 16; ++i) { p1[i] = __builtin_amdgcn_exp2f(p1[i] - mn); ps += p1[i]; }
    ps = swap_sum(ps);
    l_run = l_run * alpha + ps;
#pragma unroll
    for (int i = 0; i < 16; ++i) { o[0][i] *= alpha; o[1][i] *= alpha; }
    bf16x8 pb[4];
#pragma unroll
    for (int s = 0; s < 2; ++s) {
      u32x4 a = {cvtpk(p0[8 * s], p0[8 * s + 1]), cvtpk(p0[8 * s + 2], p0[8 * s + 3]), cvtpk(p0[8 * s + 4], p0[8 * s + 5]), cvtpk(p0[8 * s + 6], p0[8 * s + 7])};
      u32x4 b = {cvtpk(p1[8 * s], p1[8 * s + 1]), cvtpk(p1[8 * s + 2], p1[8 * s + 3]), cvtpk(p1[8 * s + 4], p1[8 * s + 5]), cvtpk(p1[8 * s + 6], p1[8 * s + 7])};
      pb[s] = __builtin_bit_cast(bf16x8, a); pb[2 + s] = __builtin_bit_cast(bf16x8, b);
    }
#pragma unroll
    for (int db = 0; db < 2; ++db)
#pragma unroll
      for (int s = 0; s < 4; ++s) {
        const s16x4 lo = __builtin_amdgcn_ds_read_tr16_b64_v4i16((lds_s16x4*)(Vs + db * 4096 + (16 * s) * 64 + vrd));
        const s16x4 hh = __builtin_amdgcn_ds_read_tr16_b64_v4i16((lds_s16x4*)(Vs + db * 4096 + (16 * s + 8) * 64 + vrd));
        const bf16x8 a = {lo[0], lo[1], lo[2], lo[3], hh[0], hh[1], hh[2], hh[3]};
        o[db] = MFMA32(a, pb[s], o[db]);
      }
  }
  const float inv = 1.f / l_run;
  const int bq = qpos;
  bf16_t* orow = it.out + (size_t)bq * it.ldo;
#pragma unroll
  for (int db = 0; db < 2; ++db)
#pragma unroll
    for (int g = 0; g < 4; ++g) {
      u32x2 v = {cvtpk(o[db][4 * g] * inv, o[db][4 * g + 1] * inv), cvtpk(o[db][4 * g + 2] * inv, o[db][4 * g + 3] * inv)};
      *(u32x2*)(orow + db * 32 + 8 * g + 4 * hi) = v;
    }
  if (MODE == 1) { if (hi == 0) it.lse[(size_t)bq * 6] = m_run + __builtin_amdgcn_logf(l_run); }
}

DI void attn_dense_skew(const bf16_t* __restrict__ Q, const bf16_t* __restrict__ K, const bf16_t* __restrict__ V, int q0, bf16_t* __restrict__ out,
                        char* smem, const int tid, const int grp) {
  constexpr int DQ = 96, CPR = 12, KST = 208, NT = SEQ / 64, STG = 64 * KST + 8192;
  const int lane = tid & 63, w = tid >> 6, r32 = lane & 31, hi = lane >> 5;
  const int qpos = q0 + w * 32 + r32;
  bf16x8 qr[DQ / 16];
#pragma unroll
  for (int d0 = 0; d0 < DQ / 16; ++d0) qr[d0] = *(const bf16x8*)(Q + (size_t)qpos * DQ + d0 * 16 + hi * 8);
  f32x16 o[2];
#pragma unroll
  for (int i = 0; i < 16; ++i) { o[0][i] = 0.f; o[1][i] = 0.f; }
  float m_run = -1e30f, l_run = 0.f;
  u32x4 rk[3], rv[2];
  auto load = [&](int t) {
#pragma unroll
    for (int i = 0; i < 3; ++i) { const int c = tid + 256 * i, row = c / CPR, kc = c - row * CPR; rk[i] = *(const u32x4*)(K + (size_t)(t * 64 + row) * DQ + kc * 8); }
#pragma unroll
    for (int i = 0; i < 2; ++i) { const int c = tid + 256 * i, row = c >> 3, kc = c & 7; rv[i] = *(const u32x4*)(V + (size_t)(t * 64 + row) * 64 + kc * 8); }
  };
  auto store = [&](int b) {
    char* Ks = smem + b * STG; char* Vs = Ks + 64 * KST;
#pragma unroll
    for (int i = 0; i < 3; ++i) { const int c = tid + 256 * i, row = c / CPR, kc = c - row * CPR; *(u32x4*)(Ks + row * KST + kc * 16) = rk[i]; }
#pragma unroll
    for (int i = 0; i < 2; ++i) { const int c = tid + 256 * i, row = c >> 3, kc = c & 7; *(u32x4*)(Vs + (kc >> 2) * 4096 + row * 64 + (kc & 3) * 16) = rv[i]; }
  };
  const int vrd = ((lane >> 5) * 4 + ((lane & 15) >> 2)) * 64 + ((lane >> 4) & 1) * 32 + (lane & 3) * 8;
  __syncthreads();
  load(0); store(0); load(1);
  __syncthreads();
  if (grp == 1) __syncthreads();
  for (int t = 0; t < NT; ++t) {
    const char* Ks = smem + (t & 1) * STG; const char* Vs = Ks + 64 * KST;
    if (t + 1 < NT) store((t + 1) & 1);
    if (t + 2 < NT) load(t + 2);
    f32x16 p0, p1;
#pragma unroll
    for (int i = 0; i < 16; ++i) { p0[i] = 0.f; p1[i] = 0.f; }
#pragma unroll
    for (int d0 = 0; d0 < DQ / 16; ++d0) {
      const bf16x8 k0 = *(const bf16x8*)(Ks + r32 * KST + d0 * 32 + hi * 16);
      const bf16x8 k1 = *(const bf16x8*)(Ks + (32 + r32) * KST + d0 * 32 + hi * 16);
      p0 = MFMA32(k0, qr[d0], p0); p1 = MFMA32(k1, qr[d0], p1);
    }
    asm volatile("" : "+v"(p0), "+v"(p1));
    __syncthreads();
    asm volatile("" : "+v"(p0), "+v"(p1));
    float pmax = p0[0];
#pragma unroll
    for (int i = 1; i < 16; ++i) pmax = fmaxf(pmax, p0[i]);
#pragma unroll
    for (int i = 0; i < 16; ++i) pmax = fmaxf(pmax, p1[i]);
    pmax = swap_max(pmax);
    const float mn = fmaxf(m_run, pmax);
    const float alpha = __builtin_amdgcn_exp2f(m_run - mn);
    m_run = mn;
    float ps = 0.f;
#pragma unroll
    for (int i = 0; i < 16; ++i) { p0[i] = __builtin_amdgcn_exp2f(p0[i] - mn); ps += p0[i]; }
#pragma unroll
    for (int i = 0; i < 16; ++i) { p1[i] = __builtin_amdgcn_exp2f(p1[i] - mn); ps += p1[i]; }
    ps = swap_sum(ps);
    l_run = l_run * alpha + ps;
#pragma unroll
    for (int i = 0; i < 16; ++i) { o[0][i] *= alpha; o[1][i] *= alpha; }
    bf16x8 pb[4];
#pragma unroll
    for (int s = 0; s < 2; ++s) {
      u32x4 a = {cvtpk(p0[8 * s], p0[8 * s + 1]), cvtpk(p0[8 * s + 2], p0[8 * s + 3]), cvtpk(p0[8 * s + 4], p0[8 * s + 5]), cvtpk(p0[8 * s + 6], p0[8 * s + 7])};
      u32x4 b = {cvtpk(p1[8 * s], p1[8 * s + 1]), cvtpk(p1[8 * s + 2], p1[8 * s + 3]), cvtpk(p1[8 * s + 4], p1[8 * s + 5]), cvtpk(p1[8 * s + 6], p1[8 * s + 7])};
      pb[s] = __builtin_bit_cast(bf16x8, a); pb[2 + s] = __builtin_bit_cast(bf16x8, b);
    }
#pragma unroll
    for (int db = 0; db < 2; ++db)
#pragma unroll
      for (int s = 0; s < 4; ++s) {
        const s16x4 lo = __builtin_amdgcn_ds_read_tr16_b64_v4i16((lds_s16x4*)(Vs + db * 4096 + (16 * s) * 64 + vrd));
        const s16x4 hh = __builtin_amdgcn_ds_read_tr16_b64_v4i16((lds_s16x4*)(Vs + db * 4096 + (16 * s + 8) * 64 + vrd));
        const bf16x8 a = {lo[0], lo[1], lo[2], lo[3], hh[0], hh[1], hh[2], hh[3]};
        o[db] = MFMA32(a, pb[s], o[db]);
      }
    asm volatile("" : "+v"(o[0]), "+v"(o[1]));
    __syncthreads();
    asm volatile("" : "+v"(o[0]), "+v"(o[1]));
  }
  if (grp == 0) __syncthreads();
  const float inv = 1.f / l_run;
  bf16_t* orow = out + (size_t)qpos * 384;
#pragma unroll
  for (int db = 0; db < 2; ++db)
#pragma unroll
    for (int g = 0; g < 4; ++g) {
      u32x2 v = {cvtpk(o[db][4 * g] * inv, o[db][4 * g + 1] * inv), cvtpk(o[db][4 * g + 2] * inv, o[db][4 * g + 3] * inv)};
      *(u32x2*)(orow + db * 32 + 8 * g + 4 * hi) = v;
    }
}

DI float wave_sum(float v) {
  v += __shfl_xor(v, 32); v += __shfl_xor(v, 16); v += __shfl_xor(v, 8); v += __shfl_xor(v, 4); v += __shfl_xor(v, 2); v += __shfl_xor(v, 1); return v;
}
DI float gain_of(const Params& p, int kind, int l, int k) {
  switch (kind) {
    case 0: return p.g_mix[l * 1024 + k];
    case 1: return p.q_norm[l * 256 + k];
    case 2: return p.kv_norm[l * 128 + k];
    case 3: return k < 384 ? p.on_a[l * 384 + k] : (k < 768 ? p.on_b[l * 384 + k - 384] : p.on_c[l * 256 + k - 768]);
    case 4: return p.g_mlp[l * 1024 + k];
    default: return 1.f;
  }
}
DI int map_col(int kind, int n) {
  if (kind == 0) {
    if (n < 384) return n;
    if (n < 448) { const int wv = n - 384, c = wv & 31, sub = wv >> 5; return c < 16 ? 384 + sub * 16 + c : -1; }
    if (n < 1600) return 416 + (n - 448);
    if (n < 2368) return 1568 + (n - 1600);
    return -1;
  }
  if (kind == 1) {
    if (n < 384) return (n >> 6) * 96 + (n & 63);
    if (n < 576) { const int wv = n - 384, g = wv >> 6, wi = wv & 63, sub = wi >> 5, c = wi & 31, hd = 2 * g + (c >> 4), fi = c & 15; return hd * 96 + 64 + sub * 16 + fi; }
    return -1;
  }
  return n;
}
DI void wtile(const Params& p, const float* src, int Nsrc, bf16_t* dst, int K, int kt, int nt, int kind, int l, char* smem, const int tid) {
  float* tile = (float*)smem;
  const int lane = tid & 63, wv = tid >> 6;
  __syncthreads();
  const int n = nt * 64 + lane, sc = map_col(kind, n);
#pragma unroll 4
  for (int r = 0; r < 8; ++r) {
    const int kl = r * 8 + wv, k = kt * 64 + kl;
    float v = 0.f;
    if (sc >= 0) v = src[(size_t)k * Nsrc + sc] * gain_of(p, kind, l, k);
    tile[kl * 65 + lane] = v;
  }
  __syncthreads();
#pragma unroll 4
  for (int r = 0; r < 8; ++r) {
    const int nl = r * 8 + wv;
    dst[(size_t)(nt * 64 + nl) * K + kt * 64 + lane] = f2bf(tile[lane * 65 + nl]);
  }
}

NI void phase_prep() {
  const Params& p = kparams(); char* smem = g_smem; const int tid = otid(), bid = obid();
  char* ws = p.ws;
  constexpr int T_WIN = (N_IN_PAD / 64) * 16, T_WUQ = (N_UQ_PAD / 64) * 4, T_WUKV = (N_UKV / 64) * 2, T_WOUT = 16 * 16, T_W1 = 64 * 16, T_W2 = 16 * 64;
  constexpr int T_L = T_WIN + T_WUQ + T_WUKV + T_WOUT + T_W1 + T_W2;
  for (int j = bid; j < NLAYER * T_L; j += gridDim.x) {
    const int l = j / T_L; int r = j - l * T_L;
    char* lw = ws + OFF_W + (size_t)l * LW_SIZE;
    if (r < T_WIN) { wtile(p, p.w_in + (size_t)l * 1024 * 2336, 2336, (bf16_t*)(lw + LW_WIN), 1024, r & 15, r >> 4, 0, l, smem, tid); continue; }
    r -= T_WIN;
    if (r < T_WUQ) { wtile(p, p.w_uq + (size_t)l * 256 * 576, 576, (bf16_t*)(lw + LW_WUQ), 256, r & 3, r >> 2, 1, l, smem, tid); continue; }
    r -= T_WUQ;
    if (r < T_WUKV) { wtile(p, p.w_ukv + (size_t)l * 128 * 768, 768, (bf16_t*)(lw + LW_WUKV), 128, r & 1, r >> 1, 2, l, smem, tid); continue; }
    r -= T_WUKV;
    if (r < T_WOUT) { wtile(p, p.w_out + (size_t)l * 1024 * 1024, 1024, (bf16_t*)(lw + LW_WOUT), 1024, r & 15, r >> 4, 3, l, smem, tid); continue; }
    r -= T_WOUT;
    if (r < T_W1) { wtile(p, p.w_mlp_in + (size_t)l * 1024 * 4096, 4096, (bf16_t*)(lw + LW_W1), 1024, r & 15, r >> 4, 4, l, smem, tid); continue; }
    r -= T_W1;
    wtile(p, p.w_mlp_out + (size_t)l * 4096 * 1024, 1024, (bf16_t*)(lw + LW_W2), 4096, r & 63, r >> 6, 5, l, smem, tid);
  }
  const size_t gtid = (size_t)bid * NTHR + tid, gsz = (size_t)gridDim.x * NTHR;
  bf16_t* xb = (bf16_t*)(ws + OFF_XB);
  {
    const int lane = tid & 63, gw = bid * (NTHR / 64) + (tid >> 6), nw = gridDim.x * (NTHR / 64);
    float* px1 = (float*)(ws + OFF_PX1);
    for (int row = gw; row < NTOK; row += nw) {
      float ss = 0.f;
#pragma unroll
      for (int j = 0; j < 4; ++j) {
        const f32x4 a = *(const f32x4*)(p.x + (size_t)row * DM + j * 256 + lane * 4);
        ss += a[0] * a[0] + a[1] * a[1] + a[2] * a[2] + a[3] * a[3];
        u32x2 o = {cvtpk(a[0], a[1]), cvtpk(a[2], a[3])};
        *(u32x2*)(xb + (size_t)row * DM + j * 256 + lane * 4) = o;
      }
      ss = wave_sum(ss);
      if (lane < 16) px1[(size_t)row * 16 + lane] = lane == 0 ? ss : 0.f;
    }
  }
  float* c32 = (float*)(ws + OFF_COS32); float* s32 = (float*)(ws + OFF_SIN32); float* c16 = (float*)(ws + OFF_COS16); float* s16 = (float*)(ws + OFF_SIN16);
  for (size_t i = gtid; i < (size_t)SEQ * 48; i += gsz) {
    int pos, fi; float invf; float *cd, *sd;
    if (i < (size_t)SEQ * 32) { pos = (int)(i >> 5); fi = (int)(i & 31); invf = __builtin_amdgcn_exp2f(-(float)fi * (13.287712379549449f / 32.f)); cd = c32 + i; sd = s32 + i; }
    else { const size_t j = i - (size_t)SEQ * 32; pos = (int)(j >> 4); fi = (int)(j & 15); invf = __builtin_amdgcn_exp2f(-(float)fi * (13.287712379549449f / 16.f)); cd = c16 + j; sd = s16 + j; }
    const float ang = (float)pos * invf;
    const double rev = (double)ang * 0.15915494309189535;
    const float fr = (float)(rev - rint(rev));
    *cd = __builtin_amdgcn_cosf(fr); *sd = __builtin_amdgcn_sinf(fr);
  }
}

NI void phase_g1(int l_) {
  const Params& p = kparams(); char* smem = g_smem; const int l = __builtin_amdgcn_readfirstlane(l_); const int tid = otid(), bid = obid(); (void)tid; (void)bid;
  char* ws = p.ws;
  EpiG1 e;
  e.cqkv = (bf16_t*)(ws + OFF_CQKV); e.KA = (bf16_t*)(ws + OFF_KA); e.qB = (bf16_t*)(ws + OFF_QB); e.qC = (bf16_t*)(ws + OFF_QC);
  e.cos32 = (const float*)(ws + OFF_COS32); e.sin32 = (const float*)(ws + OFF_SIN32); e.cos16 = (const float*)(ws + OFF_COS16); e.sin16 = (const float*)(ws + OFF_SIN16);
  e.qs = p.qscaleB; e.pq = (float*)(ws + OFF_PQ); e.pkv = (float*)(ws + OFF_PKV);
  const bf16_t* A = (const bf16_t*)(ws + OFF_XB);
  const bf16_t* Bt = (const bf16_t*)(ws + OFF_W + (size_t)l * LW_SIZE + LW_WIN);
  constexpr int NNT = N_IN_PAD / 256;
  FOR_TILES(NNT, mt, nt, gemm_tile<16>(A, 1024, Bt, 1024, 1024, mt * 256, nt * 256, e, tid, (const float*)(ws + OFF_PX1));)
}
NI void phase_g2(int l_) {
  const Params& p = kparams(); char* smem = g_smem; const int l = __builtin_amdgcn_readfirstlane(l_); const int tid = otid(), bid = obid(); (void)tid; (void)bid;
  char* ws = p.ws;
  const bf16_t* A = (const bf16_t*)(ws + OFF_CQKV);
  EpiUQ eq; eq.QA = (bf16_t*)(ws + OFF_QA); eq.cos16 = (const float*)(ws + OFF_COS16); eq.sin16 = (const float*)(ws + OFF_SIN16); eq.qs = p.qscaleA;
  EpiUKV ek; ek.KA = (bf16_t*)(ws + OFF_KA); ek.VA = (bf16_t*)(ws + OFF_VA);
  const bf16_t* Wq = (const bf16_t*)(ws + OFF_W + (size_t)l * LW_SIZE + LW_WUQ);
  const bf16_t* Wkv = (const bf16_t*)(ws + OFF_W + (size_t)l * LW_SIZE + LW_WUKV);
  FOR_TILES(3, mt, nt, gemm_tile<4>(A, 384, Wq, 256, 256, mt * 256, nt * 256, eq, tid, (const float*)(ws + OFF_PQ));)
  FOR_TILES(3, mt, nt, gemm_tile<2>(A + 256, 384, Wkv, 128, 128, mt * 256, nt * 256, ek, tid, (const float*)(ws + OFF_PKV));)
}
NI void phase_attn(int l_) {
  const Params& p = kparams(); char* smem = g_smem; const int l = __builtin_amdgcn_readfirstlane(l_); const int tid = otid(), bid = obid(); (void)tid; (void)bid;
  char* ws = p.ws;
  constexpr int NA = 1536, NBI = 4608, NC = 1024;
  const int grp = tid >> 8, t256 = tid & 255; char* gsm = smem + grp * ATT_LDS;
  for (int i0 = bid * 2; i0 < NA; i0 += gridDim.x * 2) {
    const int i = i0 + grp, xcd = (i >> 1) & 7, j = ((i >> 4) << 1) | (i & 1);
    const int bh = (j >> 6) * 8 + xcd, qb = j & 63, b = bh / 6, h = bh - b * 6;
    attn_dense_skew((const bf16_t*)(ws + OFF_QA) + (size_t)bh * SEQ * 96, (const bf16_t*)(ws + OFF_KA) + (size_t)bh * SEQ * 96, (const bf16_t*)(ws + OFF_VA) + (size_t)bh * SEQ * 64,
                    qb * 128, (bf16_t*)(ws + OFF_OA) + (size_t)b * SEQ * 384 + h * 64, gsm, t256, grp);
  }
  for (int i0 = bid * 2; i0 < NBI; i0 += gridDim.x * 2) {
    AttnItem it{};
    const int i = i0 + grp, xcd = (i >> 1) & 7, j = ((i >> 4) << 1) | (i & 1);
    const int g = (j >> 6) * 8 + xcd, c = j & 63, br = g / 24, bh = g - br * 24, b = bh / 6, h = bh - b * 6;
    const int dil = br == 0 ? 1 : (br == 1 ? 4 : 16), cpr = 64 / dil;
    it.Q = (const bf16_t*)(ws + OFF_QB) + (size_t)bh * SEQ * 64; it.K = (const bf16_t*)(ws + OFF_KB) + (size_t)bh * SEQ * 64; it.V = (const bf16_t*)(ws + OFF_VB) + (size_t)bh * SEQ * 64;
    it.dil = dil; it.res = c / cpr; it.n0 = (c - it.res * cpr) * 128; it.N = SEQ / dil;
    it.out = (bf16_t*)(ws + OFF_OB) + (size_t)br * NTOK * 384 + (size_t)b * SEQ * 384 + h * 64; it.ldo = 384;
    it.lse = (float*)(ws + OFF_LSEB) + (size_t)br * NTOK * 6 + (size_t)b * SEQ * 6 + h;
    attn_block<64, 1>(it, gsm, t256);
  }
  for (int i0 = bid * 2; i0 < NC; i0 += gridDim.x * 2) {
    AttnItem it{};
    const int i = i0 + grp, xcd = (i >> 1) & 7, j = ((i >> 4) << 1) | (i & 1);
    const int bh = (j >> 6) * 8 + xcd, blk = j & 63, b = bh >> 2, h = bh & 3;
    it.Q = (const bf16_t*)(ws + OFF_QC) + (size_t)bh * SEQ * 64; it.K = (const bf16_t*)(ws + OFF_KC) + (size_t)bh * SEQ * 64; it.V = (const bf16_t*)(ws + OFF_VC) + (size_t)bh * SEQ * 64;
    it.nrb = blk >> 2; it.ncb = blk & 3;
    it.kr0 = min(max(8 * it.nrb - 4, 0), 112); it.kc0 = min(max(16 * it.ncb - 8, 0), 32);
    it.out = (bf16_t*)(ws + OFF_OC) + (size_t)b * SEQ * 256 + h * 64; it.ldo = 256;
    it.rpb = p.rpb + ((size_t)l * 4 + h) * 465;
    attn_block<64, 2>(it, gsm, t256);
  }
}
NI void phase_mix() {
  const Params& p = kparams(); const int tid = otid(), bid = obid();
  char* ws = p.ws;
  const int lane = tid & 63, gw = bid * (NTHR / 64) + (tid >> 6), nw = gridDim.x * (NTHR / 64);
  const bf16_t* oA = (const bf16_t*)(ws + OFF_OA); const bf16_t* oB = (const bf16_t*)(ws + OFF_OB); const bf16_t* oC = (const bf16_t*)(ws + OFF_OC);
  const float* lse = (const float*)(ws + OFF_LSEB);
  bf16_t* mixed = (bf16_t*)(ws + OFF_MIXED);
  for (int tok = gw; tok < NTOK; tok += nw) {
    float v[16];
    if (lane < 24 || lane >= 48) {
      const bf16_t* src = lane < 24 ? oA + (size_t)tok * 384 + lane * 16 : oC + (size_t)tok * 256 + (lane - 48) * 16;
      const u32x4 a = *(const u32x4*)src, b = *(const u32x4*)(src + 8);
#pragma unroll
      for (int j = 0; j < 4; ++j) { v[2 * j] = bf2f(a[j] & 0xffffu); v[2 * j + 1] = bf2f(a[j] >> 16); v[8 + 2 * j] = bf2f(b[j] & 0xffffu); v[8 + 2 * j + 1] = bf2f(b[j] >> 16); }
    } else {
      const int col = (lane - 24) * 16, hd = col >> 6;
      const float l0 = lse[(size_t)tok * 6 + hd], l1 = lse[(size_t)NTOK * 6 + (size_t)tok * 6 + hd], l2 = lse[(size_t)2 * NTOK * 6 + (size_t)tok * 6 + hd];
      const float mx = fmaxf(l0, fmaxf(l1, l2));
      float w0 = __builtin_amdgcn_exp2f(l0 - mx), w1 = __builtin_amdgcn_exp2f(l1 - mx), w2 = __builtin_amdgcn_exp2f(l2 - mx);
      const float wi = 1.f / (w0 + w1 + w2); w0 *= wi; w1 *= wi; w2 *= wi;
#pragma unroll
      for (int j = 0; j < 16; ++j) v[j] = 0.f;
#pragma unroll
      for (int br = 0; br < 3; ++br) {
        const float wb = br == 0 ? w0 : (br == 1 ? w1 : w2);
        const bf16_t* src = oB + (size_t)br * NTOK * 384 + (size_t)tok * 384 + col;
        const u32x4 a = *(const u32x4*)src, b = *(const u32x4*)(src + 8);
#pragma unroll
        for (int j = 0; j < 4; ++j) { v[2 * j] += wb * bf2f(a[j] & 0xffffu); v[2 * j + 1] += wb * bf2f(a[j] >> 16); v[8 + 2 * j] += wb * bf2f(b[j] & 0xffffu); v[8 + 2 * j + 1] += wb * bf2f(b[j] >> 16); }
      }
    }
    float ss = 0.f;
#pragma unroll
    for (int j = 0; j < 16; ++j) ss += v[j] * v[j];
    const float sa = wave_sum(lane < 24 ? ss : 0.f), sb = wave_sum((lane >= 24 && lane < 48) ? ss : 0.f), sc = wave_sum(lane >= 48 ? ss : 0.f);
    const float rs = lane < 24 ? rsqrtf(sa * (1.f / 384.f) + 1e-6f) : (lane < 48 ? rsqrtf(sb * (1.f / 384.f) + 1e-6f) : rsqrtf(sc * (1.f / 256.f) + 1e-6f));
    u32x4 oa, ob;
#pragma unroll
    for (int j = 0; j < 4; ++j) { oa[j] = cvtpk(v[2 * j] * rs, v[2 * j + 1] * rs); ob[j] = cvtpk(v[8 + 2 * j] * rs, v[8 + 2 * j + 1] * rs); }
    bf16_t* dst = mixed + (size_t)tok * 1024 + lane * 16;
    *(u32x4*)dst = oa; *(u32x4*)(dst + 8) = ob;
  }
}
NI void phase_wout(int l_) {
  const Params& p = kparams(); char* smem = g_smem; const int l = __builtin_amdgcn_readfirstlane(l_); const int tid = otid(), bid = obid(); (void)tid; (void)bid;
  char* ws = p.ws;
  EpiRes e; e.xold = (l == 0) ? p.x : p.out; e.xf = p.out; e.xb = (bf16_t*)(ws + OFF_XB); e.pout = (float*)(ws + OFF_PX2);
  const bf16_t* A = (const bf16_t*)(ws + OFF_MIXED);
  const bf16_t* Bt = (const bf16_t*)(ws + OFF_W + (size_t)l * LW_SIZE + LW_WOUT);
  FOR_TILES(4, mt, nt, gemm_tile<0>(A, 1024, Bt, 1024, 1024, mt * 256, nt * 256, e, tid, nullptr);)
}
NI void phase_mlp1(int l_) {
  const Params& p = kparams(); char* smem = g_smem; const int l = __builtin_amdgcn_readfirstlane(l_); const int tid = otid(), bid = obid(); (void)tid; (void)bid;
  char* ws = p.ws;
  EpiMlp1 e; e.hid = (bf16_t*)(ws + OFF_HID);
  const bf16_t* A = (const bf16_t*)(ws + OFF_XB);
  const bf16_t* Bt = (const bf16_t*)(ws + OFF_W + (size_t)l * LW_SIZE + LW_W1);
  FOR_TILES(16, mt, nt, gemm_tile<16>(A, 1024, Bt, 1024, 1024, mt * 256, nt * 256, e, tid, (const float*)(ws + OFF_PX2));)
}
NI void phase_mlp2(int l_) {
  const Params& p = kparams(); char* smem = g_smem; const int l = __builtin_amdgcn_readfirstlane(l_); const int tid = otid(), bid = obid(); (void)tid; (void)bid;
  char* ws = p.ws;
  EpiRes e; e.xold = p.out; e.xf = p.out; e.xb = (bf16_t*)(ws + OFF_XB); e.pout = (float*)(ws + OFF_PX1);
  const bf16_t* A = (const bf16_t*)(ws + OFF_HID);
  const bf16_t* Bt = (const bf16_t*)(ws + OFF_W + (size_t)l * LW_SIZE + LW_W2);
  FOR_TILES(4, mt, nt, gemm_tile<0>(A, DFF, Bt, DFF, DFF, mt * 256, nt * 256, e, tid, nullptr);)
}
NI void phase_final() {
  const Params& p = kparams(); const int tid = otid(), bid = obid();
  const int lane = tid & 63, gw = bid * (NTHR / 64) + (tid >> 6), nw = gridDim.x * (NTHR / 64);
  for (int tok = gw; tok < NTOK; tok += nw) {
    float* row = p.out + (size_t)tok * DM;
    f32x4 v[4]; float ss = 0.f;
#pragma unroll
    for (int j = 0; j < 4; ++j) { v[j] = *(const f32x4*)(row + j * 256 + lane * 4); ss += v[j][0] * v[j][0] + v[j][1] * v[j][1] + v[j][2] * v[j][2] + v[j][3] * v[j][3]; }
    ss = wave_sum(ss);
    const float rs = rsqrtf(ss * (1.f / 1024.f) + 1e-6f);
#pragma unroll
    for (int j = 0; j < 4; ++j) { const f32x4 g = *(const f32x4*)(p.g_final + j * 256 + lane * 4); f32x4 o = {v[j][0] * rs * g[0], v[j][1] * rs * g[1], v[j][2] * rs * g[2], v[j][3] * rs * g[3]}; *(f32x4*)(row + j * 256 + lane * 4) = o; }
  }
}

constexpr int NPHASE = 2 + 7 * NLAYER;
DI void run_phase(int ph) {
  if (ph == 0) { phase_prep(); return; }
  if (ph == NPHASE - 1) { phase_final(); return; }
  const int l = (ph - 1) / 7, st = (ph - 1) - l * 7;
  switch (st) {
    case 0: phase_g1(l); break;
    case 1: phase_g2(l); break;
    case 2: phase_attn(l); break;
    case 3: phase_mix(); break;
    case 4: phase_wout(l); break;
    case 5: phase_mlp1(l); break;
    default: phase_mlp2(l); break;
  }
}

__global__ void __launch_bounds__(512) mega(Params p, int ph_lo, int ph_hi) {
  cg::grid_group grid = cg::this_grid();
  for (int ph = ph_lo; ph < ph_hi; ++ph) {
    run_phase(ph);
    if (ph + 1 < ph_hi) grid.sync();
  }
}

extern "C" void kernel_launch(void* const* d_in, const int* in_sizes, int n_in, void* d_out, int out_size, void* d_ws, size_t ws_size, hipStream_t stream) {
  static int grid_blocks = 0;
  if (!grid_blocks) {
    int dev = 0, cus = 0, per_cu = 0;
    (void)hipGetDevice(&dev);
    (void)hipDeviceGetAttribute(&cus, hipDeviceAttributeMultiprocessorCount, dev);
    (void)hipOccupancyMaxActiveBlocksPerMultiprocessor(&per_cu, mega, NTHR, 0);
    if (per_cu > 1) per_cu = 1;
    grid_blocks = cus * per_cu;
    if (ws_size < OFF_END) fprintf(stderr, "kernel_launch: workspace too small: %zu < %zu\n", ws_size, (size_t)OFF_END);
  }
  Params p;
  memset(&p, 0, sizeof(p));
  p.x = (const float*)d_in[0]; p.g_mix = (const float*)d_in[1]; p.w_in = (const float*)d_in[2]; p.q_norm = (const float*)d_in[3];
  p.w_uq = (const float*)d_in[4]; p.kv_norm = (const float*)d_in[5]; p.w_ukv = (const float*)d_in[6]; p.rpb = (const float*)d_in[7];
  p.on_a = (const float*)d_in[8]; p.on_b = (const float*)d_in[9]; p.on_c = (const float*)d_in[10]; p.w_out = (const float*)d_in[11];
  p.g_mlp = (const float*)d_in[12]; p.w_mlp_in = (const float*)d_in[13]; p.w_mlp_out = (const float*)d_in[14]; p.g_final = (const float*)d_in[15];
  p.out = (float*)d_out; p.ws = (char*)d_ws;
  p.qscaleA = (float)(1.4426950408889634 / std::sqrt(96.0));
  p.qscaleB = (float)(1.4426950408889634 * 0.125);
#if ONE_LAUNCH
  int lo = 0, hi = NPHASE;
  void* args[] = {&p, &lo, &hi};
  hipError_t e = hipLaunchCooperativeKernel((void*)mega, dim3(grid_blocks), dim3(NTHR), args, 0, stream);
  if (e != hipSuccess) fprintf(stderr, "cooperative launch failed: %s (grid %d)\n", hipGetErrorString(e), grid_blocks);
#else
  for (int ph = 0; ph < NPHASE; ++ph) hipLaunchKernelGGL(mega, dim3(grid_blocks), dim3(NTHR), 0, stream, p, ph, ph + 1);
#endif
}
```

```cpp
#include <hip/hip_runtime.h>
#include <hip/hip_cooperative_groups.h>
#include <cstdio>
#include <cmath>
#include <cstring>
namespace cg = cooperative_groups;

#ifndef ONE_LAUNCH
#define ONE_LAUNCH 1
#endif

#define DI __device__ __forceinline__
typedef unsigned short bf16_t;
typedef short bf16x8 __attribute__((ext_vector_type(8)));
typedef short s16x4 __attribute__((ext_vector_type(4)));
typedef float f32x16 __attribute__((ext_vector_type(16)));
typedef float f32x2 __attribute__((ext_vector_type(2)));
typedef float f32x4 __attribute__((ext_vector_type(4)));
typedef __bf16 bf2_t __attribute__((ext_vector_type(2)));
typedef unsigned u32x4 __attribute__((ext_vector_type(4)));
typedef unsigned u32x2 __attribute__((ext_vector_type(2)));
typedef __attribute__((address_space(3))) s16x4 lds_s16x4;

constexpr int SEQ = 8192, NB = 4, NTOK = NB * SEQ, DM = 1024, NLAYER = 4;
constexpr int N_IN_PAD = 2560, N_UQ_PAD = 768, N_UKV = 768, DFF = 4096;
constexpr int NTHR = 512;

constexpr size_t SZ_XB = (size_t)NTOK * DM * 2;
constexpr size_t SZ_WIN = (size_t)N_IN_PAD * 1024 * 2, SZ_WUQ = (size_t)N_UQ_PAD * 256 * 2, SZ_WUKV = (size_t)N_UKV * 128 * 2,
                 SZ_WOUT = (size_t)1024 * 1024 * 2, SZ_W1 = (size_t)DFF * 1024 * 2, SZ_W2 = (size_t)1024 * DFF * 2;
constexpr size_t LW_WIN = 0, LW_WUQ = LW_WIN + SZ_WIN, LW_WUKV = LW_WUQ + SZ_WUQ, LW_WOUT = LW_WUKV + SZ_WUKV, LW_W1 = LW_WOUT + SZ_WOUT,
                 LW_W2 = LW_W1 + SZ_W1, LW_SIZE = LW_W2 + SZ_W2;
constexpr size_t OFF_XB = 0, OFF_W = OFF_XB + SZ_XB, OFF_TAB = OFF_W + NLAYER * LW_SIZE;
constexpr size_t OFF_COS32 = OFF_TAB, OFF_SIN32 = OFF_COS32 + (size_t)SEQ * 32 * 4, OFF_COS16 = OFF_SIN32 + (size_t)SEQ * 32 * 4,
                 OFF_SIN16 = OFF_COS16 + (size_t)SEQ * 16 * 4, OFF_ATT = OFF_SIN16 + (size_t)SEQ * 16 * 4;
constexpr size_t SZ_T384 = (size_t)NTOK * 384 * 2, SZ_QA = (size_t)NB * 6 * SEQ * 96 * 2, SZ_H6 = (size_t)NB * 6 * SEQ * 64 * 2,
                 SZ_H4 = (size_t)NB * 4 * SEQ * 64 * 2;
constexpr size_t OFF_CQKV = OFF_ATT;
constexpr size_t OFF_OA = OFF_CQKV;
constexpr size_t OFF_QA = OFF_CQKV + SZ_T384, OFF_KA = OFF_QA + SZ_QA, OFF_VA = OFF_KA + SZ_QA;
constexpr size_t OFF_QB = OFF_VA + SZ_H6, OFF_KB = OFF_QB + SZ_H6, OFF_VB = OFF_KB + SZ_H6;
constexpr size_t OFF_QC = OFF_VB + SZ_H6, OFF_KC = OFF_QC + SZ_H4, OFF_VC = OFF_KC + SZ_H4;
constexpr size_t OFF_OB = OFF_VC + SZ_H4, OFF_LSEB = OFF_OB + 3 * SZ_T384, OFF_OC = OFF_LSEB + (size_t)3 * NTOK * 6 * 4;
constexpr size_t OFF_SSQ = OFF_OC + (size_t)NTOK * 256 * 2;
constexpr size_t OFF_PX1 = OFF_SSQ, OFF_PX2 = OFF_PX1 + (size_t)NTOK * 16 * 4, OFF_PQ = OFF_PX2 + (size_t)NTOK * 16 * 4, OFF_PKV = OFF_PQ + (size_t)NTOK * 4 * 4;
constexpr size_t OFF_END = OFF_PKV + (size_t)NTOK * 2 * 4;
constexpr size_t OFF_MIXED = OFF_QA;
constexpr size_t OFF_HID = OFF_ATT;
static_assert(OFF_HID + (size_t)NTOK * DFF * 2 <= OFF_SSQ, "hid fits");
static_assert(OFF_MIXED + (size_t)NTOK * DM * 2 <= OFF_VA, "mixed fits");

struct Params {
  const float *x, *g_mix, *w_in, *q_norm, *w_uq, *kv_norm, *w_ukv, *rpb, *on_a, *on_b, *on_c, *w_out, *g_mlp, *w_mlp_in, *w_mlp_out, *g_final;
  float* out; char* ws;
  float qscaleA, qscaleB;
};
__shared__ __attribute__((aligned(1024))) char g_smem[131072];
#define NI __device__ __forceinline__
DI const Params& kparams() { return *(const Params*)__builtin_amdgcn_kernarg_segment_ptr(); }

DI unsigned cvtpk(float lo, float hi) { f32x2 v = {lo, hi}; bf2_t b = __builtin_convertvector(v, bf2_t); return __builtin_bit_cast(unsigned, b); }
DI bf16_t f2bf(float x) { return (bf16_t)(cvtpk(x, 0.f) & 0xffffu); }
DI float bf2f(unsigned h) { return __uint_as_float(h << 16); }
DI int crow(int i, int h) { return (i & 3) + 8 * (i >> 2) + 4 * h; }
#define MFMA32(a, b, c) __builtin_amdgcn_mfma_f32_32x32x16_bf16((a), (b), (c), 0, 0, 0)
DI float fdot2bf(unsigned a, float c) { bf2_t v = __builtin_bit_cast(bf2_t, a); return __builtin_amdgcn_fdot2_f32_bf16(v, v, c, false); }
DI float swap_max(float v) { auto rr = __builtin_amdgcn_permlane32_swap(__float_as_uint(v), __float_as_uint(v), false, false); return fmaxf(__uint_as_float(rr[0]), __uint_as_float(rr[1])); }
DI float swap_sum(float v) { auto rr = __builtin_amdgcn_permlane32_swap(__float_as_uint(v), __float_as_uint(v), false, false); return __uint_as_float(rr[0]) + __uint_as_float(rr[1]); }

constexpr int ATT_LDS = 45056;
#define FOR_TILES(NN, MT, NT, BODY) { const bool xm_ = gridDim.x == 256; const int st_ = xm_ ? (bid >> 3) : bid, sp_ = xm_ ? 32 : (int)gridDim.x, cn_ = xm_ ? 16 * (NN) : (NTOK / 256) * (NN); \
  for (int j_ = st_; j_ < cn_; j_ += sp_) { int MT = j_ / (NN); const int NT = j_ - MT * (NN); if (xm_) MT += (bid & 7) * 16; BODY } }
DI int otid() { int t = threadIdx.x; asm volatile("" : "+v"(t)); return t; }
DI int obid() { int t = blockIdx.x; asm volatile("" : "+s"(t)); return t; }

template <int NSLOT, class Epi>
DI void gemm_tile(const bf16_t* __restrict__ A, int lda, const bf16_t* __restrict__ Bt, int ldb, int K, int m0, int n0, const Epi& epi, const int tid, const float* pin) {
  const int lane = tid & 63, w = tid >> 6, wm = w >> 2, wn = w & 3, r32 = lane & 31, hi = lane >> 5;
  char* smem = g_smem;
  const int lrow = lane >> 3;
  const int c0 = (lane & 7) ^ (lane >> 4), c1 = (lane & 7) ^ ((lane >> 4) | 4);
  const char* Ab = (const char*)(A + (size_t)m0 * lda);
  const char* Bb = (const char*)(Bt + (size_t)n0 * ldb);
  const unsigned oa0 = (unsigned)(((w * 32 + lrow) * lda + c0 * 8) * 2), oa1 = (unsigned)(((w * 32 + lrow) * lda + c1 * 8) * 2);
  const unsigned ob0 = (unsigned)(((w * 32 + lrow) * ldb + c0 * 8) * 2), ob1 = (unsigned)(((w * 32 + lrow) * ldb + c1 * 8) * 2);
  const int dma_off = (w * 32) * 128 + lane * 16;
  f32x16 acc[4][2];
#pragma unroll
  for (int mi = 0; mi < 4; ++mi)
#pragma unroll
    for (int nj = 0; nj < 2; ++nj)
#pragma unroll
      for (int i = 0; i < 16; ++i) acc[mi][nj][i] = 0.f;
  const int nk = K >> 6;
  const int sw = (r32 >> 1) & 7, sh = sw >> 1, lo16 = 16 * (hi ^ (sw & 1));
  const int a_off = (wm * 128 + r32) * 128 + lo16;
  const int b_off = 32768 + (wn * 64 + r32) * 128 + lo16;
  __syncthreads();
  {
    char* sa = smem + dma_off;
#pragma unroll
    for (int j = 0; j < 4; ++j) {
      __builtin_amdgcn_global_load_lds((const unsigned*)(Ab + (size_t)(j * 8 * lda) * 2 + ((j & 1) ? oa1 : oa0)), (unsigned*)(sa + j * 1024), 16, 0, 0);
      __builtin_amdgcn_global_load_lds((const unsigned*)(Bb + (size_t)(j * 8 * ldb) * 2 + ((j & 1) ? ob1 : ob0)), (unsigned*)(sa + 32768 + j * 1024), 16, 0, 0);
    }
  }
  for (int kt = 0; kt < nk; ++kt) {
    __syncthreads();
    if (kt + 1 < nk) {
      char* sa = smem + ((kt + 1) & 1) * 65536 + dma_off;
      const int k0 = (kt + 1) * 64;
#pragma unroll
      for (int j = 0; j < 4; ++j) {
        __builtin_amdgcn_global_load_lds((const unsigned*)(Ab + (size_t)(j * 8 * lda + k0) * 2 + ((j & 1) ? oa1 : oa0)), (unsigned*)(sa + j * 1024), 16, 0, 0);
        __builtin_amdgcn_global_load_lds((const unsigned*)(Bb + (size_t)(j * 8 * ldb + k0) * 2 + ((j & 1) ? ob1 : ob0)), (unsigned*)(sa + 32768 + j * 1024), 16, 0, 0);
      }
    }
    const char* sb = smem + (kt & 1) * 65536;
#pragma unroll
    for (int ks = 0; ks < 4; ++ks) {
      const int koff = 32 * (ks ^ sh);
      bf16x8 af[4], bfr[2];
#pragma unroll
      for (int mi = 0; mi < 4; ++mi) af[mi] = *(const bf16x8*)(sb + a_off + mi * 4096 + koff);
#pragma unroll
      for (int nj = 0; nj < 2; ++nj) bfr[nj] = *(const bf16x8*)(sb + b_off + nj * 4096 + koff);
#pragma unroll
      for (int mi = 0; mi < 4; ++mi)
#pragma unroll
        for (int nj = 0; nj < 2; ++nj) acc[mi][nj] = MFMA32(af[mi], bfr[nj], acc[mi][nj]);
    }
  }
  float* rstd_s = (float*)smem;
  if (NSLOT > 0) {
    __syncthreads();
    if (tid < 256) {
      const float* pr = pin + (size_t)(m0 + tid) * NSLOT;
      float sacc = 0.f;
      if (NSLOT >= 4) {
#pragma unroll
        for (int q = 0; q < NSLOT / 4; ++q) { const f32x4 v = *(const f32x4*)(pr + 4 * q); sacc += (v[0] + v[1]) + (v[2] + v[3]); }
      } else {
#pragma unroll
        for (int q = 0; q < NSLOT; ++q) sacc += pr[q];
      }
      rstd_s[tid] = rsqrtf(sacc / (float)K + 1e-6f);
    }
    __syncthreads();
  }
  int lane2 = lane, w2 = w; asm volatile("" : "+v"(lane2), "+v"(w2));
  epi(acc, m0, (w2 >> 2) * 128, n0 + (w2 & 3) * 64, lane2, rstd_s);
}
DI void row_ssq_put(float v, float* dst, int lane) {
  v += __shfl_xor(v, 1); v += __shfl_xor(v, 2); v += __shfl_xor(v, 4); v += __shfl_xor(v, 8); v += __shfl_xor(v, 16);
  if ((lane & 31) == 0) *dst = v;
}

struct EpiG1 {
  bf16_t *cqkv, *KA, *qB, *qC; const float *cos32, *sin32, *cos16, *sin16; float qs; float *pq, *pkv;
  DI void operator()(f32x16 (&acc)[4][2], int m0, int lr0, int col0, int lane, const float* rstd_s) const {
    const int c = lane & 31, h = lane >> 5, cb = col0 >> 6;
    if (cb >= 37) return;
#define G1_ROW const int lr = lr0 + mi * 32 + crow(i, h), tok = m0 + lr, b = tok >> 13, s = tok & 8191; (void)b; (void)s; \
               const float rs = rstd_s[lr]; float v0 = acc[mi][0][i] * rs, v1 = acc[mi][1][i] * rs;
    if (cb < 6) {
#pragma unroll
      for (int mi = 0; mi < 4; ++mi)
#pragma unroll
        for (int i = 0; i < 16; ++i) {
        if ((i & 3) == 0) __builtin_amdgcn_sched_barrier(0);
          G1_ROW
          bf16_t* d = cqkv + (size_t)tok * 384 + cb * 64 + c; d[0] = f2bf(v0); d[32] = f2bf(v1);
          row_ssq_put(v0 * v0 + v1 * v1, cb < 4 ? pq + (size_t)tok * 4 + cb : pkv + (size_t)tok * 2 + (cb - 4), lane);
        }
    } else if (cb == 6) {
#pragma unroll
      for (int mi = 0; mi < 4; ++mi)
#pragma unroll
        for (int i = 0; i < 16; ++i) {
        if ((i & 3) == 0) __builtin_amdgcn_sched_barrier(0);
          G1_ROW
          if (c < 16) {
            const float cs = cos16[s * 16 + c], sn = sin16[s * 16 + c];
            const bf16_t o1 = f2bf(v0 * cs - v1 * sn), o2 = f2bf(v0 * sn + v1 * cs);
#pragma unroll
            for (int hd = 0; hd < 6; ++hd) { bf16_t* d = KA + ((size_t)(b * 6 + hd) * SEQ + s) * 96 + 64 + c; d[0] = o1; d[16] = o2; }
          }
        }
    } else if (cb < 25) {
      const int idx = cb - 7, which = idx / 6, hd = idx - which * 6;
      bf16_t* base = qB + (size_t)which * (SZ_H6 / 2) + (size_t)hd * SEQ * 64 + c;
      const float sc = which == 0 ? qs : 1.f;
      if (which < 2) {
#pragma unroll
        for (int mi = 0; mi < 4; ++mi)
#pragma unroll
          for (int i = 0; i < 16; ++i) {
        if ((i & 3) == 0) __builtin_amdgcn_sched_barrier(0);
            G1_ROW
            const float cs = cos32[s * 32 + c] * sc, sn = sin32[s * 32 + c] * sc;
            bf16_t* d = base + ((size_t)(b * 6) * SEQ + s) * 64;
            d[0] = f2bf(v0 * cs - v1 * sn); d[32] = f2bf(v0 * sn + v1 * cs);
          }
      } else {
#pragma unroll
        for (int mi = 0; mi < 4; ++mi)
#pragma unroll
          for (int i = 0; i < 16; ++i) {
        if ((i & 3) == 0) __builtin_amdgcn_sched_barrier(0);
            G1_ROW
            bf16_t* d = base + ((size_t)(b * 6) * SEQ + s) * 64;
            d[0] = f2bf(v0); d[32] = f2bf(v1);
          }
      }
    } else {
      const int idx = cb - 25, which = idx >> 2, hd = idx & 3;
      bf16_t* base = qC + (size_t)which * (SZ_H4 / 2) + (size_t)hd * SEQ * 64 + c;
      const float sc = which == 0 ? qs : 1.f;
#pragma unroll
      for (int mi = 0; mi < 4; ++mi)
#pragma unroll
        for (int i = 0; i < 16; ++i) {
        if ((i & 3) == 0) __builtin_amdgcn_sched_barrier(0);
          G1_ROW
          bf16_t* d = base + ((size_t)(b * 4) * SEQ + s) * 64;
          d[0] = f2bf(v0 * sc); d[32] = f2bf(v1 * sc);
        }
    }
#undef G1_ROW
  }
};
struct EpiUQ {
  bf16_t* QA; const float *cos16, *sin16; float qs;
  DI void operator()(f32x16 (&acc)[4][2], int m0, int lr0, int col0, int lane, const float* rstd_s) const {
    const int c = lane & 31, h = lane >> 5, cb = col0 >> 6;
    if (cb >= 9) return;
#pragma unroll
    for (int mi = 0; mi < 4; ++mi)
#pragma unroll
      for (int i = 0; i < 16; ++i) {
        if ((i & 3) == 0) __builtin_amdgcn_sched_barrier(0);
        const int lr = lr0 + mi * 32 + crow(i, h), tok = m0 + lr, b = tok >> 13, s = tok & 8191;
        const float rs = rstd_s[lr] * qs;
        const float v0 = acc[mi][0][i] * rs, v1 = acc[mi][1][i] * rs;
        if (cb < 6) {
          bf16_t* d = QA + ((size_t)(b * 6 + cb) * SEQ + s) * 96 + c; d[0] = f2bf(v0); d[32] = f2bf(v1);
        } else {
          const int hd = 2 * (cb - 6) + (c >> 4), fi = c & 15;
          const float cs = cos16[s * 16 + fi], sn = sin16[s * 16 + fi];
          bf16_t* d = QA + ((size_t)(b * 6 + hd) * SEQ + s) * 96 + 64 + fi;
          d[0] = f2bf(v0 * cs - v1 * sn); d[16] = f2bf(v0 * sn + v1 * cs);
        }
      }
  }
};
struct EpiUKV {
  bf16_t *KA, *VA;
  DI void operator()(f32x16 (&acc)[4][2], int m0, int lr0, int col0, int lane, const float* rstd_s) const {
    const int c = lane & 31, h = lane >> 5, cb = col0 >> 6, hd = cb >> 1, isv = cb & 1;
#pragma unroll
    for (int mi = 0; mi < 4; ++mi)
#pragma unroll
      for (int i = 0; i < 16; ++i) {
        if ((i & 3) == 0) __builtin_amdgcn_sched_barrier(0);
        const int lr = lr0 + mi * 32 + crow(i, h), tok = m0 + lr, b = tok >> 13, s = tok & 8191;
        const float rs = rstd_s[lr];
        const float v0 = acc[mi][0][i] * rs, v1 = acc[mi][1][i] * rs;
        bf16_t* d = isv ? VA + ((size_t)(b * 6 + hd) * SEQ + s) * 64 + c : KA + ((size_t)(b * 6 + hd) * SEQ + s) * 96 + c;
        d[0] = f2bf(v0); d[32] = f2bf(v1);
      }
  }
};
struct EpiRes {
  const float* xold; float* xf; bf16_t* xb; float* pout;
  DI void operator()(f32x16 (&acc)[4][2], int m0, int lr0, int col0, int lane, const float* rstd_s) const {
    const int c = lane & 31, h = lane >> 5;
#pragma unroll
    for (int mi = 0; mi < 4; ++mi)
#pragma unroll
      for (int i = 0; i < 16; ++i) {
        if ((i & 3) == 0) __builtin_amdgcn_sched_barrier(0);
        const int row = m0 + lr0 + mi * 32 + crow(i, h);
        const size_t o = (size_t)row * DM + col0 + c;
        const float v0 = xold[o] + acc[mi][0][i], v1 = xold[o + 32] + acc[mi][1][i];
        xf[o] = v0; xf[o + 32] = v1; xb[o] = f2bf(v0); xb[o + 32] = f2bf(v1);
        row_ssq_put(v0 * v0 + v1 * v1, pout + (size_t)row * 16 + (col0 >> 6), lane);
      }
  }
};
struct EpiMlp1 {
  bf16_t* hid;
  DI void operator()(f32x16 (&acc)[4][2], int m0, int lr0, int col0, int lane, const float* rstd_s) const {
    const int c = lane & 31, h = lane >> 5;
#pragma unroll
    for (int mi = 0; mi < 4; ++mi)
#pragma unroll
      for (int i = 0; i < 16; ++i) {
        if ((i & 3) == 0) __builtin_amdgcn_sched_barrier(0);
        const int lr = lr0 + mi * 32 + crow(i, h);
        const float rs = rstd_s[lr];
        const float v0 = fmaxf(acc[mi][0][i] * rs, 0.f), v1 = fmaxf(acc[mi][1][i] * rs, 0.f);
        bf16_t* d = hid + (size_t)(m0 + lr) * DFF + col0 + c; d[0] = f2bf(v0 * v0); d[32] = f2bf(v1 * v1);
      }
  }
};

struct AttnItem {
  const bf16_t *Q, *K, *V;
  int q0;
  int n0, dil, res, N;
  int nrb, ncb, kr0, kc0;
  bf16_t* out; int ldo;
  float* lse;
  const float* rpb;
};

template <int DQ, int MODE>
DI void attn_block(const AttnItem& it, char* smem, const int tid) {
  constexpr int CPR = DQ / 8, KST = DQ * 2 + 16, KCH = (64 * CPR) / 256, NT = MODE == 0 ? SEQ / 64 : MODE == 1 ? 4 : 8;
  const int lane = tid & 63, w = tid >> 6, r32 = lane & 31, hi = lane >> 5;
  char* Ks = smem; char* Vs = smem + 64 * KST; float* bias_s = (float*)(smem + 64 * KST + 8192);
  const int qi = w * 32 + r32;
  int qpos;
  if (MODE == 0) qpos = it.q0 + qi;
  else if (MODE == 1) qpos = (it.n0 + qi) * it.dil + it.res;
  else qpos = (8 * it.nrb + (qi >> 4)) * 64 + 16 * it.ncb + (qi & 15);
  __syncthreads();
  if (MODE == 2) { for (int i = tid; i < 465; i += 256) bias_s[i] = it.rpb[i] * 1.4426950408889634f; }
  bf16x8 qr[DQ / 16];
#pragma unroll
  for (int d0 = 0; d0 < DQ / 16; ++d0) qr[d0] = *(const bf16x8*)(it.Q + (size_t)qpos * DQ + d0 * 16 + hi * 8);
  f32x16 o[2];
#pragma unroll
  for (int i = 0; i < 16; ++i) { o[0][i] = 0.f; o[1][i] = 0.f; }
  float m_run = -1e30f, l_run = 0.f;
  u32x4 rk[KCH], rv[2];
  auto kpos = [&](int t, int row) -> int {
    if (MODE == 0) return t * 64 + row;
    if (MODE == 1) { int n = it.n0 - 64 + 64 * t + row; n = n < 0 ? 0 : (n > it.N - 1 ? it.N - 1 : n); return n * it.dil + it.res; }
    return (it.kr0 + 2 * t + (row >> 5)) * 64 + it.kc0 + (row & 31);
  };
  auto load = [&](int t) {
#pragma unroll
    for (int i = 0; i < KCH; ++i) { const int c = tid + 256 * i, row = c / CPR, kc = c - row * CPR; rk[i] = *(const u32x4*)(it.K + (size_t)kpos(t, row) * DQ + kc * 8); }
#pragma unroll
    for (int i = 0; i < 2; ++i) { const int c = tid + 256 * i, row = c >> 3, kc = c & 7; rv[i] = *(const u32x4*)(it.V + (size_t)kpos(t, row) * 64 + kc * 8); }
  };
  const int vrd = ((lane >> 5) * 4 + ((lane & 15) >> 2)) * 64 + ((lane >> 4) & 1) * 32 + (lane & 3) * 8;
  load(0);
  for (int t = 0; t < NT; ++t) {
    __syncthreads();
#pragma unroll
    for (int i = 0; i < KCH; ++i) { const int c = tid + 256 * i, row = c / CPR, kc = c - row * CPR; *(u32x4*)(Ks + row * KST + kc * 16) = rk[i]; }
#pragma unroll
    for (int i = 0; i < 2; ++i) { const int c = tid + 256 * i, row = c >> 3, kc = c & 7; *(u32x4*)(Vs + (kc >> 2) * 4096 + row * 64 + (kc & 3) * 16) = rv[i]; }
    __syncthreads();
    if (t + 1 < NT) load(t + 1);
    bool skip = false;
    if (MODE == 1) skip = (w < 2) ? (t == 3) : (t == 0);
    if (MODE == 2) {
      const int rq_lo = 8 * it.nrb + 2 * w, rq_hi = rq_lo + 1;
      const int rs_lo = min(max(rq_lo - 4, 0), 120), rs_hi = min(max(rq_hi - 4, 0), 120) + 7;
      const int kr = it.kr0 + 2 * t;
      skip = (kr + 1 < rs_lo) || (kr > rs_hi);
    }
    if (skip) continue;
    f32x16 p0, p1;
#pragma unroll
    for (int i = 0; i < 16; ++i) { p0[i] = 0.f; p1[i] = 0.f; }
#pragma unroll
    for (int d0 = 0; d0 < DQ / 16; ++d0) {
      const bf16x8 k0 = *(const bf16x8*)(Ks + r32 * KST + d0 * 32 + hi * 16);
      const bf16x8 k1 = *(const bf16x8*)(Ks + (32 + r32) * KST + d0 * 32 + hi * 16);
      p0 = MFMA32(k0, qr[d0], p0); p1 = MFMA32(k1, qr[d0], p1);
    }
    if (MODE == 1) {
      const int nq = it.n0 + qi, kb = it.n0 - 64 + 64 * t;
#pragma unroll
      for (int i = 0; i < 16; ++i) {
        const int nk = kb + crow(i, hi), nk2 = nk + 32;
        const int d1 = nq - nk, d2 = nq - nk2;
        const bool ok1 = (d1 <= 64) && (d1 >= -64) && (nk >= 0) && (nk < it.N);
        const bool ok2 = (d2 <= 64) && (d2 >= -64) && (nk2 >= 0) && (nk2 < it.N);
        p0[i] = ok1 ? p0[i] : -INFINITY; p1[i] = ok2 ? p1[i] : -INFINITY;
      }
    }
    if (MODE == 2) {
      const int rq = 8 * it.nrb + (qi >> 4), cq = 16 * it.ncb + (qi & 15);
      const int rs_ = min(max(rq - 4, 0), 120), cs_ = min(max(cq - 8, 0), 48);
      const int kr = it.kr0 + 2 * t;
      const bool okr0 = (kr >= rs_) && (kr < rs_ + 8), okr1 = (kr + 1 >= rs_) && (kr + 1 < rs_ + 8);
      const int bi0 = (kr - rq + 7) * 31 - cq + 15;
#pragma unroll
      for (int i = 0; i < 16; ++i) {
        const int kc = it.kc0 + crow(i, hi);
        const bool okc = (kc >= cs_) && (kc < cs_ + 16);
        const bool ok0 = okc && okr0, ok1 = okc && okr1;
        const float b0 = bias_s[ok0 ? bi0 + kc : 0], b1 = bias_s[ok1 ? bi0 + 31 + kc : 0];
        p0[i] = ok0 ? p0[i] + b0 : -INFINITY; p1[i] = ok1 ? p1[i] + b1 : -INFINITY;
      }
    }
    float pmax = p0[0];
#pragma unroll
    for (int i = 1; i < 16; ++i) pmax = fmaxf(pmax, p0[i]);
#pragma unroll
    for (int i = 0; i < 16; ++i) pmax = fmaxf(pmax, p1[i]);
    pmax = swap_max(pmax);
    const float mn = fmaxf(m_run, pmax);
    const float alpha = __builtin_amdgcn_exp2f(m_run - mn);
    m_run = mn;
    float ps = 0.f;
#pragma unroll
    for (int i = 0; i < 16; ++i) { p0[i] = __builtin_amdgcn_exp2f(p0[i] - mn); ps += p0[i]; }
#pragma unroll
    for (int i = 0; i < 16; ++i) { p1[i] = __builtin_amdgcn_exp2f(p1[i] - mn); ps += p1[i]; }
    ps = swap_sum(ps);
    l_run = l_run * alpha + ps;
#pragma unroll
    for (int i = 0; i < 16; ++i) { o[0][i] *= alpha; o[1][i] *= alpha; }
    bf16x8 pb[4];
#pragma unroll
    for (int s = 0; s < 2; ++s) {
      u32x4 a = {cvtpk(p0[8 * s], p0[8 * s + 1]), cvtpk(p0[8 * s + 2], p0[8 * s + 3]), cvtpk(p0[8 * s + 4], p0[8 * s + 5]), cvtpk(p0[8 * s + 6], p0[8 * s + 7])};
      u32x4 b = {cvtpk(p1[8 * s], p1[8 * s + 1]), cvtpk(p1[8 * s + 2], p1[8 * s + 3]), cvtpk(p1[8 * s + 4], p1[8 * s + 5]), cvtpk(p1[8 * s + 6], p1[8 * s + 7])};
      pb[s] = __builtin_bit_cast(bf16x8, a); pb[2 + s] = __builtin_bit_cast(bf16x8, b);
    }
#pragma unroll
    for (int db = 0; db < 2; ++db)
#pragma unroll
      for (int s = 0; s < 4; ++s) {
        const s16x4 lo = __builtin_amdgcn_ds_read_tr16_b64_v4i16((lds_s16x4*)(Vs + db * 4096 + (16 * s) * 64 + vrd));
        const s16x4 hh = __builtin_amdgcn_ds_read_tr16_b64_v4i16((lds_s16x4*)(Vs + db * 4096 + (16 * s + 8) * 64 + vrd));
        const bf16x8 a = {lo[0], lo[1], lo[2], lo[3], hh[0], hh[1], hh[2], hh[3]};
        o[db] = MFMA32(a, pb[s], o[db]);
      }
  }
  const float inv = 1.f / l_run;
  const int bq = qpos;
  bf16_t* orow = it.out + (size_t)bq * it.ldo;
#pragma unroll
  for (int db = 0; db < 2; ++db)
#pragma unroll
    for (int g = 0; g < 4; ++g) {
      u32x2 v = {cvtpk(o[db][4 * g] * inv, o[db][4 * g + 1] * inv), cvtpk(o[db][4 * g + 2] * inv, o[db][4 * g + 3] * inv)};
      *(u32x2*)(orow + db * 32 + 8 * g + 4 * hi) = v;
    }
  if (MODE == 1) { if (hi == 0) it.lse[(size_t)bq * 6] = m_run + __builtin_amdgcn_logf(l_run); }
}

DI void attn_dense_skew(const bf16_t* __restrict__ Q, const bf16_t* __restrict__ K, const bf16_t* __restrict__ V, int q0, bf16_t* __restrict__ out,
                        char* smem, const int tid, const int grp) {
  constexpr int DQ = 96, CPR = 12, KST = 208, NT = SEQ / 64, STG = 64 * KST + 8192;
  const int lane = tid & 63, w = tid >> 6, r32 = lane & 31, hi = lane >> 5;
  const int qpos = q0 + w * 32 + r32;
  bf16x8 qr[DQ / 16];
#pragma unroll
  for (int d0 = 0; d0 < DQ / 16; ++d0) qr[d0] = *(const bf16x8*)(Q + (size_t)qpos * DQ + d0 * 16 + hi * 8);
  f32x16 o[2];
#pragma unroll
  for (int i = 0; i < 16; ++i) { o[0][i] = 0.f; o[1][i] = 0.f; }
  float m_run = -1e30f, l_run = 0.f;
  u32x4 rk[3], rv[2];
  auto load = [&](int t) {
#pragma unroll
    for (int i = 0; i < 3; ++i) { const int c = tid + 256 * i, row = c / CPR, kc = c - row * CPR; rk[i] = *(const u32x4*)(K + (size_t)(t * 64 + row) * DQ + kc * 8); }
#pragma unroll
    for (int i = 0; i < 2; ++i) { const int c = tid + 256 * i, row = c >> 3, kc = c & 7; rv[i] = *(const u32x4*)(V + (size_t)(t * 64 + row) * 64 + kc * 8); }
  };
  auto store = [&](int b) {
    char* Ks = smem + b * STG; char* Vs = Ks + 64 * KST;
#pragma unroll
    for (int i = 0; i < 3; ++i) { const int c = tid + 256 * i, row = c / CPR, kc = c - row * CPR; *(u32x4*)(Ks + row * KST + kc * 16) = rk[i]; }
#pragma unroll
    for (int i = 0; i < 2; ++i) { const int c = tid + 256 * i, row = c >> 3, kc = c & 7; *(u32x4*)(Vs + (kc >> 2) * 4096 + row * 64 + (kc & 3) * 16) = rv[i]; }
  };
  const int vrd = ((lane >> 5) * 4 + ((lane & 15) >> 2)) * 64 + ((lane >> 4) & 1) * 32 + (lane & 3) * 8;
  __syncthreads();
  load(0); store(0); load(1);
  __syncthreads();
  if (grp == 1) __syncthreads();
  for (int t = 0; t < NT; ++t) {
    const char* Ks = smem + (t & 1) * STG; const char* Vs = Ks + 64 * KST;
    if (t + 1 < NT) store((t + 1) & 1);
    if (t + 2 < NT) load(t + 2);
    f32x16 p0, p1;
#pragma unroll
    for (int i = 0; i < 16; ++i) { p0[i] = 0.f; p1[i] = 0.f; }
    {
      const char* kp = Ks + r32 * KST + hi * 16;
      bf16x8 ka[2][2];
      ka[0][0] = *(const bf16x8*)(kp); ka[0][1] = *(const bf16x8*)(kp + 32 * KST);
      ka[1][0] = *(const bf16x8*)(kp + 32); ka[1][1] = *(const bf16x8*)(kp + 32 * KST + 32);
#pragma unroll
      for (int d0 = 0; d0 < DQ / 16; ++d0) {
        p0 = MFMA32(ka[d0 & 1][0], qr[d0], p0); p1 = MFMA32(ka[d0 & 1][1], qr[d0], p1);
        if (d0 + 2 < DQ / 16) { ka[d0 & 1][0] = *(const bf16x8*)(kp + (d0 + 2) * 32); ka[d0 & 1][1] = *(const bf16x8*)(kp + 32 * KST + (d0 + 2) * 32); }
      }
    }
    asm volatile("" : "+v"(p0), "+v"(p1));
    __syncthreads();
    asm volatile("" : "+v"(p0), "+v"(p1));
    s16x4 vlo[4], vhi[4];
#pragma unroll
    for (int s2 = 0; s2 < 4; ++s2) {
      vlo[s2] = __builtin_amdgcn_ds_read_tr16_b64_v4i16((lds_s16x4*)(Vs + (16 * s2) * 64 + vrd));
      vhi[s2] = __builtin_amdgcn_ds_read_tr16_b64_v4i16((lds_s16x4*)(Vs + (16 * s2 + 8) * 64 + vrd));
    }
    float pmax = p0[0];
#pragma unroll
    for (int i = 1; i < 16; ++i) pmax = fmaxf(pmax, p0[i]);
#pragma unroll
    for (int i = 0; i < 16; ++i) pmax = fmaxf(pmax, p1[i]);
    pmax = swap_max(pmax);
    const float mn = fmaxf(m_run, pmax);
    const float alpha = __builtin_amdgcn_exp2f(m_run - mn);
    m_run = mn;
    float ps = 0.f;
#pragma unroll
    for (int i = 0; i < 16; ++i) { p0[i] = __builtin_amdgcn_exp2f(p0[i] - mn); ps += p0[i]; }
#pragma unroll
    for (int i = 0; i < 16; ++i) { p1[i] = __builtin_amdgcn_exp2f(p1[i] - mn); ps += p1[i]; }
    ps = swap_sum(ps);
    l_run = l_run * alpha + ps;
#pragma unroll
    for (int i = 0; i < 16; ++i) { o[0][i] *= alpha; o[1][i] *= alpha; }
    bf16x8 pb[4];
#pragma unroll
    for (int s = 0; s < 2; ++s) {
      u32x4 a = {cvtpk(p0[8 * s], p0[8 * s + 1]), cvtpk(p0[8 * s + 2], p0[8 * s + 3]), cvtpk(p0[8 * s + 4], p0[8 * s + 5]), cvtpk(p0[8 * s + 6], p0[8 * s + 7])};
      u32x4 b = {cvtpk(p1[8 * s], p1[8 * s + 1]), cvtpk(p1[8 * s + 2], p1[8 * s + 3]), cvtpk(p1[8 * s + 4], p1[8 * s + 5]), cvtpk(p1[8 * s + 6], p1[8 * s + 7])};
      pb[s] = __builtin_bit_cast(bf16x8, a); pb[2 + s] = __builtin_bit_cast(bf16x8, b);
    }
    {
      s16x4 wlo[4], whi[4];
#pragma unroll
      for (int s2 = 0; s2 < 4; ++s2) {
        wlo[s2] = __builtin_amdgcn_ds_read_tr16_b64_v4i16((lds_s16x4*)(Vs + 4096 + (16 * s2) * 64 + vrd));
        whi[s2] = __builtin_amdgcn_ds_read_tr16_b64_v4i16((lds_s16x4*)(Vs + 4096 + (16 * s2 + 8) * 64 + vrd));
      }
#pragma unroll
      for (int s2 = 0; s2 < 4; ++s2) { const bf16x8 a = {vlo[s2][0], vlo[s2][1], vlo[s2][2], vlo[s2][3], vhi[s2][0], vhi[s2][1], vhi[s2][2], vhi[s2][3]}; o[0] = MFMA32(a, pb[s2], o[0]); }
#pragma unroll
      for (int s2 = 0; s2 < 4; ++s2) { const bf16x8 a = {wlo[s2][0], wlo[s2][1], wlo[s2][2], wlo[s2][3], whi[s2][0], whi[s2][1], whi[s2][2], whi[s2][3]}; o[1] = MFMA32(a, pb[s2], o[1]); }
    }
    asm volatile("" : "+v"(o[0]), "+v"(o[1]));
    __syncthreads();
    asm volatile("" : "+v"(o[0]), "+v"(o[1]));
  }
  if (grp == 0) __syncthreads();
  const float inv = 1.f / l_run;
  bf16_t* orow = out + (size_t)qpos * 384;
#pragma unroll
  for (int db = 0; db < 2; ++db)
#pragma unroll
    for (int g = 0; g < 4; ++g) {
      u32x2 v = {cvtpk(o[db][4 * g] * inv, o[db][4 * g + 1] * inv), cvtpk(o[db][4 * g + 2] * inv, o[db][4 * g + 3] * inv)};
      *(u32x2*)(orow + db * 32 + 8 * g + 4 * hi) = v;
    }
}

DI float wave_sum(float v) {
  v += __shfl_xor(v, 32); v += __shfl_xor(v, 16); v += __shfl_xor(v, 8); v += __shfl_xor(v, 4); v += __shfl_xor(v, 2); v += __shfl_xor(v, 1); return v;
}
DI float gain_of(const Params& p, int kind, int l, int k) {
  switch (kind) {
    case 0: return p.g_mix[l * 1024 + k];
    case 1: return p.q_norm[l * 256 + k];
    case 2: return p.kv_norm[l * 128 + k];
    case 3: return k < 384 ? p.on_a[l * 384 + k] : (k < 768 ? p.on_b[l * 384 + k - 384] : p.on_c[l * 256 + k - 768]);
    case 4: return p.g_mlp[l * 1024 + k];
    default: return 1.f;
  }
}
DI int map_col(int kind, int n) {
  if (kind == 0) {
    if (n < 384) return n;
    if (n < 448) { const int wv = n - 384, c = wv & 31, sub = wv >> 5; return c < 16 ? 384 + sub * 16 + c : -1; }
    if (n < 1600) return 416 + (n - 448);
    if (n < 2368) return 1568 + (n - 1600);
    return -1;
  }
  if (kind == 1) {
    if (n < 384) return (n >> 6) * 96 + (n & 63);
    if (n < 576) { const int wv = n - 384, g = wv >> 6, wi = wv & 63, sub = wi >> 5, c = wi & 31, hd = 2 * g + (c >> 4), fi = c & 15; return hd * 96 + 64 + sub * 16 + fi; }
    return -1;
  }
  return n;
}
DI void wtile(const Params& p, const float* src, int Nsrc, bf16_t* dst, int K, int kt, int nt, int kind, int l, char* smem, const int tid) {
  float* tile = (float*)smem;
  const int lane = tid & 63, wv = tid >> 6;
  __syncthreads();
  const int n = nt * 64 + lane, sc = map_col(kind, n);
#pragma unroll 4
  for (int r = 0; r < 8; ++r) {
    const int kl = r * 8 + wv, k = kt * 64 + kl;
    float v = 0.f;
    if (sc >= 0) v = src[(size_t)k * Nsrc + sc] * gain_of(p, kind, l, k);
    tile[kl * 65 + lane] = v;
  }
  __syncthreads();
#pragma unroll 4
  for (int r = 0; r < 8; ++r) {
    const int nl = r * 8 + wv;
    dst[(size_t)(nt * 64 + nl) * K + kt * 64 + lane] = f2bf(tile[lane * 65 + nl]);
  }
}

NI void phase_prep() {
  const Params& p = kparams(); char* smem = g_smem; const int tid = otid(), bid = obid();
  char* ws = p.ws;
  constexpr int T_WIN = (N_IN_PAD / 64) * 16, T_WUQ = (N_UQ_PAD / 64) * 4, T_WUKV = (N_UKV / 64) * 2, T_WOUT = 16 * 16, T_W1 = 64 * 16, T_W2 = 16 * 64;
  constexpr int T_L = T_WIN + T_WUQ + T_WUKV + T_WOUT + T_W1 + T_W2;
  for (int j = bid; j < NLAYER * T_L; j += gridDim.x) {
    const int l = j / T_L; int r = j - l * T_L;
    char* lw = ws + OFF_W + (size_t)l * LW_SIZE;
    if (r < T_WIN) { wtile(p, p.w_in + (size_t)l * 1024 * 2336, 2336, (bf16_t*)(lw + LW_WIN), 1024, r & 15, r >> 4, 0, l, smem, tid); continue; }
    r -= T_WIN;
    if (r < T_WUQ) { wtile(p, p.w_uq + (size_t)l * 256 * 576, 576, (bf16_t*)(lw + LW_WUQ), 256, r & 3, r >> 2, 1, l, smem, tid); continue; }
    r -= T_WUQ;
    if (r < T_WUKV) { wtile(p, p.w_ukv + (size_t)l * 128 * 768, 768, (bf16_t*)(lw + LW_WUKV), 128, r & 1, r >> 1, 2, l, smem, tid); continue; }
    r -= T_WUKV;
    if (r < T_WOUT) { wtile(p, p.w_out + (size_t)l * 1024 * 1024, 1024, (bf16_t*)(lw + LW_WOUT), 1024, r & 15, r >> 4, 3, l, smem, tid); continue; }
    r -= T_WOUT;
    if (r < T_W1) { wtile(p, p.w_mlp_in + (size_t)l * 1024 * 4096, 4096, (bf16_t*)(lw + LW_W1), 1024, r & 15, r >> 4, 4, l, smem, tid); continue; }
    r -= T_W1;
    wtile(p, p.w_mlp_out + (size_t)l * 4096 * 1024, 1024, (bf16_t*)(lw + LW_W2), 4096, r & 63, r >> 6, 5, l, smem, tid);
  }
  const size_t gtid = (size_t)bid * NTHR + tid, gsz = (size_t)gridDim.x * NTHR;
  bf16_t* xb = (bf16_t*)(ws + OFF_XB);
  {
    const int lane = tid & 63, gw = bid * (NTHR / 64) + (tid >> 6), nw = gridDim.x * (NTHR / 64);
    float* px1 = (float*)(ws + OFF_PX1);
    for (int row = gw; row < NTOK; row += nw) {
      float ss = 0.f;
#pragma unroll
      for (int j = 0; j < 4; ++j) {
        const f32x4 a = *(const f32x4*)(p.x + (size_t)row * DM + j * 256 + lane * 4);
        ss += a[0] * a[0] + a[1] * a[1] + a[2] * a[2] + a[3] * a[3];
        u32x2 o = {cvtpk(a[0], a[1]), cvtpk(a[2], a[3])};
        *(u32x2*)(xb + (size_t)row * DM + j * 256 + lane * 4) = o;
      }
      ss = wave_sum(ss);
      if (lane < 16) px1[(size_t)row * 16 + lane] = lane == 0 ? ss : 0.f;
    }
  }
  float* c32 = (float*)(ws + OFF_COS32); float* s32 = (float*)(ws + OFF_SIN32); float* c16 = (float*)(ws + OFF_COS16); float* s16 = (float*)(ws + OFF_SIN16);
  for (size_t i = gtid; i < (size_t)SEQ * 48; i += gsz) {
    int pos, fi; float invf; float *cd, *sd;
    if (i < (size_t)SEQ * 32) { pos = (int)(i >> 5); fi = (int)(i & 31); invf = __builtin_amdgcn_exp2f(-(float)fi * (13.287712379549449f / 32.f)); cd = c32 + i; sd = s32 + i; }
    else { const size_t j = i - (size_t)SEQ * 32; pos = (int)(j >> 4); fi = (int)(j & 15); invf = __builtin_amdgcn_exp2f(-(float)fi * (13.287712379549449f / 16.f)); cd = c16 + j; sd = s16 + j; }
    const float ang = (float)pos * invf;
    const double rev = (double)ang * 0.15915494309189535;
    const float fr = (float)(rev - rint(rev));
    *cd = __builtin_amdgcn_cosf(fr); *sd = __builtin_amdgcn_sinf(fr);
  }
}

NI void phase_g1(int l_) {
  const Params& p = kparams(); char* smem = g_smem; const int l = __builtin_amdgcn_readfirstlane(l_); const int tid = otid(), bid = obid(); (void)tid; (void)bid;
  char* ws = p.ws;
  EpiG1 e;
  e.cqkv = (bf16_t*)(ws + OFF_CQKV); e.KA = (bf16_t*)(ws + OFF_KA); e.qB = (bf16_t*)(ws + OFF_QB); e.qC = (bf16_t*)(ws + OFF_QC);
  e.cos32 = (const float*)(ws + OFF_COS32); e.sin32 = (const float*)(ws + OFF_SIN32); e.cos16 = (const float*)(ws + OFF_COS16); e.sin16 = (const float*)(ws + OFF_SIN16);
  e.qs = p.qscaleB; e.pq = (float*)(ws + OFF_PQ); e.pkv = (float*)(ws + OFF_PKV);
  const bf16_t* A = (const bf16_t*)(ws + OFF_XB);
  const bf16_t* Bt = (const bf16_t*)(ws + OFF_W + (size_t)l * LW_SIZE + LW_WIN);
  constexpr int NNT = N_IN_PAD / 256;
  FOR_TILES(NNT, mt, nt, gemm_tile<16>(A, 1024, Bt, 1024, 1024, mt * 256, nt * 256, e, tid, (const float*)(ws + OFF_PX1));)
}
NI void phase_g2(int l_) {
  const Params& p = kparams(); char* smem = g_smem; const int l = __builtin_amdgcn_readfirstlane(l_); const int tid = otid(), bid = obid(); (void)tid; (void)bid;
  char* ws = p.ws;
  const bf16_t* A = (const bf16_t*)(ws + OFF_CQKV);
  EpiUQ eq; eq.QA = (bf16_t*)(ws + OFF_QA); eq.cos16 = (const float*)(ws + OFF_COS16); eq.sin16 = (const float*)(ws + OFF_SIN16); eq.qs = p.qscaleA;
  EpiUKV ek; ek.KA = (bf16_t*)(ws + OFF_KA); ek.VA = (bf16_t*)(ws + OFF_VA);
  const bf16_t* Wq = (const bf16_t*)(ws + OFF_W + (size_t)l * LW_SIZE + LW_WUQ);
  const bf16_t* Wkv = (const bf16_t*)(ws + OFF_W + (size_t)l * LW_SIZE + LW_WUKV);
  FOR_TILES(3, mt, nt, gemm_tile<4>(A, 384, Wq, 256, 256, mt * 256, nt * 256, eq, tid, (const float*)(ws + OFF_PQ));)
  FOR_TILES(3, mt, nt, gemm_tile<2>(A + 256, 384, Wkv, 128, 128, mt * 256, nt * 256, ek, tid, (const float*)(ws + OFF_PKV));)
}
NI void phase_attn(int l_) {
  const Params& p = kparams(); char* smem = g_smem; const int l = __builtin_amdgcn_readfirstlane(l_); const int tid = otid(), bid = obid(); (void)tid; (void)bid;
  char* ws = p.ws;
  constexpr int NA = 1536, NBI = 4608, NC = 1024;
  const int grp = tid >> 8, t256 = tid & 255; char* gsm = smem + grp * ATT_LDS;
  for (int i0 = bid * 2; i0 < NA; i0 += gridDim.x * 2) {
    const int i = i0 + grp, xcd = (i >> 1) & 7, j = ((i >> 4) << 1) | (i & 1);
    const int bh = (j >> 6) * 8 + xcd, qb = j & 63, b = bh / 6, h = bh - b * 6;
    attn_dense_skew((const bf16_t*)(ws + OFF_QA) + (size_t)bh * SEQ * 96, (const bf16_t*)(ws + OFF_KA) + (size_t)bh * SEQ * 96, (const bf16_t*)(ws + OFF_VA) + (size_t)bh * SEQ * 64,
                    qb * 128, (bf16_t*)(ws + OFF_OA) + (size_t)b * SEQ * 384 + h * 64, gsm, t256, grp);
  }
  for (int i0 = bid * 2; i0 < NBI; i0 += gridDim.x * 2) {
    AttnItem it{};
    const int i = i0 + grp, xcd = (i >> 1) & 7, j = ((i >> 4) << 1) | (i & 1);
    const int g = (j >> 6) * 8 + xcd, c = j & 63, br = g / 24, bh = g - br * 24, b = bh / 6, h = bh - b * 6;
    const int dil = br == 0 ? 1 : (br == 1 ? 4 : 16), cpr = 64 / dil;
    it.Q = (const bf16_t*)(ws + OFF_QB) + (size_t)bh * SEQ * 64; it.K = (const bf16_t*)(ws + OFF_KB) + (size_t)bh * SEQ * 64; it.V = (const bf16_t*)(ws + OFF_VB) + (size_t)bh * SEQ * 64;
    it.dil = dil; it.res = c / cpr; it.n0 = (c - it.res * cpr) * 128; it.N = SEQ / dil;
    it.out = (bf16_t*)(ws + OFF_OB) + (size_t)br * NTOK * 384 + (size_t)b * SEQ * 384 + h * 64; it.ldo = 384;
    it.lse = (float*)(ws + OFF_LSEB) + (size_t)br * NTOK * 6 + (size_t)b * SEQ * 6 + h;
    attn_block<64, 1>(it, gsm, t256);
  }
  for (int i0 = bid * 2; i0 < NC; i0 += gridDim.x * 2) {
    AttnItem it{};
    const int i = i0 + grp, xcd = (i >> 1) & 7, j = ((i >> 4) << 1) | (i & 1);
    const int bh = (j >> 6) * 8 + xcd, blk = j & 63, b = bh >> 2, h = bh & 3;
    it.Q = (const bf16_t*)(ws + OFF_QC) + (size_t)bh * SEQ * 64; it.K = (const bf16_t*)(ws + OFF_KC) + (size_t)bh * SEQ * 64; it.V = (const bf16_t*)(ws + OFF_VC) + (size_t)bh * SEQ * 64;
    it.nrb = blk >> 2; it.ncb = blk & 3;
    it.kr0 = min(max(8 * it.nrb - 4, 0), 112); it.kc0 = min(max(16 * it.ncb - 8, 0), 32);
    it.out = (bf16_t*)(ws + OFF_OC) + (size_t)b * SEQ * 256 + h * 64; it.ldo = 256;
    it.rpb = p.rpb + ((size_t)l * 4 + h) * 465;
    attn_block<64, 2>(it, gsm, t256);
  }
}
NI void phase_mix() {
  const Params& p = kparams(); const int tid = otid(), bid = obid();
  char* ws = p.ws;
  const int lane = tid & 63, gw = bid * (NTHR / 64) + (tid >> 6), nw = gridDim.x * (NTHR / 64);
  const bf16_t* oA = (const bf16_t*)(ws + OFF_OA); const bf16_t* oB = (const bf16_t*)(ws + OFF_OB); const bf16_t* oC = (const bf16_t*)(ws + OFF_OC);
  const float* lse = (const float*)(ws + OFF_LSEB);
  bf16_t* mixed = (bf16_t*)(ws + OFF_MIXED);
  for (int tok = gw; tok < NTOK; tok += nw) {
    float v[16];
    if (lane < 24 || lane >= 48) {
      const bf16_t* src = lane < 24 ? oA + (size_t)tok * 384 + lane * 16 : oC + (size_t)tok * 256 + (lane - 48) * 16;
      const u32x4 a = *(const u32x4*)src, b = *(const u32x4*)(src + 8);
#pragma unroll
      for (int j = 0; j < 4; ++j) { v[2 * j] = bf2f(a[j] & 0xffffu); v[2 * j + 1] = bf2f(a[j] >> 16); v[8 + 2 * j] = bf2f(b[j] & 0xffffu); v[8 + 2 * j + 1] = bf2f(b[j] >> 16); }
    } else {
      const int col = (lane - 24) * 16, hd = col >> 6;
      const float l0 = lse[(size_t)tok * 6 + hd], l1 = lse[(size_t)NTOK * 6 + (size_t)tok * 6 + hd], l2 = lse[(size_t)2 * NTOK * 6 + (size_t)tok * 6 + hd];
      const float mx = fmaxf(l0, fmaxf(l1, l2));
      float w0 = __builtin_amdgcn_exp2f(l0 - mx), w1 = __builtin_amdgcn_exp2f(l1 - mx), w2 = __builtin_amdgcn_exp2f(l2 - mx);
      const float wi = 1.f / (w0 + w1 + w2); w0 *= wi; w1 *= wi; w2 *= wi;
#pragma unroll
      for (int j = 0; j < 16; ++j) v[j] = 0.f;
#pragma unroll
      for (int br = 0; br < 3; ++br) {
        const float wb = br == 0 ? w0 : (br == 1 ? w1 : w2);
        const bf16_t* src = oB + (size_t)br * NTOK * 384 + (size_t)tok * 384 + col;
        const u32x4 a = *(const u32x4*)src, b = *(const u32x4*)(src + 8);
#pragma unroll
        for (int j = 0; j < 4; ++j) { v[2 * j] += wb * bf2f(a[j] & 0xffffu); v[2 * j + 1] += wb * bf2f(a[j] >> 16); v[8 + 2 * j] += wb * bf2f(b[j] & 0xffffu); v[8 + 2 * j + 1] += wb * bf2f(b[j] >> 16); }
      }
    }
    float ss = 0.f;
#pragma unroll
    for (int j = 0; j < 16; ++j) ss += v[j] * v[j];
    const float sa = wave_sum(lane < 24 ? ss : 0.f), sb = wave_sum((lane >= 24 && lane < 48) ? ss : 0.f), sc = wave_sum(lane >= 48 ? ss : 0.f);
    const float rs = lane < 24 ? rsqrtf(sa * (1.f / 384.f) + 1e-6f) : (lane < 48 ? rsqrtf(sb * (1.f / 384.f) + 1e-6f) : rsqrtf(sc * (1.f / 256.f) + 1e-6f));
    u32x4 oa, ob;
#pragma unroll
    for (int j = 0; j < 4; ++j) { oa[j] = cvtpk(v[2 * j] * rs, v[2 * j + 1] * rs); ob[j] = cvtpk(v[8 + 2 * j] * rs, v[8 + 2 * j + 1] * rs); }
    bf16_t* dst = mixed + (size_t)tok * 1024 + lane * 16;
    *(u32x4*)dst = oa; *(u32x4*)(dst + 8) = ob;
  }
}
NI void phase_wout(int l_) {
  const Params& p = kparams(); char* smem = g_smem; const int l = __builtin_amdgcn_readfirstlane(l_); const int tid = otid(), bid = obid(); (void)tid; (void)bid;
  char* ws = p.ws;
  EpiRes e; e.xold = (l == 0) ? p.x : p.out; e.xf = p.out; e.xb = (bf16_t*)(ws + OFF_XB); e.pout = (float*)(ws + OFF_PX2);
  const bf16_t* A = (const bf16_t*)(ws + OFF_MIXED);
  const bf16_t* Bt = (const bf16_t*)(ws + OFF_W + (size_t)l * LW_SIZE + LW_WOUT);
  FOR_TILES(4, mt, nt, gemm_tile<0>(A, 1024, Bt, 1024, 1024, mt * 256, nt * 256, e, tid, nullptr);)
}
NI void phase_mlp1(int l_) {
  const Params& p = kparams(); char* smem = g_smem; const int l = __builtin_amdgcn_readfirstlane(l_); const int tid = otid(), bid = obid(); (void)tid; (void)bid;
  char* ws = p.ws;
  EpiMlp1 e; e.hid = (bf16_t*)(ws + OFF_HID);
  const bf16_t* A = (const bf16_t*)(ws + OFF_XB);
  const bf16_t* Bt = (const bf16_t*)(ws + OFF_W + (size_t)l * LW_SIZE + LW_W1);
  FOR_TILES(16, mt, nt, gemm_tile<16>(A, 1024, Bt, 1024, 1024, mt * 256, nt * 256, e, tid, (const float*)(ws + OFF_PX2));)
}
NI void phase_mlp2(int l_) {
  const Params& p = kparams(); char* smem = g_smem; const int l = __builtin_amdgcn_readfirstlane(l_); const int tid = otid(), bid = obid(); (void)tid; (void)bid;
  char* ws = p.ws;
  EpiRes e; e.xold = p.out; e.xf = p.out; e.xb = (bf16_t*)(ws + OFF_XB); e.pout = (float*)(ws + OFF_PX1);
  const bf16_t* A = (const bf16_t*)(ws + OFF_HID);
  const bf16_t* Bt = (const bf16_t*)(ws + OFF_W + (size_t)l * LW_SIZE + LW_W2);
  FOR_TILES(4, mt, nt, gemm_tile<0>(A, DFF, Bt, DFF, DFF, mt * 256, nt * 256, e, tid, nullptr);)
}
NI void phase_final() {
  const Params& p = kparams(); const int tid = otid(), bid = obid();
  const int lane = tid & 63, gw = bid * (NTHR / 64) + (tid >> 6), nw = gridDim.x * (NTHR / 64);
  for (int tok = gw; tok < NTOK; tok += nw) {
    float* row = p.out + (size_t)tok * DM;
    f32x4 v[4]; float ss = 0.f;
#pragma unroll
    for (int j = 0; j < 4; ++j) { v[j] = *(const f32x4*)(row + j * 256 + lane * 4); ss += v[j][0] * v[j][0] + v[j][1] * v[j][1] + v[j][2] * v[j][2] + v[j][3] * v[j][3]; }
    ss = wave_sum(ss);
    const float rs = rsqrtf(ss * (1.f / 1024.f) + 1e-6f);
#pragma unroll
    for (int j = 0; j < 4; ++j) { const f32x4 g = *(const f32x4*)(p.g_final + j * 256 + lane * 4); f32x4 o = {v[j][0] * rs * g[0], v[j][1] * rs * g[1], v[j][2] * rs * g[2], v[j][3] * rs * g[3]}; *(f32x4*)(row + j * 256 + lane * 4) = o; }
  }
}

constexpr int NPHASE = 2 + 7 * NLAYER;
DI void run_phase(int ph) {
  if (ph == 0) { phase_prep(); return; }
  if (ph == NPHASE - 1) { phase_final(); return; }
  const int l = (ph - 1) / 7, st = (ph - 1) - l * 7;
  switch (st) {
    case 0: phase_g1(l); break;
    case 1: phase_g2(l); break;
    case 2: phase_attn(l); break;
    case 3: phase_mix(); break;
    case 4: phase_wout(l); break;
    case 5: phase_mlp1(l); break;
    default: phase_mlp2(l); break;
  }
}

__global__ void __launch_bounds__(512) mega(Params p, int ph_lo, int ph_hi) {
  cg::grid_group grid = cg::this_grid();
  for (int ph = ph_lo; ph < ph_hi; ++ph) {
    run_phase(ph);
    if (ph + 1 < ph_hi) grid.sync();
  }
}

extern "C" void kernel_launch(void* const* d_in, const int* in_sizes, int n_in, void* d_out, int out_size, void* d_ws, size_t ws_size, hipStream_t stream) {
  static int grid_blocks = 0;
  if (!grid_blocks) {
    int dev = 0, cus = 0, per_cu = 0;
    (void)hipGetDevice(&dev);
    (void)hipDeviceGetAttribute(&cus, hipDeviceAttributeMultiprocessorCount, dev);
    (void)hipOccupancyMaxActiveBlocksPerMultiprocessor(&per_cu, mega, NTHR, 0);
    if (per_cu > 1) per_cu = 1;
    grid_blocks = cus * per_cu;
    if (ws_size < OFF_END) fprintf(stderr, "kernel_launch: workspace too small: %zu < %zu\n", ws_size, (size_t)OFF_END);
  }
  Params p;
  memset(&p, 0, sizeof(p));
  p.x = (const float*)d_in[0]; p.g_mix = (const float*)d_in[1]; p.w_in = (const float*)d_in[2]; p.q_norm = (const float*)d_in[3];
  p.w_uq = (const float*)d_in[4]; p.kv_norm = (const float*)d_in[5]; p.w_ukv = (const float*)d_in[6]; p.rpb = (const float*)d_in[7];
  p.on_a = (const float*)d_in[8]; p.on_b = (const float*)d_in[9]; p.on_c = (const float*)d_in[10]; p.w_out = (const float*)d_in[11];
  p.g_mlp = (const float*)d_in[12]; p.w_mlp_in = (const float*)d_in[13]; p.w_mlp_out = (const float*)d_in[14]; p.g_final = (const float*)d_in[15];
  p.out = (float*)d_out; p.ws = (char*)d_ws;
  p.qscaleA = (float)(1.4426950408889634 / std::sqrt(96.0));
  p.qscaleB = (float)(1.4426950408889634 * 0.125);
#if ONE_LAUNCH
  int lo = 0, hi = NPHASE;
  void* args[] = {&p, &lo, &hi};
  hipError_t e = hipLaunchCooperativeKernel((void*)mega, dim3(grid_blocks), dim3(NTHR), args, 0, stream);
  if (e != hipSuccess) fprintf(stderr, "cooperative launch failed: %s (grid %d)\n", hipGetErrorString(e), grid_blocks);
#else
  for (int ph = 0; ph < NPHASE; ++ph) hipLaunchKernelGGL(mega, dim3(grid_blocks), dim3(NTHR), 0, stream, p, ph, ph + 1);
#endif
}
```

```cpp
#include <hip/hip_runtime.h>
#include <hip/hip_cooperative_groups.h>
#include <cstdio>
#include <cmath>
#include <cstring>
namespace cg = cooperative_groups;

#ifndef ONE_LAUNCH
#define ONE_LAUNCH 1
#endif

#define DI __device__ __forceinline__
typedef unsigned short bf16_t;
typedef short bf16x8 __attribute__((ext_vector_type(8)));
typedef short s16x4 __attribute__((ext_vector_type(4)));
typedef float f32x16 __attribute__((ext_vector_type(16)));
typedef float f32x2 __attribute__((ext_vector_type(2)));
typedef float f32x4 __attribute__((ext_vector_type(4)));
typedef __bf16 bf2_t __attribute__((ext_vector_type(2)));
typedef unsigned u32x4 __attribute__((ext_vector_type(4)));
typedef unsigned u32x2 __attribute__((ext_vector_type(2)));
typedef __attribute__((address_space(3))) s16x4 lds_s16x4;

constexpr int SEQ = 8192, NB = 4, NTOK = NB * SEQ, DM = 1024, NLAYER = 4;
constexpr int N_IN_PAD = 2560, N_UQ_PAD = 768, N_UKV = 768, DFF = 4096;
constexpr int NTHR = 512;

constexpr size_t SZ_XB = (size_t)NTOK * DM * 2;
constexpr size_t SZ_WIN = (size_t)N_IN_PAD * 1024 * 2, SZ_WUQ = (size_t)N_UQ_PAD * 256 * 2, SZ_WUKV = (size_t)N_UKV * 128 * 2,
                 SZ_WOUT = (size_t)1024 * 1024 * 2, SZ_W1 = (size_t)DFF * 1024 * 2, SZ_W2 = (size_t)1024 * DFF * 2;
constexpr size_t LW_WIN = 0, LW_WUQ = LW_WIN + SZ_WIN, LW_WUKV = LW_WUQ + SZ_WUQ, LW_WOUT = LW_WUKV + SZ_WUKV, LW_W1 = LW_WOUT + SZ_WOUT,
                 LW_W2 = LW_W1 + SZ_W1, LW_SIZE = LW_W2 + SZ_W2;
constexpr size_t OFF_XB = 0, OFF_W = OFF_XB + SZ_XB, OFF_TAB = OFF_W + NLAYER * LW_SIZE;
constexpr size_t OFF_COS32 = OFF_TAB, OFF_SIN32 = OFF_COS32 + (size_t)SEQ * 32 * 4, OFF_COS16 = OFF_SIN32 + (size_t)SEQ * 32 * 4,
                 OFF_SIN16 = OFF_COS16 + (size_t)SEQ * 16 * 4, OFF_ATT = OFF_SIN16 + (size_t)SEQ * 16 * 4;
constexpr size_t SZ_T384 = (size_t)NTOK * 384 * 2, SZ_QA = (size_t)NB * 6 * SEQ * 96 * 2, SZ_H6 = (size_t)NB * 6 * SEQ * 64 * 2,
                 SZ_H4 = (size_t)NB * 4 * SEQ * 64 * 2;
constexpr size_t OFF_CQKV = OFF_ATT;
constexpr size_t OFF_OA = OFF_CQKV;
constexpr size_t OFF_QA = OFF_CQKV + SZ_T384, OFF_KA = OFF_QA + SZ_QA, OFF_VA = OFF_KA + SZ_QA;
constexpr size_t OFF_QB = OFF_VA + SZ_H6, OFF_KB = OFF_QB + SZ_H6, OFF_VB = OFF_KB + SZ_H6;
constexpr size_t OFF_QC = OFF_VB + SZ_H6, OFF_KC = OFF_QC + SZ_H4, OFF_VC = OFF_KC + SZ_H4;
constexpr size_t OFF_OB = OFF_VC + SZ_H4, OFF_LSEB = OFF_OB + 3 * SZ_T384, OFF_OC = OFF_LSEB + (size_t)3 * NTOK * 6 * 4;
constexpr size_t OFF_SSQ = OFF_OC + (size_t)NTOK * 256 * 2;
constexpr size_t OFF_PX1 = OFF_SSQ, OFF_PX2 = OFF_PX1 + (size_t)NTOK * 16 * 4, OFF_PQ = OFF_PX2 + (size_t)NTOK * 16 * 4, OFF_PKV = OFF_PQ + (size_t)NTOK * 4 * 4;
constexpr size_t OFF_END = OFF_PKV + (size_t)NTOK * 2 * 4;
constexpr size_t OFF_MIXED = OFF_QA;
constexpr size_t OFF_HID = OFF_ATT;
static_assert(OFF_HID + (size_t)NTOK * DFF * 2 <= OFF_SSQ, "hid fits");
static_assert(OFF_MIXED + (size_t)NTOK * DM * 2 <= OFF_VA, "mixed fits");

struct Params {
  const float *x, *g_mix, *w_in, *q_norm, *w_uq, *kv_norm, *w_ukv, *rpb, *on_a, *on_b, *on_c, *w_out, *g_mlp, *w_mlp_in, *w_mlp_out, *g_final;
  float* out; char* ws;
  float qscaleA, qscaleB;
};
__shared__ __attribute__((aligned(1024))) char g_smem[131072];
#define NI __device__ __forceinline__
DI const Params& kparams() { return *(const Params*)__builtin_amdgcn_kernarg_segment_ptr(); }

DI unsigned cvtpk(float lo, float hi) { f32x2 v = {lo, hi}; bf2_t b = __builtin_convertvector(v, bf2_t); return __builtin_bit_cast(unsigned, b); }
DI bf16_t f2bf(float x) { return (bf16_t)(cvtpk(x, 0.f) & 0xffffu); }
DI float bf2f(unsigned h) { return __uint_as_float(h << 16); }
DI int crow(int i, int h) { return (i & 3) + 8 * (i >> 2) + 4 * h; }
#define MFMA32(a, b, c) __builtin_amdgcn_mfma_f32_32x32x16_bf16((a), (b), (c), 0, 0, 0)
DI float fdot2bf(unsigned a, float c) { bf2_t v = __builtin_bit_cast(bf2_t, a); return __builtin_amdgcn_fdot2_f32_bf16(v, v, c, false); }
DI float swap_max(float v) { auto rr = __builtin_amdgcn_permlane32_swap(__float_as_uint(v), __float_as_uint(v), false, false); return fmaxf(__uint_as_float(rr[0]), __uint_as_float(rr[1])); }
DI float swap_sum(float v) { auto rr = __builtin_amdgcn_permlane32_swap(__float_as_uint(v), __float_as_uint(v), false, false); return __uint_as_float(rr[0]) + __uint_as_float(rr[1]); }

constexpr int ATT_LDS = 45056;
#define FOR_TILES(NN, MT, NT, BODY) { const bool xm_ = gridDim.x == 256; const int st_ = xm_ ? (bid >> 3) : bid, sp_ = xm_ ? 32 : (int)gridDim.x, cn_ = xm_ ? 16 * (NN) : (NTOK / 256) * (NN); \
  for (int j_ = st_; j_ < cn_; j_ += sp_) { int MT = j_ / (NN); const int NT = j_ - MT * (NN); if (xm_) MT += (bid & 7) * 16; BODY } }
DI int otid() { int t = threadIdx.x; asm volatile("" : "+v"(t)); return t; }
DI int obid() { int t = blockIdx.x; asm volatile("" : "+s"(t)); return t; }

template <int NSLOT, class Epi>
DI void gemm_tile(const bf16_t* __restrict__ A, int lda, const bf16_t* __restrict__ Bt, int ldb, int K, int m0, int n0, const Epi& epi, const int tid, const float* pin) {
  const int lane = tid & 63, w = tid >> 6, wm = w >> 2, wn = w & 3, r32 = lane & 31, hi = lane >> 5;
  char* smem = g_smem;
  const int lrow = lane >> 3;
  const int c0 = (lane & 7) ^ (lane >> 4), c1 = (lane & 7) ^ ((lane >> 4) | 4);
  const char* Ab = (const char*)(A + (size_t)m0 * lda);
  const char* Bb = (const char*)(Bt + (size_t)n0 * ldb);
  const unsigned oa0 = (unsigned)(((w * 32 + lrow) * lda + c0 * 8) * 2), oa1 = (unsigned)(((w * 32 + lrow) * lda + c1 * 8) * 2);
  const unsigned ob0 = (unsigned)(((w * 32 + lrow) * ldb + c0 * 8) * 2), ob1 = (unsigned)(((w * 32 + lrow) * ldb + c1 * 8) * 2);
  const int dma_off = (w * 32) * 128 + lane * 16;
  f32x16 acc[4][2];
#pragma unroll
  for (int mi = 0; mi < 4; ++mi)
#pragma unroll
    for (int nj = 0; nj < 2; ++nj)
#pragma unroll
      for (int i = 0; i < 16; ++i) acc[mi][nj][i] = 0.f;
  const int nk = K >> 6;
  const int sw = (r32 >> 1) & 7, sh = sw >> 1, lo16 = 16 * (hi ^ (sw & 1));
  const int a_off = (wm * 128 + r32) * 128 + lo16;
  const int b_off = 32768 + (wn * 64 + r32) * 128 + lo16;
  __syncthreads();
  {
    char* sa = smem + dma_off;
#pragma unroll
    for (int j = 0; j < 4; ++j) {
      __builtin_amdgcn_global_load_lds((const unsigned*)(Ab + (size_t)(j * 8 * lda) * 2 + ((j & 1) ? oa1 : oa0)), (unsigned*)(sa + j * 1024), 16, 0, 0);
      __builtin_amdgcn_global_load_lds((const unsigned*)(Bb + (size_t)(j * 8 * ldb) * 2 + ((j & 1) ? ob1 : ob0)), (unsigned*)(sa + 32768 + j * 1024), 16, 0, 0);
    }
  }
  for (int kt = 0; kt < nk; ++kt) {
    __syncthreads();
    if (kt + 1 < nk) {
      char* sa = smem + ((kt + 1) & 1) * 65536 + dma_off;
      const int k0 = (kt + 1) * 64;
#pragma unroll
      for (int j = 0; j < 4; ++j) {
        __builtin_amdgcn_global_load_lds((const unsigned*)(Ab + (size_t)(j * 8 * lda + k0) * 2 + ((j & 1) ? oa1 : oa0)), (unsigned*)(sa + j * 1024), 16, 0, 0);
        __builtin_amdgcn_global_load_lds((const unsigned*)(Bb + (size_t)(j * 8 * ldb + k0) * 2 + ((j & 1) ? ob1 : ob0)), (unsigned*)(sa + 32768 + j * 1024), 16, 0, 0);
      }
    }
    const char* sb = smem + (kt & 1) * 65536;
#pragma unroll
    for (int ks = 0; ks < 4; ++ks) {
      const int koff = 32 * (ks ^ sh);
      bf16x8 af[4], bfr[2];
#pragma unroll
      for (int mi = 0; mi < 4; ++mi) af[mi] = *(const bf16x8*)(sb + a_off + mi * 4096 + koff);
#pragma unroll
      for (int nj = 0; nj < 2; ++nj) bfr[nj] = *(const bf16x8*)(sb + b_off + nj * 4096 + koff);
#pragma unroll
      for (int mi = 0; mi < 4; ++mi)
#pragma unroll
        for (int nj = 0; nj < 2; ++nj) acc[mi][nj] = MFMA32(af[mi], bfr[nj], acc[mi][nj]);
    }
  }
  float* rstd_s = (float*)smem;
  if (NSLOT > 0) {
    __syncthreads();
    if (tid < 256) {
      const float* pr = pin + (size_t)(m0 + tid) * NSLOT;
      float sacc = 0.f;
      if (NSLOT >= 4) {
#pragma unroll
        for (int q = 0; q < NSLOT / 4; ++q) { const f32x4 v = *(const f32x4*)(pr + 4 * q); sacc += (v[0] + v[1]) + (v[2] + v[3]); }
      } else {
#pragma unroll
        for (int q = 0; q < NSLOT; ++q) sacc += pr[q];
      }
      rstd_s[tid] = rsqrtf(sacc / (float)K + 1e-6f);
    }
    __syncthreads();
  }
  int lane2 = lane, w2 = w; asm volatile("" : "+v"(lane2), "+v"(w2));
  epi(acc, m0, (w2 >> 2) * 128, n0 + (w2 & 3) * 64, lane2, rstd_s);
}
DI void row_ssq_put(float v, float* dst, int lane) {
  v += __shfl_xor(v, 1); v += __shfl_xor(v, 2); v += __shfl_xor(v, 4); v += __shfl_xor(v, 8); v += __shfl_xor(v, 16);
  if ((lane & 31) == 0) *dst = v;
}

struct EpiG1 {
  bf16_t *cqkv, *KA, *qB, *qC; const float *cos32, *sin32, *cos16, *sin16; float qs; float *pq, *pkv;
  DI void operator()(f32x16 (&acc)[4][2], int m0, int lr0, int col0, int lane, const float* rstd_s) const {
    const int c = lane & 31, h = lane >> 5, cb = col0 >> 6;
    if (cb >= 37) return;
#define G1_ROW const int lr = lr0 + mi * 32 + crow(i, h), tok = m0 + lr, b = tok >> 13, s = tok & 8191; (void)b; (void)s; \
               const float rs = rstd_s[lr]; float v0 = acc[mi][0][i] * rs, v1 = acc[mi][1][i] * rs;
    if (cb < 6) {
#pragma unroll
      for (int mi = 0; mi < 4; ++mi)
#pragma unroll
        for (int i = 0; i < 16; ++i) {
        if ((i & 3) == 0) __builtin_amdgcn_sched_barrier(0);
          G1_ROW
          bf16_t* d = cqkv + (size_t)tok * 384 + cb * 64 + c; d[0] = f2bf(v0); d[32] = f2bf(v1);
          row_ssq_put(v0 * v0 + v1 * v1, cb < 4 ? pq + (size_t)tok * 4 + cb : pkv + (size_t)tok * 2 + (cb - 4), lane);
        }
    } else if (cb == 6) {
#pragma unroll
      for (int mi = 0; mi < 4; ++mi)
#pragma unroll
        for (int i = 0; i < 16; ++i) {
        if ((i & 3) == 0) __builtin_amdgcn_sched_barrier(0);
          G1_ROW
          if (c < 16) {
            const float cs = cos16[s * 16 + c], sn = sin16[s * 16 + c];
            const bf16_t o1 = f2bf(v0 * cs - v1 * sn), o2 = f2bf(v0 * sn + v1 * cs);
#pragma unroll
            for (int hd = 0; hd < 6; ++hd) { bf16_t* d = KA + ((size_t)(b * 6 + hd) * SEQ + s) * 96 + 64 + c; d[0] = o1; d[16] = o2; }
          }
        }
    } else if (cb < 25) {
      const int idx = cb - 7, which = idx / 6, hd = idx - which * 6;
      bf16_t* base = qB + (size_t)which * (SZ_H6 / 2) + (size_t)hd * SEQ * 64 + c;
      const float sc = which == 0 ? qs : 1.f;
      if (which < 2) {
#pragma unroll
        for (int mi = 0; mi < 4; ++mi)
#pragma unroll
          for (int i = 0; i < 16; ++i) {
        if ((i & 3) == 0) __builtin_amdgcn_sched_barrier(0);
            G1_ROW
            const float cs = cos32[s * 32 + c] * sc, sn = sin32[s * 32 + c] * sc;
            bf16_t* d = base + ((size_t)(b * 6) * SEQ + s) * 64;
            d[0] = f2bf(v0 * cs - v1 * sn); d[32] = f2bf(v0 * sn + v1 * cs);
          }
      } else {
#pragma unroll
        for (int mi = 0; mi < 4; ++mi)
#pragma unroll
          for (int i = 0; i < 16; ++i) {
        if ((i & 3) == 0) __builtin_amdgcn_sched_barrier(0);
            G1_ROW
            bf16_t* d = base + ((size_t)(b * 6) * SEQ + s) * 64;
            d[0] = f2bf(v0); d[32] = f2bf(v1);
          }
      }
    } else {
      const int idx = cb - 25, which = idx >> 2, hd = idx & 3;
      bf16_t* base = qC + (size_t)which * (SZ_H4 / 2) + (size_t)hd * SEQ * 64 + c;
      const float sc = which == 0 ? qs : 1.f;
#pragma unroll
      for (int mi = 0; mi < 4; ++mi)
#pragma unroll
        for (int i = 0; i < 16; ++i) {
        if ((i & 3) == 0) __builtin_amdgcn_sched_barrier(0);
          G1_ROW
          bf16_t* d = base + ((size_t)(b * 4) * SEQ + s) * 64;
          d[0] = f2bf(v0 * sc); d[32] = f2bf(v1 * sc);
        }
    }
#undef G1_ROW
  }
};
struct EpiUQ {
  bf16_t* QA; const float *cos16, *sin16; float qs;
  DI void operator()(f32x16 (&acc)[4][2], int m0, int lr0, int col0, int lane, const float* rstd_s) const {
    const int c = lane & 31, h = lane >> 5, cb = col0 >> 6;
    if (cb >= 9) return;
#pragma unroll
    for (int mi = 0; mi < 4; ++mi)
#pragma unroll
      for (int i = 0; i < 16; ++i) {
        if ((i & 3) == 0) __builtin_amdgcn_sched_barrier(0);
        const int lr = lr0 + mi * 32 + crow(i, h), tok = m0 + lr, b = tok >> 13, s = tok & 8191;
        const float rs = rstd_s[lr] * qs;
        const float v0 = acc[mi][0][i] * rs, v1 = acc[mi][1][i] * rs;
        if (cb < 6) {
          bf16_t* d = QA + ((size_t)(b * 6 + cb) * SEQ + s) * 96 + c; d[0] = f2bf(v0); d[32] = f2bf(v1);
        } else {
          const int hd = 2 * (cb - 6) + (c >> 4), fi = c & 15;
          const float cs = cos16[s * 16 + fi], sn = sin16[s * 16 + fi];
          bf16_t* d = QA + ((size_t)(b * 6 + hd) * SEQ + s) * 96 + 64 + fi;
          d[0] = f2bf(v0 * cs - v1 * sn); d[16] = f2bf(v0 * sn + v1 * cs);
        }
      }
  }
};
struct EpiUKV {
  bf16_t *KA, *VA;
  DI void operator()(f32x16 (&acc)[4][2], int m0, int lr0, int col0, int lane, const float* rstd_s) const {
    const int c = lane & 31, h = lane >> 5, cb = col0 >> 6, hd = cb >> 1, isv = cb & 1;
#pragma unroll
    for (int mi = 0; mi < 4; ++mi)
#pragma unroll
      for (int i = 0; i < 16; ++i) {
        if ((i & 3) == 0) __builtin_amdgcn_sched_barrier(0);
        const int lr = lr0 + mi * 32 + crow(i, h), tok = m0 + lr, b = tok >> 13, s = tok & 8191;
        const float rs = rstd_s[lr];
        const float v0 = acc[mi][0][i] * rs, v1 = acc[mi][1][i] * rs;
        bf16_t* d = isv ? VA + ((size_t)(b * 6 + hd) * SEQ + s) * 64 + c : KA + ((size_t)(b * 6 + hd) * SEQ + s) * 96 + c;
        d[0] = f2bf(v0); d[32] = f2bf(v1);
      }
  }
};
struct EpiRes {
  bf16_t* xb; float* pout;
  DI void operator()(f32x16 (&acc)[4][2], int m0, int lr0, int col0, int lane, const float* rstd_s) const {
    const int c = lane & 31, h = lane >> 5;
#pragma unroll
    for (int mi = 0; mi < 4; ++mi)
#pragma unroll
      for (int i = 0; i < 16; ++i) {
        if ((i & 3) == 0) __builtin_amdgcn_sched_barrier(0);
        const int row = m0 + lr0 + mi * 32 + crow(i, h);
        const size_t o = (size_t)row * DM + col0 + c;
        const float v0 = bf2f(xb[o]) + acc[mi][0][i], v1 = bf2f(xb[o + 32]) + acc[mi][1][i];
        xb[o] = f2bf(v0); xb[o + 32] = f2bf(v1);
        row_ssq_put(v0 * v0 + v1 * v1, pout + (size_t)row * 16 + (col0 >> 6), lane);
      }
  }
};
struct EpiMlp1 {
  bf16_t* hid;
  DI void operator()(f32x16 (&acc)[4][2], int m0, int lr0, int col0, int lane, const float* rstd_s) const {
    const int c = lane & 31, h = lane >> 5;
#pragma unroll
    for (int mi = 0; mi < 4; ++mi)
#pragma unroll
      for (int i = 0; i < 16; ++i) {
        if ((i & 3) == 0) __builtin_amdgcn_sched_barrier(0);
        const int lr = lr0 + mi * 32 + crow(i, h);
        const float rs = rstd_s[lr];
        const float v0 = fmaxf(acc[mi][0][i] * rs, 0.f), v1 = fmaxf(acc[mi][1][i] * rs, 0.f);
        bf16_t* d = hid + (size_t)(m0 + lr) * DFF + col0 + c; d[0] = f2bf(v0 * v0); d[32] = f2bf(v1 * v1);
      }
  }
};

struct AttnItem {
  const bf16_t *Q, *K, *V;
  int q0;
  int n0, dil, res, N;
  int nrb, ncb, kr0, kc0;
  bf16_t* out; int ldo;
  float* lse;
  const float* rpb;
};

template <int DQ, int MODE>
DI void attn_block(const AttnItem& it, char* smem, const int tid) {
  constexpr int CPR = DQ / 8, KST = DQ * 2 + 16, KCH = (64 * CPR) / 256, NT = MODE == 0 ? SEQ / 64 : MODE == 1 ? 4 : 8;
  const int lane = tid & 63, w = tid >> 6, r32 = lane & 31, hi = lane >> 5;
  char* Ks = smem; char* Vs = smem + 64 * KST; float* bias_s = (float*)(smem + 64 * KST + 8192);
  const int qi = w * 32 + r32;
  int qpos;
  if (MODE == 0) qpos = it.q0 + qi;
  else if (MODE == 1) qpos = (it.n0 + qi) * it.dil + it.res;
  else qpos = (8 * it.nrb + (qi >> 4)) * 64 + 16 * it.ncb + (qi & 15);
  __syncthreads();
  if (MODE == 2) { for (int i = tid; i < 465; i += 256) bias_s[i] = it.rpb[i] * 1.4426950408889634f; }
  bf16x8 qr[DQ / 16];
#pragma unroll
  for (int d0 = 0; d0 < DQ / 16; ++d0) qr[d0] = *(const bf16x8*)(it.Q + (size_t)qpos * DQ + d0 * 16 + hi * 8);
  f32x16 o[2];
#pragma unroll
  for (int i = 0; i < 16; ++i) { o[0][i] = 0.f; o[1][i] = 0.f; }
  float m_run = -1e30f, l_run = 0.f;
  u32x4 rk[KCH], rv[2];
  auto kpos = [&](int t, int row) -> int {
    if (MODE == 0) return t * 64 + row;
    if (MODE == 1) { int n = it.n0 - 64 + 64 * t + row; n = n < 0 ? 0 : (n > it.N - 1 ? it.N - 1 : n); return n * it.dil + it.res; }
    return (it.kr0 + 2 * t + (row >> 5)) * 64 + it.kc0 + (row & 31);
  };
  auto load = [&](int t) {
#pragma unroll
    for (int i = 0; i < KCH; ++i) { const int c = tid + 256 * i, row = c / CPR, kc = c - row * CPR; rk[i] = *(const u32x4*)(it.K + (size_t)kpos(t, row) * DQ + kc * 8); }
#pragma unroll
    for (int i = 0; i < 2; ++i) { const int c = tid + 256 * i, row = c >> 3, kc = c & 7; rv[i] = *(const u32x4*)(it.V + (size_t)kpos(t, row) * 64 + kc * 8); }
  };
  const int vrd = ((lane >> 5) * 4 + ((lane & 15) >> 2)) * 64 + ((lane >> 4) & 1) * 32 + (lane & 3) * 8;
  load(0);
  for (int t = 0; t < NT; ++t) {
    __syncthreads();
#pragma unroll
    for (int i = 0; i < KCH; ++i) { const int c = tid + 256 * i, row = c / CPR, kc = c - row * CPR; *(u32x4*)(Ks + row * KST + kc * 16) = rk[i]; }
#pragma unroll
    for (int i = 0; i < 2; ++i) { const int c = tid + 256 * i, row = c >> 3, kc = c & 7; *(u32x4*)(Vs + (kc >> 2) * 4096 + row * 64 + (kc & 3) * 16) = rv[i]; }
    __syncthreads();
    if (t + 1 < NT) load(t + 1);
    bool skip = false;
    if (MODE == 1) skip = (w < 2) ? (t == 3) : (t == 0);
    if (MODE == 2) {
      const int rq_lo = 8 * it.nrb + 2 * w, rq_hi = rq_lo + 1;
      const int rs_lo = min(max(rq_lo - 4, 0), 120), rs_hi = min(max(rq_hi - 4, 0), 120) + 7;
      const int kr = it.kr0 + 2 * t;
      skip = (kr + 1 < rs_lo) || (kr > rs_hi);
    }
    if (skip) continue;
    f32x16 p0, p1;
#pragma unroll
    for (int i = 0; i < 16; ++i) { p0[i] = 0.f; p1[i] = 0.f; }
#pragma unroll
    for (int d0 = 0; d0 < DQ / 16; ++d0) {
      const bf16x8 k0 = *(const bf16x8*)(Ks + r32 * KST + d0 * 32 + hi * 16);
      const bf16x8 k1 = *(const bf16x8*)(Ks + (32 + r32) * KST + d0 * 32 + hi * 16);
      p0 = MFMA32(k0, qr[d0], p0); p1 = MFMA32(k1, qr[d0], p1);
    }
    if (MODE == 1) {
      const int nq = it.n0 + qi, kb = it.n0 - 64 + 64 * t;
#pragma unroll
      for (int i = 0; i < 16; ++i) {
        const int nk = kb + crow(i, hi), nk2 = nk + 32;
        const int d1 = nq - nk, d2 = nq - nk2;
        const bool ok1 = (d1 <= 64) && (d1 >= -64) && (nk >= 0) && (nk < it.N);
        const bool ok2 = (d2 <= 64) && (d2 >= -64) && (nk2 >= 0) && (nk2 < it.N);
        p0[i] = ok1 ? p0[i] : -INFINITY; p1[i] = ok2 ? p1[i] : -INFINITY;
      }
    }
    if (MODE == 2) {
      const int rq = 8 * it.nrb + (qi >> 4), cq = 16 * it.ncb + (qi & 15);
      const int rs_ = min(max(rq - 4, 0), 120), cs_ = min(max(cq - 8, 0), 48);
      const int kr = it.kr0 + 2 * t;
      const bool okr0 = (kr >= rs_) && (kr < rs_ + 8), okr1 = (kr + 1 >= rs_) && (kr + 1 < rs_ + 8);
      const int bi0 = (kr - rq + 7) * 31 - cq + 15;
#pragma unroll
      for (int i = 0; i < 16; ++i) {
        const int kc = it.kc0 + crow(i, hi);
        const bool okc = (kc >= cs_) && (kc < cs_ + 16);
        const bool ok0 = okc && okr0, ok1 = okc && okr1;
        const float b0 = bias_s[ok0 ? bi0 + kc : 0], b1 = bias_s[ok1 ? bi0 + 31 + kc : 0];
        p0[i] = ok0 ? p0[i] + b0 : -INFINITY; p1[i] = ok1 ? p1[i] + b1 : -INFINITY;
      }
    }
    float pmax = p0[0];
#pragma unroll
    for (int i = 1; i < 16; ++i) pmax = fmaxf(pmax, p0[i]);
#pragma unroll
    for (int i = 0; i < 16; ++i) pmax = fmaxf(pmax, p1[i]);
    pmax = swap_max(pmax);
    const float mn = fmaxf(m_run, pmax);
    const float alpha = __builtin_amdgcn_exp2f(m_run - mn);
    m_run = mn;
    float ps = 0.f;
#pragma unroll
    for (int i = 0; i < 16; ++i) { p0[i] = __builtin_amdgcn_exp2f(p0[i] - mn); ps += p0[i]; }
#pragma unroll
    for (int i = 0; i < 16; ++i) { p1[i] = __builtin_amdgcn_exp2f(p1[i] - mn); ps += p1[i]; }
    ps = swap_sum(ps);
    l_run = l_run * alpha + ps;
#pragma unroll
    for (int i = 0; i < 16; ++i) { o[0][i] *= alpha; o[1][i] *= alpha; }
    bf16x8 pb[4];
#pragma unroll
    for (int s = 0; s < 2; ++s) {
      u32x4 a = {cvtpk(p0[8 * s], p0[8 * s + 1]), cvtpk(p0[8 * s + 2], p0[8 * s + 3]), cvtpk(p0[8 * s + 4], p0[8 * s + 5]), cvtpk(p0[8 * s + 6], p0[8 * s + 7])};
      u32x4 b = {cvtpk(p1[8 * s], p1[8 * s + 1]), cvtpk(p1[8 * s + 2], p1[8 * s + 3]), cvtpk(p1[8 * s + 4], p1[8 * s + 5]), cvtpk(p1[8 * s + 6], p1[8 * s + 7])};
      pb[s] = __builtin_bit_cast(bf16x8, a); pb[2 + s] = __builtin_bit_cast(bf16x8, b);
    }
#pragma unroll
    for (int db = 0; db < 2; ++db)
#pragma unroll
      for (int s = 0; s < 4; ++s) {
        const s16x4 lo = __builtin_amdgcn_ds_read_tr16_b64_v4i16((lds_s16x4*)(Vs + db * 4096 + (16 * s) * 64 + vrd));
        const s16x4 hh = __builtin_amdgcn_ds_read_tr16_b64_v4i16((lds_s16x4*)(Vs + db * 4096 + (16 * s + 8) * 64 + vrd));
        const bf16x8 a = {lo[0], lo[1], lo[2], lo[3], hh[0], hh[1], hh[2], hh[3]};
        o[db] = MFMA32(a, pb[s], o[db]);
      }
  }
  const float inv = 1.f / l_run;
  const int bq = qpos;
  bf16_t* orow = it.out + (size_t)bq * it.ldo;
#pragma unroll
  for (int db = 0; db < 2; ++db)
#pragma unroll
    for (int g = 0; g < 4; ++g) {
      u32x2 v = {cvtpk(o[db][4 * g] * inv, o[db][4 * g + 1] * inv), cvtpk(o[db][4 * g + 2] * inv, o[db][4 * g + 3] * inv)};
      *(u32x2*)(orow + db * 32 + 8 * g + 4 * hi) = v;
    }
  if (MODE == 1) { if (hi == 0) it.lse[(size_t)bq * 6] = m_run + __builtin_amdgcn_logf(l_run); }
}

DI void attn_dense_skew(const bf16_t* __restrict__ Q, const bf16_t* __restrict__ K, const bf16_t* __restrict__ V, int q0, bf16_t* __restrict__ out,
                        char* smem, const int tid, const int grp) {
  constexpr int DQ = 96, CPR = 12, KST = 208, NT = SEQ / 64, STG = 64 * KST + 8192;
  const int lane = tid & 63, w = tid >> 6, r32 = lane & 31, hi = lane >> 5;
  const int qpos = q0 + w * 32 + r32;
  bf16x8 qr[DQ / 16];
#pragma unroll
  for (int d0 = 0; d0 < DQ / 16; ++d0) qr[d0] = *(const bf16x8*)(Q + (size_t)qpos * DQ + d0 * 16 + hi * 8);
  f32x16 o[2];
#pragma unroll
  for (int i = 0; i < 16; ++i) { o[0][i] = 0.f; o[1][i] = 0.f; }
  float m_run = -1e30f, l_run = 0.f;
  u32x4 rk[3], rv[2];
  auto load = [&](int t) {
#pragma unroll
    for (int i = 0; i < 3; ++i) { const int c = tid + 256 * i, row = c / CPR, kc = c - row * CPR; rk[i] = *(const u32x4*)(K + (size_t)(t * 64 + row) * DQ + kc * 8); }
#pragma unroll
    for (int i = 0; i < 2; ++i) { const int c = tid + 256 * i, row = c >> 3, kc = c & 7; rv[i] = *(const u32x4*)(V + (size_t)(t * 64 + row) * 64 + kc * 8); }
  };
  auto store = [&](int b) {
    char* Ks = smem + b * STG; char* Vs = Ks + 64 * KST;
#pragma unroll
    for (int i = 0; i < 3; ++i) { const int c = tid + 256 * i, row = c / CPR, kc = c - row * CPR; *(u32x4*)(Ks + row * KST + kc * 16) = rk[i]; }
#pragma unroll
    for (int i = 0; i < 2; ++i) { const int c = tid + 256 * i, row = c >> 3, kc = c & 7; *(u32x4*)(Vs + (kc >> 2) * 4096 + row * 64 + (kc & 3) * 16) = rv[i]; }
  };
  const int vrd = ((lane >> 5) * 4 + ((lane & 15) >> 2)) * 64 + ((lane >> 4) & 1) * 32 + (lane & 3) * 8;
  __syncthreads();
  load(0); store(0); load(1);
  __syncthreads();
  if (grp == 1) __syncthreads();
  for (int t = 0; t < NT; ++t) {
    const char* Ks = smem + (t & 1) * STG; const char* Vs = Ks + 64 * KST;
    if (t + 1 < NT) store((t + 1) & 1);
    if (t + 2 < NT) load(t + 2);
    f32x16 p0, p1;
#pragma unroll
    for (int i = 0; i < 16; ++i) { p0[i] = 0.f; p1[i] = 0.f; }
    {
      const char* kp = Ks + r32 * KST + hi * 16;
      bf16x8 ka[2][2];
      ka[0][0] = *(const bf16x8*)(kp); ka[0][1] = *(const bf16x8*)(kp + 32 * KST);
      ka[1][0] = *(const bf16x8*)(kp + 32); ka[1][1] = *(const bf16x8*)(kp + 32 * KST + 32);
#pragma unroll
      for (int d0 = 0; d0 < DQ / 16; ++d0) {
        p0 = MFMA32(ka[d0 & 1][0], qr[d0], p0); p1 = MFMA32(ka[d0 & 1][1], qr[d0], p1);
        if (d0 + 2 < DQ / 16) { ka[d0 & 1][0] = *(const bf16x8*)(kp + (d0 + 2) * 32); ka[d0 & 1][1] = *(const bf16x8*)(kp + 32 * KST + (d0 + 2) * 32); }
      }
    }
    asm volatile("" : "+v"(p0), "+v"(p1));
    __syncthreads();
    asm volatile("" : "+v"(p0), "+v"(p1));
    s16x4 vlo[4], vhi[4];
#pragma unroll
    for (int s2 = 0; s2 < 4; ++s2) {
      vlo[s2] = __builtin_amdgcn_ds_read_tr16_b64_v4i16((lds_s16x4*)(Vs + (16 * s2) * 64 + vrd));
      vhi[s2] = __builtin_amdgcn_ds_read_tr16_b64_v4i16((lds_s16x4*)(Vs + (16 * s2 + 8) * 64 + vrd));
    }
    float pmax = p0[0];
#pragma unroll
    for (int i = 1; i < 16; ++i) pmax = fmaxf(pmax, p0[i]);
#pragma unroll
    for (int i = 0; i < 16; ++i) pmax = fmaxf(pmax, p1[i]);
    pmax = swap_max(pmax);
    const float mn = fmaxf(m_run, pmax);
    const float alpha = __builtin_amdgcn_exp2f(m_run - mn);
    m_run = mn;
    float ps = 0.f;
#pragma unroll
    for (int i = 0; i < 16; ++i) { p0[i] = __builtin_amdgcn_exp2f(p0[i] - mn); ps += p0[i]; }
#pragma unroll
    for (int i = 0; i < 16; ++i) { p1[i] = __builtin_amdgcn_exp2f(p1[i] - mn); ps += p1[i]; }
    ps = swap_sum(ps);
    l_run = l_run * alpha + ps;
#pragma unroll
    for (int i = 0; i < 16; ++i) { o[0][i] *= alpha; o[1][i] *= alpha; }
    bf16x8 pb[4];
#pragma unroll
    for (int s = 0; s < 2; ++s) {
      u32x4 a = {cvtpk(p0[8 * s], p0[8 * s + 1]), cvtpk(p0[8 * s + 2], p0[8 * s + 3]), cvtpk(p0[8 * s + 4], p0[8 * s + 5]), cvtpk(p0[8 * s + 6], p0[8 * s + 7])};
      u32x4 b = {cvtpk(p1[8 * s], p1[8 * s + 1]), cvtpk(p1[8 * s + 2], p1[8 * s + 3]), cvtpk(p1[8 * s + 4], p1[8 * s + 5]), cvtpk(p1[8 * s + 6], p1[8 * s + 7])};
      pb[s] = __builtin_bit_cast(bf16x8, a); pb[2 + s] = __builtin_bit_cast(bf16x8, b);
    }
    {
      s16x4 wlo[4], whi[4];
#pragma unroll
      for (int s2 = 0; s2 < 4; ++s2) {
        wlo[s2] = __builtin_amdgcn_ds_read_tr16_b64_v4i16((lds_s16x4*)(Vs + 4096 + (16 * s2) * 64 + vrd));
        whi[s2] = __builtin_amdgcn_ds_read_tr16_b64_v4i16((lds_s16x4*)(Vs + 4096 + (16 * s2 + 8) * 64 + vrd));
      }
#pragma unroll
      for (int s2 = 0; s2 < 4; ++s2) { const bf16x8 a = {vlo[s2][0], vlo[s2][1], vlo[s2][2], vlo[s2][3], vhi[s2][0], vhi[s2][1], vhi[s2][2], vhi[s2][3]}; o[0] = MFMA32(a, pb[s2], o[0]); }
#pragma unroll
      for (int s2 = 0; s2 < 4; ++s2) { const bf16x8 a = {wlo[s2][0], wlo[s2][1], wlo[s2][2], wlo[s2][3], whi[s2][0], whi[s2][1], whi[s2][2], whi[s2][3]}; o[1] = MFMA32(a, pb[s2], o[1]); }
    }
    asm volatile("" : "+v"(o[0]), "+v"(o[1]));
    __syncthreads();
    asm volatile("" : "+v"(o[0]), "+v"(o[1]));
  }
  if (grp == 0) __syncthreads();
  const float inv = 1.f / l_run;
  bf16_t* orow = out + (size_t)qpos * 384;
#pragma unroll
  for (int db = 0; db < 2; ++db)
#pragma unroll
    for (int g = 0; g < 4; ++g) {
      u32x2 v = {cvtpk(o[db][4 * g] * inv, o[db][4 * g + 1] * inv), cvtpk(o[db][4 * g + 2] * inv, o[db][4 * g + 3] * inv)};
      *(u32x2*)(orow + db * 32 + 8 * g + 4 * hi) = v;
    }
}

DI float wave_sum(float v) {
  v += __shfl_xor(v, 32); v += __shfl_xor(v, 16); v += __shfl_xor(v, 8); v += __shfl_xor(v, 4); v += __shfl_xor(v, 2); v += __shfl_xor(v, 1); return v;
}
DI float gain_of(const Params& p, int kind, int l, int k) {
  switch (kind) {
    case 0: return p.g_mix[l * 1024 + k];
    case 1: return p.q_norm[l * 256 + k];
    case 2: return p.kv_norm[l * 128 + k];
    case 3: return k < 384 ? p.on_a[l * 384 + k] : (k < 768 ? p.on_b[l * 384 + k - 384] : p.on_c[l * 256 + k - 768]);
    case 4: return p.g_mlp[l * 1024 + k];
    default: return 1.f;
  }
}
DI int map_col(int kind, int n) {
  if (kind == 0) {
    if (n < 384) return n;
    if (n < 448) { const int wv = n - 384, c = wv & 31, sub = wv >> 5; return c < 16 ? 384 + sub * 16 + c : -1; }
    if (n < 1600) return 416 + (n - 448);
    if (n < 2368) return 1568 + (n - 1600);
    return -1;
  }
  if (kind == 1) {
    if (n < 384) return (n >> 6) * 96 + (n & 63);
    if (n < 576) { const int wv = n - 384, g = wv >> 6, wi = wv & 63, sub = wi >> 5, c = wi & 31, hd = 2 * g + (c >> 4), fi = c & 15; return hd * 96 + 64 + sub * 16 + fi; }
    return -1;
  }
  return n;
}
DI void wtile(const Params& p, const float* src, int Nsrc, bf16_t* dst, int K, int kt, int nt, int kind, int l, char* smem, const int tid) {
  float* tile = (float*)smem;
  const int lane = tid & 63, wv = tid >> 6;
  __syncthreads();
  const int n = nt * 64 + lane, sc = map_col(kind, n);
#pragma unroll 4
  for (int r = 0; r < 8; ++r) {
    const int kl = r * 8 + wv, k = kt * 64 + kl;
    float v = 0.f;
    if (sc >= 0) v = src[(size_t)k * Nsrc + sc] * gain_of(p, kind, l, k);
    tile[kl * 65 + lane] = v;
  }
  __syncthreads();
#pragma unroll 4
  for (int r = 0; r < 8; ++r) {
    const int nl = r * 8 + wv;
    dst[(size_t)(nt * 64 + nl) * K + kt * 64 + lane] = f2bf(tile[lane * 65 + nl]);
  }
}

NI void phase_prep() {
  const Params& p = kparams(); char* smem = g_smem; const int tid = otid(), bid = obid();
  char* ws = p.ws;
  constexpr int T_WIN = (N_IN_PAD / 64) * 16, T_WUQ = (N_UQ_PAD / 64) * 4, T_WUKV = (N_UKV / 64) * 2, T_WOUT = 16 * 16, T_W1 = 64 * 16, T_W2 = 16 * 64;
  constexpr int T_L = T_WIN + T_WUQ + T_WUKV + T_WOUT + T_W1 + T_W2;
  for (int j = bid; j < NLAYER * T_L; j += gridDim.x) {
    const int l = j / T_L; int r = j - l * T_L;
    char* lw = ws + OFF_W + (size_t)l * LW_SIZE;
    if (r < T_WIN) { wtile(p, p.w_in + (size_t)l * 1024 * 2336, 2336, (bf16_t*)(lw + LW_WIN), 1024, r & 15, r >> 4, 0, l, smem, tid); continue; }
    r -= T_WIN;
    if (r < T_WUQ) { wtile(p, p.w_uq + (size_t)l * 256 * 576, 576, (bf16_t*)(lw + LW_WUQ), 256, r & 3, r >> 2, 1, l, smem, tid); continue; }
    r -= T_WUQ;
    if (r < T_WUKV) { wtile(p, p.w_ukv + (size_t)l * 128 * 768, 768, (bf16_t*)(lw + LW_WUKV), 128, r & 1, r >> 1, 2, l, smem, tid); continue; }
    r -= T_WUKV;
    if (r < T_WOUT) { wtile(p, p.w_out + (size_t)l * 1024 * 1024, 1024, (bf16_t*)(lw + LW_WOUT), 1024, r & 15, r >> 4, 3, l, smem, tid); continue; }
    r -= T_WOUT;
    if (r < T_W1) { wtile(p, p.w_mlp_in + (size_t)l * 1024 * 4096, 4096, (bf16_t*)(lw + LW_W1), 1024, r & 15, r >> 4, 4, l, smem, tid); continue; }
    r -= T_W1;
    wtile(p, p.w_mlp_out + (size_t)l * 4096 * 1024, 1024, (bf16_t*)(lw + LW_W2), 4096, r & 63, r >> 6, 5, l, smem, tid);
  }
  const size_t gtid = (size_t)bid * NTHR + tid, gsz = (size_t)gridDim.x * NTHR;
  bf16_t* xb = (bf16_t*)(ws + OFF_XB);
  {
    const int lane = tid & 63, gw = bid * (NTHR / 64) + (tid >> 6), nw = gridDim.x * (NTHR / 64);
    float* px1 = (float*)(ws + OFF_PX1);
    for (int row = gw; row < NTOK; row += nw) {
      float ss = 0.f;
#pragma unroll
      for (int j = 0; j < 4; ++j) {
        const f32x4 a = *(const f32x4*)(p.x + (size_t)row * DM + j * 256 + lane * 4);
        ss += a[0] * a[0] + a[1] * a[1] + a[2] * a[2] + a[3] * a[3];
        u32x2 o = {cvtpk(a[0], a[1]), cvtpk(a[2], a[3])};
        *(u32x2*)(xb + (size_t)row * DM + j * 256 + lane * 4) = o;
      }
      ss = wave_sum(ss);
      if (lane < 16) px1[(size_t)row * 16 + lane] = lane == 0 ? ss : 0.f;
    }
  }
  float* c32 = (float*)(ws + OFF_COS32); float* s32 = (float*)(ws + OFF_SIN32); float* c16 = (float*)(ws + OFF_COS16); float* s16 = (float*)(ws + OFF_SIN16);
  for (size_t i = gtid; i < (size_t)SEQ * 48; i += gsz) {
    int pos, fi; float invf; float *cd, *sd;
    if (i < (size_t)SEQ * 32) { pos = (int)(i >> 5); fi = (int)(i & 31); invf = __builtin_amdgcn_exp2f(-(float)fi * (13.287712379549449f / 32.f)); cd = c32 + i; sd = s32 + i; }
    else { const size_t j = i - (size_t)SEQ * 32; pos = (int)(j >> 4); fi = (int)(j & 15); invf = __builtin_amdgcn_exp2f(-(float)fi * (13.287712379549449f / 16.f)); cd = c16 + j; sd = s16 + j; }
    const float ang = (float)pos * invf;
    const double rev = (double)ang * 0.15915494309189535;
    const float fr = (float)(rev - rint(rev));
    *cd = __builtin_amdgcn_cosf(fr); *sd = __builtin_amdgcn_sinf(fr);
  }
}

NI void phase_g1(int l_) {
  const Params& p = kparams(); char* smem = g_smem; const int l = __builtin_amdgcn_readfirstlane(l_); const int tid = otid(), bid = obid(); (void)tid; (void)bid;
  char* ws = p.ws;
  EpiG1 e;
  e.cqkv = (bf16_t*)(ws + OFF_CQKV); e.KA = (bf16_t*)(ws + OFF_KA); e.qB = (bf16_t*)(ws + OFF_QB); e.qC = (bf16_t*)(ws + OFF_QC);
  e.cos32 = (const float*)(ws + OFF_COS32); e.sin32 = (const float*)(ws + OFF_SIN32); e.cos16 = (const float*)(ws + OFF_COS16); e.sin16 = (const float*)(ws + OFF_SIN16);
  e.qs = p.qscaleB; e.pq = (float*)(ws + OFF_PQ); e.pkv = (float*)(ws + OFF_PKV);
  const bf16_t* A = (const bf16_t*)(ws + OFF_XB);
  const bf16_t* Bt = (const bf16_t*)(ws + OFF_W + (size_t)l * LW_SIZE + LW_WIN);
  constexpr int NNT = N_IN_PAD / 256;
  FOR_TILES(NNT, mt, nt, gemm_tile<16>(A, 1024, Bt, 1024, 1024, mt * 256, nt * 256, e, tid, (const float*)(ws + OFF_PX1));)
}
NI void phase_g2(int l_) {
  const Params& p = kparams(); char* smem = g_smem; const int l = __builtin_amdgcn_readfirstlane(l_); const int tid = otid(), bid = obid(); (void)tid; (void)bid;
  char* ws = p.ws;
  const bf16_t* A = (const bf16_t*)(ws + OFF_CQKV);
  EpiUQ eq; eq.QA = (bf16_t*)(ws + OFF_QA); eq.cos16 = (const float*)(ws + OFF_COS16); eq.sin16 = (const float*)(ws + OFF_SIN16); eq.qs = p.qscaleA;
  EpiUKV ek; ek.KA = (bf16_t*)(ws + OFF_KA); ek.VA = (bf16_t*)(ws + OFF_VA);
  const bf16_t* Wq = (const bf16_t*)(ws + OFF_W + (size_t)l * LW_SIZE + LW_WUQ);
  const bf16_t* Wkv = (const bf16_t*)(ws + OFF_W + (size_t)l * LW_SIZE + LW_WUKV);
  FOR_TILES(3, mt, nt, gemm_tile<4>(A, 384, Wq, 256, 256, mt * 256, nt * 256, eq, tid, (const float*)(ws + OFF_PQ));)
  FOR_TILES(3, mt, nt, gemm_tile<2>(A + 256, 384, Wkv, 128, 128, mt * 256, nt * 256, ek, tid, (const float*)(ws + OFF_PKV));)
}
NI void phase_attn(int l_) {
  const Params& p = kparams(); char* smem = g_smem; const int l = __builtin_amdgcn_readfirstlane(l_); const int tid = otid(), bid = obid(); (void)tid; (void)bid;
  char* ws = p.ws;
  constexpr int NA = 1536, NBI = 4608, NC = 1024;
  const int grp = tid >> 8, t256 = tid & 255; char* gsm = smem + grp * ATT_LDS;
  for (int i0 = bid * 2; i0 < NA; i0 += gridDim.x * 2) {
    const int i = i0 + grp, xcd = (i >> 1) & 7, j = ((i >> 4) << 1) | (i & 1);
    const int bh = (j >> 6) * 8 + xcd, qb = j & 63, b = bh / 6, h = bh - b * 6;
    attn_dense_skew((const bf16_t*)(ws + OFF_QA) + (size_t)bh * SEQ * 96, (const bf16_t*)(ws + OFF_KA) + (size_t)bh * SEQ * 96, (const bf16_t*)(ws + OFF_VA) + (size_t)bh * SEQ * 64,
                    qb * 128, (bf16_t*)(ws + OFF_OA) + (size_t)b * SEQ * 384 + h * 64, gsm, t256, grp);
  }
  for (int i0 = bid * 2; i0 < NBI; i0 += gridDim.x * 2) {
    AttnItem it{};
    const int i = i0 + grp, xcd = (i >> 1) & 7, j = ((i >> 4) << 1) | (i & 1);
    const int g = (j >> 6) * 8 + xcd, c = j & 63, br = g / 24, bh = g - br * 24, b = bh / 6, h = bh - b * 6;
    const int dil = br == 0 ? 1 : (br == 1 ? 4 : 16), cpr = 64 / dil;
    it.Q = (const bf16_t*)(ws + OFF_QB) + (size_t)bh * SEQ * 64; it.K = (const bf16_t*)(ws + OFF_KB) + (size_t)bh * SEQ * 64; it.V = (const bf16_t*)(ws + OFF_VB) + (size_t)bh * SEQ * 64;
    it.dil = dil; it.res = c / cpr; it.n0 = (c - it.res * cpr) * 128; it.N = SEQ / dil;
    it.out = (bf16_t*)(ws + OFF_OB) + (size_t)br * NTOK * 384 + (size_t)b * SEQ * 384 + h * 64; it.ldo = 384;
    it.lse = (float*)(ws + OFF_LSEB) + (size_t)br * NTOK * 6 + (size_t)b * SEQ * 6 + h;
    attn_block<64, 1>(it, gsm, t256);
  }
  for (int i0 = bid * 2; i0 < NC; i0 += gridDim.x * 2) {
    AttnItem it{};
    const int i = i0 + grp, xcd = (i >> 1) & 7, j = ((i >> 4) << 1) | (i & 1);
    const int bh = (j >> 6) * 8 + xcd, blk = j & 63, b = bh >> 2, h = bh & 3;
    it.Q = (const bf16_t*)(ws + OFF_QC) + (size_t)bh * SEQ * 64; it.K = (const bf16_t*)(ws + OFF_KC) + (size_t)bh * SEQ * 64; it.V = (const bf16_t*)(ws + OFF_VC) + (size_t)bh * SEQ * 64;
    it.nrb = blk >> 2; it.ncb = blk & 3;
    it.kr0 = min(max(8 * it.nrb - 4, 0), 112); it.kc0 = min(max(16 * it.ncb - 8, 0), 32);
    it.out = (bf16_t*)(ws + OFF_OC) + (size_t)b * SEQ * 256 + h * 64; it.ldo = 256;
    it.rpb = p.rpb + ((size_t)l * 4 + h) * 465;
    attn_block<64, 2>(it, gsm, t256);
  }
}
NI void phase_mix() {
  const Params& p = kparams(); const int tid = otid(), bid = obid();
  char* ws = p.ws;
  const int lane = tid & 63, gw = bid * (NTHR / 64) + (tid >> 6), nw = gridDim.x * (NTHR / 64);
  const bf16_t* oA = (const bf16_t*)(ws + OFF_OA); const bf16_t* oB = (const bf16_t*)(ws + OFF_OB); const bf16_t* oC = (const bf16_t*)(ws + OFF_OC);
  const float* lse = (const float*)(ws + OFF_LSEB);
  bf16_t* mixed = (bf16_t*)(ws + OFF_MIXED);
  for (int tok = gw; tok < NTOK; tok += nw) {
    float v[16];
    if (lane < 24 || lane >= 48) {
      const bf16_t* src = lane < 24 ? oA + (size_t)tok * 384 + lane * 16 : oC + (size_t)tok * 256 + (lane - 48) * 16;
      const u32x4 a = *(const u32x4*)src, b = *(const u32x4*)(src + 8);
#pragma unroll
      for (int j = 0; j < 4; ++j) { v[2 * j] = bf2f(a[j] & 0xffffu); v[2 * j + 1] = bf2f(a[j] >> 16); v[8 + 2 * j] = bf2f(b[j] & 0xffffu); v[8 + 2 * j + 1] = bf2f(b[j] >> 16); }
    } else {
      const int col = (lane - 24) * 16, hd = col >> 6;
      const float l0 = lse[(size_t)tok * 6 + hd], l1 = lse[(size_t)NTOK * 6 + (size_t)tok * 6 + hd], l2 = lse[(size_t)2 * NTOK * 6 + (size_t)tok * 6 + hd];
      const float mx = fmaxf(l0, fmaxf(l1, l2));
      float w0 = __builtin_amdgcn_exp2f(l0 - mx), w1 = __builtin_amdgcn_exp2f(l1 - mx), w2 = __builtin_amdgcn_exp2f(l2 - mx);
      const float wi = 1.f / (w0 + w1 + w2); w0 *= wi; w1 *= wi; w2 *= wi;
#pragma unroll
      for (int j = 0; j < 16; ++j) v[j] = 0.f;
#pragma unroll
      for (int br = 0; br < 3; ++br) {
        const float wb = br == 0 ? w0 : (br == 1 ? w1 : w2);
        const bf16_t* src = oB + (size_t)br * NTOK * 384 + (size_t)tok * 384 + col;
        const u32x4 a = *(const u32x4*)src, b = *(const u32x4*)(src + 8);
#pragma unroll
        for (int j = 0; j < 4; ++j) { v[2 * j] += wb * bf2f(a[j] & 0xffffu); v[2 * j + 1] += wb * bf2f(a[j] >> 16); v[8 + 2 * j] += wb * bf2f(b[j] & 0xffffu); v[8 + 2 * j + 1] += wb * bf2f(b[j] >> 16); }
      }
    }
    float ss = 0.f;
#pragma unroll
    for (int j = 0; j < 16; ++j) ss += v[j] * v[j];
    const float sa = wave_sum(lane < 24 ? ss : 0.f), sb = wave_sum((lane >= 24 && lane < 48) ? ss : 0.f), sc = wave_sum(lane >= 48 ? ss : 0.f);
    const float rs = lane < 24 ? rsqrtf(sa * (1.f / 384.f) + 1e-6f) : (lane < 48 ? rsqrtf(sb * (1.f / 384.f) + 1e-6f) : rsqrtf(sc * (1.f / 256.f) + 1e-6f));
    u32x4 oa, ob;
#pragma unroll
    for (int j = 0; j < 4; ++j) { oa[j] = cvtpk(v[2 * j] * rs, v[2 * j + 1] * rs); ob[j] = cvtpk(v[8 + 2 * j] * rs, v[8 + 2 * j + 1] * rs); }
    bf16_t* dst = mixed + (size_t)tok * 1024 + lane * 16;
    *(u32x4*)dst = oa; *(u32x4*)(dst + 8) = ob;
  }
}
NI void phase_wout(int l_) {
  const Params& p = kparams(); char* smem = g_smem; const int l = __builtin_amdgcn_readfirstlane(l_); const int tid = otid(), bid = obid(); (void)tid; (void)bid;
  char* ws = p.ws;
  EpiRes e; e.xb = (bf16_t*)(ws + OFF_XB); e.pout = (float*)(ws + OFF_PX2);
  const bf16_t* A = (const bf16_t*)(ws + OFF_MIXED);
  const bf16_t* Bt = (const bf16_t*)(ws + OFF_W + (size_t)l * LW_SIZE + LW_WOUT);
  FOR_TILES(4, mt, nt, gemm_tile<0>(A, 1024, Bt, 1024, 1024, mt * 256, nt * 256, e, tid, nullptr);)
}
NI void phase_mlp1(int l_) {
  const Params& p = kparams(); char* smem = g_smem; const int l = __builtin_amdgcn_readfirstlane(l_); const int tid = otid(), bid = obid(); (void)tid; (void)bid;
  char* ws = p.ws;
  EpiMlp1 e; e.hid = (bf16_t*)(ws + OFF_HID);
  const bf16_t* A = (const bf16_t*)(ws + OFF_XB);
  const bf16_t* Bt = (const bf16_t*)(ws + OFF_W + (size_t)l * LW_SIZE + LW_W1);
  FOR_TILES(16, mt, nt, gemm_tile<16>(A, 1024, Bt, 1024, 1024, mt * 256, nt * 256, e, tid, (const float*)(ws + OFF_PX2));)
}
NI void phase_mlp2(int l_) {
  const Params& p = kparams(); char* smem = g_smem; const int l = __builtin_amdgcn_readfirstlane(l_); const int tid = otid(), bid = obid(); (void)tid; (void)bid;
  char* ws = p.ws;
  EpiRes e; e.xb = (bf16_t*)(ws + OFF_XB); e.pout = (float*)(ws + OFF_PX1);
  const bf16_t* A = (const bf16_t*)(ws + OFF_HID);
  const bf16_t* Bt = (const bf16_t*)(ws + OFF_W + (size_t)l * LW_SIZE + LW_W2);
  FOR_TILES(4, mt, nt, gemm_tile<0>(A, DFF, Bt, DFF, DFF, mt * 256, nt * 256, e, tid, nullptr);)
}
NI void phase_final() {
  const Params& p = kparams(); const int tid = otid(), bid = obid();
  const int lane = tid & 63, gw = bid * (NTHR / 64) + (tid >> 6), nw = gridDim.x * (NTHR / 64);
  const bf16_t* xb = (const bf16_t*)(p.ws + OFF_XB);
  for (int tok = gw; tok < NTOK; tok += nw) {
    float* row = p.out + (size_t)tok * DM;
    f32x4 v[4]; float ss = 0.f;
#pragma unroll
    for (int j = 0; j < 4; ++j) {
      const u32x2 r = *(const u32x2*)(xb + (size_t)tok * DM + j * 256 + lane * 4);
      v[j] = f32x4{bf2f(r[0] & 0xffffu), bf2f(r[0] >> 16), bf2f(r[1] & 0xffffu), bf2f(r[1] >> 16)};
      ss += v[j][0] * v[j][0] + v[j][1] * v[j][1] + v[j][2] * v[j][2] + v[j][3] * v[j][3];
    }
    ss = wave_sum(ss);
    const float rs = rsqrtf(ss * (1.f / 1024.f) + 1e-6f);
#pragma unroll
    for (int j = 0; j < 4; ++j) { const f32x4 g = *(const f32x4*)(p.g_final + j * 256 + lane * 4); f32x4 o = {v[j][0] * rs * g[0], v[j][1] * rs * g[1], v[j][2] * rs * g[2], v[j][3] * rs * g[3]}; *(f32x4*)(row + j * 256 + lane * 4) = o; }
  }
}

constexpr int NPHASE = 2 + 7 * NLAYER;
DI void run_phase(int ph) {
  if (ph == 0) { phase_prep(); return; }
  if (ph == NPHASE - 1) { phase_final(); return; }
  const int l = (ph - 1) / 7, st = (ph - 1) - l * 7;
  switch (st) {
    case 0: phase_g1(l); break;
    case 1: phase_g2(l); break;
    case 2: phase_attn(l); break;
    case 3: phase_mix(); break;
    case 4: phase_wout(l); break;
    case 5: phase_mlp1(l); break;
    default: phase_mlp2(l); break;
  }
}

__global__ void __launch_bounds__(512) mega(Params p, int ph_lo, int ph_hi) {
  cg::grid_group grid = cg::this_grid();
  for (int ph = ph_lo; ph < ph_hi; ++ph) {
    run_phase(ph);
    if (ph + 1 < ph_hi) grid.sync();
  }
}

extern "C" void kernel_launch(void* const* d_in, const int* in_sizes, int n_in, void* d_out, int out_size, void* d_ws, size_t ws_size, hipStream_t stream) {
  static int grid_blocks = 0;
  if (!grid_blocks) {
    int dev = 0, cus = 0, per_cu = 0;
    (void)hipGetDevice(&dev);
    (void)hipDeviceGetAttribute(&cus, hipDeviceAttributeMultiprocessorCount, dev);
    (void)hipOccupancyMaxActiveBlocksPerMultiprocessor(&per_cu, mega, NTHR, 0);
    if (per_cu > 1) per_cu = 1;
    grid_blocks = cus * per_cu;
    if (ws_size < OFF_END) fprintf(stderr, "kernel_launch: workspace too small: %zu < %zu\n", ws_size, (size_t)OFF_END);
  }
  Params p;
  memset(&p, 0, sizeof(p));
  p.x = (const float*)d_in[0]; p.g_mix = (const float*)d_in[1]; p.w_in = (const float*)d_in[2]; p.q_norm = (const float*)d_in[3];
  p.w_uq = (const float*)d_in[4]; p.kv_norm = (const float*)d_in[5]; p.w_ukv = (const float*)d_in[6]; p.rpb = (const float*)d_in[7];
  p.on_a = (const float*)d_in[8]; p.on_b = (const float*)d_in[9]; p.on_c = (const float*)d_in[10]; p.w_out = (const float*)d_in[11];
  p.g_mlp = (const float*)d_in[12]; p.w_mlp_in = (const float*)d_in[13]; p.w_mlp_out = (const float*)d_in[14]; p.g_final = (const float*)d_in[15];
  p.out = (float*)d_out; p.ws = (char*)d_ws;
  p.qscaleA = (float)(1.4426950408889634 / std::sqrt(96.0));
  p.qscaleB = (float)(1.4426950408889634 * 0.125);
#if ONE_LAUNCH
  int lo = 0, hi = NPHASE;
  void* args[] = {&p, &lo, &hi};
  hipError_t e = hipLaunchCooperativeKernel((void*)mega, dim3(grid_blocks), dim3(NTHR), args, 0, stream);
  if (e != hipSuccess) fprintf(stderr, "cooperative launch failed: %s (grid %d)\n", hipGetErrorString(e), grid_blocks);
#else
  for (int ph = 0; ph < NPHASE; ++ph) hipLaunchKernelGGL(mega, dim3(grid_blocks), dim3(NTHR), 0, stream, p, ph, ph + 1);
#endif
}
```

```cpp
#include <hip/hip_runtime.h>
#include <hip/hip_cooperative_groups.h>
#include <cstdio>
#include <cmath>
#include <cstring>
namespace cg = cooperative_groups;

#ifndef ONE_LAUNCH
#define ONE_LAUNCH 1
#endif

#define DI __device__ __forceinline__
typedef unsigned short bf16_t;
typedef short bf16x8 __attribute__((ext_vector_type(8)));
typedef short s16x4 __attribute__((ext_vector_type(4)));
typedef float f32x16 __attribute__((ext_vector_type(16)));
typedef float f32x2 __attribute__((ext_vector_type(2)));
typedef float f32x4 __attribute__((ext_vector_type(4)));
typedef __bf16 bf2_t __attribute__((ext_vector_type(2)));
typedef unsigned u32x4 __attribute__((ext_vector_type(4)));
typedef unsigned u32x2 __attribute__((ext_vector_type(2)));
typedef __attribute__((address_space(3))) s16x4 lds_s16x4;

constexpr int SEQ = 8192, NB = 4, NTOK = NB * SEQ, DM = 1024, NLAYER = 4;
constexpr int N_IN_PAD = 2560, N_UQ_PAD = 768, N_UKV = 768, DFF = 4096;
constexpr int NTHR = 512;

constexpr size_t SZ_XB = (size_t)NTOK * DM * 2;
constexpr size_t SZ_WIN = (size_t)N_IN_PAD * 1024 * 2, SZ_WUQ = (size_t)N_UQ_PAD * 256 * 2, SZ_WUKV = (size_t)N_UKV * 128 * 2,
                 SZ_WOUT = (size_t)1024 * 1024 * 2, SZ_W1 = (size_t)DFF * 1024 * 2, SZ_W2 = (size_t)1024 * DFF * 2;
constexpr size_t LW_WIN = 0, LW_WUQ = LW_WIN + SZ_WIN, LW_WUKV = LW_WUQ + SZ_WUQ, LW_WOUT = LW_WUKV + SZ_WUKV, LW_W1 = LW_WOUT + SZ_WOUT,
                 LW_W2 = LW_W1 + SZ_W1, LW_SIZE = LW_W2 + SZ_W2;
constexpr size_t OFF_XB = 0, OFF_W = OFF_XB + SZ_XB, OFF_TAB = OFF_W + NLAYER * LW_SIZE;
constexpr size_t OFF_COS32 = OFF_TAB, OFF_SIN32 = OFF_COS32 + (size_t)SEQ * 32 * 4, OFF_COS16 = OFF_SIN32 + (size_t)SEQ * 32 * 4,
                 OFF_SIN16 = OFF_COS16 + (size_t)SEQ * 16 * 4, OFF_ATT = OFF_SIN16 + (size_t)SEQ * 16 * 4;
constexpr size_t SZ_T384 = (size_t)NTOK * 384 * 2, SZ_QA = (size_t)NB * 6 * SEQ * 96 * 2, SZ_H6 = (size_t)NB * 6 * SEQ * 64 * 2,
                 SZ_H4 = (size_t)NB * 4 * SEQ * 64 * 2;
constexpr size_t OFF_CQKV = OFF_ATT;
constexpr size_t OFF_OA = OFF_CQKV;
constexpr size_t OFF_QA = OFF_CQKV + SZ_T384, OFF_KA = OFF_QA + SZ_QA, OFF_VA = OFF_KA + SZ_QA;
constexpr size_t OFF_QB = OFF_VA + SZ_H6, OFF_KB = OFF_QB + SZ_H6, OFF_VB = OFF_KB + SZ_H6;
constexpr size_t OFF_QC = OFF_VB + SZ_H6, OFF_KC = OFF_QC + SZ_H4, OFF_VC = OFF_KC + SZ_H4;
constexpr size_t OFF_OB = OFF_VC + SZ_H4, OFF_LSEB = OFF_OB + 3 * SZ_T384, OFF_OC = OFF_LSEB + (size_t)3 * NTOK * 6 * 4;
constexpr size_t OFF_SSQ = OFF_OC + (size_t)NTOK * 256 * 2;
constexpr size_t OFF_PX1 = OFF_SSQ, OFF_PX2 = OFF_PX1 + (size_t)NTOK * 16 * 4, OFF_PQ = OFF_PX2 + (size_t)NTOK * 16 * 4, OFF_PKV = OFF_PQ + (size_t)NTOK * 4 * 4;
constexpr size_t OFF_END = OFF_PKV + (size_t)NTOK * 2 * 4;
constexpr size_t OFF_MIXED = OFF_QA;
constexpr size_t OFF_HID = OFF_ATT;
static_assert(OFF_HID + (size_t)NTOK * DFF * 2 <= OFF_SSQ, "hid fits");
static_assert(OFF_MIXED + (size_t)NTOK * DM * 2 <= OFF_VA, "mixed fits");

struct Params {
  const float *x, *g_mix, *w_in, *q_norm, *w_uq, *kv_norm, *w_ukv, *rpb, *on_a, *on_b, *on_c, *w_out, *g_mlp, *w_mlp_in, *w_mlp_out, *g_final;
  float* out; char* ws;
  float qscaleA, qscaleB;
};
__shared__ __attribute__((aligned(1024))) char g_smem[131072];
#define NI __device__ __forceinline__
DI const Params& kparams() { return *(const Params*)__builtin_amdgcn_kernarg_segment_ptr(); }

DI unsigned cvtpk(float lo, float hi) { f32x2 v = {lo, hi}; bf2_t b = __builtin_convertvector(v, bf2_t); return __builtin_bit_cast(unsigned, b); }
DI bf16_t f2bf(float x) { return (bf16_t)(cvtpk(x, 0.f) & 0xffffu); }
DI float bf2f(unsigned h) { return __uint_as_float(h << 16); }
DI int crow(int i, int h) { return (i & 3) + 8 * (i >> 2) + 4 * h; }
#define MFMA32(a, b, c) __builtin_amdgcn_mfma_f32_32x32x16_bf16((a), (b), (c), 0, 0, 0)
DI float fdot2bf(unsigned a, float c) { bf2_t v = __builtin_bit_cast(bf2_t, a); return __builtin_amdgcn_fdot2_f32_bf16(v, v, c, false); }
DI float swap_max(float v) { auto rr = __builtin_amdgcn_permlane32_swap(__float_as_uint(v), __float_as_uint(v), false, false); return fmaxf(__uint_as_float(rr[0]), __uint_as_float(rr[1])); }
DI float swap_sum(float v) { auto rr = __builtin_amdgcn_permlane32_swap(__float_as_uint(v), __float_as_uint(v), false, false); return __uint_as_float(rr[0]) + __uint_as_float(rr[1]); }

constexpr int ATT_LDS = 53248;
#define FOR_TILES(NN, MT, NT, BODY) { const bool xm_ = gridDim.x == 256; const int st_ = xm_ ? (bid >> 3) : bid, sp_ = xm_ ? 32 : (int)gridDim.x, cn_ = xm_ ? 16 * (NN) : (NTOK / 256) * (NN); \
  for (int j_ = st_; j_ < cn_; j_ += sp_) { int MT = j_ / (NN); const int NT = j_ - MT * (NN); if (xm_) MT += (bid & 7) * 16; BODY } }
DI int otid() { int t = threadIdx.x; asm volatile("" : "+v"(t)); return t; }
DI int obid() { int t = blockIdx.x; asm volatile("" : "+s"(t)); return t; }

template <int NSLOT, class Epi>
DI void gemm_tile(const bf16_t* __restrict__ A, int lda, const bf16_t* __restrict__ Bt, int ldb, int K, int m0, int n0, const Epi& epi, const int tid, const float* pin) {
  const int lane = tid & 63, w = tid >> 6, wm = w >> 2, wn = w & 3, r32 = lane & 31, hi = lane >> 5;
  char* smem = g_smem;
  const int lrow = lane >> 3;
  const int c0 = (lane & 7) ^ (lane >> 4), c1 = (lane & 7) ^ ((lane >> 4) | 4);
  const char* Ab = (const char*)(A + (size_t)m0 * lda);
  const char* Bb = (const char*)(Bt + (size_t)n0 * ldb);
  const unsigned oa0 = (unsigned)(((w * 32 + lrow) * lda + c0 * 8) * 2), oa1 = (unsigned)(((w * 32 + lrow) * lda + c1 * 8) * 2);
  const unsigned ob0 = (unsigned)(((w * 32 + lrow) * ldb + c0 * 8) * 2), ob1 = (unsigned)(((w * 32 + lrow) * ldb + c1 * 8) * 2);
  const int dma_off = (w * 32) * 128 + lane * 16;
  f32x16 acc[4][2];
#pragma unroll
  for (int mi = 0; mi < 4; ++mi)
#pragma unroll
    for (int nj = 0; nj < 2; ++nj)
#pragma unroll
      for (int i = 0; i < 16; ++i) acc[mi][nj][i] = 0.f;
  const int nk = K >> 6;
  const int sw = (r32 >> 1) & 7, sh = sw >> 1, lo16 = 16 * (hi ^ (sw & 1));
  const int a_off = (wm * 128 + r32) * 128 + lo16;
  const int b_off = 32768 + (wn * 64 + r32) * 128 + lo16;
  __syncthreads();
  {
    char* sa = smem + dma_off;
#pragma unroll
    for (int j = 0; j < 4; ++j) {
      __builtin_amdgcn_global_load_lds((const unsigned*)(Ab + (size_t)(j * 8 * lda) * 2 + ((j & 1) ? oa1 : oa0)), (unsigned*)(sa + j * 1024), 16, 0, 0);
      __builtin_amdgcn_global_load_lds((const unsigned*)(Bb + (size_t)(j * 8 * ldb) * 2 + ((j & 1) ? ob1 : ob0)), (unsigned*)(sa + 32768 + j * 1024), 16, 0, 0);
    }
  }
  for (int kt = 0; kt < nk; ++kt) {
    __syncthreads();
    if (kt + 1 < nk) {
      char* sa = smem + ((kt + 1) & 1) * 65536 + dma_off;
      const int k0 = (kt + 1) * 64;
#pragma unroll
      for (int j = 0; j < 4; ++j) {
        __builtin_amdgcn_global_load_lds((const unsigned*)(Ab + (size_t)(j * 8 * lda + k0) * 2 + ((j & 1) ? oa1 : oa0)), (unsigned*)(sa + j * 1024), 16, 0, 0);
        __builtin_amdgcn_global_load_lds((const unsigned*)(Bb + (size_t)(j * 8 * ldb + k0) * 2 + ((j & 1) ? ob1 : ob0)), (unsigned*)(sa + 32768 + j * 1024), 16, 0, 0);
      }
    }
    const char* sb = smem + (kt & 1) * 65536;
#pragma unroll
    for (int ks = 0; ks < 4; ++ks) {
      const int koff = 32 * (ks ^ sh);
      bf16x8 af[4], bfr[2];
#pragma unroll
      for (int mi = 0; mi < 4; ++mi) af[mi] = *(const bf16x8*)(sb + a_off + mi * 4096 + koff);
#pragma unroll
      for (int nj = 0; nj < 2; ++nj) bfr[nj] = *(const bf16x8*)(sb + b_off + nj * 4096 + koff);
#pragma unroll
      for (int mi = 0; mi < 4; ++mi)
#pragma unroll
        for (int nj = 0; nj < 2; ++nj) acc[mi][nj] = MFMA32(af[mi], bfr[nj], acc[mi][nj]);
    }
  }
  float* rstd_s = (float*)smem;
  if (NSLOT > 0) {
    __syncthreads();
    if (tid < 256) {
      const float* pr = pin + (size_t)(m0 + tid) * NSLOT;
      float sacc = 0.f;
      if (NSLOT >= 4) {
#pragma unroll
        for (int q = 0; q < NSLOT / 4; ++q) { const f32x4 v = *(const f32x4*)(pr + 4 * q); sacc += (v[0] + v[1]) + (v[2] + v[3]); }
      } else {
#pragma unroll
        for (int q = 0; q < NSLOT; ++q) sacc += pr[q];
      }
      rstd_s[tid] = rsqrtf(sacc / (float)K + 1e-6f);
    }
    __syncthreads();
  }
  int lane2 = lane, w2 = w; asm volatile("" : "+v"(lane2), "+v"(w2));
  epi(acc, m0, (w2 >> 2) * 128, n0 + (w2 & 3) * 64, lane2, rstd_s);
}
DI void row_ssq_put(float v, float* dst, int lane) {
  v += __shfl_xor(v, 1); v += __shfl_xor(v, 2); v += __shfl_xor(v, 4); v += __shfl_xor(v, 8); v += __shfl_xor(v, 16);
  if ((lane & 31) == 0) *dst = v;
}

struct EpiG1 {
  bf16_t *cqkv, *KA, *qB, *qC; const float *cos32, *sin32, *cos16, *sin16; float qs; float *pq, *pkv;
  DI void operator()(f32x16 (&acc)[4][2], int m0, int lr0, int col0, int lane, const float* rstd_s) const {
    const int c = lane & 31, h = lane >> 5, cb = col0 >> 6;
    if (cb >= 37) return;
#define G1_ROW const int lr = lr0 + mi * 32 + crow(i, h), tok = m0 + lr, b = tok >> 13, s = tok & 8191; (void)b; (void)s; \
               const float rs = rstd_s[lr]; float v0 = acc[mi][0][i] * rs, v1 = acc[mi][1][i] * rs;
    if (cb < 6) {
#pragma unroll
      for (int mi = 0; mi < 4; ++mi)
#pragma unroll
        for (int i = 0; i < 16; ++i) {
        if ((i & 3) == 0) __builtin_amdgcn_sched_barrier(0);
          G1_ROW
          bf16_t* d = cqkv + (size_t)tok * 384 + cb * 64 + c; d[0] = f2bf(v0); d[32] = f2bf(v1);
          row_ssq_put(v0 * v0 + v1 * v1, cb < 4 ? pq + (size_t)tok * 4 + cb : pkv + (size_t)tok * 2 + (cb - 4), lane);
        }
    } else if (cb == 6) {
#pragma unroll
      for (int mi = 0; mi < 4; ++mi)
#pragma unroll
        for (int i = 0; i < 16; ++i) {
        if ((i & 3) == 0) __builtin_amdgcn_sched_barrier(0);
          G1_ROW
          if (c < 16) {
            const float cs = cos16[s * 16 + c], sn = sin16[s * 16 + c];
            const bf16_t o1 = f2bf(v0 * cs - v1 * sn), o2 = f2bf(v0 * sn + v1 * cs);
#pragma unroll
            for (int hd = 0; hd < 6; ++hd) { bf16_t* d = KA + ((size_t)(b * 6 + hd) * SEQ + s) * 96 + 64 + c; d[0] = o1; d[16] = o2; }
          }
        }
    } else if (cb < 25) {
      const int idx = cb - 7, which = idx / 6, hd = idx - which * 6;
      bf16_t* base = qB + (size_t)which * (SZ_H6 / 2) + (size_t)hd * SEQ * 64 + c;
      const float sc = which == 0 ? qs : 1.f;
      if (which < 2) {
#pragma unroll
        for (int mi = 0; mi < 4; ++mi)
#pragma unroll
          for (int i = 0; i < 16; ++i) {
        if ((i & 3) == 0) __builtin_amdgcn_sched_barrier(0);
            G1_ROW
            const float cs = cos32[s * 32 + c] * sc, sn = sin32[s * 32 + c] * sc;
            bf16_t* d = base + ((size_t)(b * 6) * SEQ + s) * 64;
            d[0] = f2bf(v0 * cs - v1 * sn); d[32] = f2bf(v0 * sn + v1 * cs);
          }
      } else {
#pragma unroll
        for (int mi = 0; mi < 4; ++mi)
#pragma unroll
          for (int i = 0; i < 16; ++i) {
        if ((i & 3) == 0) __builtin_amdgcn_sched_barrier(0);
            G1_ROW
            bf16_t* d = base + ((size_t)(b * 6) * SEQ + s) * 64;
            d[0] = f2bf(v0); d[32] = f2bf(v1);
          }
      }
    } else {
      const int idx = cb - 25, which = idx >> 2, hd = idx & 3;
      bf16_t* base = qC + (size_t)which * (SZ_H4 / 2) + (size_t)hd * SEQ * 64 + c;
      const float sc = which == 0 ? qs : 1.f;
#pragma unroll
      for (int mi = 0; mi < 4; ++mi)
#pragma unroll
        for (int i = 0; i < 16; ++i) {
        if ((i & 3) == 0) __builtin_amdgcn_sched_barrier(0);
          G1_ROW
          bf16_t* d = base + ((size_t)(b * 4) * SEQ + s) * 64;
          d[0] = f2bf(v0 * sc); d[32] = f2bf(v1 * sc);
        }
    }
#undef G1_ROW
  }
};
struct EpiUQ {
  bf16_t* QA; const float *cos16, *sin16; float qs;
  DI void operator()(f32x16 (&acc)[4][2], int m0, int lr0, int col0, int lane, const float* rstd_s) const {
    const int c = lane & 31, h = lane >> 5, cb = col0 >> 6;
    if (cb >= 9) return;
#pragma unroll
    for (int mi = 0; mi < 4; ++mi)
#pragma unroll
      for (int i = 0; i < 16; ++i) {
        if ((i & 3) == 0) __builtin_amdgcn_sched_barrier(0);
        const int lr = lr0 + mi * 32 + crow(i, h), tok = m0 + lr, b = tok >> 13, s = tok & 8191;
        const float rs = rstd_s[lr] * qs;
        const float v0 = acc[mi][0][i] * rs, v1 = acc[mi][1][i] * rs;
        if (cb < 6) {
          bf16_t* d = QA + ((size_t)(b * 6 + cb) * SEQ + s) * 96 + c; d[0] = f2bf(v0); d[32] = f2bf(v1);
        } else {
          const int hd = 2 * (cb - 6) + (c >> 4), fi = c & 15;
          const float cs = cos16[s * 16 + fi], sn = sin16[s * 16 + fi];
          bf16_t* d = QA + ((size_t)(b * 6 + hd) * SEQ + s) * 96 + 64 + fi;
          d[0] = f2bf(v0 * cs - v1 * sn); d[16] = f2bf(v0 * sn + v1 * cs);
        }
      }
  }
};
struct EpiUKV {
  bf16_t *KA, *VA;
  DI void operator()(f32x16 (&acc)[4][2], int m0, int lr0, int col0, int lane, const float* rstd_s) const {
    const int c = lane & 31, h = lane >> 5, cb = col0 >> 6, hd = cb >> 1, isv = cb & 1;
#pragma unroll
    for (int mi = 0; mi < 4; ++mi)
#pragma unroll
      for (int i = 0; i < 16; ++i) {
        if ((i & 3) == 0) __builtin_amdgcn_sched_barrier(0);
        const int lr = lr0 + mi * 32 + crow(i, h), tok = m0 + lr, b = tok >> 13, s = tok & 8191;
        const float rs = rstd_s[lr];
        const float v0 = acc[mi][0][i] * rs, v1 = acc[mi][1][i] * rs;
        bf16_t* d = isv ? VA + ((size_t)(b * 6 + hd) * SEQ + s) * 64 + c : KA + ((size_t)(b * 6 + hd) * SEQ + s) * 96 + c;
        d[0] = f2bf(v0); d[32] = f2bf(v1);
      }
  }
};
struct EpiRes {
  bf16_t* xb; float* pout;
  DI void operator()(f32x16 (&acc)[4][2], int m0, int lr0, int col0, int lane, const float* rstd_s) const {
    const int c = lane & 31, h = lane >> 5;
#pragma unroll
    for (int mi = 0; mi < 4; ++mi)
#pragma unroll
      for (int i = 0; i < 16; ++i) {
        if ((i & 3) == 0) __builtin_amdgcn_sched_barrier(0);
        const int row = m0 + lr0 + mi * 32 + crow(i, h);
        const size_t o = (size_t)row * DM + col0 + c;
        const float v0 = bf2f(xb[o]) + acc[mi][0][i], v1 = bf2f(xb[o + 32]) + acc[mi][1][i];
        xb[o] = f2bf(v0); xb[o + 32] = f2bf(v1);
        row_ssq_put(v0 * v0 + v1 * v1, pout + (size_t)row * 16 + (col0 >> 6), lane);
      }
  }
};
struct EpiMlp1 {
  bf16_t* hid;
  DI void operator()(f32x16 (&acc)[4][2], int m0, int lr0, int col0, int lane, const float* rstd_s) const {
    const int c = lane & 31, h = lane >> 5;
#pragma unroll
    for (int mi = 0; mi < 4; ++mi)
#pragma unroll
      for (int i = 0; i < 16; ++i) {
        if ((i & 3) == 0) __builtin_amdgcn_sched_barrier(0);
        const int lr = lr0 + mi * 32 + crow(i, h);
        const float rs = rstd_s[lr];
        const float v0 = fmaxf(acc[mi][0][i] * rs, 0.f), v1 = fmaxf(acc[mi][1][i] * rs, 0.f);
        bf16_t* d = hid + (size_t)(m0 + lr) * DFF + col0 + c; d[0] = f2bf(v0 * v0); d[32] = f2bf(v1 * v1);
      }
  }
};

struct AttnItem {
  const bf16_t *Q, *K, *V;
  int q0;
  int n0, dil, res, N;
  int nrb, ncb, kr0, kc0;
  bf16_t* out; int ldo;
  float* lse;
  const float* rpb;
};

template <int DQ, int MODE>
DI void attn_block(const AttnItem& it, char* smem, const int tid) {
  constexpr int CPR = DQ / 8, KST = DQ * 2 + 16, KCH = (64 * CPR) / 256, NT = MODE == 0 ? SEQ / 64 : MODE == 1 ? 4 : 8;
  const int lane = tid & 63, w = tid >> 6, r32 = lane & 31, hi = lane >> 5;
  char* Ks = smem; char* Vs = smem + 64 * KST; float* bias_s = (float*)(smem + 64 * KST + 8192);
  const int qi = w * 32 + r32;
  int qpos;
  if (MODE == 0) qpos = it.q0 + qi;
  else if (MODE == 1) qpos = (it.n0 + qi) * it.dil + it.res;
  else qpos = (8 * it.nrb + (qi >> 4)) * 64 + 16 * it.ncb + (qi & 15);
  __syncthreads();
  if (MODE == 2) { for (int i = tid; i < 465; i += 256) bias_s[i] = it.rpb[i] * 1.4426950408889634f; }
  bf16x8 qr[DQ / 16];
#pragma unroll
  for (int d0 = 0; d0 < DQ / 16; ++d0) qr[d0] = *(const bf16x8*)(it.Q + (size_t)qpos * DQ + d0 * 16 + hi * 8);
  f32x16 o[2];
#pragma unroll
  for (int i = 0; i < 16; ++i) { o[0][i] = 0.f; o[1][i] = 0.f; }
  float m_run = -1e30f, l_run = 0.f;
  u32x4 rk[KCH], rv[2];
  auto kpos = [&](int t, int row) -> int {
    if (MODE == 0) return t * 64 + row;
    if (MODE == 1) { int n = it.n0 - 64 + 64 * t + row; n = n < 0 ? 0 : (n > it.N - 1 ? it.N - 1 : n); return n * it.dil + it.res; }
    return (it.kr0 + 2 * t + (row >> 5)) * 64 + it.kc0 + (row & 31);
  };
  auto load = [&](int t) {
#pragma unroll
    for (int i = 0; i < KCH; ++i) { const int c = tid + 256 * i, row = c / CPR, kc = c - row * CPR; rk[i] = *(const u32x4*)(it.K + (size_t)kpos(t, row) * DQ + kc * 8); }
#pragma unroll
    for (int i = 0; i < 2; ++i) { const int c = tid + 256 * i, row = c >> 3, kc = c & 7; rv[i] = *(const u32x4*)(it.V + (size_t)kpos(t, row) * 64 + kc * 8); }
  };
  const int vrd = ((lane >> 5) * 4 + ((lane & 15) >> 2)) * 64 + ((lane >> 4) & 1) * 32 + (lane & 3) * 8;
  load(0);
  for (int t = 0; t < NT; ++t) {
    __syncthreads();
#pragma unroll
    for (int i = 0; i < KCH; ++i) { const int c = tid + 256 * i, row = c / CPR, kc = c - row * CPR; *(u32x4*)(Ks + row * KST + kc * 16) = rk[i]; }
#pragma unroll
    for (int i = 0; i < 2; ++i) { const int c = tid + 256 * i, row = c >> 3, kc = c & 7; *(u32x4*)(Vs + (kc >> 2) * 4096 + row * 64 + (kc & 3) * 16) = rv[i]; }
    __syncthreads();
    if (t + 1 < NT) load(t + 1);
    bool skip = false;
    if (MODE == 1) skip = (w < 2) ? (t == 3) : (t == 0);
    if (MODE == 2) {
      const int rq_lo = 8 * it.nrb + 2 * w, rq_hi = rq_lo + 1;
      const int rs_lo = min(max(rq_lo - 4, 0), 120), rs_hi = min(max(rq_hi - 4, 0), 120) + 7;
      const int kr = it.kr0 + 2 * t;
      skip = (kr + 1 < rs_lo) || (kr > rs_hi);
    }
    if (skip) continue;
    f32x16 p0, p1;
#pragma unroll
    for (int i = 0; i < 16; ++i) { p0[i] = 0.f; p1[i] = 0.f; }
#pragma unroll
    for (int d0 = 0; d0 < DQ / 16; ++d0) {
      const bf16x8 k0 = *(const bf16x8*)(Ks + r32 * KST + d0 * 32 + hi * 16);
      const bf16x8 k1 = *(const bf16x8*)(Ks + (32 + r32) * KST + d0 * 32 + hi * 16);
      p0 = MFMA32(k0, qr[d0], p0); p1 = MFMA32(k1, qr[d0], p1);
    }
    if (MODE == 1) {
      const int nq = it.n0 + qi, kb = it.n0 - 64 + 64 * t;
#pragma unroll
      for (int i = 0; i < 16; ++i) {
        const int nk = kb + crow(i, hi), nk2 = nk + 32;
        const int d1 = nq - nk, d2 = nq - nk2;
        const bool ok1 = (d1 <= 64) && (d1 >= -64) && (nk >= 0) && (nk < it.N);
        const bool ok2 = (d2 <= 64) && (d2 >= -64) && (nk2 >= 0) && (nk2 < it.N);
        p0[i] = ok1 ? p0[i] : -INFINITY; p1[i] = ok2 ? p1[i] : -INFINITY;
      }
    }
    if (MODE == 2) {
      const int rq = 8 * it.nrb + (qi >> 4), cq = 16 * it.ncb + (qi & 15);
      const int rs_ = min(max(rq - 4, 0), 120), cs_ = min(max(cq - 8, 0), 48);
      const int kr = it.kr0 + 2 * t;
      const bool okr0 = (kr >= rs_) && (kr < rs_ + 8), okr1 = (kr + 1 >= rs_) && (kr + 1 < rs_ + 8);
      const int bi0 = (kr - rq + 7) * 31 - cq + 15;
#pragma unroll
      for (int i = 0; i < 16; ++i) {
        const int kc = it.kc0 + crow(i, hi);
        const bool okc = (kc >= cs_) && (kc < cs_ + 16);
        const bool ok0 = okc && okr0, ok1 = okc && okr1;
        const float b0 = bias_s[ok0 ? bi0 + kc : 0], b1 = bias_s[ok1 ? bi0 + 31 + kc : 0];
        p0[i] = ok0 ? p0[i] + b0 : -INFINITY; p1[i] = ok1 ? p1[i] + b1 : -INFINITY;
      }
    }
    float pmax = p0[0];
#pragma unroll
    for (int i = 1; i < 16; ++i) pmax = fmaxf(pmax, p0[i]);
#pragma unroll
    for (int i = 0; i < 16; ++i) pmax = fmaxf(pmax, p1[i]);
    pmax = swap_max(pmax);
    const float mn = fmaxf(m_run, pmax);
    const float alpha = __builtin_amdgcn_exp2f(m_run - mn);
    m_run = mn;
    float ps = 0.f;
#pragma unroll
    for (int i = 0; i < 16; ++i) { p0[i] = __builtin_amdgcn_exp2f(p0[i] - mn); ps += p0[i]; }
#pragma unroll
    for (int i = 0; i < 16; ++i) { p1[i] = __builtin_amdgcn_exp2f(p1[i] - mn); ps += p1[i]; }
    ps = swap_sum(ps);
    l_run = l_run * alpha + ps;
#pragma unroll
    for (int i = 0; i < 16; ++i) { o[0][i] *= alpha; o[1][i] *= alpha; }
    bf16x8 pb[4];
#pragma unroll
    for (int s = 0; s < 2; ++s) {
      u32x4 a = {cvtpk(p0[8 * s], p0[8 * s + 1]), cvtpk(p0[8 * s + 2], p0[8 * s + 3]), cvtpk(p0[8 * s + 4], p0[8 * s + 5]), cvtpk(p0[8 * s + 6], p0[8 * s + 7])};
      u32x4 b = {cvtpk(p1[8 * s], p1[8 * s + 1]), cvtpk(p1[8 * s + 2], p1[8 * s + 3]), cvtpk(p1[8 * s + 4], p1[8 * s + 5]), cvtpk(p1[8 * s + 6], p1[8 * s + 7])};
      pb[s] = __builtin_bit_cast(bf16x8, a); pb[2 + s] = __builtin_bit_cast(bf16x8, b);
    }
#pragma unroll
    for (int db = 0; db < 2; ++db)
#pragma unroll
      for (int s = 0; s < 4; ++s) {
        const s16x4 lo = __builtin_amdgcn_ds_read_tr16_b64_v4i16((lds_s16x4*)(Vs + db * 4096 + (16 * s) * 64 + vrd));
        const s16x4 hh = __builtin_amdgcn_ds_read_tr16_b64_v4i16((lds_s16x4*)(Vs + db * 4096 + (16 * s + 8) * 64 + vrd));
        const bf16x8 a = {lo[0], lo[1], lo[2], lo[3], hh[0], hh[1], hh[2], hh[3]};
        o[db] = MFMA32(a, pb[s], o[db]);
      }
  }
  const float inv = 1.f / l_run;
  const int bq = qpos;
  bf16_t* orow = it.out + (size_t)bq * it.ldo;
#pragma unroll
  for (int db = 0; db < 2; ++db)
#pragma unroll
    for (int g = 0; g < 4; ++g) {
      u32x2 v = {cvtpk(o[db][4 * g] * inv, o[db][4 * g + 1] * inv), cvtpk(o[db][4 * g + 2] * inv, o[db][4 * g + 3] * inv)};
      *(u32x2*)(orow + db * 32 + 8 * g + 4 * hi) = v;
    }
  if (MODE == 1) { if (hi == 0) it.lse[(size_t)bq * 6] = m_run + __builtin_amdgcn_logf(l_run); }
}

DI void attn_dense_skew(const bf16_t* __restrict__ Q, const bf16_t* __restrict__ K, const bf16_t* __restrict__ V, int q0, bf16_t* __restrict__ out,
                        char* smem, const int tid512, const int grp) {
  constexpr int DQ = 96, CPR = 12, KST = 208, NT = SEQ / 64, KB = 64 * KST, VOFF = 2 * KB;
  const int lane = tid512 & 63, w = (tid512 >> 6) & 3, r32 = lane & 31, hi = lane >> 5;
  const int qpos = q0 + w * 32 + r32;
  bf16x8 qr[DQ / 16];
#pragma unroll
  for (int d0 = 0; d0 < DQ / 16; ++d0) qr[d0] = *(const bf16x8*)(Q + (size_t)qpos * DQ + d0 * 16 + hi * 8);
  f32x16 o[2];
#pragma unroll
  for (int i = 0; i < 16; ++i) { o[0][i] = 0.f; o[1][i] = 0.f; }
  float m_run = -1e30f, l_run = 0.f;
  const int kr0 = tid512 / CPR, kc0 = tid512 - kr0 * CPR, c1 = tid512 + 512, kr1 = c1 / CPR, kc1 = c1 - kr1 * CPR, vr = tid512 >> 3, vc = tid512 & 7;
  const bool two = tid512 < 256;
  const bf16_t* Kp0 = K + (size_t)kr0 * DQ + kc0 * 8; const bf16_t* Kp1 = K + (size_t)kr1 * DQ + kc1 * 8; const bf16_t* Vp = V + (size_t)vr * 64 + vc * 8;
  const int ks0 = kr0 * KST + kc0 * 16, ks1 = kr1 * KST + kc1 * 16, vs0 = VOFF + (vc >> 2) * 4096 + vr * 64 + (vc & 3) * 16;
  u32x4 rk0, rk1 = u32x4{0u, 0u, 0u, 0u}, rv;
  auto load = [&](int t) {
    const size_t ro = (size_t)t * 64;
    rk0 = *(const u32x4*)(Kp0 + ro * DQ); if (two) rk1 = *(const u32x4*)(Kp1 + ro * DQ); rv = *(const u32x4*)(Vp + ro * 64);
  };
  auto store = [&](int kb, int vb) {
    char* kbp = smem + kb * KB;
    *(u32x4*)(kbp + ks0) = rk0; if (two) *(u32x4*)(kbp + ks1) = rk1; *(u32x4*)(smem + vb * 8192 + vs0) = rv;
  };
  const int vrd = ((lane >> 5) * 4 + ((lane & 15) >> 2)) * 64 + ((lane >> 4) & 1) * 32 + (lane & 3) * 8;
  __syncthreads();
  load(0); store(0, 0); load(1);
  __syncthreads();
  if (grp == 1) __syncthreads();
  int vcur = 0;
  for (int t = 0; t < NT; ++t) {
    const int vnext = vcur == 2 ? 0 : vcur + 1;
    const char* Ks = smem + (t & 1) * KB; const char* Vs = smem + VOFF + vcur * 8192;
    if (t + 1 < NT) store((t + 1) & 1, vnext);
    if (t + 2 < NT) load(t + 2);
    f32x16 p0, p1;
#pragma unroll
    for (int i = 0; i < 16; ++i) { p0[i] = 0.f; p1[i] = 0.f; }
    {
      const char* kp = Ks + r32 * KST + hi * 16;
      bf16x8 ka[2][2];
      ka[0][0] = *(const bf16x8*)(kp); ka[0][1] = *(const bf16x8*)(kp + 32 * KST);
      ka[1][0] = *(const bf16x8*)(kp + 32); ka[1][1] = *(const bf16x8*)(kp + 32 * KST + 32);
#pragma unroll
      for (int d0 = 0; d0 < DQ / 16; ++d0) {
        p0 = MFMA32(ka[d0 & 1][0], qr[d0], p0); p1 = MFMA32(ka[d0 & 1][1], qr[d0], p1);
        if (d0 + 2 < DQ / 16) { ka[d0 & 1][0] = *(const bf16x8*)(kp + (d0 + 2) * 32); ka[d0 & 1][1] = *(const bf16x8*)(kp + 32 * KST + (d0 + 2) * 32); }
      }
    }
    asm volatile("" : "+v"(p0), "+v"(p1));
    __syncthreads();
    asm volatile("" : "+v"(p0), "+v"(p1));
    s16x4 vlo[4], vhi[4];
#pragma unroll
    for (int s2 = 0; s2 < 4; ++s2) {
      vlo[s2] = __builtin_amdgcn_ds_read_tr16_b64_v4i16((lds_s16x4*)(Vs + (16 * s2) * 64 + vrd));
      vhi[s2] = __builtin_amdgcn_ds_read_tr16_b64_v4i16((lds_s16x4*)(Vs + (16 * s2 + 8) * 64 + vrd));
    }
    float pmax = p0[0];
#pragma unroll
    for (int i = 1; i < 16; ++i) pmax = fmaxf(pmax, p0[i]);
#pragma unroll
    for (int i = 0; i < 16; ++i) pmax = fmaxf(pmax, p1[i]);
    pmax = swap_max(pmax);
    const float mn = fmaxf(m_run, pmax);
    const float alpha = __builtin_amdgcn_exp2f(m_run - mn);
    m_run = mn;
    float ps = 0.f;
#pragma unroll
    for (int i = 0; i < 16; ++i) { p0[i] = __builtin_amdgcn_exp2f(p0[i] - mn); ps += p0[i]; }
#pragma unroll
    for (int i = 0; i < 16; ++i) { p1[i] = __builtin_amdgcn_exp2f(p1[i] - mn); ps += p1[i]; }
    ps = swap_sum(ps);
    l_run = l_run * alpha + ps;
#pragma unroll
    for (int i = 0; i < 16; ++i) { o[0][i] *= alpha; o[1][i] *= alpha; }
    bf16x8 pb[4];
#pragma unroll
    for (int s = 0; s < 2; ++s) {
      u32x4 a = {cvtpk(p0[8 * s], p0[8 * s + 1]), cvtpk(p0[8 * s + 2], p0[8 * s + 3]), cvtpk(p0[8 * s + 4], p0[8 * s + 5]), cvtpk(p0[8 * s + 6], p0[8 * s + 7])};
      u32x4 b = {cvtpk(p1[8 * s], p1[8 * s + 1]), cvtpk(p1[8 * s + 2], p1[8 * s + 3]), cvtpk(p1[8 * s + 4], p1[8 * s + 5]), cvtpk(p1[8 * s + 6], p1[8 * s + 7])};
      pb[s] = __builtin_bit_cast(bf16x8, a); pb[2 + s] = __builtin_bit_cast(bf16x8, b);
    }
    {
      s16x4 wlo[4], whi[4];
#pragma unroll
      for (int s2 = 0; s2 < 4; ++s2) {
        wlo[s2] = __builtin_amdgcn_ds_read_tr16_b64_v4i16((lds_s16x4*)(Vs + 4096 + (16 * s2) * 64 + vrd));
        whi[s2] = __builtin_amdgcn_ds_read_tr16_b64_v4i16((lds_s16x4*)(Vs + 4096 + (16 * s2 + 8) * 64 + vrd));
      }
#pragma unroll
      for (int s2 = 0; s2 < 4; ++s2) { const bf16x8 a = {vlo[s2][0], vlo[s2][1], vlo[s2][2], vlo[s2][3], vhi[s2][0], vhi[s2][1], vhi[s2][2], vhi[s2][3]}; o[0] = MFMA32(a, pb[s2], o[0]); }
#pragma unroll
      for (int s2 = 0; s2 < 4; ++s2) { const bf16x8 a = {wlo[s2][0], wlo[s2][1], wlo[s2][2], wlo[s2][3], whi[s2][0], whi[s2][1], whi[s2][2], whi[s2][3]}; o[1] = MFMA32(a, pb[s2], o[1]); }
    }
    asm volatile("" : "+v"(o[0]), "+v"(o[1]));
    __syncthreads();
    asm volatile("" : "+v"(o[0]), "+v"(o[1]));
    vcur = vnext;
  }
  if (grp == 0) __syncthreads();
  const float inv = 1.f / l_run;
  bf16_t* orow = out + (size_t)qpos * 384;
#pragma unroll
  for (int db = 0; db < 2; ++db)
#pragma unroll
    for (int g = 0; g < 4; ++g) {
      u32x2 v = {cvtpk(o[db][4 * g] * inv, o[db][4 * g + 1] * inv), cvtpk(o[db][4 * g + 2] * inv, o[db][4 * g + 3] * inv)};
      *(u32x2*)(orow + db * 32 + 8 * g + 4 * hi) = v;
    }
}

DI float wave_sum(float v) {
  v += __shfl_xor(v, 32); v += __shfl_xor(v, 16); v += __shfl_xor(v, 8); v += __shfl_xor(v, 4); v += __shfl_xor(v, 2); v += __shfl_xor(v, 1); return v;
}
DI float gain_of(const Params& p, int kind, int l, int k) {
  switch (kind) {
    case 0: return p.g_mix[l * 1024 + k];
    case 1: return p.q_norm[l * 256 + k];
    case 2: return p.kv_norm[l * 128 + k];
    case 3: return k < 384 ? p.on_a[l * 384 + k] : (k < 768 ? p.on_b[l * 384 + k - 384] : p.on_c[l * 256 + k - 768]);
    case 4: return p.g_mlp[l * 1024 + k];
    default: return 1.f;
  }
}
DI int map_col(int kind, int n) {
  if (kind == 0) {
    if (n < 384) return n;
    if (n < 448) { const int wv = n - 384, c = wv & 31, sub = wv >> 5; return c < 16 ? 384 + sub * 16 + c : -1; }
    if (n < 1600) return 416 + (n - 448);
    if (n < 2368) return 1568 + (n - 1600);
    return -1;
  }
  if (kind == 1) {
    if (n < 384) return (n >> 6) * 96 + (n & 63);
    if (n < 576) { const int wv = n - 384, g = wv >> 6, wi = wv & 63, sub = wi >> 5, c = wi & 31, hd = 2 * g + (c >> 4), fi = c & 15; return hd * 96 + 64 + sub * 16 + fi; }
    return -1;
  }
  return n;
}
DI void wtile(const Params& p, const float* src, int Nsrc, bf16_t* dst, int K, int kt, int nt, int kind, int l, char* smem, const int tid) {
  float* tile = (float*)smem;
  const int lane = tid & 63, wv = tid >> 6;
  __syncthreads();
  const int n = nt * 64 + lane, sc = map_col(kind, n);
#pragma unroll 4
  for (int r = 0; r < 8; ++r) {
    const int kl = r * 8 + wv, k = kt * 64 + kl;
    float v = 0.f;
    if (sc >= 0) v = src[(size_t)k * Nsrc + sc] * gain_of(p, kind, l, k);
    tile[kl * 65 + lane] = v;
  }
  __syncthreads();
#pragma unroll 4
  for (int r = 0; r < 8; ++r) {
    const int nl = r * 8 + wv;
    dst[(size_t)(nt * 64 + nl) * K + kt * 64 + lane] = f2bf(tile[lane * 65 + nl]);
  }
}

NI void phase_prep() {
  const Params& p = kparams(); char* smem = g_smem; const int tid = otid(), bid = obid();
  char* ws = p.ws;
  constexpr int T_WIN = (N_IN_PAD / 64) * 16, T_WUQ = (N_UQ_PAD / 64) * 4, T_WUKV = (N_UKV / 64) * 2, T_WOUT = 16 * 16, T_W1 = 64 * 16, T_W2 = 16 * 64;
  constexpr int T_L = T_WIN + T_WUQ + T_WUKV + T_WOUT + T_W1 + T_W2;
  for (int j = bid; j < NLAYER * T_L; j += gridDim.x) {
    const int l = j / T_L; int r = j - l * T_L;
    char* lw = ws + OFF_W + (size_t)l * LW_SIZE;
    if (r < T_WIN) { wtile(p, p.w_in + (size_t)l * 1024 * 2336, 2336, (bf16_t*)(lw + LW_WIN), 1024, r & 15, r >> 4, 0, l, smem, tid); continue; }
    r -= T_WIN;
    if (r < T_WUQ) { wtile(p, p.w_uq + (size_t)l * 256 * 576, 576, (bf16_t*)(lw + LW_WUQ), 256, r & 3, r >> 2, 1, l, smem, tid); continue; }
    r -= T_WUQ;
    if (r < T_WUKV) { wtile(p, p.w_ukv + (size_t)l * 128 * 768, 768, (bf16_t*)(lw + LW_WUKV), 128, r & 1, r >> 1, 2, l, smem, tid); continue; }
    r -= T_WUKV;
    if (r < T_WOUT) { wtile(p, p.w_out + (size_t)l * 1024 * 1024, 1024, (bf16_t*)(lw + LW_WOUT), 1024, r & 15, r >> 4, 3, l, smem, tid); continue; }
    r -= T_WOUT;
    if (r < T_W1) { wtile(p, p.w_mlp_in + (size_t)l * 1024 * 4096, 4096, (bf16_t*)(lw + LW_W1), 1024, r & 15, r >> 4, 4, l, smem, tid); continue; }
    r -= T_W1;
    wtile(p, p.w_mlp_out + (size_t)l * 4096 * 1024, 1024, (bf16_t*)(lw + LW_W2), 4096, r & 63, r >> 6, 5, l, smem, tid);
  }
  const size_t gtid = (size_t)bid * NTHR + tid, gsz = (size_t)gridDim.x * NTHR;
  bf16_t* xb = (bf16_t*)(ws + OFF_XB);
  {
    const int lane = tid & 63, gw = bid * (NTHR / 64) + (tid >> 6), nw = gridDim.x * (NTHR / 64);
    float* px1 = (float*)(ws + OFF_PX1);
    for (int row = gw; row < NTOK; row += nw) {
      float ss = 0.f;
#pragma unroll
      for (int j = 0; j < 4; ++j) {
        const f32x4 a = *(const f32x4*)(p.x + (size_t)row * DM + j * 256 + lane * 4);
        ss += a[0] * a[0] + a[1] * a[1] + a[2] * a[2] + a[3] * a[3];
        u32x2 o = {cvtpk(a[0], a[1]), cvtpk(a[2], a[3])};
        *(u32x2*)(xb + (size_t)row * DM + j * 256 + lane * 4) = o;
      }
      ss = wave_sum(ss);
      if (lane < 16) px1[(size_t)row * 16 + lane] = lane == 0 ? ss : 0.f;
    }
  }
  float* c32 = (float*)(ws + OFF_COS32); float* s32 = (float*)(ws + OFF_SIN32); float* c16 = (float*)(ws + OFF_COS16); float* s16 = (float*)(ws + OFF_SIN16);
  for (size_t i = gtid; i < (size_t)SEQ * 48; i += gsz) {
    int pos, fi; float invf; float *cd, *sd;
    if (i < (size_t)SEQ * 32) { pos = (int)(i >> 5); fi = (int)(i & 31); invf = __builtin_amdgcn_exp2f(-(float)fi * (13.287712379549449f / 32.f)); cd = c32 + i; sd = s32 + i; }
    else { const size_t j = i - (size_t)SEQ * 32; pos = (int)(j >> 4); fi = (int)(j & 15); invf = __builtin_amdgcn_exp2f(-(float)fi * (13.287712379549449f / 16.f)); cd = c16 + j; sd = s16 + j; }
    const float ang = (float)pos * invf;
    const double rev = (double)ang * 0.15915494309189535;
    const float fr = (float)(rev - rint(rev));
    *cd = __builtin_amdgcn_cosf(fr); *sd = __builtin_amdgcn_sinf(fr);
  }
}

NI void phase_g1(int l_) {
  const Params& p = kparams(); char* smem = g_smem; const int l = __builtin_amdgcn_readfirstlane(l_); const int tid = otid(), bid = obid(); (void)tid; (void)bid;
  char* ws = p.ws;
  EpiG1 e;
  e.cqkv = (bf16_t*)(ws + OFF_CQKV); e.KA = (bf16_t*)(ws + OFF_KA); e.qB = (bf16_t*)(ws + OFF_QB); e.qC = (bf16_t*)(ws + OFF_QC);
  e.cos32 = (const float*)(ws + OFF_COS32); e.sin32 = (const float*)(ws + OFF_SIN32); e.cos16 = (const float*)(ws + OFF_COS16); e.sin16 = (const float*)(ws + OFF_SIN16);
  e.qs = p.qscaleB; e.pq = (float*)(ws + OFF_PQ); e.pkv = (float*)(ws + OFF_PKV);
  const bf16_t* A = (const bf16_t*)(ws + OFF_XB);
  const bf16_t* Bt = (const bf16_t*)(ws + OFF_W + (size_t)l * LW_SIZE + LW_WIN);
  constexpr int NNT = N_IN_PAD / 256;
  FOR_TILES(NNT, mt, nt, gemm_tile<16>(A, 1024, Bt, 1024, 1024, mt * 256, nt * 256, e, tid, (const float*)(ws + OFF_PX1));)
}
NI void phase_g2(int l_) {
  const Params& p = kparams(); char* smem = g_smem; const int l = __builtin_amdgcn_readfirstlane(l_); const int tid = otid(), bid = obid(); (void)tid; (void)bid;
  char* ws = p.ws;
  const bf16_t* A = (const bf16_t*)(ws + OFF_CQKV);
  EpiUQ eq; eq.QA = (bf16_t*)(ws + OFF_QA); eq.cos16 = (const float*)(ws + OFF_COS16); eq.sin16 = (const float*)(ws + OFF_SIN16); eq.qs = p.qscaleA;
  EpiUKV ek; ek.KA = (bf16_t*)(ws + OFF_KA); ek.VA = (bf16_t*)(ws + OFF_VA);
  const bf16_t* Wq = (const bf16_t*)(ws + OFF_W + (size_t)l * LW_SIZE + LW_WUQ);
  const bf16_t* Wkv = (const bf16_t*)(ws + OFF_W + (size_t)l * LW_SIZE + LW_WUKV);
  FOR_TILES(3, mt, nt, gemm_tile<4>(A, 384, Wq, 256, 256, mt * 256, nt * 256, eq, tid, (const float*)(ws + OFF_PQ));)
  FOR_TILES(3, mt, nt, gemm_tile<2>(A + 256, 384, Wkv, 128, 128, mt * 256, nt * 256, ek, tid, (const float*)(ws + OFF_PKV));)
}
NI void phase_attn(int l_) {
  const Params& p = kparams(); char* smem = g_smem; const int l = __builtin_amdgcn_readfirstlane(l_); const int tid = otid(), bid = obid(); (void)tid; (void)bid;
  char* ws = p.ws;
  constexpr int NA = 1536, NBI = 4608, NC = 1024;
  const int grp = tid >> 8, t256 = tid & 255; char* gsm = smem + grp * ATT_LDS;
  for (int i0 = bid * 2; i0 < NA; i0 += gridDim.x * 2) {
    const int i = i0 + grp, xcd = (i >> 1) & 7, j = ((i >> 4) << 1) | (i & 1);
    const int bh = (j >> 6) * 8 + xcd, qb = j & 63, b = bh / 6, h = bh - b * 6;
    attn_dense_skew((const bf16_t*)(ws + OFF_QA) + (size_t)bh * SEQ * 96, (const bf16_t*)(ws + OFF_KA) + (size_t)bh * SEQ * 96, (const bf16_t*)(ws + OFF_VA) + (size_t)bh * SEQ * 64,
                    qb * 128, (bf16_t*)(ws + OFF_OA) + (size_t)b * SEQ * 384 + h * 64, smem, tid, grp);
  }
  for (int i0 = bid * 2; i0 < NBI; i0 += gridDim.x * 2) {
    AttnItem it{};
    const int i = i0 + grp, xcd = (i >> 1) & 7, j = ((i >> 4) << 1) | (i & 1);
    const int g = (j >> 6) * 8 + xcd, c = j & 63, br = g / 24, bh = g - br * 24, b = bh / 6, h = bh - b * 6;
    const int dil = br == 0 ? 1 : (br == 1 ? 4 : 16), cpr = 64 / dil;
    it.Q = (const bf16_t*)(ws + OFF_QB) + (size_t)bh * SEQ * 64; it.K = (const bf16_t*)(ws + OFF_KB) + (size_t)bh * SEQ * 64; it.V = (const bf16_t*)(ws + OFF_VB) + (size_t)bh * SEQ * 64;
    it.dil = dil; it.res = c / cpr; it.n0 = (c - it.res * cpr) * 128; it.N = SEQ / dil;
    it.out = (bf16_t*)(ws + OFF_OB) + (size_t)br * NTOK * 384 + (size_t)b * SEQ * 384 + h * 64; it.ldo = 384;
    it.lse = (float*)(ws + OFF_LSEB) + (size_t)br * NTOK * 6 + (size_t)b * SEQ * 6 + h;
    attn_block<64, 1>(it, gsm, t256);
  }
  for (int i0 = bid * 2; i0 < NC; i0 += gridDim.x * 2) {
    AttnItem it{};
    const int i = i0 + grp, xcd = (i >> 1) & 7, j = ((i >> 4) << 1) | (i & 1);
    const int bh = (j >> 6) * 8 + xcd, blk = j & 63, b = bh >> 2, h = bh & 3;
    it.Q = (const bf16_t*)(ws + OFF_QC) + (size_t)bh * SEQ * 64; it.K = (const bf16_t*)(ws + OFF_KC) + (size_t)bh * SEQ * 64; it.V = (const bf16_t*)(ws + OFF_VC) + (size_t)bh * SEQ * 64;
    it.nrb = blk >> 2; it.ncb = blk & 3;
    it.kr0 = min(max(8 * it.nrb - 4, 0), 112); it.kc0 = min(max(16 * it.ncb - 8, 0), 32);
    it.out = (bf16_t*)(ws + OFF_OC) + (size_t)b * SEQ * 256 + h * 64; it.ldo = 256;
    it.rpb = p.rpb + ((size_t)l * 4 + h) * 465;
    attn_block<64, 2>(it, gsm, t256);
  }
}
NI void phase_mix() {
  const Params& p = kparams(); const int tid = otid(), bid = obid();
  char* ws = p.ws;
  const int lane = tid & 63, gw = bid * (NTHR / 64) + (tid >> 6), nw = gridDim.x * (NTHR / 64);
  const bf16_t* oA = (const bf16_t*)(ws + OFF_OA); const bf16_t* oB = (const bf16_t*)(ws + OFF_OB); const bf16_t* oC = (const bf16_t*)(ws + OFF_OC);
  const float* lse = (const float*)(ws + OFF_LSEB);
  bf16_t* mixed = (bf16_t*)(ws + OFF_MIXED);
  for (int tok = gw; tok < NTOK; tok += nw) {
    float v[16];
    if (lane < 24 || lane >= 48) {
      const bf16_t* src = lane < 24 ? oA + (size_t)tok * 384 + lane * 16 : oC + (size_t)tok * 256 + (lane - 48) * 16;
      const u32x4 a = *(const u32x4*)src, b = *(const u32x4*)(src + 8);
#pragma unroll
      for (int j = 0; j < 4; ++j) { v[2 * j] = bf2f(a[j] & 0xffffu); v[2 * j + 1] = bf2f(a[j] >> 16); v[8 + 2 * j] = bf2f(b[j] & 0xffffu); v[8 + 2 * j + 1] = bf2f(b[j] >> 16); }
    } else {
      const int col = (lane - 24) * 16, hd = col >> 6;
      const float l0 = lse[(size_t)tok * 6 + hd], l1 = lse[(size_t)NTOK * 6 + (size_t)tok * 6 + hd], l2 = lse[(size_t)2 * NTOK * 6 + (size_t)tok * 6 + hd];
      const float mx = fmaxf(l0, fmaxf(l1, l2));
      float w0 = __builtin_amdgcn_exp2f(l0 - mx), w1 = __builtin_amdgcn_exp2f(l1 - mx), w2 = __builtin_amdgcn_exp2f(l2 - mx);
      const float wi = 1.f / (w0 + w1 + w2); w0 *= wi; w1 *= wi; w2 *= wi;
#pragma unroll
      for (int j = 0; j < 16; ++j) v[j] = 0.f;
#pragma unroll
      for (int br = 0; br < 3; ++br) {
        const float wb = br == 0 ? w0 : (br == 1 ? w1 : w2);
        const bf16_t* src = oB + (size_t)br * NTOK * 384 + (size_t)tok * 384 + col;
        const u32x4 a = *(const u32x4*)src, b = *(const u32x4*)(src + 8);
#pragma unroll
        for (int j = 0; j < 4; ++j) { v[2 * j] += wb * bf2f(a[j] & 0xffffu); v[2 * j + 1] += wb * bf2f(a[j] >> 16); v[8 + 2 * j] += wb * bf2f(b[j] & 0xffffu); v[8 + 2 * j + 1] += wb * bf2f(b[j] >> 16); }
      }
    }
    float ss = 0.f;
#pragma unroll
    for (int j = 0; j < 16; ++j) ss += v[j] * v[j];
    const float sa = wave_sum(lane < 24 ? ss : 0.f), sb = wave_sum((lane >= 24 && lane < 48) ? ss : 0.f), sc = wave_sum(lane >= 48 ? ss : 0.f);
    const float rs = lane < 24 ? rsqrtf(sa * (1.f / 384.f) + 1e-6f) : (lane < 48 ? rsqrtf(sb * (1.f / 384.f) + 1e-6f) : rsqrtf(sc * (1.f / 256.f) + 1e-6f));
    u32x4 oa, ob;
#pragma unroll
    for (int j = 0; j < 4; ++j) { oa[j] = cvtpk(v[2 * j] * rs, v[2 * j + 1] * rs); ob[j] = cvtpk(v[8 + 2 * j] * rs, v[8 + 2 * j + 1] * rs); }
    bf16_t* dst = mixed + (size_t)tok * 1024 + lane * 16;
    *(u32x4*)dst = oa; *(u32x4*)(dst + 8) = ob;
  }
}
NI void phase_wout(int l_) {
  const Params& p = kparams(); char* smem = g_smem; const int l = __builtin_amdgcn_readfirstlane(l_); const int tid = otid(), bid = obid(); (void)tid; (void)bid;
  char* ws = p.ws;
  EpiRes e; e.xb = (bf16_t*)(ws + OFF_XB); e.pout = (float*)(ws + OFF_PX2);
  const bf16_t* A = (const bf16_t*)(ws + OFF_MIXED);
  const bf16_t* Bt = (const bf16_t*)(ws + OFF_W + (size_t)l * LW_SIZE + LW_WOUT);
  FOR_TILES(4, mt, nt, gemm_tile<0>(A, 1024, Bt, 1024, 1024, mt * 256, nt * 256, e, tid, nullptr);)
}
NI void phase_mlp1(int l_) {
  const Params& p = kparams(); char* smem = g_smem; const int l = __builtin_amdgcn_readfirstlane(l_); const int tid = otid(), bid = obid(); (void)tid; (void)bid;
  char* ws = p.ws;
  EpiMlp1 e; e.hid = (bf16_t*)(ws + OFF_HID);
  const bf16_t* A = (const bf16_t*)(ws + OFF_XB);
  const bf16_t* Bt = (const bf16_t*)(ws + OFF_W + (size_t)l * LW_SIZE + LW_W1);
  FOR_TILES(16, mt, nt, gemm_tile<16>(A, 1024, Bt, 1024, 1024, mt * 256, nt * 256, e, tid, (const float*)(ws + OFF_PX2));)
}
NI void phase_mlp2(int l_) {
  const Params& p = kparams(); char* smem = g_smem; const int l = __builtin_amdgcn_readfirstlane(l_); const int tid = otid(), bid = obid(); (void)tid; (void)bid;
  char* ws = p.ws;
  EpiRes e; e.xb = (bf16_t*)(ws + OFF_XB); e.pout = (float*)(ws + OFF_PX1);
  const bf16_t* A = (const bf16_t*)(ws + OFF_HID);
  const bf16_t* Bt = (const bf16_t*)(ws + OFF_W + (size_t)l * LW_SIZE + LW_W2);
  FOR_TILES(4, mt, nt, gemm_tile<0>(A, DFF, Bt, DFF, DFF, mt * 256, nt * 256, e, tid, nullptr);)
}
NI void phase_final() {
  const Params& p = kparams(); const int tid = otid(), bid = obid();
  const int lane = tid & 63, gw = bid * (NTHR / 64) + (tid >> 6), nw = gridDim.x * (NTHR / 64);
  const bf16_t* xb = (const bf16_t*)(p.ws + OFF_XB);
  for (int tok = gw; tok < NTOK; tok += nw) {
    float* row = p.out + (size_t)tok * DM;
    f32x4 v[4]; float ss = 0.f;
#pragma unroll
    for (int j = 0; j < 4; ++j) {
      const u32x2 r = *(const u32x2*)(xb + (size_t)tok * DM + j * 256 + lane * 4);
      v[j] = f32x4{bf2f(r[0] & 0xffffu), bf2f(r[0] >> 16), bf2f(r[1] & 0xffffu), bf2f(r[1] >> 16)};
      ss += v[j][0] * v[j][0] + v[j][1] * v[j][1] + v[j][2] * v[j][2] + v[j][3] * v[j][3];
    }
    ss = wave_sum(ss);
    const float rs = rsqrtf(ss * (1.f / 1024.f) + 1e-6f);
#pragma unroll
    for (int j = 0; j < 4; ++j) { const f32x4 g = *(const f32x4*)(p.g_final + j * 256 + lane * 4); f32x4 o = {v[j][0] * rs * g[0], v[j][1] * rs * g[1], v[j][2] * rs * g[2], v[j][3] * rs * g[3]}; *(f32x4*)(row + j * 256 + lane * 4) = o; }
  }
}

constexpr int NPHASE = 2 + 7 * NLAYER;
DI void run_phase(int ph) {
  if (ph == 0) { phase_prep(); return; }
  if (ph == NPHASE - 1) { phase_final(); return; }
  const int l = (ph - 1) / 7, st = (ph - 1) - l * 7;
  switch (st) {
    case 0: phase_g1(l); break;
    case 1: phase_g2(l); break;
    case 2: phase_attn(l); break;
    case 3: phase_mix(); break;
    case 4: phase_wout(l); break;
    case 5: phase_mlp1(l); break;
    default: phase_mlp2(l); break;
  }
}

__global__ void __launch_bounds__(512) mega(Params p, int ph_lo, int ph_hi) {
  cg::grid_group grid = cg::this_grid();
  for (int ph = ph_lo; ph < ph_hi; ++ph) {
    run_phase(ph);
    if (ph + 1 < ph_hi) grid.sync();
  }
}

extern "C" void kernel_launch(void* const* d_in, const int* in_sizes, int n_in, void* d_out, int out_size, void* d_ws, size_t ws_size, hipStream_t stream) {
  static int grid_blocks = 0;
  if (!grid_blocks) {
    int dev = 0, cus = 0, per_cu = 0;
    (void)hipGetDevice(&dev);
    (void)hipDeviceGetAttribute(&cus, hipDeviceAttributeMultiprocessorCount, dev);
    (void)hipOccupancyMaxActiveBlocksPerMultiprocessor(&per_cu, mega, NTHR, 0);
    if (per_cu > 1) per_cu = 1;
    grid_blocks = cus * per_cu;
    if (ws_size < OFF_END) fprintf(stderr, "kernel_launch: workspace too small: %zu < %zu\n", ws_size, (size_t)OFF_END);
  }
  Params p;
  memset(&p, 0, sizeof(p));
  p.x = (const float*)d_in[0]; p.g_mix = (const float*)d_in[1]; p.w_in = (const float*)d_in[2]; p.q_norm = (const float*)d_in[3];
  p.w_uq = (const float*)d_in[4]; p.kv_norm = (const float*)d_in[5]; p.w_ukv = (const float*)d_in[6]; p.rpb = (const float*)d_in[7];
  p.on_a = (const float*)d_in[8]; p.on_b = (const float*)d_in[9]; p.on_c = (const float*)d_in[10]; p.w_out = (const float*)d_in[11];
  p.g_mlp = (const float*)d_in[12]; p.w_mlp_in = (const float*)d_in[13]; p.w_mlp_out = (const float*)d_in[14]; p.g_final = (const float*)d_in[15];
  p.out = (float*)d_out; p.ws = (char*)d_ws;
  p.qscaleA = (float)(1.4426950408889634 / std::sqrt(96.0));
  p.qscaleB = (float)(1.4426950408889634 * 0.125);
#if ONE_LAUNCH
  int lo = 0, hi = NPHASE;
  void* args[] = {&p, &lo, &hi};
  hipError_t e = hipLaunchCooperativeKernel((void*)mega, dim3(grid_blocks), dim3(NTHR), args, 0, stream);
  if (e != hipSuccess) fprintf(stderr, "cooperative launch failed: %s (grid %d)\n", hipGetErrorString(e), grid_blocks);
#else
  for (int ph = 0; ph < NPHASE; ++ph) hipLaunchKernelGGL(mega, dim3(grid_blocks), dim3(NTHR), 0, stream, p, ph, ph + 1);
#endif
}
```

```cpp
#include <hip/hip_runtime.h>
#include <hip/hip_cooperative_groups.h>
#include <cstdio>
#include <cmath>
#include <cstring>
namespace cg = cooperative_groups;

#ifndef ONE_LAUNCH
#define ONE_LAUNCH 1
#endif

#define DI __device__ __forceinline__
typedef unsigned short bf16_t;
typedef short bf16x8 __attribute__((ext_vector_type(8)));
typedef short s16x4 __attribute__((ext_vector_type(4)));
typedef float f32x16 __attribute__((ext_vector_type(16)));
typedef float f32x2 __attribute__((ext_vector_type(2)));
typedef float f32x4 __attribute__((ext_vector_type(4)));
typedef __bf16 bf2_t __attribute__((ext_vector_type(2)));
typedef unsigned u32x4 __attribute__((ext_vector_type(4)));
typedef unsigned u32x2 __attribute__((ext_vector_type(2)));
typedef __attribute__((address_space(3))) s16x4 lds_s16x4;

constexpr int SEQ = 8192, NB = 4, NTOK = NB * SEQ, DM = 1024, NLAYER = 4;
constexpr int N_IN_PAD = 2560, N_UQ_PAD = 768, N_UKV = 768, DFF = 4096;
constexpr int NTHR = 512;

constexpr size_t SZ_XB = (size_t)NTOK * DM * 2;
constexpr size_t SZ_WIN = (size_t)N_IN_PAD * 1024 * 2, SZ_WUQ = (size_t)N_UQ_PAD * 256 * 2, SZ_WUKV = (size_t)N_UKV * 128 * 2,
                 SZ_WOUT = (size_t)1024 * 1024 * 2, SZ_W1 = (size_t)DFF * 1024 * 2, SZ_W2 = (size_t)1024 * DFF * 2;
constexpr size_t LW_WIN = 0, LW_WUQ = LW_WIN + SZ_WIN, LW_WUKV = LW_WUQ + SZ_WUQ, LW_WOUT = LW_WUKV + SZ_WUKV, LW_W1 = LW_WOUT + SZ_WOUT,
                 LW_W2 = LW_W1 + SZ_W1, LW_SIZE = LW_W2 + SZ_W2;
constexpr size_t OFF_XB = 0, OFF_W = OFF_XB + SZ_XB, OFF_TAB = OFF_W + NLAYER * LW_SIZE;
constexpr size_t OFF_COS32 = OFF_TAB, OFF_SIN32 = OFF_COS32 + (size_t)SEQ * 32 * 4, OFF_COS16 = OFF_SIN32 + (size_t)SEQ * 32 * 4,
                 OFF_SIN16 = OFF_COS16 + (size_t)SEQ * 16 * 4, OFF_ATT = OFF_SIN16 + (size_t)SEQ * 16 * 4;
constexpr size_t SZ_T384 = (size_t)NTOK * 384 * 2, SZ_QA = (size_t)NB * 6 * SEQ * 96 * 2, SZ_H6 = (size_t)NB * 6 * SEQ * 64 * 2,
                 SZ_H4 = (size_t)NB * 4 * SEQ * 64 * 2;
constexpr size_t OFF_CQKV = OFF_ATT;
constexpr size_t OFF_OA = OFF_CQKV;
constexpr size_t OFF_QA = OFF_CQKV + SZ_T384, OFF_KA = OFF_QA + SZ_QA, OFF_VA = OFF_KA + SZ_QA;
constexpr size_t OFF_QB = OFF_VA + SZ_H6, OFF_KB = OFF_QB + SZ_H6, OFF_VB = OFF_KB + SZ_H6;
constexpr size_t OFF_QC = OFF_VB + SZ_H6, OFF_KC = OFF_QC + SZ_H4, OFF_VC = OFF_KC + SZ_H4;
constexpr size_t OFF_OB = OFF_VC + SZ_H4, OFF_LSEB = OFF_OB + 3 * SZ_T384, OFF_OC = OFF_LSEB + (size_t)3 * NTOK * 6 * 4;
constexpr size_t OFF_SSQ = OFF_OC + (size_t)NTOK * 256 * 2;
constexpr size_t OFF_PX1 = OFF_SSQ, OFF_PX2 = OFF_PX1 + (size_t)NTOK * 16 * 4, OFF_PQ = OFF_PX2 + (size_t)NTOK * 16 * 4, OFF_PKV = OFF_PQ + (size_t)NTOK * 4 * 4;
constexpr size_t OFF_END = OFF_PKV + (size_t)NTOK * 2 * 4;
constexpr size_t OFF_MIXED = OFF_QA;
constexpr size_t OFF_HID = OFF_ATT;
static_assert(OFF_HID + (size_t)NTOK * DFF * 2 <= OFF_SSQ, "hid fits");
static_assert(OFF_MIXED + (size_t)NTOK * DM * 2 <= OFF_VA, "mixed fits");

struct Params {
  const float *x, *g_mix, *w_in, *q_norm, *w_uq, *kv_norm, *w_ukv, *rpb, *on_a, *on_b, *on_c, *w_out, *g_mlp, *w_mlp_in, *w_mlp_out, *g_final;
  float* out; char* ws;
  float qscaleA, qscaleB;
};
__shared__ __attribute__((aligned(1024))) char g_smem[131072];
#define NI __device__ __forceinline__
DI const Params& kparams() { return *(const Params*)__builtin_amdgcn_kernarg_segment_ptr(); }

DI unsigned cvtpk(float lo, float hi) { f32x2 v = {lo, hi}; bf2_t b = __builtin_convertvector(v, bf2_t); return __builtin_bit_cast(unsigned, b); }
DI bf16_t f2bf(float x) { return (bf16_t)(cvtpk(x, 0.f) & 0xffffu); }
DI float bf2f(unsigned h) { return __uint_as_float(h << 16); }
DI int crow(int i, int h) { return (i & 3) + 8 * (i >> 2) + 4 * h; }
#define MFMA32(a, b, c) __builtin_amdgcn_mfma_f32_32x32x16_bf16((a), (b), (c), 0, 0, 0)
DI float fdot2bf(unsigned a, float c) { bf2_t v = __builtin_bit_cast(bf2_t, a); return __builtin_amdgcn_fdot2_f32_bf16(v, v, c, false); }
DI float swap_max(float v) { auto rr = __builtin_amdgcn_permlane32_swap(__float_as_uint(v), __float_as_uint(v), false, false); return fmaxf(__uint_as_float(rr[0]), __uint_as_float(rr[1])); }
DI float swap_sum(float v) { auto rr = __builtin_amdgcn_permlane32_swap(__float_as_uint(v), __float_as_uint(v), false, false); return __uint_as_float(rr[0]) + __uint_as_float(rr[1]); }

constexpr int ATT_LDS = 53248;
#define FOR_TILES(NN, MT, NT, BODY) { const bool xm_ = gridDim.x == 256; const int st_ = xm_ ? (bid >> 3) : bid, sp_ = xm_ ? 32 : (int)gridDim.x, cn_ = xm_ ? 16 * (NN) : (NTOK / 256) * (NN); \
  for (int j_ = st_; j_ < cn_; j_ += sp_) { int MT = j_ / (NN); const int NT = j_ - MT * (NN); if (xm_) MT += (bid & 7) * 16; BODY } }
DI int otid() { int t = threadIdx.x; asm volatile("" : "+v"(t)); return t; }
DI int obid() { int t = blockIdx.x; asm volatile("" : "+s"(t)); return t; }

template <int NSLOT, class Epi>
DI void gemm_tile(const bf16_t* __restrict__ A, int lda, const bf16_t* __restrict__ Bt, int ldb, int K, int m0, int n0, const Epi& epi, const int tid, const float* pin) {
  const int lane = tid & 63, w = tid >> 6, wm = w >> 2, wn = w & 3, r32 = lane & 31, hi = lane >> 5;
  char* smem = g_smem;
  const int lrow = lane >> 3;
  const int c0 = (lane & 7) ^ (lane >> 4), c1 = (lane & 7) ^ ((lane >> 4) | 4);
  const char* Ab = (const char*)(A + (size_t)m0 * lda);
  const char* Bb = (const char*)(Bt + (size_t)n0 * ldb);
  const unsigned oa0 = (unsigned)(((w * 32 + lrow) * lda + c0 * 8) * 2), oa1 = (unsigned)(((w * 32 + lrow) * lda + c1 * 8) * 2);
  const unsigned ob0 = (unsigned)(((w * 32 + lrow) * ldb + c0 * 8) * 2), ob1 = (unsigned)(((w * 32 + lrow) * ldb + c1 * 8) * 2);
  const int dma_off = (w * 32) * 128 + lane * 16;
  f32x16 acc[4][2];
#pragma unroll
  for (int mi = 0; mi < 4; ++mi)
#pragma unroll
    for (int nj = 0; nj < 2; ++nj)
#pragma unroll
      for (int i = 0; i < 16; ++i) acc[mi][nj][i] = 0.f;
  const int nk = K >> 6;
  const int sw = (r32 >> 1) & 7, sh = sw >> 1, lo16 = 16 * (hi ^ (sw & 1));
  const int a_off = (wm * 128 + r32) * 128 + lo16;
  const int b_off = 32768 + (wn * 64 + r32) * 128 + lo16;
  __syncthreads();
  {
    char* sa = smem + dma_off;
#pragma unroll
    for (int j = 0; j < 4; ++j) {
      __builtin_amdgcn_global_load_lds((const unsigned*)(Ab + (size_t)(j * 8 * lda) * 2 + ((j & 1) ? oa1 : oa0)), (unsigned*)(sa + j * 1024), 16, 0, 0);
      __builtin_amdgcn_global_load_lds((const unsigned*)(Bb + (size_t)(j * 8 * ldb) * 2 + ((j & 1) ? ob1 : ob0)), (unsigned*)(sa + 32768 + j * 1024), 16, 0, 0);
    }
  }
  for (int kt = 0; kt < nk; ++kt) {
    __syncthreads();
    if (kt + 1 < nk) {
      char* sa = smem + ((kt + 1) & 1) * 65536 + dma_off;
      const int k0 = (kt + 1) * 64;
#pragma unroll
      for (int j = 0; j < 4; ++j) {
        __builtin_amdgcn_global_load_lds((const unsigned*)(Ab + (size_t)(j * 8 * lda + k0) * 2 + ((j & 1) ? oa1 : oa0)), (unsigned*)(sa + j * 1024), 16, 0, 0);
        __builtin_amdgcn_global_load_lds((const unsigned*)(Bb + (size_t)(j * 8 * ldb + k0) * 2 + ((j & 1) ? ob1 : ob0)), (unsigned*)(sa + 32768 + j * 1024), 16, 0, 0);
      }
    }
    const char* sb = smem + (kt & 1) * 65536;
#pragma unroll
    for (int ks = 0; ks < 4; ++ks) {
      const int koff = 32 * (ks ^ sh);
      bf16x8 af[4], bfr[2];
#pragma unroll
      for (int mi = 0; mi < 4; ++mi) af[mi] = *(const bf16x8*)(sb + a_off + mi * 4096 + koff);
#pragma unroll
      for (int nj = 0; nj < 2; ++nj) bfr[nj] = *(const bf16x8*)(sb + b_off + nj * 4096 + koff);
#pragma unroll
      for (int mi = 0; mi < 4; ++mi)
#pragma unroll
        for (int nj = 0; nj < 2; ++nj) acc[mi][nj] = MFMA32(af[mi], bfr[nj], acc[mi][nj]);
    }
  }
  float* rstd_s = (float*)smem;
  if (NSLOT > 0) {
    __syncthreads();
    if (tid < 256) {
      const float* pr = pin + (size_t)(m0 + tid) * NSLOT;
      float sacc = 0.f;
      if (NSLOT >= 4) {
#pragma unroll
        for (int q = 0; q < NSLOT / 4; ++q) { const f32x4 v = *(const f32x4*)(pr + 4 * q); sacc += (v[0] + v[1]) + (v[2] + v[3]); }
      } else {
#pragma unroll
        for (int q = 0; q < NSLOT; ++q) sacc += pr[q];
      }
      rstd_s[tid] = rsqrtf(sacc / (float)K + 1e-6f);
    }
    __syncthreads();
  }
  int lane2 = lane, w2 = w; asm volatile("" : "+v"(lane2), "+v"(w2));
  epi(acc, m0, (w2 >> 2) * 128, n0 + (w2 & 3) * 64, lane2, rstd_s);
}
DI void row_ssq_put(float v, float* dst, int lane) {
  v += __shfl_xor(v, 1); v += __shfl_xor(v, 2); v += __shfl_xor(v, 4); v += __shfl_xor(v, 8); v += __shfl_xor(v, 16);
  if ((lane & 31) == 0) *dst = v;
}

struct EpiG1 {
  bf16_t *cqkv, *KA, *qB, *qC; const float *cos32, *sin32, *cos16, *sin16; float qs; float *pq, *pkv;
  DI void operator()(f32x16 (&acc)[4][2], int m0, int lr0, int col0, int lane, const float* rstd_s) const {
    const int c = lane & 31, h = lane >> 5, cb = col0 >> 6;
    if (cb >= 37) return;
#define G1_ROW const int lr = lr0 + mi * 32 + crow(i, h), tok = m0 + lr, b = tok >> 13, s = tok & 8191; (void)b; (void)s; \
               const float rs = rstd_s[lr]; float v0 = acc[mi][0][i] * rs, v1 = acc[mi][1][i] * rs;
    if (cb < 6) {
#pragma unroll
      for (int mi = 0; mi < 4; ++mi)
#pragma unroll
        for (int i = 0; i < 16; ++i) {
        if ((i & 3) == 0) __builtin_amdgcn_sched_barrier(0);
          G1_ROW
          bf16_t* d = cqkv + (size_t)tok * 384 + cb * 64 + c; d[0] = f2bf(v0); d[32] = f2bf(v1);
          row_ssq_put(v0 * v0 + v1 * v1, cb < 4 ? pq + (size_t)tok * 4 + cb : pkv + (size_t)tok * 2 + (cb - 4), lane);
        }
    } else if (cb == 6) {
#pragma unroll
      for (int mi = 0; mi < 4; ++mi)
#pragma unroll
        for (int i = 0; i < 16; ++i) {
        if ((i & 3) == 0) __builtin_amdgcn_sched_barrier(0);
          G1_ROW
          if (c < 16) {
            const float cs = cos16[s * 16 + c], sn = sin16[s * 16 + c];
            const bf16_t o1 = f2bf(v0 * cs - v1 * sn), o2 = f2bf(v0 * sn + v1 * cs);
#pragma unroll
            for (int hd = 0; hd < 6; ++hd) { bf16_t* d = KA + ((size_t)(b * 6 + hd) * SEQ + s) * 96 + 64 + c; d[0] = o1; d[16] = o2; }
          }
        }
    } else if (cb < 25) {
      const int idx = cb - 7, which = idx / 6, hd = idx - which * 6;
      bf16_t* base = qB + (size_t)which * (SZ_H6 / 2) + (size_t)hd * SEQ * 64 + c;
      const float sc = which == 0 ? qs : 1.f;
      if (which < 2) {
#pragma unroll
        for (int mi = 0; mi < 4; ++mi)
#pragma unroll
          for (int i = 0; i < 16; ++i) {
        if ((i & 3) == 0) __builtin_amdgcn_sched_barrier(0);
            G1_ROW
            const float cs = cos32[s * 32 + c] * sc, sn = sin32[s * 32 + c] * sc;
            bf16_t* d = base + ((size_t)(b * 6) * SEQ + s) * 64;
            d[0] = f2bf(v0 * cs - v1 * sn); d[32] = f2bf(v0 * sn + v1 * cs);
          }
      } else {
#pragma unroll
        for (int mi = 0; mi < 4; ++mi)
#pragma unroll
          for (int i = 0; i < 16; ++i) {
        if ((i & 3) == 0) __builtin_amdgcn_sched_barrier(0);
            G1_ROW
            bf16_t* d = base + ((size_t)(b * 6) * SEQ + s) * 64;
            d[0] = f2bf(v0); d[32] = f2bf(v1);
          }
      }
    } else {
      const int idx = cb - 25, which = idx >> 2, hd = idx & 3;
      bf16_t* base = qC + (size_t)which * (SZ_H4 / 2) + (size_t)hd * SEQ * 64 + c;
      const float sc = which == 0 ? qs : 1.f;
#pragma unroll
      for (int mi = 0; mi < 4; ++mi)
#pragma unroll
        for (int i = 0; i < 16; ++i) {
        if ((i & 3) == 0) __builtin_amdgcn_sched_barrier(0);
          G1_ROW
          bf16_t* d = base + ((size_t)(b * 4) * SEQ + s) * 64;
          d[0] = f2bf(v0 * sc); d[32] = f2bf(v1 * sc);
        }
    }
#undef G1_ROW
  }
};
struct EpiUQ {
  bf16_t* QA; const float *cos16, *sin16; float qs;
  DI void operator()(f32x16 (&acc)[4][2], int m0, int lr0, int col0, int lane, const float* rstd_s) const {
    const int c = lane & 31, h = lane >> 5, cb = col0 >> 6;
    if (cb >= 9) return;
#pragma unroll
    for (int mi = 0; mi < 4; ++mi)
#pragma unroll
      for (int i = 0; i < 16; ++i) {
        if ((i & 3) == 0) __builtin_amdgcn_sched_barrier(0);
        const int lr = lr0 + mi * 32 + crow(i, h), tok = m0 + lr, b = tok >> 13, s = tok & 8191;
        const float rs = rstd_s[lr] * qs;
        const float v0 = acc[mi][0][i] * rs, v1 = acc[mi][1][i] * rs;
        if (cb < 6) {
          bf16_t* d = QA + ((size_t)(b * 6 + cb) * SEQ + s) * 96 + c; d[0] = f2bf(v0); d[32] = f2bf(v1);
        } else {
          const int hd = 2 * (cb - 6) + (c >> 4), fi = c & 15;
          const float cs = cos16[s * 16 + fi], sn = sin16[s * 16 + fi];
          bf16_t* d = QA + ((size_t)(b * 6 + hd) * SEQ + s) * 96 + 64 + fi;
          d[0] = f2bf(v0 * cs - v1 * sn); d[16] = f2bf(v0 * sn + v1 * cs);
        }
      }
  }
};
struct EpiUKV {
  bf16_t *KA, *VA;
  DI void operator()(f32x16 (&acc)[4][2], int m0, int lr0, int col0, int lane, const float* rstd_s) const {
    const int c = lane & 31, h = lane >> 5, cb = col0 >> 6, hd = cb >> 1, isv = cb & 1;
#pragma unroll
    for (int mi = 0; mi < 4; ++mi)
#pragma unroll
      for (int i = 0; i < 16; ++i) {
        if ((i & 3) == 0) __builtin_amdgcn_sched_barrier(0);
        const int lr = lr0 + mi * 32 + crow(i, h), tok = m0 + lr, b = tok >> 13, s = tok & 8191;
        const float rs = rstd_s[lr];
        const float v0 = acc[mi][0][i] * rs, v1 = acc[mi][1][i] * rs;
        bf16_t* d = isv ? VA + ((size_t)(b * 6 + hd) * SEQ + s) * 64 + c : KA + ((size_t)(b * 6 + hd) * SEQ + s) * 96 + c;
        d[0] = f2bf(v0); d[32] = f2bf(v1);
      }
  }
};
struct EpiRes {
  bf16_t* xb; float* pout;
  DI void operator()(f32x16 (&acc)[4][2], int m0, int lr0, int col0, int lane, const float* rstd_s) const {
    const int c = lane & 31, h = lane >> 5;
#pragma unroll
    for (int mi = 0; mi < 4; ++mi)
#pragma unroll
      for (int i = 0; i < 16; ++i) {
        if ((i & 3) == 0) __builtin_amdgcn_sched_barrier(0);
        const int row = m0 + lr0 + mi * 32 + crow(i, h);
        const size_t o = (size_t)row * DM + col0 + c;
        const float v0 = bf2f(xb[o]) + acc[mi][0][i], v1 = bf2f(xb[o + 32]) + acc[mi][1][i];
        xb[o] = f2bf(v0); xb[o + 32] = f2bf(v1);
        row_ssq_put(v0 * v0 + v1 * v1, pout + (size_t)row * 16 + (col0 >> 6), lane);
      }
  }
};
struct EpiMlp1 {
  bf16_t* hid;
  DI void operator()(f32x16 (&acc)[4][2], int m0, int lr0, int col0, int lane, const float* rstd_s) const {
    const int c = lane & 31, h = lane >> 5;
#pragma unroll
    for (int mi = 0; mi < 4; ++mi)
#pragma unroll
      for (int i = 0; i < 16; ++i) {
        if ((i & 3) == 0) __builtin_amdgcn_sched_barrier(0);
        const int lr = lr0 + mi * 32 + crow(i, h);
        const float rs = rstd_s[lr];
        const float v0 = fmaxf(acc[mi][0][i] * rs, 0.f), v1 = fmaxf(acc[mi][1][i] * rs, 0.f);
        *(unsigned*)(hid + (size_t)(m0 + lr) * DFF + col0 + 2 * c) = cvtpk(v0 * v0, v1 * v1);
      }
  }
};

struct AttnItem {
  const bf16_t *Q, *K, *V;
  int q0;
  int n0, dil, res, N;
  int nrb, ncb, kr0, kc0;
  bf16_t* out; int ldo;
  float* lse;
  const float* rpb;
};

template <int DQ, int MODE>
DI void attn_block(const AttnItem& it, char* smem, const int tid) {
  constexpr int CPR = DQ / 8, KST = DQ * 2 + 16, KCH = (64 * CPR) / 256, NT = MODE == 0 ? SEQ / 64 : MODE == 1 ? 4 : 8;
  const int lane = tid & 63, w = tid >> 6, r32 = lane & 31, hi = lane >> 5;
  char* Ks = smem; char* Vs = smem + 64 * KST; float* bias_s = (float*)(smem + 64 * KST + 8192);
  const int qi = w * 32 + r32;
  int qpos;
  if (MODE == 0) qpos = it.q0 + qi;
  else if (MODE == 1) qpos = (it.n0 + qi) * it.dil + it.res;
  else qpos = (8 * it.nrb + (qi >> 4)) * 64 + 16 * it.ncb + (qi & 15);
  __syncthreads();
  if (MODE == 2) { for (int i = tid; i < 465; i += 256) bias_s[i] = it.rpb[i] * 1.4426950408889634f; }
  bf16x8 qr[DQ / 16];
#pragma unroll
  for (int d0 = 0; d0 < DQ / 16; ++d0) qr[d0] = *(const bf16x8*)(it.Q + (size_t)qpos * DQ + d0 * 16 + hi * 8);
  f32x16 o[2];
#pragma unroll
  for (int i = 0; i < 16; ++i) { o[0][i] = 0.f; o[1][i] = 0.f; }
  float m_run = -1e30f, l_run = 0.f;
  u32x4 rk[KCH], rv[2];
  auto kpos = [&](int t, int row) -> int {
    if (MODE == 0) return t * 64 + row;
    if (MODE == 1) { int n = it.n0 - 64 + 64 * t + row; n = n < 0 ? 0 : (n > it.N - 1 ? it.N - 1 : n); return n * it.dil + it.res; }
    return (it.kr0 + 2 * t + (row >> 5)) * 64 + it.kc0 + (row & 31);
  };
  auto load = [&](int t) {
#pragma unroll
    for (int i = 0; i < KCH; ++i) { const int c = tid + 256 * i, row = c / CPR, kc = c - row * CPR; rk[i] = *(const u32x4*)(it.K + (size_t)kpos(t, row) * DQ + kc * 8); }
#pragma unroll
    for (int i = 0; i < 2; ++i) { const int c = tid + 256 * i, row = c >> 3, kc = c & 7; rv[i] = *(const u32x4*)(it.V + (size_t)kpos(t, row) * 64 + kc * 8); }
  };
  const int vrd = ((lane >> 5) * 4 + ((lane & 15) >> 2)) * 64 + ((lane >> 4) & 1) * 32 + (lane & 3) * 8;
  load(0);
  for (int t = 0; t < NT; ++t) {
    __syncthreads();
#pragma unroll
    for (int i = 0; i < KCH; ++i) { const int c = tid + 256 * i, row = c / CPR, kc = c - row * CPR; *(u32x4*)(Ks + row * KST + kc * 16) = rk[i]; }
#pragma unroll
    for (int i = 0; i < 2; ++i) { const int c = tid + 256 * i, row = c >> 3, kc = c & 7; *(u32x4*)(Vs + (kc >> 2) * 4096 + row * 64 + (kc & 3) * 16) = rv[i]; }
    __syncthreads();
    if (t + 1 < NT) load(t + 1);
    bool skip = false;
    if (MODE == 1) skip = (w < 2) ? (t == 3) : (t == 0);
    if (MODE == 2) {
      const int rq_lo = 8 * it.nrb + 2 * w, rq_hi = rq_lo + 1;
      const int rs_lo = min(max(rq_lo - 4, 0), 120), rs_hi = min(max(rq_hi - 4, 0), 120) + 7;
      const int kr = it.kr0 + 2 * t;
      skip = (kr + 1 < rs_lo) || (kr > rs_hi);
    }
    if (skip) continue;
    f32x16 p0, p1;
#pragma unroll
    for (int i = 0; i < 16; ++i) { p0[i] = 0.f; p1[i] = 0.f; }
#pragma unroll
    for (int d0 = 0; d0 < DQ / 16; ++d0) {
      const bf16x8 k0 = *(const bf16x8*)(Ks + r32 * KST + d0 * 32 + hi * 16);
      const bf16x8 k1 = *(const bf16x8*)(Ks + (32 + r32) * KST + d0 * 32 + hi * 16);
      p0 = MFMA32(k0, qr[d0], p0); p1 = MFMA32(k1, qr[d0], p1);
    }
    if (MODE == 1) {
      const int nq = it.n0 + qi, kb = it.n0 - 64 + 64 * t;
#pragma unroll
      for (int i = 0; i < 16; ++i) {
        const int nk = kb + crow(i, hi), nk2 = nk + 32;
        const int d1 = nq - nk, d2 = nq - nk2;
        const bool ok1 = (d1 <= 64) && (d1 >= -64) && (nk >= 0) && (nk < it.N);
        const bool ok2 = (d2 <= 64) && (d2 >= -64) && (nk2 >= 0) && (nk2 < it.N);
        p0[i] = ok1 ? p0[i] : -INFINITY; p1[i] = ok2 ? p1[i] : -INFINITY;
      }
    }
    if (MODE == 2) {
      const int rq = 8 * it.nrb + (qi >> 4), cq = 16 * it.ncb + (qi & 15);
      const int rs_ = min(max(rq - 4, 0), 120), cs_ = min(max(cq - 8, 0), 48);
      const int kr = it.kr0 + 2 * t;
      const bool okr0 = (kr >= rs_) && (kr < rs_ + 8), okr1 = (kr + 1 >= rs_) && (kr + 1 < rs_ + 8);
      const int bi0 = (kr - rq + 7) * 31 - cq + 15;
#pragma unroll
      for (int i = 0; i < 16; ++i) {
        const int kc = it.kc0 + crow(i, hi);
        const bool okc = (kc >= cs_) && (kc < cs_ + 16);
        const bool ok0 = okc && okr0, ok1 = okc && okr1;
        const float b0 = bias_s[ok0 ? bi0 + kc : 0], b1 = bias_s[ok1 ? bi0 + 31 + kc : 0];
        p0[i] = ok0 ? p0[i] + b0 : -INFINITY; p1[i] = ok1 ? p1[i] + b1 : -INFINITY;
      }
    }
    float pmax = p0[0];
#pragma unroll
    for (int i = 1; i < 16; ++i) pmax = fmaxf(pmax, p0[i]);
#pragma unroll
    for (int i = 0; i < 16; ++i) pmax = fmaxf(pmax, p1[i]);
    pmax = swap_max(pmax);
    const float mn = fmaxf(m_run, pmax);
    const float alpha = __builtin_amdgcn_exp2f(m_run - mn);
    m_run = mn;
    float ps = 0.f;
#pragma unroll
    for (int i = 0; i < 16; ++i) { p0[i] = __builtin_amdgcn_exp2f(p0[i] - mn); ps += p0[i]; }
#pragma unroll
    for (int i = 0; i < 16; ++i) { p1[i] = __builtin_amdgcn_exp2f(p1[i] - mn); ps += p1[i]; }
    ps = swap_sum(ps);
    l_run = l_run * alpha + ps;
#pragma unroll
    for (int i = 0; i < 16; ++i) { o[0][i] *= alpha; o[1][i] *= alpha; }
    bf16x8 pb[4];
#pragma unroll
    for (int s = 0; s < 2; ++s) {
      u32x4 a = {cvtpk(p0[8 * s], p0[8 * s + 1]), cvtpk(p0[8 * s + 2], p0[8 * s + 3]), cvtpk(p0[8 * s + 4], p0[8 * s + 5]), cvtpk(p0[8 * s + 6], p0[8 * s + 7])};
      u32x4 b = {cvtpk(p1[8 * s], p1[8 * s + 1]), cvtpk(p1[8 * s + 2], p1[8 * s + 3]), cvtpk(p1[8 * s + 4], p1[8 * s + 5]), cvtpk(p1[8 * s + 6], p1[8 * s + 7])};
      pb[s] = __builtin_bit_cast(bf16x8, a); pb[2 + s] = __builtin_bit_cast(bf16x8, b);
    }
#pragma unroll
    for (int db = 0; db < 2; ++db)
#pragma unroll
      for (int s = 0; s < 4; ++s) {
        const s16x4 lo = __builtin_amdgcn_ds_read_tr16_b64_v4i16((lds_s16x4*)(Vs + db * 4096 + (16 * s) * 64 + vrd));
        const s16x4 hh = __builtin_amdgcn_ds_read_tr16_b64_v4i16((lds_s16x4*)(Vs + db * 4096 + (16 * s + 8) * 64 + vrd));
        const bf16x8 a = {lo[0], lo[1], lo[2], lo[3], hh[0], hh[1], hh[2], hh[3]};
        o[db] = MFMA32(a, pb[s], o[db]);
      }
  }
  const float inv = 1.f / l_run;
  const int bq = qpos;
  bf16_t* orow = it.out + (size_t)bq * it.ldo;
#pragma unroll
  for (int db = 0; db < 2; ++db)
#pragma unroll
    for (int g = 0; g < 4; ++g) {
      u32x2 v = {cvtpk(o[db][4 * g] * inv, o[db][4 * g + 1] * inv), cvtpk(o[db][4 * g + 2] * inv, o[db][4 * g + 3] * inv)};
      *(u32x2*)(orow + db * 32 + 8 * g + 4 * hi) = v;
    }
  if (MODE == 1) { if (hi == 0) it.lse[(size_t)bq * 6] = m_run + __builtin_amdgcn_logf(l_run); }
}

DI void attn_dense_skew(const bf16_t* __restrict__ Q, const bf16_t* __restrict__ K, const bf16_t* __restrict__ V, int q0, bf16_t* __restrict__ out,
                        char* smem, const int tid512, const int grp) {
  constexpr int DQ = 96, CPR = 12, KST = 208, NT = SEQ / 64, KB = 64 * KST, VOFF = 2 * KB;
  const int lane = tid512 & 63, w = (tid512 >> 6) & 3, r32 = lane & 31, hi = lane >> 5;
  const int qpos = q0 + w * 32 + r32;
  bf16x8 qr[DQ / 16];
#pragma unroll
  for (int d0 = 0; d0 < DQ / 16; ++d0) qr[d0] = *(const bf16x8*)(Q + (size_t)qpos * DQ + d0 * 16 + hi * 8);
  f32x16 o[2];
#pragma unroll
  for (int i = 0; i < 16; ++i) { o[0][i] = 0.f; o[1][i] = 0.f; }
  float m_run = -1e30f, l_run = 0.f;
  const int kr0 = tid512 / CPR, kc0 = tid512 - kr0 * CPR, c1 = tid512 + 512, kr1 = c1 / CPR, kc1 = c1 - kr1 * CPR, vr = tid512 >> 3, vc = tid512 & 7;
  const bool two = tid512 < 256;
  const bf16_t* Kp0 = K + (size_t)kr0 * DQ + kc0 * 8; const bf16_t* Kp1 = K + (size_t)kr1 * DQ + kc1 * 8; const bf16_t* Vp = V + (size_t)vr * 64 + vc * 8;
  const int ks0 = kr0 * KST + kc0 * 16, ks1 = kr1 * KST + kc1 * 16, vs0 = VOFF + (vc >> 2) * 4096 + vr * 64 + (vc & 3) * 16;
  u32x4 rk0, rk1 = u32x4{0u, 0u, 0u, 0u}, rv;
  auto load = [&](int t) {
    const size_t ro = (size_t)t * 64;
    rk0 = *(const u32x4*)(Kp0 + ro * DQ); if (two) rk1 = *(const u32x4*)(Kp1 + ro * DQ); rv = *(const u32x4*)(Vp + ro * 64);
  };
  auto store = [&](int kb, int vb) {
    char* kbp = smem + kb * KB;
    *(u32x4*)(kbp + ks0) = rk0; if (two) *(u32x4*)(kbp + ks1) = rk1; *(u32x4*)(smem + vb * 8192 + vs0) = rv;
  };
  const int vrd = ((lane >> 5) * 4 + ((lane & 15) >> 2)) * 64 + ((lane >> 4) & 1) * 32 + (lane & 3) * 8;
  __syncthreads();
  load(0); store(0, 0); load(1);
  __syncthreads();
  if (grp == 1) __syncthreads();
  int vcur = 0;
  for (int t = 0; t < NT; ++t) {
    const int vnext = vcur == 2 ? 0 : vcur + 1;
    const char* Ks = smem + (t & 1) * KB; const char* Vs = smem + VOFF + vcur * 8192;
    if (t + 1 < NT) store((t + 1) & 1, vnext);
    if (t + 2 < NT) load(t + 2);
    f32x16 p0, p1;
#pragma unroll
    for (int i = 0; i < 16; ++i) { p0[i] = 0.f; p1[i] = 0.f; }
    {
      const char* kp = Ks + r32 * KST + hi * 16;
      bf16x8 ka[2][2];
      ka[0][0] = *(const bf16x8*)(kp); ka[0][1] = *(const bf16x8*)(kp + 32 * KST);
      ka[1][0] = *(const bf16x8*)(kp + 32); ka[1][1] = *(const bf16x8*)(kp + 32 * KST + 32);
#pragma unroll
      for (int d0 = 0; d0 < DQ / 16; ++d0) {
        p0 = MFMA32(ka[d0 & 1][0], qr[d0], p0); p1 = MFMA32(ka[d0 & 1][1], qr[d0], p1);
        if (d0 + 2 < DQ / 16) { ka[d0 & 1][0] = *(const bf16x8*)(kp + (d0 + 2) * 32); ka[d0 & 1][1] = *(const bf16x8*)(kp + 32 * KST + (d0 + 2) * 32); }
      }
    }
    asm volatile("" : "+v"(p0), "+v"(p1));
    __syncthreads();
    asm volatile("" : "+v"(p0), "+v"(p1));
    s16x4 vlo[4], vhi[4];
#pragma unroll
    for (int s2 = 0; s2 < 4; ++s2) {
      vlo[s2] = __builtin_amdgcn_ds_read_tr16_b64_v4i16((lds_s16x4*)(Vs + (16 * s2) * 64 + vrd));
      vhi[s2] = __builtin_amdgcn_ds_read_tr16_b64_v4i16((lds_s16x4*)(Vs + (16 * s2 + 8) * 64 + vrd));
    }
    float pmax = p0[0];
#pragma unroll
    for (int i = 1; i < 16; ++i) pmax = fmaxf(pmax, p0[i]);
#pragma unroll
    for (int i = 0; i < 16; ++i) pmax = fmaxf(pmax, p1[i]);
    pmax = swap_max(pmax);
    const float mn = fmaxf(m_run, pmax);
    const float alpha = __builtin_amdgcn_exp2f(m_run - mn);
    m_run = mn;
    float ps = 0.f;
#pragma unroll
    for (int i = 0; i < 16; ++i) { p0[i] = __builtin_amdgcn_exp2f(p0[i] - mn); ps += p0[i]; }
#pragma unroll
    for (int i = 0; i < 16; ++i) { p1[i] = __builtin_amdgcn_exp2f(p1[i] - mn); ps += p1[i]; }
    ps = swap_sum(ps);
    l_run = l_run * alpha + ps;
#pragma unroll
    for (int i = 0; i < 16; ++i) { o[0][i] *= alpha; o[1][i] *= alpha; }
    bf16x8 pb[4];
#pragma unroll
    for (int s = 0; s < 2; ++s) {
      u32x4 a = {cvtpk(p0[8 * s], p0[8 * s + 1]), cvtpk(p0[8 * s + 2], p0[8 * s + 3]), cvtpk(p0[8 * s + 4], p0[8 * s + 5]), cvtpk(p0[8 * s + 6], p0[8 * s + 7])};
      u32x4 b = {cvtpk(p1[8 * s], p1[8 * s + 1]), cvtpk(p1[8 * s + 2], p1[8 * s + 3]), cvtpk(p1[8 * s + 4], p1[8 * s + 5]), cvtpk(p1[8 * s + 6], p1[8 * s + 7])};
      pb[s] = __builtin_bit_cast(bf16x8, a); pb[2 + s] = __builtin_bit_cast(bf16x8, b);
    }
    {
      s16x4 wlo[4], whi[4];
#pragma unroll
      for (int s2 = 0; s2 < 4; ++s2) {
        wlo[s2] = __builtin_amdgcn_ds_read_tr16_b64_v4i16((lds_s16x4*)(Vs + 4096 + (16 * s2) * 64 + vrd));
        whi[s2] = __builtin_amdgcn_ds_read_tr16_b64_v4i16((lds_s16x4*)(Vs + 4096 + (16 * s2 + 8) * 64 + vrd));
      }
#pragma unroll
      for (int s2 = 0; s2 < 4; ++s2) { const bf16x8 a = {vlo[s2][0], vlo[s2][1], vlo[s2][2], vlo[s2][3], vhi[s2][0], vhi[s2][1], vhi[s2][2], vhi[s2][3]}; o[0] = MFMA32(a, pb[s2], o[0]); }
#pragma unroll
      for (int s2 = 0; s2 < 4; ++s2) { const bf16x8 a = {wlo[s2][0], wlo[s2][1], wlo[s2][2], wlo[s2][3], whi[s2][0], whi[s2][1], whi[s2][2], whi[s2][3]}; o[1] = MFMA32(a, pb[s2], o[1]); }
    }
    asm volatile("" : "+v"(o[0]), "+v"(o[1]));
    __syncthreads();
    asm volatile("" : "+v"(o[0]), "+v"(o[1]));
    vcur = vnext;
  }
  if (grp == 0) __syncthreads();
  const float inv = 1.f / l_run;
  bf16_t* orow = out + (size_t)qpos * 384;
#pragma unroll
  for (int db = 0; db < 2; ++db)
#pragma unroll
    for (int g = 0; g < 4; ++g) {
      u32x2 v = {cvtpk(o[db][4 * g] * inv, o[db][4 * g + 1] * inv), cvtpk(o[db][4 * g + 2] * inv, o[db][4 * g + 3] * inv)};
      *(u32x2*)(orow + db * 32 + 8 * g + 4 * hi) = v;
    }
}

DI float wave_sum(float v) {
  v += __shfl_xor(v, 32); v += __shfl_xor(v, 16); v += __shfl_xor(v, 8); v += __shfl_xor(v, 4); v += __shfl_xor(v, 2); v += __shfl_xor(v, 1); return v;
}
DI float gain_of(const Params& p, int kind, int l, int k) {
  switch (kind) {
    case 0: return p.g_mix[l * 1024 + k];
    case 1: return p.q_norm[l * 256 + k];
    case 2: return p.kv_norm[l * 128 + k];
    case 3: return k < 384 ? p.on_a[l * 384 + k] : (k < 768 ? p.on_b[l * 384 + k - 384] : p.on_c[l * 256 + k - 768]);
    case 4: return p.g_mlp[l * 1024 + k];
    default: return 1.f;
  }
}
DI int map_col(int kind, int n) {
  if (kind == 0) {
    if (n < 384) return n;
    if (n < 448) { const int wv = n - 384, c = wv & 31, sub = wv >> 5; return c < 16 ? 384 + sub * 16 + c : -1; }
    if (n < 1600) return 416 + (n - 448);
    if (n < 2368) return 1568 + (n - 1600);
    return -1;
  }
  if (kind == 1) {
    if (n < 384) return (n >> 6) * 96 + (n & 63);
    if (n < 576) { const int wv = n - 384, g = wv >> 6, wi = wv & 63, sub = wi >> 5, c = wi & 31, hd = 2 * g + (c >> 4), fi = c & 15; return hd * 96 + 64 + sub * 16 + fi; }
    return -1;
  }
  return n;
}
DI void wtile(const Params& p, const float* src, int Nsrc, bf16_t* dst, int K, int kt, int nt, int kind, int l, char* smem, const int tid) {
  float* tile = (float*)smem;
  const int lane = tid & 63, wv = tid >> 6;
  __syncthreads();
  const int n = nt * 64 + lane, sc = map_col(kind, n);
#pragma unroll 4
  for (int r = 0; r < 8; ++r) {
    const int kl = r * 8 + wv, kd = kt * 64 + kl;
    const int k = kind == 5 ? ((kd & ~63) | ((kd & 1) << 5) | ((kd & 63) >> 1)) : kd;
    float v = 0.f;
    if (sc >= 0) v = src[(size_t)k * Nsrc + sc] * gain_of(p, kind, l, k);
    tile[kl * 65 + lane] = v;
  }
  __syncthreads();
#pragma unroll 4
  for (int r = 0; r < 8; ++r) {
    const int nl = r * 8 + wv;
    dst[(size_t)(nt * 64 + nl) * K + kt * 64 + lane] = f2bf(tile[lane * 65 + nl]);
  }
}

NI void phase_prep() {
  const Params& p = kparams(); char* smem = g_smem; const int tid = otid(), bid = obid();
  char* ws = p.ws;
  constexpr int T_WIN = (N_IN_PAD / 64) * 16, T_WUQ = (N_UQ_PAD / 64) * 4, T_WUKV = (N_UKV / 64) * 2, T_WOUT = 16 * 16, T_W1 = 64 * 16, T_W2 = 16 * 64;
  constexpr int T_L = T_WIN + T_WUQ + T_WUKV + T_WOUT + T_W1 + T_W2;
  for (int j = bid; j < NLAYER * T_L; j += gridDim.x) {
    const int l = j / T_L; int r = j - l * T_L;
    char* lw = ws + OFF_W + (size_t)l * LW_SIZE;
    if (r < T_WIN) { wtile(p, p.w_in + (size_t)l * 1024 * 2336, 2336, (bf16_t*)(lw + LW_WIN), 1024, r & 15, r >> 4, 0, l, smem, tid); continue; }
    r -= T_WIN;
    if (r < T_WUQ) { wtile(p, p.w_uq + (size_t)l * 256 * 576, 576, (bf16_t*)(lw + LW_WUQ), 256, r & 3, r >> 2, 1, l, smem, tid); continue; }
    r -= T_WUQ;
    if (r < T_WUKV) { wtile(p, p.w_ukv + (size_t)l * 128 * 768, 768, (bf16_t*)(lw + LW_WUKV), 128, r & 1, r >> 1, 2, l, smem, tid); continue; }
    r -= T_WUKV;
    if (r < T_WOUT) { wtile(p, p.w_out + (size_t)l * 1024 * 1024, 1024, (bf16_t*)(lw + LW_WOUT), 1024, r & 15, r >> 4, 3, l, smem, tid); continue; }
    r -= T_WOUT;
    if (r < T_W1) { wtile(p, p.w_mlp_in + (size_t)l * 1024 * 4096, 4096, (bf16_t*)(lw + LW_W1), 1024, r & 15, r >> 4, 4, l, smem, tid); continue; }
    r -= T_W1;
    wtile(p, p.w_mlp_out + (size_t)l * 4096 * 1024, 1024, (bf16_t*)(lw + LW_W2), 4096, r & 63, r >> 6, 5, l, smem, tid);
  }
  const size_t gtid = (size_t)bid * NTHR + tid, gsz = (size_t)gridDim.x * NTHR;
  bf16_t* xb = (bf16_t*)(ws + OFF_XB);
  {
    const int lane = tid & 63, gw = bid * (NTHR / 64) + (tid >> 6), nw = gridDim.x * (NTHR / 64);
    float* px1 = (float*)(ws + OFF_PX1);
    for (int row = gw; row < NTOK; row += nw) {
      float ss = 0.f;
#pragma unroll
      for (int j = 0; j < 4; ++j) {
        const f32x4 a = *(const f32x4*)(p.x + (size_t)row * DM + j * 256 + lane * 4);
        ss += a[0] * a[0] + a[1] * a[1] + a[2] * a[2] + a[3] * a[3];
        u32x2 o = {cvtpk(a[0], a[1]), cvtpk(a[2], a[3])};
        *(u32x2*)(xb + (size_t)row * DM + j * 256 + lane * 4) = o;
      }
      ss = wave_sum(ss);
      if (lane < 16) px1[(size_t)row * 16 + lane] = lane == 0 ? ss : 0.f;
    }
  }
  float* c32 = (float*)(ws + OFF_COS32); float* s32 = (float*)(ws + OFF_SIN32); float* c16 = (float*)(ws + OFF_COS16); float* s16 = (float*)(ws + OFF_SIN16);
  for (size_t i = gtid; i < (size_t)SEQ * 48; i += gsz) {
    int pos, fi; float invf; float *cd, *sd;
    if (i < (size_t)SEQ * 32) { pos = (int)(i >> 5); fi = (int)(i & 31); invf = __builtin_amdgcn_exp2f(-(float)fi * (13.287712379549449f / 32.f)); cd = c32 + i; sd = s32 + i; }
    else { const size_t j = i - (size_t)SEQ * 32; pos = (int)(j >> 4); fi = (int)(j & 15); invf = __builtin_amdgcn_exp2f(-(float)fi * (13.287712379549449f / 16.f)); cd = c16 + j; sd = s16 + j; }
    const float ang = (float)pos * invf;
    const double rev = (double)ang * 0.15915494309189535;
    const float fr = (float)(rev - rint(rev));
    *cd = __builtin_amdgcn_cosf(fr); *sd = __builtin_amdgcn_sinf(fr);
  }
}

NI void phase_g1(int l_) {
  const Params& p = kparams(); char* smem = g_smem; const int l = __builtin_amdgcn_readfirstlane(l_); const int tid = otid(), bid = obid(); (void)tid; (void)bid;
  char* ws = p.ws;
  EpiG1 e;
  e.cqkv = (bf16_t*)(ws + OFF_CQKV); e.KA = (bf16_t*)(ws + OFF_KA); e.qB = (bf16_t*)(ws + OFF_QB); e.qC = (bf16_t*)(ws + OFF_QC);
  e.cos32 = (const float*)(ws + OFF_COS32); e.sin32 = (const float*)(ws + OFF_SIN32); e.cos16 = (const float*)(ws + OFF_COS16); e.sin16 = (const float*)(ws + OFF_SIN16);
  e.qs = p.qscaleB; e.pq = (float*)(ws + OFF_PQ); e.pkv = (float*)(ws + OFF_PKV);
  const bf16_t* A = (const bf16_t*)(ws + OFF_XB);
  const bf16_t* Bt = (const bf16_t*)(ws + OFF_W + (size_t)l * LW_SIZE + LW_WIN);
  constexpr int NNT = N_IN_PAD / 256;
  FOR_TILES(NNT, mt, nt, gemm_tile<16>(A, 1024, Bt, 1024, 1024, mt * 256, nt * 256, e, tid, (const float*)(ws + OFF_PX1));)
}
NI void phase_g2(int l_) {
  const Params& p = kparams(); char* smem = g_smem; const int l = __builtin_amdgcn_readfirstlane(l_); const int tid = otid(), bid = obid(); (void)tid; (void)bid;
  char* ws = p.ws;
  const bf16_t* A = (const bf16_t*)(ws + OFF_CQKV);
  EpiUQ eq; eq.QA = (bf16_t*)(ws + OFF_QA); eq.cos16 = (const float*)(ws + OFF_COS16); eq.sin16 = (const float*)(ws + OFF_SIN16); eq.qs = p.qscaleA;
  EpiUKV ek; ek.KA = (bf16_t*)(ws + OFF_KA); ek.VA = (bf16_t*)(ws + OFF_VA);
  const bf16_t* Wq = (const bf16_t*)(ws + OFF_W + (size_t)l * LW_SIZE + LW_WUQ);
  const bf16_t* Wkv = (const bf16_t*)(ws + OFF_W + (size_t)l * LW_SIZE + LW_WUKV);
  FOR_TILES(3, mt, nt, gemm_tile<4>(A, 384, Wq, 256, 256, mt * 256, nt * 256, eq, tid, (const float*)(ws + OFF_PQ));)
  FOR_TILES(3, mt, nt, gemm_tile<2>(A + 256, 384, Wkv, 128, 128, mt * 256, nt * 256, ek, tid, (const float*)(ws + OFF_PKV));)
}
NI void phase_attn(int l_) {
  const Params& p = kparams(); char* smem = g_smem; const int l = __builtin_amdgcn_readfirstlane(l_); const int tid = otid(), bid = obid(); (void)tid; (void)bid;
  char* ws = p.ws;
  constexpr int NA = 1536, NBI = 4608, NC = 1024;
  const int grp = tid >> 8, t256 = tid & 255; char* gsm = smem + grp * ATT_LDS;
  for (int i0 = bid * 2; i0 < NA; i0 += gridDim.x * 2) {
    const int i = i0 + grp, xcd = (i >> 1) & 7, j = ((i >> 4) << 1) | (i & 1);
    const int bh = (j >> 6) * 8 + xcd, qb = j & 63, b = bh / 6, h = bh - b * 6;
    attn_dense_skew((const bf16_t*)(ws + OFF_QA) + (size_t)bh * SEQ * 96, (const bf16_t*)(ws + OFF_KA) + (size_t)bh * SEQ * 96, (const bf16_t*)(ws + OFF_VA) + (size_t)bh * SEQ * 64,
                    qb * 128, (bf16_t*)(ws + OFF_OA) + (size_t)b * SEQ * 384 + h * 64, smem, tid, grp);
  }
  for (int i0 = bid * 2; i0 < NBI; i0 += gridDim.x * 2) {
    AttnItem it{};
    const int i = i0 + grp, xcd = (i >> 1) & 7, j = ((i >> 4) << 1) | (i & 1);
    const int g = (j >> 6) * 8 + xcd, c = j & 63, br = g / 24, bh = g - br * 24, b = bh / 6, h = bh - b * 6;
    const int dil = br == 0 ? 1 : (br == 1 ? 4 : 16), cpr = 64 / dil;
    it.Q = (const bf16_t*)(ws + OFF_QB) + (size_t)bh * SEQ * 64; it.K = (const bf16_t*)(ws + OFF_KB) + (size_t)bh * SEQ * 64; it.V = (const bf16_t*)(ws + OFF_VB) + (size_t)bh * SEQ * 64;
    it.dil = dil; it.res = c / cpr; it.n0 = (c - it.res * cpr) * 128; it.N = SEQ / dil;
    it.out = (bf16_t*)(ws + OFF_OB) + (size_t)br * NTOK * 384 + (size_t)b * SEQ * 384 + h * 64; it.ldo = 384;
    it.lse = (float*)(ws + OFF_LSEB) + (size_t)br * NTOK * 6 + (size_t)b * SEQ * 6 + h;
    attn_block<64, 1>(it, gsm, t256);
  }
  for (int i0 = bid * 2; i0 < NC; i0 += gridDim.x * 2) {
    AttnItem it{};
    const int i = i0 + grp, xcd = (i >> 1) & 7, j = ((i >> 4) << 1) | (i & 1);
    const int bh = (j >> 6) * 8 + xcd, blk = j & 63, b = bh >> 2, h = bh & 3;
    it.Q = (const bf16_t*)(ws + OFF_QC) + (size_t)bh * SEQ * 64; it.K = (const bf16_t*)(ws + OFF_KC) + (size_t)bh * SEQ * 64; it.V = (const bf16_t*)(ws + OFF_VC) + (size_t)bh * SEQ * 64;
    it.nrb = blk >> 2; it.ncb = blk & 3;
    it.kr0 = min(max(8 * it.nrb - 4, 0), 112); it.kc0 = min(max(16 * it.ncb - 8, 0), 32);
    it.out = (bf16_t*)(ws + OFF_OC) + (size_t)b * SEQ * 256 + h * 64; it.ldo = 256;
    it.rpb = p.rpb + ((size_t)l * 4 + h) * 465;
    attn_block<64, 2>(it, gsm, t256);
  }
}
NI void phase_mix() {
  const Params& p = kparams(); const int tid = otid(), bid = obid();
  char* ws = p.ws;
  const int lane = tid & 63, gw = bid * (NTHR / 64) + (tid >> 6), nw = gridDim.x * (NTHR / 64);
  const bf16_t* oA = (const bf16_t*)(ws + OFF_OA); const bf16_t* oB = (const bf16_t*)(ws + OFF_OB); const bf16_t* oC = (const bf16_t*)(ws + OFF_OC);
  const float* lse = (const float*)(ws + OFF_LSEB);
  bf16_t* mixed = (bf16_t*)(ws + OFF_MIXED);
  for (int tok = gw; tok < NTOK; tok += nw) {
    float v[16];
    if (lane < 24 || lane >= 48) {
      const bf16_t* src = lane < 24 ? oA + (size_t)tok * 384 + lane * 16 : oC + (size_t)tok * 256 + (lane - 48) * 16;
      const u32x4 a = *(const u32x4*)src, b = *(const u32x4*)(src + 8);
#pragma unroll
      for (int j = 0; j < 4; ++j) { v[2 * j] = bf2f(a[j] & 0xffffu); v[2 * j + 1] = bf2f(a[j] >> 16); v[8 + 2 * j] = bf2f(b[j] & 0xffffu); v[8 + 2 * j + 1] = bf2f(b[j] >> 16); }
    } else {
      const int col = (lane - 24) * 16, hd = col >> 6;
      const float l0 = lse[(size_t)tok * 6 + hd], l1 = lse[(size_t)NTOK * 6 + (size_t)tok * 6 + hd], l2 = lse[(size_t)2 * NTOK * 6 + (size_t)tok * 6 + hd];
      const float mx = fmaxf(l0, fmaxf(l1, l2));
      float w0 = __builtin_amdgcn_exp2f(l0 - mx), w1 = __builtin_amdgcn_exp2f(l1 - mx), w2 = __builtin_amdgcn_exp2f(l2 - mx);
      const float wi = 1.f / (w0 + w1 + w2); w0 *= wi; w1 *= wi; w2 *= wi;
#pragma unroll
      for (int j = 0; j < 16; ++j) v[j] = 0.f;
#pragma unroll
      for (int br = 0; br < 3; ++br) {
        const float wb = br == 0 ? w0 : (br == 1 ? w1 : w2);
        const bf16_t* src = oB + (size_t)br * NTOK * 384 + (size_t)tok * 384 + col;
        const u32x4 a = *(const u32x4*)src, b = *(const u32x4*)(src + 8);
#pragma unroll
        for (int j = 0; j < 4; ++j) { v[2 * j] += wb * bf2f(a[j] & 0xffffu); v[2 * j + 1] += wb * bf2f(a[j] >> 16); v[8 + 2 * j] += wb * bf2f(b[j] & 0xffffu); v[8 + 2 * j + 1] += wb * bf2f(b[j] >> 16); }
      }
    }
    float ss = 0.f;
#pragma unroll
    for (int j = 0; j < 16; ++j) ss += v[j] * v[j];
    const float sa = wave_sum(lane < 24 ? ss : 0.f), sb = wave_sum((lane >= 24 && lane < 48) ? ss : 0.f), sc = wave_sum(lane >= 48 ? ss : 0.f);
    const float rs = lane < 24 ? rsqrtf(sa * (1.f / 384.f) + 1e-6f) : (lane < 48 ? rsqrtf(sb * (1.f / 384.f) + 1e-6f) : rsqrtf(sc * (1.f / 256.f) + 1e-6f));
    u32x4 oa, ob;
#pragma unroll
    for (int j = 0; j < 4; ++j) { oa[j] = cvtpk(v[2 * j] * rs, v[2 * j + 1] * rs); ob[j] = cvtpk(v[8 + 2 * j] * rs, v[8 + 2 * j + 1] * rs); }
    bf16_t* dst = mixed + (size_t)tok * 1024 + lane * 16;
    *(u32x4*)dst = oa; *(u32x4*)(dst + 8) = ob;
  }
}
NI void phase_wout(int l_) {
  const Params& p = kparams(); char* smem = g_smem; const int l = __builtin_amdgcn_readfirstlane(l_); const int tid = otid(), bid = obid(); (void)tid; (void)bid;
  char* ws = p.ws;
  EpiRes e; e.xb = (bf16_t*)(ws + OFF_XB); e.pout = (float*)(ws + OFF_PX2);
  const bf16_t* A = (const bf16_t*)(ws + OFF_MIXED);
  const bf16_t* Bt = (const bf16_t*)(ws + OFF_W + (size_t)l * LW_SIZE + LW_WOUT);
  FOR_TILES(4, mt, nt, gemm_tile<0>(A, 1024, Bt, 1024, 1024, mt * 256, nt * 256, e, tid, nullptr);)
}
NI void phase_mlp1(int l_) {
  const Params& p = kparams(); char* smem = g_smem; const int l = __builtin_amdgcn_readfirstlane(l_); const int tid = otid(), bid = obid(); (void)tid; (void)bid;
  char* ws = p.ws;
  EpiMlp1 e; e.hid = (bf16_t*)(ws + OFF_HID);
  const bf16_t* A = (const bf16_t*)(ws + OFF_XB);
  const bf16_t* Bt = (const bf16_t*)(ws + OFF_W + (size_t)l * LW_SIZE + LW_W1);
  FOR_TILES(16, mt, nt, gemm_tile<16>(A, 1024, Bt, 1024, 1024, mt * 256, nt * 256, e, tid, (const float*)(ws + OFF_PX2));)
}
NI void phase_mlp2(int l_) {
  const Params& p = kparams(); char* smem = g_smem; const int l = __builtin_amdgcn_readfirstlane(l_); const int tid = otid(), bid = obid(); (void)tid; (void)bid;
  char* ws = p.ws;
  EpiRes e; e.xb = (bf16_t*)(ws + OFF_XB); e.pout = (float*)(ws + OFF_PX1);
  const bf16_t* A = (const bf16_t*)(ws + OFF_HID);
  const bf16_t* Bt = (const bf16_t*)(ws + OFF_W + (size_t)l * LW_SIZE + LW_W2);
  FOR_TILES(4, mt, nt, gemm_tile<0>(A, DFF, Bt, DFF, DFF, mt * 256, nt * 256, e, tid, nullptr);)
}
NI void phase_final() {
  const Params& p = kparams(); const int tid = otid(), bid = obid();
  const int lane = tid & 63, gw = bid * (NTHR / 64) + (tid >> 6), nw = gridDim.x * (NTHR / 64);
  const bf16_t* xb = (const bf16_t*)(p.ws + OFF_XB);
  for (int tok = gw; tok < NTOK; tok += nw) {
    float* row = p.out + (size_t)tok * DM;
    f32x4 v[4]; float ss = 0.f;
#pragma unroll
    for (int j = 0; j < 4; ++j) {
      const u32x2 r = *(const u32x2*)(xb + (size_t)tok * DM + j * 256 + lane * 4);
      v[j] = f32x4{bf2f(r[0] & 0xffffu), bf2f(r[0] >> 16), bf2f(r[1] & 0xffffu), bf2f(r[1] >> 16)};
      ss += v[j][0] * v[j][0] + v[j][1] * v[j][1] + v[j][2] * v[j][2] + v[j][3] * v[j][3];
    }
    ss = wave_sum(ss);
    const float rs = rsqrtf(ss * (1.f / 1024.f) + 1e-6f);
#pragma unroll
    for (int j = 0; j < 4; ++j) { const f32x4 g = *(const f32x4*)(p.g_final + j * 256 + lane * 4); f32x4 o = {v[j][0] * rs * g[0], v[j][1] * rs * g[1], v[j][2] * rs * g[2], v[j][3] * rs * g[3]}; *(f32x4*)(row + j * 256 + lane * 4) = o; }
  }
}

constexpr int NPHASE = 2 + 7 * NLAYER;
DI void run_phase(int ph) {
  if (ph == 0) { phase_prep(); return; }
  if (ph == NPHASE - 1) { phase_final(); return; }
  const int l = (ph - 1) / 7, st = (ph - 1) - l * 7;
  switch (st) {
    case 0: phase_g1(l); break;
    case 1: phase_g2(l); break;
    case 2: phase_attn(l); break;
    case 3: phase_mix(); break;
    case 4: phase_wout(l); break;
    case 5: phase_mlp1(l); break;
    default: phase_mlp2(l); break;
  }
}

__global__ void __launch_bounds__(512) mega(Params p, int ph_lo, int ph_hi) {
  cg::grid_group grid = cg::this_grid();
  for (int ph = ph_lo; ph < ph_hi; ++ph) {
    run_phase(ph);
    if (ph + 1 < ph_hi) grid.sync();
  }
}

extern "C" void kernel_launch(void* const* d_in, const int* in_sizes, int n_in, void* d_out, int out_size, void* d_ws, size_t ws_size, hipStream_t stream) {
  static int grid_blocks = 0;
  if (!grid_blocks) {
    int dev = 0, cus = 0, per_cu = 0;
    (void)hipGetDevice(&dev);
    (void)hipDeviceGetAttribute(&cus, hipDeviceAttributeMultiprocessorCount, dev);
    (void)hipOccupancyMaxActiveBlocksPerMultiprocessor(&per_cu, mega, NTHR, 0);
    if (per_cu > 1) per_cu = 1;
    grid_blocks = cus * per_cu;
    if (ws_size < OFF_END) fprintf(stderr, "kernel_launch: workspace too small: %zu < %zu\n", ws_size, (size_t)OFF_END);
  }
  Params p;
  memset(&p, 0, sizeof(p));
  p.x = (const float*)d_in[0]; p.g_mix = (const float*)d_in[1]; p.w_in = (const float*)d_in[2]; p.q_norm = (const float*)d_in[3];
  p.w_uq = (const float*)d_in[4]; p.kv_norm = (const float*)d_in[5]; p.w_ukv = (const float*)d_in[6]; p.rpb = (const float*)d_in[7];
  p.on_a = (const float*)d_in[8]; p.on_b = (const float*)d_in[9]; p.on_c = (const float*)d_in[10]; p.w_out = (const float*)d_in[11];
  p.g_mlp = (const float*)d_in[12]; p.w_mlp_in = (const float*)d_in[13]; p.w_mlp_out = (const float*)d_in[14]; p.g_final = (const float*)d_in[15];
  p.out = (float*)d_out; p.ws = (char*)d_ws;
  p.qscaleA = (float)(1.4426950408889634 / std::sqrt(96.0));
  p.qscaleB = (float)(1.4426950408889634 * 0.125);
#if ONE_LAUNCH
  int lo = 0, hi = NPHASE;
  void* args[] = {&p, &lo, &hi};
  hipError_t e = hipLaunchCooperativeKernel((void*)mega, dim3(grid_blocks), dim3(NTHR), args, 0, stream);
  if (e != hipSuccess) fprintf(stderr, "cooperative launch failed: %s (grid %d)\n", hipGetErrorString(e), grid_blocks);
#else
  for (int ph = 0; ph < NPHASE; ++ph) hipLaunchKernelGGL(mega, dim3(grid_blocks), dim3(NTHR), 0, stream, p, ph, ph + 1);
#endif
}
```

```cpp
#include <hip/hip_runtime.h>
#include <hip/hip_cooperative_groups.h>
#include <cstdio>
#include <cmath>
#include <cstring>
namespace cg = cooperative_groups;

#ifndef ONE_LAUNCH
#define ONE_LAUNCH 1
#endif

#define DI __device__ __forceinline__
typedef unsigned short bf16_t;
typedef short bf16x8 __attribute__((ext_vector_type(8)));
typedef short s16x4 __attribute__((ext_vector_type(4)));
typedef float f32x16 __attribute__((ext_vector_type(16)));
typedef float f32x2 __attribute__((ext_vector_type(2)));
typedef float f32x4 __attribute__((ext_vector_type(4)));
typedef __bf16 bf2_t __attribute__((ext_vector_type(2)));
typedef unsigned u32x4 __attribute__((ext_vector_type(4)));
typedef unsigned u32x2 __attribute__((ext_vector_type(2)));
typedef __attribute__((address_space(3))) s16x4 lds_s16x4;

constexpr int SEQ = 8192, NB = 4, NTOK = NB * SEQ, DM = 1024, NLAYER = 4;
constexpr int N_IN_PAD = 2560, N_UQ_PAD = 768, N_UKV = 768, DFF = 4096;
constexpr int NTHR = 512;

constexpr size_t SZ_XB = (size_t)NTOK * DM * 2;
constexpr size_t SZ_WIN = (size_t)N_IN_PAD * 1024 * 2, SZ_WUQ = (size_t)N_UQ_PAD * 256 * 2, SZ_WUKV = (size_t)N_UKV * 128 * 2,
                 SZ_WOUT = (size_t)1024 * 1024 * 2, SZ_W1 = (size_t)DFF * 1024 * 2, SZ_W2 = (size_t)1024 * DFF * 2;
constexpr size_t LW_WIN = 0, LW_WUQ = LW_WIN + SZ_WIN, LW_WUKV = LW_WUQ + SZ_WUQ, LW_WOUT = LW_WUKV + SZ_WUKV, LW_W1 = LW_WOUT + SZ_WOUT,
                 LW_W2 = LW_W1 + SZ_W1, LW_SIZE = LW_W2 + SZ_W2;
constexpr size_t OFF_XB = 0, OFF_W = OFF_XB + SZ_XB, OFF_TAB = OFF_W + NLAYER * LW_SIZE;
constexpr size_t OFF_COS32 = OFF_TAB, OFF_SIN32 = OFF_COS32 + (size_t)SEQ * 32 * 4, OFF_COS16 = OFF_SIN32 + (size_t)SEQ * 32 * 4,
                 OFF_SIN16 = OFF_COS16 + (size_t)SEQ * 16 * 4, OFF_ATT = OFF_SIN16 + (size_t)SEQ * 16 * 4;
constexpr size_t SZ_T384 = (size_t)NTOK * 384 * 2, SZ_QA = (size_t)NB * 6 * SEQ * 96 * 2, SZ_H6 = (size_t)NB * 6 * SEQ * 64 * 2,
                 SZ_H4 = (size_t)NB * 4 * SEQ * 64 * 2;
constexpr size_t OFF_CQKV = OFF_ATT;
constexpr size_t OFF_OA = OFF_CQKV;
constexpr size_t OFF_QA = OFF_CQKV + SZ_T384, OFF_KA = OFF_QA + SZ_QA, OFF_VA = OFF_KA + SZ_QA;
constexpr size_t OFF_QB = OFF_VA + SZ_H6, OFF_KB = OFF_QB + SZ_H6, OFF_VB = OFF_KB + SZ_H6;
constexpr size_t OFF_QC = OFF_VB + SZ_H6, OFF_KC = OFF_QC + SZ_H4, OFF_VC = OFF_KC + SZ_H4;
constexpr size_t OFF_OB = OFF_VC + SZ_H4, OFF_LSEB = OFF_OB + 3 * SZ_T384, OFF_OC = OFF_LSEB + (size_t)3 * NTOK * 6 * 4;
constexpr size_t OFF_SSQ = OFF_OC + (size_t)NTOK * 256 * 2;
constexpr size_t OFF_PX1 = OFF_SSQ, OFF_PX2 = OFF_PX1 + (size_t)NTOK * 16 * 4, OFF_PQ = OFF_PX2 + (size_t)NTOK * 16 * 4, OFF_PKV = OFF_PQ + (size_t)NTOK * 4 * 4;
constexpr size_t OFF_END = OFF_PKV + (size_t)NTOK * 2 * 4;
constexpr size_t OFF_MIXED = OFF_QA;
constexpr size_t OFF_HID = OFF_ATT;
static_assert(OFF_HID + (size_t)NTOK * DFF * 2 <= OFF_SSQ, "hid fits");
static_assert(OFF_MIXED + (size_t)NTOK * DM * 2 <= OFF_VA, "mixed fits");

struct Params {
  const float *x, *g_mix, *w_in, *q_norm, *w_uq, *kv_norm, *w_ukv, *rpb, *on_a, *on_b, *on_c, *w_out, *g_mlp, *w_mlp_in, *w_mlp_out, *g_final;
  float* out; char* ws;
  float qscaleA, qscaleB;
};
__shared__ __attribute__((aligned(1024))) char g_smem[131072];
#define NI __device__ __forceinline__
DI const Params& kparams() { return *(const Params*)__builtin_amdgcn_kernarg_segment_ptr(); }

DI unsigned cvtpk(float lo, float hi) { f32x2 v = {lo, hi}; bf2_t b = __builtin_convertvector(v, bf2_t); return __builtin_bit_cast(unsigned, b); }
DI bf16_t f2bf(float x) { return (bf16_t)(cvtpk(x, 0.f) & 0xffffu); }
DI float bf2f(unsigned h) { return __uint_as_float(h << 16); }
DI int crow(int i, int h) { return (i & 3) + 8 * (i >> 2) + 4 * h; }
#define MFMA32(a, b, c) __builtin_amdgcn_mfma_f32_32x32x16_bf16((a), (b), (c), 0, 0, 0)
DI float fdot2bf(unsigned a, float c) { bf2_t v = __builtin_bit_cast(bf2_t, a); return __builtin_amdgcn_fdot2_f32_bf16(v, v, c, false); }
DI float swap_max(float v) { auto rr = __builtin_amdgcn_permlane32_swap(__float_as_uint(v), __float_as_uint(v), false, false); return fmaxf(__uint_as_float(rr[0]), __uint_as_float(rr[1])); }
DI float swap_sum(float v) { auto rr = __builtin_amdgcn_permlane32_swap(__float_as_uint(v), __float_as_uint(v), false, false); return __uint_as_float(rr[0]) + __uint_as_float(rr[1]); }

constexpr int ATT_LDS = 53248;
#define FOR_TILES(NN, MT, NT, BODY) { const bool xm_ = gridDim.x == 256; const int st_ = xm_ ? (bid >> 3) : bid, sp_ = xm_ ? 32 : (int)gridDim.x, cn_ = xm_ ? 16 * (NN) : (NTOK / 256) * (NN); \
  for (int j_ = st_; j_ < cn_; j_ += sp_) { int MT = j_ / (NN); const int NT = j_ - MT * (NN); if (xm_) MT += (bid & 7) * 16; BODY } }
DI int otid() { int t = threadIdx.x; asm volatile("" : "+v"(t)); return t; }
DI int obid() { int t = blockIdx.x; asm volatile("" : "+s"(t)); return t; }

template <int NSLOT, class Epi>
DI void gemm_tile(const bf16_t* __restrict__ A, int lda, const bf16_t* __restrict__ Bt, int ldb, int K, int m0, int n0, const Epi& epi, const int tid, const float* pin) {
  const int lane = tid & 63, w = tid >> 6, wm = w >> 2, wn = w & 3, r32 = lane & 31, hi = lane >> 5;
  char* smem = g_smem;
  const int lrow = lane >> 3;
  const int c0 = (lane & 7) ^ (lane >> 4), c1 = (lane & 7) ^ ((lane >> 4) | 4);
  const char* Ab = (const char*)(A + (size_t)m0 * lda);
  const char* Bb = (const char*)(Bt + (size_t)n0 * ldb);
  const unsigned oa0 = (unsigned)(((w * 32 + lrow) * lda + c0 * 8) * 2), oa1 = (unsigned)(((w * 32 + lrow) * lda + c1 * 8) * 2);
  const unsigned ob0 = (unsigned)(((w * 32 + lrow) * ldb + c0 * 8) * 2), ob1 = (unsigned)(((w * 32 + lrow) * ldb + c1 * 8) * 2);
  const int dma_off = (w * 32) * 128 + lane * 16;
  f32x16 acc[4][2];
#pragma unroll
  for (int mi = 0; mi < 4; ++mi)
#pragma unroll
    for (int nj = 0; nj < 2; ++nj)
#pragma unroll
      for (int i = 0; i < 16; ++i) acc[mi][nj][i] = 0.f;
  const int nk = K >> 6;
  const int sw = (r32 >> 1) & 7, sh = sw >> 1, lo16 = 16 * (hi ^ (sw & 1));
  const int a_off = (wm * 128 + r32) * 128 + lo16;
  const int b_off = 32768 + (wn * 64 + r32) * 128 + lo16;
  __syncthreads();
  {
    char* sa = smem + dma_off;
#pragma unroll
    for (int j = 0; j < 4; ++j) {
      __builtin_amdgcn_global_load_lds((const unsigned*)(Ab + (size_t)(j * 8 * lda) * 2 + ((j & 1) ? oa1 : oa0)), (unsigned*)(sa + j * 1024), 16, 0, 0);
      __builtin_amdgcn_global_load_lds((const unsigned*)(Bb + (size_t)(j * 8 * ldb) * 2 + ((j & 1) ? ob1 : ob0)), (unsigned*)(sa + 32768 + j * 1024), 16, 0, 0);
    }
  }
  for (int kt = 0; kt < nk; ++kt) {
    __syncthreads();
    if (kt + 1 < nk) {
      char* sa = smem + ((kt + 1) & 1) * 65536 + dma_off;
      const int k0 = (kt + 1) * 64;
#pragma unroll
      for (int j = 0; j < 4; ++j) {
        __builtin_amdgcn_global_load_lds((const unsigned*)(Ab + (size_t)(j * 8 * lda + k0) * 2 + ((j & 1) ? oa1 : oa0)), (unsigned*)(sa + j * 1024), 16, 0, 0);
        __builtin_amdgcn_global_load_lds((const unsigned*)(Bb + (size_t)(j * 8 * ldb + k0) * 2 + ((j & 1) ? ob1 : ob0)), (unsigned*)(sa + 32768 + j * 1024), 16, 0, 0);
      }
    }
    const char* sb = smem + (kt & 1) * 65536;
#pragma unroll
    for (int ks = 0; ks < 4; ++ks) {
      const int koff = 32 * (ks ^ sh);
      bf16x8 af[4], bfr[2];
#pragma unroll
      for (int mi = 0; mi < 4; ++mi) af[mi] = *(const bf16x8*)(sb + a_off + mi * 4096 + koff);
#pragma unroll
      for (int nj = 0; nj < 2; ++nj) bfr[nj] = *(const bf16x8*)(sb + b_off + nj * 4096 + koff);
#pragma unroll
      for (int mi = 0; mi < 4; ++mi)
#pragma unroll
        for (int nj = 0; nj < 2; ++nj) acc[mi][nj] = MFMA32(af[mi], bfr[nj], acc[mi][nj]);
    }
  }
  float* rstd_s = (float*)smem;
  if (NSLOT > 0) {
    __syncthreads();
    if (tid < 256) {
      const float* pr = pin + (size_t)(m0 + tid) * NSLOT;
      float sacc = 0.f;
      if (NSLOT >= 4) {
#pragma unroll
        for (int q = 0; q < NSLOT / 4; ++q) { const f32x4 v = *(const f32x4*)(pr + 4 * q); sacc += (v[0] + v[1]) + (v[2] + v[3]); }
      } else {
#pragma unroll
        for (int q = 0; q < NSLOT; ++q) sacc += pr[q];
      }
      rstd_s[tid] = rsqrtf(sacc / (float)K + 1e-6f);
    }
    __syncthreads();
  }
  int lane2 = lane, w2 = w; asm volatile("" : "+v"(lane2), "+v"(w2));
  epi(acc, m0, (w2 >> 2) * 128, n0 + (w2 & 3) * 64, lane2, rstd_s);
}
DI void row_ssq_put(float v, float* dst, int lane) {
  v += __shfl_xor(v, 1); v += __shfl_xor(v, 2); v += __shfl_xor(v, 4); v += __shfl_xor(v, 8); v += __shfl_xor(v, 16);
  if ((lane & 31) == 0) *dst = v;
}

struct EpiG1 {
  bf16_t *cqkv, *KA, *qB, *qC; const float *cos32, *sin32, *cos16, *sin16; float qs; float *pq, *pkv;
  DI void operator()(f32x16 (&acc)[4][2], int m0, int lr0, int col0, int lane, const float* rstd_s) const {
    const int c = lane & 31, h = lane >> 5, cb = col0 >> 6;
    if (cb >= 37) return;
#define G1_ROW const int lr = lr0 + mi * 32 + crow(i, h), tok = m0 + lr, b = tok >> 13, s = tok & 8191; (void)b; (void)s; \
               const float rs = rstd_s[lr]; float v0 = acc[mi][0][i] * rs, v1 = acc[mi][1][i] * rs;
    if (cb < 6) {
#pragma unroll
      for (int mi = 0; mi < 4; ++mi)
#pragma unroll
        for (int i = 0; i < 16; ++i) {
        if ((i & 3) == 0) __builtin_amdgcn_sched_barrier(0);
          G1_ROW
          bf16_t* d = cqkv + (size_t)tok * 384 + cb * 64 + c; d[0] = f2bf(v0); d[32] = f2bf(v1);
          row_ssq_put(v0 * v0 + v1 * v1, cb < 4 ? pq + (size_t)tok * 4 + cb : pkv + (size_t)tok * 2 + (cb - 4), lane);
        }
    } else if (cb == 6) {
#pragma unroll
      for (int mi = 0; mi < 4; ++mi)
#pragma unroll
        for (int i = 0; i < 16; ++i) {
        if ((i & 3) == 0) __builtin_amdgcn_sched_barrier(0);
          G1_ROW
          if (c < 16) {
            const float cs = cos16[s * 16 + c], sn = sin16[s * 16 + c];
            const bf16_t o1 = f2bf(v0 * cs - v1 * sn), o2 = f2bf(v0 * sn + v1 * cs);
#pragma unroll
            for (int hd = 0; hd < 6; ++hd) { bf16_t* d = KA + ((size_t)(b * 6 + hd) * SEQ + s) * 96 + 64 + c; d[0] = o1; d[16] = o2; }
          }
        }
    } else if (cb < 25) {
      const int idx = cb - 7, which = idx / 6, hd = idx - which * 6;
      bf16_t* base = qB + (size_t)which * (SZ_H6 / 2) + (size_t)hd * SEQ * 64 + c;
      const float sc = which == 0 ? qs : 1.f;
      if (which < 2) {
#pragma unroll
        for (int mi = 0; mi < 4; ++mi)
#pragma unroll
          for (int i = 0; i < 16; ++i) {
        if ((i & 3) == 0) __builtin_amdgcn_sched_barrier(0);
            G1_ROW
            const float cs = cos32[s * 32 + c] * sc, sn = sin32[s * 32 + c] * sc;
            bf16_t* d = base + ((size_t)(b * 6) * SEQ + s) * 64;
            d[0] = f2bf(v0 * cs - v1 * sn); d[32] = f2bf(v0 * sn + v1 * cs);
          }
      } else {
#pragma unroll
        for (int mi = 0; mi < 4; ++mi)
#pragma unroll
          for (int i = 0; i < 16; ++i) {
        if ((i & 3) == 0) __builtin_amdgcn_sched_barrier(0);
            G1_ROW
            bf16_t* d = base + ((size_t)(b * 6) * SEQ + s) * 64;
            d[0] = f2bf(v0); d[32] = f2bf(v1);
          }
      }
    } else {
      const int idx = cb - 25, which = idx >> 2, hd = idx & 3;
      bf16_t* base = qC + (size_t)which * (SZ_H4 / 2) + (size_t)hd * SEQ * 64 + c;
      const float sc = which == 0 ? qs : 1.f;
#pragma unroll
      for (int mi = 0; mi < 4; ++mi)
#pragma unroll
        for (int i = 0; i < 16; ++i) {
        if ((i & 3) == 0) __builtin_amdgcn_sched_barrier(0);
          G1_ROW
          bf16_t* d = base + ((size_t)(b * 4) * SEQ + s) * 64;
          d[0] = f2bf(v0 * sc); d[32] = f2bf(v1 * sc);
        }
    }
#undef G1_ROW
  }
};
struct EpiUQ {
  bf16_t* QA; const float *cos16, *sin16; float qs;
  DI void operator()(f32x16 (&acc)[4][2], int m0, int lr0, int col0, int lane, const float* rstd_s) const {
    const int c = lane & 31, h = lane >> 5, cb = col0 >> 6;
    if (cb >= 9) return;
#pragma unroll
    for (int mi = 0; mi < 4; ++mi)
#pragma unroll
      for (int i = 0; i < 16; ++i) {
        if ((i & 3) == 0) __builtin_amdgcn_sched_barrier(0);
        const int lr = lr0 + mi * 32 + crow(i, h), tok = m0 + lr, b = tok >> 13, s = tok & 8191;
        const float rs = rstd_s[lr] * qs;
        const float v0 = acc[mi][0][i] * rs, v1 = acc[mi][1][i] * rs;
        if (cb < 6) {
          bf16_t* d = QA + ((size_t)(b * 6 + cb) * SEQ + s) * 96 + c; d[0] = f2bf(v0); d[32] = f2bf(v1);
        } else {
          const int hd = 2 * (cb - 6) + (c >> 4), fi = c & 15;
          const float cs = cos16[s * 16 + fi], sn = sin16[s * 16 + fi];
          bf16_t* d = QA + ((size_t)(b * 6 + hd) * SEQ + s) * 96 + 64 + fi;
          d[0] = f2bf(v0 * cs - v1 * sn); d[16] = f2bf(v0 * sn + v1 * cs);
        }
      }
  }
};
struct EpiUKV {
  bf16_t *KA, *VA;
  DI void operator()(f32x16 (&acc)[4][2], int m0, int lr0, int col0, int lane, const float* rstd_s) const {
    const int c = lane & 31, h = lane >> 5, cb = col0 >> 6, hd = cb >> 1, isv = cb & 1;
#pragma unroll
    for (int mi = 0; mi < 4; ++mi)
#pragma unroll
      for (int i = 0; i < 16; ++i) {
        if ((i & 3) == 0) __builtin_amdgcn_sched_barrier(0);
        const int lr = lr0 + mi * 32 + crow(i, h), tok = m0 + lr, b = tok >> 13, s = tok & 8191;
        const float rs = rstd_s[lr];
        const float v0 = acc[mi][0][i] * rs, v1 = acc[mi][1][i] * rs;
        bf16_t* d = isv ? VA + ((size_t)(b * 6 + hd) * SEQ + s) * 64 + c : KA + ((size_t)(b * 6 + hd) * SEQ + s) * 96 + c;
        d[0] = f2bf(v0); d[32] = f2bf(v1);
      }
  }
};
struct EpiRes {
  bf16_t* xb; float* pout;
  DI void operator()(f32x16 (&acc)[4][2], int m0, int lr0, int col0, int lane, const float* rstd_s) const {
    const int c = lane & 31, h = lane >> 5;
#pragma unroll
    for (int mi = 0; mi < 4; ++mi)
#pragma unroll
      for (int i = 0; i < 16; ++i) {
        if ((i & 3) == 0) __builtin_amdgcn_sched_barrier(0);
        const int row = m0 + lr0 + mi * 32 + crow(i, h);
        const size_t o = (size_t)row * DM + col0 + c;
        const float v0 = bf2f(xb[o]) + acc[mi][0][i], v1 = bf2f(xb[o + 32]) + acc[mi][1][i];
        xb[o] = f2bf(v0); xb[o + 32] = f2bf(v1);
        row_ssq_put(v0 * v0 + v1 * v1, pout + (size_t)row * 16 + (col0 >> 6), lane);
      }
  }
};
struct EpiMlp1 {
  bf16_t* hid;
  DI void operator()(f32x16 (&acc)[4][2], int m0, int lr0, int col0, int lane, const float* rstd_s) const {
    const int c = lane & 31, h = lane >> 5;
#pragma unroll
    for (int mi = 0; mi < 4; ++mi)
#pragma unroll
      for (int i = 0; i < 16; ++i) {
        if ((i & 3) == 0) __builtin_amdgcn_sched_barrier(0);
        const int lr = lr0 + mi * 32 + crow(i, h);
        const float rs = rstd_s[lr];
        const float v0 = fmaxf(acc[mi][0][i] * rs, 0.f), v1 = fmaxf(acc[mi][1][i] * rs, 0.f);
        *(unsigned*)(hid + (size_t)(m0 + lr) * DFF + col0 + 2 * c) = cvtpk(v0 * v0, v1 * v1);
      }
  }
};

struct AttnItem {
  const bf16_t *Q, *K, *V;
  int q0;
  int n0, dil, res, N;
  int nrb, ncb, kr0, kc0;
  bf16_t* out; int ldo;
  float* lse;
  const float* rpb;
};

template <int DQ, int MODE>
DI void attn_block(const AttnItem& it, char* smem, const int tid) {
  constexpr int CPR = DQ / 8, KST = DQ * 2 + 16, KCH = (64 * CPR) / 256, NT = MODE == 0 ? SEQ / 64 : MODE == 1 ? 4 : 8;
  const int lane = tid & 63, w = tid >> 6, r32 = lane & 31, hi = lane >> 5;
  char* Ks = smem; char* Vs = smem + 64 * KST; float* bias_s = (float*)(smem + 64 * KST + 8192);
  const int qi = w * 32 + r32;
  int qpos;
  if (MODE == 0) qpos = it.q0 + qi;
  else if (MODE == 1) qpos = (it.n0 + qi) * it.dil + it.res;
  else qpos = (8 * it.nrb + (qi >> 4)) * 64 + 16 * it.ncb + (qi & 15);
  __syncthreads();
  if (MODE == 2) { for (int i = tid; i < 465; i += 256) bias_s[i] = it.rpb[i] * 1.4426950408889634f; }
  bf16x8 qr[DQ / 16];
#pragma unroll
  for (int d0 = 0; d0 < DQ / 16; ++d0) qr[d0] = *(const bf16x8*)(it.Q + (size_t)qpos * DQ + d0 * 16 + hi * 8);
  f32x16 o[2];
#pragma unroll
  for (int i = 0; i < 16; ++i) { o[0][i] = 0.f; o[1][i] = 0.f; }
  float m_run = -1e30f, l_run = 0.f;
  u32x4 rk[KCH], rv[2];
  auto kpos = [&](int t, int row) -> int {
    if (MODE == 0) return t * 64 + row;
    if (MODE == 1) { int n = it.n0 - 64 + 64 * t + row; n = n < 0 ? 0 : (n > it.N - 1 ? it.N - 1 : n); return n * it.dil + it.res; }
    return (it.kr0 + 2 * t + (row >> 5)) * 64 + it.kc0 + (row & 31);
  };
  auto load = [&](int t) {
#pragma unroll
    for (int i = 0; i < KCH; ++i) { const int c = tid + 256 * i, row = c / CPR, kc = c - row * CPR; rk[i] = *(const u32x4*)(it.K + (size_t)kpos(t, row) * DQ + kc * 8); }
#pragma unroll
    for (int i = 0; i < 2; ++i) { const int c = tid + 256 * i, row = c >> 3, kc = c & 7; rv[i] = *(const u32x4*)(it.V + (size_t)kpos(t, row) * 64 + kc * 8); }
  };
  const int vrd = ((lane >> 5) * 4 + ((lane & 15) >> 2)) * 64 + ((lane >> 4) & 1) * 32 + (lane & 3) * 8;
  load(0);
  for (int t = 0; t < NT; ++t) {
    __syncthreads();
#pragma unroll
    for (int i = 0; i < KCH; ++i) { const int c = tid + 256 * i, row = c / CPR, kc = c - row * CPR; *(u32x4*)(Ks + row * KST + kc * 16) = rk[i]; }
#pragma unroll
    for (int i = 0; i < 2; ++i) { const int c = tid + 256 * i, row = c >> 3, kc = c & 7; *(u32x4*)(Vs + (kc >> 2) * 4096 + row * 64 + (kc & 3) * 16) = rv[i]; }
    __syncthreads();
    if (t + 1 < NT) load(t + 1);
    bool skip = false;
    if (MODE == 1) skip = (w < 2) ? (t == 3) : (t == 0);
    if (MODE == 2) {
      const int rq_lo = 8 * it.nrb + 2 * w, rq_hi = rq_lo + 1;
      const int rs_lo = min(max(rq_lo - 4, 0), 120), rs_hi = min(max(rq_hi - 4, 0), 120) + 7;
      const int kr = it.kr0 + 2 * t;
      skip = (kr + 1 < rs_lo) || (kr > rs_hi);
    }
    if (skip) continue;
    f32x16 p0, p1;
#pragma unroll
    for (int i = 0; i < 16; ++i) { p0[i] = 0.f; p1[i] = 0.f; }
#pragma unroll
    for (int d0 = 0; d0 < DQ / 16; ++d0) {
      const bf16x8 k0 = *(const bf16x8*)(Ks + r32 * KST + d0 * 32 + hi * 16);
      const bf16x8 k1 = *(const bf16x8*)(Ks + (32 + r32) * KST + d0 * 32 + hi * 16);
      p0 = MFMA32(k0, qr[d0], p0); p1 = MFMA32(k1, qr[d0], p1);
    }
    if (MODE == 1) {
      const int nq = it.n0 + qi, kb = it.n0 - 64 + 64 * t;
#pragma unroll
      for (int i = 0; i < 16; ++i) {
        const int nk = kb + crow(i, hi), nk2 = nk + 32;
        const int d1 = nq - nk, d2 = nq - nk2;
        const bool ok1 = (d1 <= 64) && (d1 >= -64) && (nk >= 0) && (nk < it.N);
        const bool ok2 = (d2 <= 64) && (d2 >= -64) && (nk2 >= 0) && (nk2 < it.N);
        p0[i] = ok1 ? p0[i] : -INFINITY; p1[i] = ok2 ? p1[i] : -INFINITY;
      }
    }
    if (MODE == 2) {
      const int rq = 8 * it.nrb + (qi >> 4), cq = 16 * it.ncb + (qi & 15);
      const int rs_ = min(max(rq - 4, 0), 120), cs_ = min(max(cq - 8, 0), 48);
      const int kr = it.kr0 + 2 * t;
      const bool okr0 = (kr >= rs_) && (kr < rs_ + 8), okr1 = (kr + 1 >= rs_) && (kr + 1 < rs_ + 8);
      const int bi0 = (kr - rq + 7) * 31 - cq + 15;
#pragma unroll
      for (int i = 0; i < 16; ++i) {
        const int kc = it.kc0 + crow(i, hi);
        const bool okc = (kc >= cs_) && (kc < cs_ + 16);
        const bool ok0 = okc && okr0, ok1 = okc && okr1;
        const float b0 = bias_s[ok0 ? bi0 + kc : 0], b1 = bias_s[ok1 ? bi0 + 31 + kc : 0];
        p0[i] = ok0 ? p0[i] + b0 : -INFINITY; p1[i] = ok1 ? p1[i] + b1 : -INFINITY;
      }
    }
    float pmax = p0[0];
#pragma unroll
    for (int i = 1; i < 16; ++i) pmax = fmaxf(pmax, p0[i]);
#pragma unroll
    for (int i = 0; i < 16; ++i) pmax = fmaxf(pmax, p1[i]);
    pmax = swap_max(pmax);
    const float mn = fmaxf(m_run, pmax);
    const float alpha = __builtin_amdgcn_exp2f(m_run - mn);
    m_run = mn;
    float ps = 0.f;
#pragma unroll
    for (int i = 0; i < 16; ++i) { p0[i] = __builtin_amdgcn_exp2f(p0[i] - mn); ps += p0[i]; }
#pragma unroll
    for (int i = 0; i < 16; ++i) { p1[i] = __builtin_amdgcn_exp2f(p1[i] - mn); ps += p1[i]; }
    ps = swap_sum(ps);
    l_run = l_run * alpha + ps;
#pragma unroll
    for (int i = 0; i < 16; ++i) { o[0][i] *= alpha; o[1][i] *= alpha; }
    bf16x8 pb[4];
#pragma unroll
    for (int s = 0; s < 2; ++s) {
      u32x4 a = {cvtpk(p0[8 * s], p0[8 * s + 1]), cvtpk(p0[8 * s + 2], p0[8 * s + 3]), cvtpk(p0[8 * s + 4], p0[8 * s + 5]), cvtpk(p0[8 * s + 6], p0[8 * s + 7])};
      u32x4 b = {cvtpk(p1[8 * s], p1[8 * s + 1]), cvtpk(p1[8 * s + 2], p1[8 * s + 3]), cvtpk(p1[8 * s + 4], p1[8 * s + 5]), cvtpk(p1[8 * s + 6], p1[8 * s + 7])};
      pb[s] = __builtin_bit_cast(bf16x8, a); pb[2 + s] = __builtin_bit_cast(bf16x8, b);
    }
#pragma unroll
    for (int db = 0; db < 2; ++db)
#pragma unroll
      for (int s = 0; s < 4; ++s) {
        const s16x4 lo = __builtin_amdgcn_ds_read_tr16_b64_v4i16((lds_s16x4*)(Vs + db * 4096 + (16 * s) * 64 + vrd));
        const s16x4 hh = __builtin_amdgcn_ds_read_tr16_b64_v4i16((lds_s16x4*)(Vs + db * 4096 + (16 * s + 8) * 64 + vrd));
        const bf16x8 a = {lo[0], lo[1], lo[2], lo[3], hh[0], hh[1], hh[2], hh[3]};
        o[db] = MFMA32(a, pb[s], o[db]);
      }
  }
  const float inv = 1.f / l_run;
  const int bq = qpos;
  bf16_t* orow = it.out + (size_t)bq * it.ldo;
#pragma unroll
  for (int db = 0; db < 2; ++db)
#pragma unroll
    for (int g = 0; g < 4; ++g) {
      u32x2 v = {cvtpk(o[db][4 * g] * inv, o[db][4 * g + 1] * inv), cvtpk(o[db][4 * g + 2] * inv, o[db][4 * g + 3] * inv)};
      *(u32x2*)(orow + db * 32 + 8 * g + 4 * hi) = v;
    }
  if (MODE == 1) { if (hi == 0) it.lse[(size_t)bq * 6] = m_run + __builtin_amdgcn_logf(l_run); }
}

DI void attn_dense_skew(const bf16_t* __restrict__ Q, const bf16_t* __restrict__ K, const bf16_t* __restrict__ V, int q0, bf16_t* __restrict__ out,
                        char* smem, const int tid512, const int grp) {
  constexpr int DQ = 96, CPR = 12, KST = 208, NT = SEQ / 64, KB = 64 * KST, VOFF = 2 * KB;
  const int lane = tid512 & 63, w = (tid512 >> 6) & 3, r32 = lane & 31, hi = lane >> 5;
  const int qpos = q0 + w * 32 + r32;
  bf16x8 qr[DQ / 16];
#pragma unroll
  for (int d0 = 0; d0 < DQ / 16; ++d0) qr[d0] = *(const bf16x8*)(Q + (size_t)qpos * DQ + d0 * 16 + hi * 8);
  f32x16 o[2];
#pragma unroll
  for (int i = 0; i < 16; ++i) { o[0][i] = 0.f; o[1][i] = 0.f; }
  float m_run = -1e30f, l_run = 0.f;
  const int kr0 = tid512 / CPR, kc0 = tid512 - kr0 * CPR, c1 = tid512 + 512, kr1 = c1 / CPR, kc1 = c1 - kr1 * CPR, vr = tid512 >> 3, vc = tid512 & 7;
  const bool two = tid512 < 256;
  const bf16_t* Kp0 = K + (size_t)kr0 * DQ + kc0 * 8; const bf16_t* Kp1 = K + (size_t)kr1 * DQ + kc1 * 8; const bf16_t* Vp = V + (size_t)vr * 64 + vc * 8;
  const int ks0 = kr0 * KST + kc0 * 16, ks1 = kr1 * KST + kc1 * 16, vs0 = VOFF + (vc >> 2) * 4096 + vr * 64 + (vc & 3) * 16;
  u32x4 rk0, rk1 = u32x4{0u, 0u, 0u, 0u}, rv;
  auto load = [&](int t) {
    const size_t ro = (size_t)t * 64;
    rk0 = *(const u32x4*)(Kp0 + ro * DQ); if (two) rk1 = *(const u32x4*)(Kp1 + ro * DQ); rv = *(const u32x4*)(Vp + ro * 64);
  };
  auto store = [&](int kb, int vb) {
    char* kbp = smem + kb * KB;
    *(u32x4*)(kbp + ks0) = rk0; if (two) *(u32x4*)(kbp + ks1) = rk1; *(u32x4*)(smem + vb * 8192 + vs0) = rv;
  };
  const int vrd = ((lane >> 5) * 4 + ((lane & 15) >> 2)) * 64 + ((lane >> 4) & 1) * 32 + (lane & 3) * 8;
  __syncthreads();
  load(0); store(0, 0); load(1);
  __syncthreads();
  if (grp == 1) __syncthreads();
  int vcur = 0;
  for (int t = 0; t < NT; ++t) {
    const int vnext = vcur == 2 ? 0 : vcur + 1;
    const char* Ks = smem + (t & 1) * KB; const char* Vs = smem + VOFF + vcur * 8192;
    if (t + 1 < NT) store((t + 1) & 1, vnext);
    if (t + 2 < NT) load(t + 2);
    f32x16 p0, p1;
#pragma unroll
    for (int i = 0; i < 16; ++i) { p0[i] = 0.f; p1[i] = 0.f; }
    {
      const char* kp = Ks + r32 * KST + hi * 16;
      bf16x8 ka[2][2];
      ka[0][0] = *(const bf16x8*)(kp); ka[0][1] = *(const bf16x8*)(kp + 32 * KST);
      ka[1][0] = *(const bf16x8*)(kp + 32); ka[1][1] = *(const bf16x8*)(kp + 32 * KST + 32);
#pragma unroll
      for (int d0 = 0; d0 < DQ / 16; ++d0) {
        p0 = MFMA32(ka[d0 & 1][0], qr[d0], p0); p1 = MFMA32(ka[d0 & 1][1], qr[d0], p1);
        if (d0 + 2 < DQ / 16) { ka[d0 & 1][0] = *(const bf16x8*)(kp + (d0 + 2) * 32); ka[d0 & 1][1] = *(const bf16x8*)(kp + 32 * KST + (d0 + 2) * 32); }
      }
    }
    float pmax = p0[0];
#pragma unroll
    for (int i = 1; i < 16; ++i) pmax = fmaxf(pmax, p0[i]);
#pragma unroll
    for (int i = 0; i < 16; ++i) pmax = fmaxf(pmax, p1[i]);
    pmax = swap_max(pmax);
    {
      const float mn = fmaxf(m_run, pmax);
      const float alpha = __builtin_amdgcn_exp2f(m_run - mn);
      m_run = mn; l_run *= alpha;
#pragma unroll
      for (int i = 0; i < 16; ++i) { o[0][i] *= alpha; o[1][i] *= alpha; }
    }
    asm volatile("" : "+v"(p0), "+v"(p1), "+v"(o[0]), "+v"(o[1]), "+v"(m_run));
    __syncthreads();
    asm volatile("" : "+v"(p0), "+v"(p1), "+v"(o[0]), "+v"(o[1]), "+v"(m_run));
    s16x4 vlo[4], vhi[4];
#pragma unroll
    for (int s2 = 0; s2 < 4; ++s2) {
      vlo[s2] = __builtin_amdgcn_ds_read_tr16_b64_v4i16((lds_s16x4*)(Vs + (16 * s2) * 64 + vrd));
      vhi[s2] = __builtin_amdgcn_ds_read_tr16_b64_v4i16((lds_s16x4*)(Vs + (16 * s2 + 8) * 64 + vrd));
    }
    float ps = 0.f;
#pragma unroll
    for (int i = 0; i < 16; ++i) { p0[i] = __builtin_amdgcn_exp2f(p0[i] - m_run); ps += p0[i]; }
#pragma unroll
    for (int i = 0; i < 16; ++i) { p1[i] = __builtin_amdgcn_exp2f(p1[i] - m_run); ps += p1[i]; }
    l_run += swap_sum(ps);
    bf16x8 pb[4];
#pragma unroll
    for (int s = 0; s < 2; ++s) {
      u32x4 a = {cvtpk(p0[8 * s], p0[8 * s + 1]), cvtpk(p0[8 * s + 2], p0[8 * s + 3]), cvtpk(p0[8 * s + 4], p0[8 * s + 5]), cvtpk(p0[8 * s + 6], p0[8 * s + 7])};
      u32x4 b = {cvtpk(p1[8 * s], p1[8 * s + 1]), cvtpk(p1[8 * s + 2], p1[8 * s + 3]), cvtpk(p1[8 * s + 4], p1[8 * s + 5]), cvtpk(p1[8 * s + 6], p1[8 * s + 7])};
      pb[s] = __builtin_bit_cast(bf16x8, a); pb[2 + s] = __builtin_bit_cast(bf16x8, b);
    }
    {
      s16x4 wlo[4], whi[4];
#pragma unroll
      for (int s2 = 0; s2 < 4; ++s2) {
        wlo[s2] = __builtin_amdgcn_ds_read_tr16_b64_v4i16((lds_s16x4*)(Vs + 4096 + (16 * s2) * 64 + vrd));
        whi[s2] = __builtin_amdgcn_ds_read_tr16_b64_v4i16((lds_s16x4*)(Vs + 4096 + (16 * s2 + 8) * 64 + vrd));
      }
#pragma unroll
      for (int s2 = 0; s2 < 4; ++s2) { const bf16x8 a = {vlo[s2][0], vlo[s2][1], vlo[s2][2], vlo[s2][3], vhi[s2][0], vhi[s2][1], vhi[s2][2], vhi[s2][3]}; o[0] = MFMA32(a, pb[s2], o[0]); }
#pragma unroll
      for (int s2 = 0; s2 < 4; ++s2) { const bf16x8 a = {wlo[s2][0], wlo[s2][1], wlo[s2][2], wlo[s2][3], whi[s2][0], whi[s2][1], whi[s2][2], whi[s2][3]}; o[1] = MFMA32(a, pb[s2], o[1]); }
    }
    asm volatile("" : "+v"(o[0]), "+v"(o[1]));
    __syncthreads();
    asm volatile("" : "+v"(o[0]), "+v"(o[1]));
    vcur = vnext;
  }
  if (grp == 0) __syncthreads();
  const float inv = 1.f / l_run;
  bf16_t* orow = out + (size_t)qpos * 384;
#pragma unroll
  for (int db = 0; db < 2; ++db)
#pragma unroll
    for (int g = 0; g < 4; ++g) {
      u32x2 v = {cvtpk(o[db][4 * g] * inv, o[db][4 * g + 1] * inv), cvtpk(o[db][4 * g + 2] * inv, o[db][4 * g + 3] * inv)};
      *(u32x2*)(orow + db * 32 + 8 * g + 4 * hi) = v;
    }
}

DI float wave_sum(float v) {
  v += __shfl_xor(v, 32); v += __shfl_xor(v, 16); v += __shfl_xor(v, 8); v += __shfl_xor(v, 4); v += __shfl_xor(v, 2); v += __shfl_xor(v, 1); return v;
}
DI float gain_of(const Params& p, int kind, int l, int k) {
  switch (kind) {
    case 0: return p.g_mix[l * 1024 + k];
    case 1: return p.q_norm[l * 256 + k];
    case 2: return p.kv_norm[l * 128 + k];
    case 3: return k < 384 ? p.on_a[l * 384 + k] : (k < 768 ? p.on_b[l * 384 + k - 384] : p.on_c[l * 256 + k - 768]);
    case 4: return p.g_mlp[l * 1024 + k];
    default: return 1.f;
  }
}
DI int map_col(int kind, int n) {
  if (kind == 0) {
    if (n < 384) return n;
    if (n < 448) { const int wv = n - 384, c = wv & 31, sub = wv >> 5; return c < 16 ? 384 + sub * 16 + c : -1; }
    if (n < 1600) return 416 + (n - 448);
    if (n < 2368) return 1568 + (n - 1600);
    return -1;
  }
  if (kind == 1) {
    if (n < 384) return (n >> 6) * 96 + (n & 63);
    if (n < 576) { const int wv = n - 384, g = wv >> 6, wi = wv & 63, sub = wi >> 5, c = wi & 31, hd = 2 * g + (c >> 4), fi = c & 15; return hd * 96 + 64 + sub * 16 + fi; }
    return -1;
  }
  return n;
}
DI void wtile(const Params& p, const float* src, int Nsrc, bf16_t* dst, int K, int kt, int nt, int kind, int l, char* smem, const int tid) {
  float* tile = (float*)smem;
  const int lane = tid & 63, wv = tid >> 6;
  __syncthreads();
  const int n = nt * 64 + lane, sc = map_col(kind, n);
#pragma unroll 4
  for (int r = 0; r < 8; ++r) {
    const int kl = r * 8 + wv, kd = kt * 64 + kl;
    const int k = kind == 5 ? ((kd & ~63) | ((kd & 1) << 5) | ((kd & 63) >> 1)) : kd;
    float v = 0.f;
    if (sc >= 0) v = src[(size_t)k * Nsrc + sc] * gain_of(p, kind, l, k);
    tile[kl * 65 + lane] = v;
  }
  __syncthreads();
#pragma unroll 4
  for (int r = 0; r < 8; ++r) {
    const int nl = r * 8 + wv;
    dst[(size_t)(nt * 64 + nl) * K + kt * 64 + lane] = f2bf(tile[lane * 65 + nl]);
  }
}

NI void phase_prep() {
  const Params& p = kparams(); char* smem = g_smem; const int tid = otid(), bid = obid();
  char* ws = p.ws;
  constexpr int T_WIN = (N_IN_PAD / 64) * 16, T_WUQ = (N_UQ_PAD / 64) * 4, T_WUKV = (N_UKV / 64) * 2, T_WOUT = 16 * 16, T_W1 = 64 * 16, T_W2 = 16 * 64;
  constexpr int T_L = T_WIN + T_WUQ + T_WUKV + T_WOUT + T_W1 + T_W2;
  for (int j = bid; j < NLAYER * T_L; j += gridDim.x) {
    const int l = j / T_L; int r = j - l * T_L;
    char* lw = ws + OFF_W + (size_t)l * LW_SIZE;
    if (r < T_WIN) { wtile(p, p.w_in + (size_t)l * 1024 * 2336, 2336, (bf16_t*)(lw + LW_WIN), 1024, r & 15, r >> 4, 0, l, smem, tid); continue; }
    r -= T_WIN;
    if (r < T_WUQ) { wtile(p, p.w_uq + (size_t)l * 256 * 576, 576, (bf16_t*)(lw + LW_WUQ), 256, r & 3, r >> 2, 1, l, smem, tid); continue; }
    r -= T_WUQ;
    if (r < T_WUKV) { wtile(p, p.w_ukv + (size_t)l * 128 * 768, 768, (bf16_t*)(lw + LW_WUKV), 128, r & 1, r >> 1, 2, l, smem, tid); continue; }
    r -= T_WUKV;
    if (r < T_WOUT) { wtile(p, p.w_out + (size_t)l * 1024 * 1024, 1024, (bf16_t*)(lw + LW_WOUT), 1024, r & 15, r >> 4, 3, l, smem, tid); continue; }
    r -= T_WOUT;
    if (r < T_W1) { wtile(p, p.w_mlp_in + (size_t)l * 1024 * 4096, 4096, (bf16_t*)(lw + LW_W1), 1024, r & 15, r >> 4, 4, l, smem, tid); continue; }
    r -= T_W1;
    wtile(p, p.w_mlp_out + (size_t)l * 4096 * 1024, 1024, (bf16_t*)(lw + LW_W2), 4096, r & 63, r >> 6, 5, l, smem, tid);
  }
  const size_t gtid = (size_t)bid * NTHR + tid, gsz = (size_t)gridDim.x * NTHR;
  bf16_t* xb = (bf16_t*)(ws + OFF_XB);
  {
    const int lane = tid & 63, gw = bid * (NTHR / 64) + (tid >> 6), nw = gridDim.x * (NTHR / 64);
    float* px1 = (float*)(ws + OFF_PX1);
    for (int row = gw; row < NTOK; row += nw) {
      float ss = 0.f;
#pragma unroll
      for (int j = 0; j < 4; ++j) {
        const f32x4 a = *(const f32x4*)(p.x + (size_t)row * DM + j * 256 + lane * 4);
        ss += a[0] * a[0] + a[1] * a[1] + a[2] * a[2] + a[3] * a[3];
        u32x2 o = {cvtpk(a[0], a[1]), cvtpk(a[2], a[3])};
        *(u32x2*)(xb + (size_t)row * DM + j * 256 + lane * 4) = o;
      }
      ss = wave_sum(ss);
      if (lane < 16) px1[(size_t)row * 16 + lane] = lane == 0 ? ss : 0.f;
    }
  }
  float* c32 = (float*)(ws + OFF_COS32); float* s32 = (float*)(ws + OFF_SIN32); float* c16 = (float*)(ws + OFF_COS16); float* s16 = (float*)(ws + OFF_SIN16);
  for (size_t i = gtid; i < (size_t)SEQ * 48; i += gsz) {
    int pos, fi; float invf; float *cd, *sd;
    if (i < (size_t)SEQ * 32) { pos = (int)(i >> 5); fi = (int)(i & 31); invf = __builtin_amdgcn_exp2f(-(float)fi * (13.287712379549449f / 32.f)); cd = c32 + i; sd = s32 + i; }
    else { const size_t j = i - (size_t)SEQ * 32; pos = (int)(j >> 4); fi = (int)(j & 15); invf = __builtin_amdgcn_exp2f(-(float)fi * (13.287712379549449f / 16.f)); cd = c16 + j; sd = s16 + j; }
    const float ang = (float)pos * invf;
    const double rev = (double)ang * 0.15915494309189535;
    const float fr = (float)(rev - rint(rev));
    *cd = __builtin_amdgcn_cosf(fr); *sd = __builtin_amdgcn_sinf(fr);
  }
}

NI void phase_g1(int l_) {
  const Params& p = kparams(); char* smem = g_smem; const int l = __builtin_amdgcn_readfirstlane(l_); const int tid = otid(), bid = obid(); (void)tid; (void)bid;
  char* ws = p.ws;
  EpiG1 e;
  e.cqkv = (bf16_t*)(ws + OFF_CQKV); e.KA = (bf16_t*)(ws + OFF_KA); e.qB = (bf16_t*)(ws + OFF_QB); e.qC = (bf16_t*)(ws + OFF_QC);
  e.cos32 = (const float*)(ws + OFF_COS32); e.sin32 = (const float*)(ws + OFF_SIN32); e.cos16 = (const float*)(ws + OFF_COS16); e.sin16 = (const float*)(ws + OFF_SIN16);
  e.qs = p.qscaleB; e.pq = (float*)(ws + OFF_PQ); e.pkv = (float*)(ws + OFF_PKV);
  const bf16_t* A = (const bf16_t*)(ws + OFF_XB);
  const bf16_t* Bt = (const bf16_t*)(ws + OFF_W + (size_t)l * LW_SIZE + LW_WIN);
  constexpr int NNT = N_IN_PAD / 256;
  FOR_TILES(NNT, mt, nt, gemm_tile<16>(A, 1024, Bt, 1024, 1024, mt * 256, nt * 256, e, tid, (const float*)(ws + OFF_PX1));)
}
NI void phase_g2(int l_) {
  const Params& p = kparams(); char* smem = g_smem; const int l = __builtin_amdgcn_readfirstlane(l_); const int tid = otid(), bid = obid(); (void)tid; (void)bid;
  char* ws = p.ws;
  const bf16_t* A = (const bf16_t*)(ws + OFF_CQKV);
  EpiUQ eq; eq.QA = (bf16_t*)(ws + OFF_QA); eq.cos16 = (const float*)(ws + OFF_COS16); eq.sin16 = (const float*)(ws + OFF_SIN16); eq.qs = p.qscaleA;
  EpiUKV ek; ek.KA = (bf16_t*)(ws + OFF_KA); ek.VA = (bf16_t*)(ws + OFF_VA);
  const bf16_t* Wq = (const bf16_t*)(ws + OFF_W + (size_t)l * LW_SIZE + LW_WUQ);
  const bf16_t* Wkv = (const bf16_t*)(ws + OFF_W + (size_t)l * LW_SIZE + LW_WUKV);
  FOR_TILES(3, mt, nt, gemm_tile<4>(A, 384, Wq, 256, 256, mt * 256, nt * 256, eq, tid, (const float*)(ws + OFF_PQ));)
  FOR_TILES(3, mt, nt, gemm_tile<2>(A + 256, 384, Wkv, 128, 128, mt * 256, nt * 256, ek, tid, (const float*)(ws + OFF_PKV));)
}
NI void phase_attn(int l_) {
  const Params& p = kparams(); char* smem = g_smem; const int l = __builtin_amdgcn_readfirstlane(l_); const int tid = otid(), bid = obid(); (void)tid; (void)bid;
  char* ws = p.ws;
  constexpr int NA = 1536, NBI = 4608, NC = 1024;
  const int grp = tid >> 8, t256 = tid & 255; char* gsm = smem + grp * ATT_LDS;
  for (int i0 = bid * 2; i0 < NA; i0 += gridDim.x * 2) {
    const int i = i0 + grp, xcd = (i >> 1) & 7, j = ((i >> 4) << 1) | (i & 1);
    const int bh = (j >> 6) * 8 + xcd, qb = j & 63, b = bh / 6, h = bh - b * 6;
    attn_dense_skew((const bf16_t*)(ws + OFF_QA) + (size_t)bh * SEQ * 96, (const bf16_t*)(ws + OFF_KA) + (size_t)bh * SEQ * 96, (const bf16_t*)(ws + OFF_VA) + (size_t)bh * SEQ * 64,
                    qb * 128, (bf16_t*)(ws + OFF_OA) + (size_t)b * SEQ * 384 + h * 64, smem, tid, grp);
  }
  for (int i0 = bid * 2; i0 < NBI; i0 += gridDim.x * 2) {
    AttnItem it{};
    const int i = i0 + grp, xcd = (i >> 1) & 7, j = ((i >> 4) << 1) | (i & 1);
    const int g = (j >> 6) * 8 + xcd, c = j & 63, br = g / 24, bh = g - br * 24, b = bh / 6, h = bh - b * 6;
    const int dil = br == 0 ? 1 : (br == 1 ? 4 : 16), cpr = 64 / dil;
    it.Q = (const bf16_t*)(ws + OFF_QB) + (size_t)bh * SEQ * 64; it.K = (const bf16_t*)(ws + OFF_KB) + (size_t)bh * SEQ * 64; it.V = (const bf16_t*)(ws + OFF_VB) + (size_t)bh * SEQ * 64;
    it.dil = dil; it.res = c / cpr; it.n0 = (c - it.res * cpr) * 128; it.N = SEQ / dil;
    it.out = (bf16_t*)(ws + OFF_OB) + (size_t)br * NTOK * 384 + (size_t)b * SEQ * 384 + h * 64; it.ldo = 384;
    it.lse = (float*)(ws + OFF_LSEB) + (size_t)br * NTOK * 6 + (size_t)b * SEQ * 6 + h;
    attn_block<64, 1>(it, gsm, t256);
  }
  for (int i0 = bid * 2; i0 < NC; i0 += gridDim.x * 2) {
    AttnItem it{};
    const int i = i0 + grp, xcd = (i >> 1) & 7, j = ((i >> 4) << 1) | (i & 1);
    const int bh = (j >> 6) * 8 + xcd, blk = j & 63, b = bh >> 2, h = bh & 3;
    it.Q = (const bf16_t*)(ws + OFF_QC) + (size_t)bh * SEQ * 64; it.K = (const bf16_t*)(ws + OFF_KC) + (size_t)bh * SEQ * 64; it.V = (const bf16_t*)(ws + OFF_VC) + (size_t)bh * SEQ * 64;
    it.nrb = blk >> 2; it.ncb = blk & 3;
    it.kr0 = min(max(8 * it.nrb - 4, 0), 112); it.kc0 = min(max(16 * it.ncb - 8, 0), 32);
    it.out = (bf16_t*)(ws + OFF_OC) + (size_t)b * SEQ * 256 + h * 64; it.ldo = 256;
    it.rpb = p.rpb + ((size_t)l * 4 + h) * 465;
    attn_block<64, 2>(it, gsm, t256);
  }
}
NI void phase_mix() {
  const Params& p = kparams(); const int tid = otid(), bid = obid();
  char* ws = p.ws;
  const int lane = tid & 63, gw = bid * (NTHR / 64) + (tid >> 6), nw = gridDim.x * (NTHR / 64);
  const bf16_t* oA = (const bf16_t*)(ws + OFF_OA); const bf16_t* oB = (const bf16_t*)(ws + OFF_OB); const bf16_t* oC = (const bf16_t*)(ws + OFF_OC);
  const float* lse = (const float*)(ws + OFF_LSEB);
  bf16_t* mixed = (bf16_t*)(ws + OFF_MIXED);
  for (int tok = gw; tok < NTOK; tok += nw) {
    float v[16];
    if (lane < 24 || lane >= 48) {
      const bf16_t* src = lane < 24 ? oA + (size_t)tok * 384 + lane * 16 : oC + (size_t)tok * 256 + (lane - 48) * 16;
      const u32x4 a = *(const u32x4*)src, b = *(const u32x4*)(src + 8);
#pragma unroll
      for (int j = 0; j < 4; ++j) { v[2 * j] = bf2f(a[j] & 0xffffu); v[2 * j + 1] = bf2f(a[j] >> 16); v[8 + 2 * j] = bf2f(b[j] & 0xffffu); v[8 + 2 * j + 1] = bf2f(b[j] >> 16); }
    } else {
      const int col = (lane - 24) * 16, hd = col >> 6;
      const float l0 = lse[(size_t)tok * 6 + hd], l1 = lse[(size_t)NTOK * 6 + (size_t)tok * 6 + hd], l2 = lse[(size_t)2 * NTOK * 6 + (size_t)tok * 6 + hd];
      const float mx = fmaxf(l0, fmaxf(l1, l2));
      float w0 = __builtin_amdgcn_exp2f(l0 - mx), w1 = __builtin_amdgcn_exp2f(l1 - mx), w2 = __builtin_amdgcn_exp2f(l2 - mx);
      const float wi = 1.f / (w0 + w1 + w2); w0 *= wi; w1 *= wi; w2 *= wi;
#pragma unroll
      for (int j = 0; j < 16; ++j) v[j] = 0.f;
#pragma unroll
      for (int br = 0; br < 3; ++br) {
        const float wb = br == 0 ? w0 : (br == 1 ? w1 : w2);
        const bf16_t* src = oB + (size_t)br * NTOK * 384 + (size_t)tok * 384 + col;
        const u32x4 a = *(const u32x4*)src, b = *(const u32x4*)(src + 8);
#pragma unroll
        for (int j = 0; j < 4; ++j) { v[2 * j] += wb * bf2f(a[j] & 0xffffu); v[2 * j + 1] += wb * bf2f(a[j] >> 16); v[8 + 2 * j] += wb * bf2f(b[j] & 0xffffu); v[8 + 2 * j + 1] += wb * bf2f(b[j] >> 16); }
      }
    }
    float ss = 0.f;
#pragma unroll
    for (int j = 0; j < 16; ++j) ss += v[j] * v[j];
    const float sa = wave_sum(lane < 24 ? ss : 0.f), sb = wave_sum((lane >= 24 && lane < 48) ? ss : 0.f), sc = wave_sum(lane >= 48 ? ss : 0.f);
    const float rs = lane < 24 ? rsqrtf(sa * (1.f / 384.f) + 1e-6f) : (lane < 48 ? rsqrtf(sb * (1.f / 384.f) + 1e-6f) : rsqrtf(sc * (1.f / 256.f) + 1e-6f));
    u32x4 oa, ob;
#pragma unroll
    for (int j = 0; j < 4; ++j) { oa[j] = cvtpk(v[2 * j] * rs, v[2 * j + 1] * rs); ob[j] = cvtpk(v[8 + 2 * j] * rs, v[8 + 2 * j + 1] * rs); }
    bf16_t* dst = mixed + (size_t)tok * 1024 + lane * 16;
    *(u32x4*)dst = oa; *(u32x4*)(dst + 8) = ob;
  }
}
NI void phase_wout(int l_) {
  const Params& p = kparams(); char* smem = g_smem; const int l = __builtin_amdgcn_readfirstlane(l_); const int tid = otid(), bid = obid(); (void)tid; (void)bid;
  char* ws = p.ws;
  EpiRes e; e.xb = (bf16_t*)(ws + OFF_XB); e.pout = (float*)(ws + OFF_PX2);
  const bf16_t* A = (const bf16_t*)(ws + OFF_MIXED);
  const bf16_t* Bt = (const bf16_t*)(ws + OFF_W + (size_t)l * LW_SIZE + LW_WOUT);
  FOR_TILES(4, mt, nt, gemm_tile<0>(A, 1024, Bt, 1024, 1024, mt * 256, nt * 256, e, tid, nullptr);)
}
NI void phase_mlp1(int l_) {
  const Params& p = kparams(); char* smem = g_smem; const int l = __builtin_amdgcn_readfirstlane(l_); const int tid = otid(), bid = obid(); (void)tid; (void)bid;
  char* ws = p.ws;
  EpiMlp1 e; e.hid = (bf16_t*)(ws + OFF_HID);
  const bf16_t* A = (const bf16_t*)(ws + OFF_XB);
  const bf16_t* Bt = (const bf16_t*)(ws + OFF_W + (size_t)l * LW_SIZE + LW_W1);
  FOR_TILES(16, mt, nt, gemm_tile<16>(A, 1024, Bt, 1024, 1024, mt * 256, nt * 256, e, tid, (const float*)(ws + OFF_PX2));)
}
NI void phase_mlp2(int l_) {
  const Params& p = kparams(); char* smem = g_smem; const int l = __builtin_amdgcn_readfirstlane(l_); const int tid = otid(), bid = obid(); (void)tid; (void)bid;
  char* ws = p.ws;
  EpiRes e; e.xb = (bf16_t*)(ws + OFF_XB); e.pout = (float*)(ws + OFF_PX1);
  const bf16_t* A = (const bf16_t*)(ws + OFF_HID);
  const bf16_t* Bt = (const bf16_t*)(ws + OFF_W + (size_t)l * LW_SIZE + LW_W2);
  FOR_TILES(4, mt, nt, gemm_tile<0>(A, DFF, Bt, DFF, DFF, mt * 256, nt * 256, e, tid, nullptr);)
}
NI void phase_final() {
  const Params& p = kparams(); const int tid = otid(), bid = obid();
  const int lane = tid & 63, gw = bid * (NTHR / 64) + (tid >> 6), nw = gridDim.x * (NTHR / 64);
  const bf16_t* xb = (const bf16_t*)(p.ws + OFF_XB);
  for (int tok = gw; tok < NTOK; tok += nw) {
    float* row = p.out + (size_t)tok * DM;
    f32x4 v[4]; float ss = 0.f;
#pragma unroll
    for (int j = 0; j < 4; ++j) {
      const u32x2 r = *(const u32x2*)(xb + (size_t)tok * DM + j * 256 + lane * 4);
      v[j] = f32x4{bf2f(r[0] & 0xffffu), bf2f(r[0] >> 16), bf2f(r[1] & 0xffffu), bf2f(r[1] >> 16)};
      ss += v[j][0] * v[j][0] + v[j][1] * v[j][1] + v[j][2] * v[j][2] + v[j][3] * v[j][3];
    }
    ss = wave_sum(ss);
    const float rs = rsqrtf(ss * (1.f / 1024.f) + 1e-6f);
#pragma unroll
    for (int j = 0; j < 4; ++j) { const f32x4 g = *(const f32x4*)(p.g_final + j * 256 + lane * 4); f32x4 o = {v[j][0] * rs * g[0], v[j][1] * rs * g[1], v[j][2] * rs * g[2], v[j][3] * rs * g[3]}; *(f32x4*)(row + j * 256 + lane * 4) = o; }
  }
}

constexpr int NPHASE = 2 + 7 * NLAYER;
DI void run_phase(int ph) {
  if (ph == 0) { phase_prep(); return; }
  if (ph == NPHASE - 1) { phase_final(); return; }
  const int l = (ph - 1) / 7, st = (ph - 1) - l * 7;
  switch (st) {
    case 0: phase_g1(l); break;
    case 1: phase_g2(l); break;
    case 2: phase_attn(l); break;
    case 3: phase_mix(); break;
    case 4: phase_wout(l); break;
    case 5: phase_mlp1(l); break;
    default: phase_mlp2(l); break;
  }
}

__global__ void __launch_bounds__(512) mega(Params p, int ph_lo, int ph_hi) {
  cg::grid_group grid = cg::this_grid();
  for (int ph = ph_lo; ph < ph_hi; ++ph) {
    run_phase(ph);
    if (ph + 1 < ph_hi) grid.sync();
  }
}

extern "C" void kernel_launch(void* const* d_in, const int* in_sizes, int n_in, void* d_out, int out_size, void* d_ws, size_t ws_size, hipStream_t stream) {
  static int grid_blocks = 0;
  if (!grid_blocks) {
    int dev = 0, cus = 0, per_cu = 0;
    (void)hipGetDevice(&dev);
    (void)hipDeviceGetAttribute(&cus, hipDeviceAttributeMultiprocessorCount, dev);
    (void)hipOccupancyMaxActiveBlocksPerMultiprocessor(&per_cu, mega, NTHR, 0);
    if (per_cu > 1) per_cu = 1;
    grid_blocks = cus * per_cu;
    if (ws_size < OFF_END) fprintf(stderr, "kernel_launch: workspace too small: %zu < %zu\n", ws_size, (size_t)OFF_END);
  }
  Params p;
  memset(&p, 0, sizeof(p));
  p.x = (const float*)d_in[0]; p.g_mix = (const float*)d_in[1]; p.w_in = (const float*)d_in[2]; p.q_norm = (const float*)d_in[3];
  p.w_uq = (const float*)d_in[4]; p.kv_norm = (const float*)d_in[5]; p.w_ukv = (const float*)d_in[6]; p.rpb = (const float*)d_in[7];
  p.on_a = (const float*)d_in[8]; p.on_b = (const float*)d_in[9]; p.on_c = (const float*)d_in[10]; p.w_out = (const float*)d_in[11];
  p.g_mlp = (const float*)d_in[12]; p.w_mlp_in = (const float*)d_in[13]; p.w_mlp_out = (const float*)d_in[14]; p.g_final = (const float*)d_in[15];
  p.out = (float*)d_out; p.ws = (char*)d_ws;
  p.qscaleA = (float)(1.4426950408889634 / std::sqrt(96.0));
  p.qscaleB = (float)(1.4426950408889634 * 0.125);
#if ONE_LAUNCH
  int lo = 0, hi = NPHASE;
  void* args[] = {&p, &lo, &hi};
  hipError_t e = hipLaunchCooperativeKernel((void*)mega, dim3(grid_blocks), dim3(NTHR), args, 0, stream);
  if (e != hipSuccess) fprintf(stderr, "cooperative launch failed: %s (grid %d)\n", hipGetErrorString(e), grid_blocks);
#else
  for (int ph = 0; ph < NPHASE; ++ph) hipLaunchKernelGGL(mega, dim3(grid_blocks), dim3(NTHR), 0, stream, p, ph, ph + 1);
#endif
}
```

```cpp
#include <hip/hip_runtime.h>
#include <hip/hip_cooperative_groups.h>
#include <cstdio>
#include <cmath>
#include <cstring>
namespace cg = cooperative_groups;

#ifndef ONE_LAUNCH
#define ONE_LAUNCH 1
#endif

#define DI __device__ __forceinline__
typedef unsigned short bf16_t;
typedef short bf16x8 __attribute__((ext_vector_type(8)));
typedef short s16x4 __attribute__((ext_vector_type(4)));
typedef float f32x16 __attribute__((ext_vector_type(16)));
typedef float f32x2 __attribute__((ext_vector_type(2)));
typedef float f32x4 __attribute__((ext_vector_type(4)));
typedef __bf16 bf2_t __attribute__((ext_vector_type(2)));
typedef unsigned u32x4 __attribute__((ext_vector_type(4)));
typedef unsigned u32x2 __attribute__((ext_vector_type(2)));
typedef __attribute__((address_space(3))) s16x4 lds_s16x4;

constexpr int SEQ = 8192, NB = 4, NTOK = NB * SEQ, DM = 1024, NLAYER = 4;
constexpr int N_IN_PAD = 2560, N_UQ_PAD = 768, N_UKV = 768, DFF = 4096;
constexpr int NTHR = 512;

constexpr size_t SZ_XB = (size_t)NTOK * DM * 2;
constexpr size_t SZ_WIN = (size_t)N_IN_PAD * 1024 * 2, SZ_WUQ = (size_t)N_UQ_PAD * 256 * 2, SZ_WUKV = (size_t)N_UKV * 128 * 2,
                 SZ_WOUT = (size_t)1024 * 1024 * 2, SZ_W1 = (size_t)DFF * 1024 * 2, SZ_W2 = (size_t)1024 * DFF * 2;
constexpr size_t LW_WIN = 0, LW_WUQ = LW_WIN + SZ_WIN, LW_WUKV = LW_WUQ + SZ_WUQ, LW_WOUT = LW_WUKV + SZ_WUKV, LW_W1 = LW_WOUT + SZ_WOUT,
                 LW_W2 = LW_W1 + SZ_W1, LW_SIZE = LW_W2 + SZ_W2;
constexpr size_t OFF_XB = 0, OFF_W = OFF_XB + SZ_XB, OFF_TAB = OFF_W + NLAYER * LW_SIZE;
constexpr size_t OFF_COS32 = OFF_TAB, OFF_SIN32 = OFF_COS32 + (size_t)SEQ * 32 * 4, OFF_COS16 = OFF_SIN32 + (size_t)SEQ * 32 * 4,
                 OFF_SIN16 = OFF_COS16 + (size_t)SEQ * 16 * 4, OFF_ATT = OFF_SIN16 + (size_t)SEQ * 16 * 4;
constexpr size_t SZ_T384 = (size_t)NTOK * 384 * 2, SZ_QA = (size_t)NB * 6 * SEQ * 96 * 2, SZ_H6 = (size_t)NB * 6 * SEQ * 64 * 2,
                 SZ_H4 = (size_t)NB * 4 * SEQ * 64 * 2;
constexpr size_t OFF_CQKV = OFF_ATT;
constexpr size_t OFF_OA = OFF_CQKV;
constexpr size_t OFF_QA = OFF_CQKV + SZ_T384, OFF_KA = OFF_QA + SZ_QA, OFF_VA = OFF_KA + SZ_QA;
constexpr size_t OFF_QB = OFF_VA + SZ_H6, OFF_KB = OFF_QB + SZ_H6, OFF_VB = OFF_KB + SZ_H6;
constexpr size_t OFF_QC = OFF_VB + SZ_H6, OFF_KC = OFF_QC + SZ_H4, OFF_VC = OFF_KC + SZ_H4;
constexpr size_t OFF_OB = OFF_VC + SZ_H4, OFF_LSEB = OFF_OB + 3 * SZ_T384, OFF_OC = OFF_LSEB + (size_t)3 * NTOK * 6 * 4;
constexpr size_t OFF_SSQ = OFF_OC + (size_t)NTOK * 256 * 2;
constexpr size_t OFF_PX1 = OFF_SSQ, OFF_PX2 = OFF_PX1 + (size_t)NTOK * 16 * 4, OFF_PQ = OFF_PX2 + (size_t)NTOK * 16 * 4, OFF_PKV = OFF_PQ + (size_t)NTOK * 4 * 4;
constexpr size_t OFF_BAR = OFF_PKV + (size_t)NTOK * 2 * 4;
constexpr size_t OFF_END = OFF_BAR + 256;
constexpr size_t OFF_MIXED = OFF_QA;
constexpr size_t OFF_HID = OFF_ATT;
static_assert(OFF_HID + (size_t)NTOK * DFF * 2 <= OFF_SSQ, "hid fits");
static_assert(OFF_MIXED + (size_t)NTOK * DM * 2 <= OFF_VA, "mixed fits");

struct Params {
  const float *x, *g_mix, *w_in, *q_norm, *w_uq, *kv_norm, *w_ukv, *rpb, *on_a, *on_b, *on_c, *w_out, *g_mlp, *w_mlp_in, *w_mlp_out, *g_final;
  float* out; char* ws;
  float qscaleA, qscaleB;
};
__shared__ __attribute__((aligned(1024))) char g_smem[131072];
#define NI __device__ __forceinline__
DI const Params& kparams() { return *(const Params*)__builtin_amdgcn_kernarg_segment_ptr(); }

DI unsigned cvtpk(float lo, float hi) { f32x2 v = {lo, hi}; bf2_t b = __builtin_convertvector(v, bf2_t); return __builtin_bit_cast(unsigned, b); }
DI bf16_t f2bf(float x) { return (bf16_t)(cvtpk(x, 0.f) & 0xffffu); }
DI float bf2f(unsigned h) { return __uint_as_float(h << 16); }
DI int crow(int i, int h) { return (i & 3) + 8 * (i >> 2) + 4 * h; }
#define MFMA32(a, b, c) __builtin_amdgcn_mfma_f32_32x32x16_bf16((a), (b), (c), 0, 0, 0)
DI float fdot2bf(unsigned a, float c) { bf2_t v = __builtin_bit_cast(bf2_t, a); return __builtin_amdgcn_fdot2_f32_bf16(v, v, c, false); }
DI float swap_max(float v) { auto rr = __builtin_amdgcn_permlane32_swap(__float_as_uint(v), __float_as_uint(v), false, false); return fmaxf(__uint_as_float(rr[0]), __uint_as_float(rr[1])); }
DI float swap_sum(float v) { auto rr = __builtin_amdgcn_permlane32_swap(__float_as_uint(v), __float_as_uint(v), false, false); return __uint_as_float(rr[0]) + __uint_as_float(rr[1]); }

constexpr int ATT_LDS = 53248;
#define FOR_TILES(NN, MT, NT, BODY) { const bool xm_ = gridDim.x == 256; const int st_ = xm_ ? (bid >> 3) : bid, sp_ = xm_ ? 32 : (int)gridDim.x, cn_ = xm_ ? 16 * (NN) : (NTOK / 256) * (NN); \
  for (int j_ = st_; j_ < cn_; j_ += sp_) { int MT = j_ / (NN); const int NT = j_ - MT * (NN); if (xm_) MT += (bid & 7) * 16; BODY } }
DI int otid() { int t = threadIdx.x; asm volatile("" : "+v"(t)); return t; }
DI int obid() { int t = blockIdx.x; asm volatile("" : "+s"(t)); return t; }

template <int NSLOT, class Epi>
DI void gemm_tile(const bf16_t* __restrict__ A, int lda, const bf16_t* __restrict__ Bt, int ldb, int K, int m0, int n0, const Epi& epi, const int tid, const float* pin) {
  const int lane = tid & 63, w = tid >> 6, wm = w >> 2, wn = w & 3, r32 = lane & 31, hi = lane >> 5;
  char* smem = g_smem;
  const int lrow = lane >> 3;
  const int c0 = (lane & 7) ^ (lane >> 4), c1 = (lane & 7) ^ ((lane >> 4) | 4);
  const char* Ab = (const char*)(A + (size_t)m0 * lda);
  const char* Bb = (const char*)(Bt + (size_t)n0 * ldb);
  const unsigned oa0 = (unsigned)(((w * 32 + lrow) * lda + c0 * 8) * 2), oa1 = (unsigned)(((w * 32 + lrow) * lda + c1 * 8) * 2);
  const unsigned ob0 = (unsigned)(((w * 32 + lrow) * ldb + c0 * 8) * 2), ob1 = (unsigned)(((w * 32 + lrow) * ldb + c1 * 8) * 2);
  const int dma_off = (w * 32) * 128 + lane * 16;
  f32x16 acc[4][2];
#pragma unroll
  for (int mi = 0; mi < 4; ++mi)
#pragma unroll
    for (int nj = 0; nj < 2; ++nj)
#pragma unroll
      for (int i = 0; i < 16; ++i) acc[mi][nj][i] = 0.f;
  const int nk = K >> 6;
  const int sw = (r32 >> 1) & 7, sh = sw >> 1, lo16 = 16 * (hi ^ (sw & 1));
  const int a_off = (wm * 128 + r32) * 128 + lo16;
  const int b_off = 32768 + (wn * 64 + r32) * 128 + lo16;
  __syncthreads();
  {
    char* sa = smem + dma_off;
#pragma unroll
    for (int j = 0; j < 4; ++j) {
      __builtin_amdgcn_global_load_lds((const unsigned*)(Ab + (size_t)(j * 8 * lda) * 2 + ((j & 1) ? oa1 : oa0)), (unsigned*)(sa + j * 1024), 16, 0, 0);
      __builtin_amdgcn_global_load_lds((const unsigned*)(Bb + (size_t)(j * 8 * ldb) * 2 + ((j & 1) ? ob1 : ob0)), (unsigned*)(sa + 32768 + j * 1024), 16, 0, 0);
    }
  }
  for (int kt = 0; kt < nk; ++kt) {
    __syncthreads();
    if (kt + 1 < nk) {
      char* sa = smem + ((kt + 1) & 1) * 65536 + dma_off;
      const int k0 = (kt + 1) * 64;
#pragma unroll
      for (int j = 0; j < 4; ++j) {
        __builtin_amdgcn_global_load_lds((const unsigned*)(Ab + (size_t)(j * 8 * lda + k0) * 2 + ((j & 1) ? oa1 : oa0)), (unsigned*)(sa + j * 1024), 16, 0, 0);
        __builtin_amdgcn_global_load_lds((const unsigned*)(Bb + (size_t)(j * 8 * ldb + k0) * 2 + ((j & 1) ? ob1 : ob0)), (unsigned*)(sa + 32768 + j * 1024), 16, 0, 0);
      }
    }
    const char* sb = smem + (kt & 1) * 65536;
#pragma unroll
    for (int ks = 0; ks < 4; ++ks) {
      const int koff = 32 * (ks ^ sh);
      bf16x8 af[4], bfr[2];
#pragma unroll
      for (int mi = 0; mi < 4; ++mi) af[mi] = *(const bf16x8*)(sb + a_off + mi * 4096 + koff);
#pragma unroll
      for (int nj = 0; nj < 2; ++nj) bfr[nj] = *(const bf16x8*)(sb + b_off + nj * 4096 + koff);
#pragma unroll
      for (int mi = 0; mi < 4; ++mi)
#pragma unroll
        for (int nj = 0; nj < 2; ++nj) acc[mi][nj] = MFMA32(af[mi], bfr[nj], acc[mi][nj]);
    }
  }
  float* rstd_s = (float*)smem;
  if (NSLOT > 0) {
    __syncthreads();
    if (tid < 256) {
      const float* pr = pin + (size_t)(m0 + tid) * NSLOT;
      float sacc = 0.f;
      if (NSLOT >= 4) {
#pragma unroll
        for (int q = 0; q < NSLOT / 4; ++q) { const f32x4 v = *(const f32x4*)(pr + 4 * q); sacc += (v[0] + v[1]) + (v[2] + v[3]); }
      } else {
#pragma unroll
        for (int q = 0; q < NSLOT; ++q) sacc += pr[q];
      }
      rstd_s[tid] = rsqrtf(sacc / (float)K + 1e-6f);
    }
    __syncthreads();
  }
  int lane2 = lane, w2 = w; asm volatile("" : "+v"(lane2), "+v"(w2));
  epi(acc, m0, (w2 >> 2) * 128, n0 + (w2 & 3) * 64, lane2, rstd_s);
}
DI void row_ssq_put(float v, float* dst, int lane) {
  v += __shfl_xor(v, 1); v += __shfl_xor(v, 2); v += __shfl_xor(v, 4); v += __shfl_xor(v, 8); v += __shfl_xor(v, 16);
  if ((lane & 31) == 0) *dst = v;
}

struct EpiG1 {
  bf16_t *cqkv, *KA, *qB, *qC; const float *cos32, *sin32, *cos16, *sin16; float qs; float *pq, *pkv;
  DI void operator()(f32x16 (&acc)[4][2], int m0, int lr0, int col0, int lane, const float* rstd_s) const {
    const int c = lane & 31, h = lane >> 5, cb = col0 >> 6;
    if (cb >= 37) return;
#define G1_ROW const int lr = lr0 + mi * 32 + crow(i, h), tok = m0 + lr, b = tok >> 13, s = tok & 8191; (void)b; (void)s; \
               const float rs = rstd_s[lr]; float v0 = acc[mi][0][i] * rs, v1 = acc[mi][1][i] * rs;
    if (cb < 6) {
#pragma unroll
      for (int mi = 0; mi < 4; ++mi)
#pragma unroll
        for (int i = 0; i < 16; ++i) {
        if ((i & 3) == 0) __builtin_amdgcn_sched_barrier(0);
          G1_ROW
          bf16_t* d = cqkv + (size_t)tok * 384 + cb * 64 + c; d[0] = f2bf(v0); d[32] = f2bf(v1);
          row_ssq_put(v0 * v0 + v1 * v1, cb < 4 ? pq + (size_t)tok * 4 + cb : pkv + (size_t)tok * 2 + (cb - 4), lane);
        }
    } else if (cb == 6) {
#pragma unroll
      for (int mi = 0; mi < 4; ++mi)
#pragma unroll
        for (int i = 0; i < 16; ++i) {
        if ((i & 3) == 0) __builtin_amdgcn_sched_barrier(0);
          G1_ROW
          if (c < 16) {
            const float cs = cos16[s * 16 + c], sn = sin16[s * 16 + c];
            const bf16_t o1 = f2bf(v0 * cs - v1 * sn), o2 = f2bf(v0 * sn + v1 * cs);
#pragma unroll
            for (int hd = 0; hd < 6; ++hd) { bf16_t* d = KA + ((size_t)(b * 6 + hd) * SEQ + s) * 96 + 64 + c; d[0] = o1; d[16] = o2; }
          }
        }
    } else if (cb < 25) {
      const int idx = cb - 7, which = idx / 6, hd = idx - which * 6;
      bf16_t* base = qB + (size_t)which * (SZ_H6 / 2) + (size_t)hd * SEQ * 64 + c;
      const float sc = which == 0 ? qs : 1.f;
      if (which < 2) {
#pragma unroll
        for (int mi = 0; mi < 4; ++mi)
#pragma unroll
          for (int i = 0; i < 16; ++i) {
        if ((i & 3) == 0) __builtin_amdgcn_sched_barrier(0);
            G1_ROW
            const float cs = cos32[s * 32 + c] * sc, sn = sin32[s * 32 + c] * sc;
            bf16_t* d = base + ((size_t)(b * 6) * SEQ + s) * 64;
            d[0] = f2bf(v0 * cs - v1 * sn); d[32] = f2bf(v0 * sn + v1 * cs);
          }
      } else {
#pragma unroll
        for (int mi = 0; mi < 4; ++mi)
#pragma unroll
          for (int i = 0; i < 16; ++i) {
        if ((i & 3) == 0) __builtin_amdgcn_sched_barrier(0);
            G1_ROW
            bf16_t* d = base + ((size_t)(b * 6) * SEQ + s) * 64;
            d[0] = f2bf(v0); d[32] = f2bf(v1);
          }
      }
    } else {
      const int idx = cb - 25, which = idx >> 2, hd = idx & 3;
      bf16_t* base = qC + (size_t)which * (SZ_H4 / 2) + (size_t)hd * SEQ * 64 + c;
      const float sc = which == 0 ? qs : 1.f;
#pragma unroll
      for (int mi = 0; mi < 4; ++mi)
#pragma unroll
        for (int i = 0; i < 16; ++i) {
        if ((i & 3) == 0) __builtin_amdgcn_sched_barrier(0);
          G1_ROW
          bf16_t* d = base + ((size_t)(b * 4) * SEQ + s) * 64;
          d[0] = f2bf(v0 * sc); d[32] = f2bf(v1 * sc);
        }
    }
#undef G1_ROW
  }
};
struct EpiUQ {
  bf16_t* QA; const float *cos16, *sin16; float qs;
  DI void operator()(f32x16 (&acc)[4][2], int m0, int lr0, int col0, int lane, const float* rstd_s) const {
    const int c = lane & 31, h = lane >> 5, cb = col0 >> 6;
    if (cb >= 9) return;
#pragma unroll
    for (int mi = 0; mi < 4; ++mi)
#pragma unroll
      for (int i = 0; i < 16; ++i) {
        if ((i & 3) == 0) __builtin_amdgcn_sched_barrier(0);
        const int lr = lr0 + mi * 32 + crow(i, h), tok = m0 + lr, b = tok >> 13, s = tok & 8191;
        const float rs = rstd_s[lr] * qs;
        const float v0 = acc[mi][0][i] * rs, v1 = acc[mi][1][i] * rs;
        if (cb < 6) {
          bf16_t* d = QA + ((size_t)(b * 6 + cb) * SEQ + s) * 96 + c; d[0] = f2bf(v0); d[32] = f2bf(v1);
        } else {
          const int hd = 2 * (cb - 6) + (c >> 4), fi = c & 15;
          const float cs = cos16[s * 16 + fi], sn = sin16[s * 16 + fi];
          bf16_t* d = QA + ((size_t)(b * 6 + hd) * SEQ + s) * 96 + 64 + fi;
          d[0] = f2bf(v0 * cs - v1 * sn); d[16] = f2bf(v0 * sn + v1 * cs);
        }
      }
  }
};
struct EpiUKV {
  bf16_t *KA, *VA;
  DI void operator()(f32x16 (&acc)[4][2], int m0, int lr0, int col0, int lane, const float* rstd_s) const {
    const int c = lane & 31, h = lane >> 5, cb = col0 >> 6, hd = cb >> 1, isv = cb & 1;
#pragma unroll
    for (int mi = 0; mi < 4; ++mi)
#pragma unroll
      for (int i = 0; i < 16; ++i) {
        if ((i & 3) == 0) __builtin_amdgcn_sched_barrier(0);
        const int lr = lr0 + mi * 32 + crow(i, h), tok = m0 + lr, b = tok >> 13, s = tok & 8191;
        const float rs = rstd_s[lr];
        const float v0 = acc[mi][0][i] * rs, v1 = acc[mi][1][i] * rs;
        bf16_t* d = isv ? VA + ((size_t)(b * 6 + hd) * SEQ + s) * 64 + c : KA + ((size_t)(b * 6 + hd) * SEQ + s) * 96 + c;
        d[0] = f2bf(v0); d[32] = f2bf(v1);
      }
  }
};
struct EpiRes {
  bf16_t* xb; float* pout;
  DI void operator()(f32x16 (&acc)[4][2], int m0, int lr0, int col0, int lane, const float* rstd_s) const {
    const int c = lane & 31, h = lane >> 5;
#pragma unroll
    for (int mi = 0; mi < 4; ++mi)
#pragma unroll
      for (int i = 0; i < 16; ++i) {
        if ((i & 3) == 0) __builtin_amdgcn_sched_barrier(0);
        const int row = m0 + lr0 + mi * 32 + crow(i, h);
        const size_t o = (size_t)row * DM + col0 + c;
        const float v0 = bf2f(xb[o]) + acc[mi][0][i], v1 = bf2f(xb[o + 32]) + acc[mi][1][i];
        xb[o] = f2bf(v0); xb[o + 32] = f2bf(v1);
        row_ssq_put(v0 * v0 + v1 * v1, pout + (size_t)row * 16 + (col0 >> 6), lane);
      }
  }
};
struct EpiMlp1 {
  bf16_t* hid;
  DI void operator()(f32x16 (&acc)[4][2], int m0, int lr0, int col0, int lane, const float* rstd_s) const {
    const int c = lane & 31, h = lane >> 5;
#pragma unroll
    for (int mi = 0; mi < 4; ++mi)
#pragma unroll
      for (int i = 0; i < 16; ++i) {
        if ((i & 3) == 0) __builtin_amdgcn_sched_barrier(0);
        const int lr = lr0 + mi * 32 + crow(i, h);
        const float rs = rstd_s[lr];
        const float v0 = fmaxf(acc[mi][0][i] * rs, 0.f), v1 = fmaxf(acc[mi][1][i] * rs, 0.f);
        *(unsigned*)(hid + (size_t)(m0 + lr) * DFF + col0 + 2 * c) = cvtpk(v0 * v0, v1 * v1);
      }
  }
};

struct AttnItem {
  const bf16_t *Q, *K, *V;
  int q0;
  int n0, dil, res, N;
  int nrb, ncb, kr0, kc0;
  bf16_t* out; int ldo;
  float* lse;
  const float* rpb;
};

template <int DQ, int MODE>
DI void attn_block(const AttnItem& it, char* smem, const int tid) {
  constexpr int CPR = DQ / 8, KST = DQ * 2 + 16, KCH = (64 * CPR) / 256, NT = MODE == 0 ? SEQ / 64 : MODE == 1 ? 4 : 8;
  const int lane = tid & 63, w = tid >> 6, r32 = lane & 31, hi = lane >> 5;
  char* Ks = smem; char* Vs = smem + 64 * KST; float* bias_s = (float*)(smem + 64 * KST + 8192);
  const int qi = w * 32 + r32;
  int qpos;
  if (MODE == 0) qpos = it.q0 + qi;
  else if (MODE == 1) qpos = (it.n0 + qi) * it.dil + it.res;
  else qpos = (8 * it.nrb + (qi >> 4)) * 64 + 16 * it.ncb + (qi & 15);
  __syncthreads();
  if (MODE == 2) { for (int i = tid; i < 465; i += 256) bias_s[i] = it.rpb[i] * 1.4426950408889634f; }
  bf16x8 qr[DQ / 16];
#pragma unroll
  for (int d0 = 0; d0 < DQ / 16; ++d0) qr[d0] = *(const bf16x8*)(it.Q + (size_t)qpos * DQ + d0 * 16 + hi * 8);
  f32x16 o[2];
#pragma unroll
  for (int i = 0; i < 16; ++i) { o[0][i] = 0.f; o[1][i] = 0.f; }
  float m_run = -1e30f, l_run = 0.f;
  u32x4 rk[KCH], rv[2];
  auto kpos = [&](int t, int row) -> int {
    if (MODE == 0) return t * 64 + row;
    if (MODE == 1) { int n = it.n0 - 64 + 64 * t + row; n = n < 0 ? 0 : (n > it.N - 1 ? it.N - 1 : n); return n * it.dil + it.res; }
    return (it.kr0 + 2 * t + (row >> 5)) * 64 + it.kc0 + (row & 31);
  };
  auto load = [&](int t) {
#pragma unroll
    for (int i = 0; i < KCH; ++i) { const int c = tid + 256 * i, row = c / CPR, kc = c - row * CPR; rk[i] = *(const u32x4*)(it.K + (size_t)kpos(t, row) * DQ + kc * 8); }
#pragma unroll
    for (int i = 0; i < 2; ++i) { const int c = tid + 256 * i, row = c >> 3, kc = c & 7; rv[i] = *(const u32x4*)(it.V + (size_t)kpos(t, row) * 64 + kc * 8); }
  };
  const int vrd = ((lane >> 5) * 4 + ((lane & 15) >> 2)) * 64 + ((lane >> 4) & 1) * 32 + (lane & 3) * 8;
  load(0);
  for (int t = 0; t < NT; ++t) {
    __syncthreads();
#pragma unroll
    for (int i = 0; i < KCH; ++i) { const int c = tid + 256 * i, row = c / CPR, kc = c - row * CPR; *(u32x4*)(Ks + row * KST + kc * 16) = rk[i]; }
#pragma unroll
    for (int i = 0; i < 2; ++i) { const int c = tid + 256 * i, row = c >> 3, kc = c & 7; *(u32x4*)(Vs + (kc >> 2) * 4096 + row * 64 + (kc & 3) * 16) = rv[i]; }
    __syncthreads();
    if (t + 1 < NT) load(t + 1);
    bool skip = false;
    if (MODE == 1) skip = (w < 2) ? (t == 3) : (t == 0);
    if (MODE == 2) {
      const int rq_lo = 8 * it.nrb + 2 * w, rq_hi = rq_lo + 1;
      const int rs_lo = min(max(rq_lo - 4, 0), 120), rs_hi = min(max(rq_hi - 4, 0), 120) + 7;
      const int kr = it.kr0 + 2 * t;
      skip = (kr + 1 < rs_lo) || (kr > rs_hi);
    }
    if (skip) continue;
    f32x16 p0, p1;
#pragma unroll
    for (int i = 0; i < 16; ++i) { p0[i] = 0.f; p1[i] = 0.f; }
#pragma unroll
    for (int d0 = 0; d0 < DQ / 16; ++d0) {
      const bf16x8 k0 = *(const bf16x8*)(Ks + r32 * KST + d0 * 32 + hi * 16);
      const bf16x8 k1 = *(const bf16x8*)(Ks + (32 + r32) * KST + d0 * 32 + hi * 16);
      p0 = MFMA32(k0, qr[d0], p0); p1 = MFMA32(k1, qr[d0], p1);
    }
    if (MODE == 1) {
      const int nq = it.n0 + qi, kb = it.n0 - 64 + 64 * t;
#pragma unroll
      for (int i = 0; i < 16; ++i) {
        const int nk = kb + crow(i, hi), nk2 = nk + 32;
        const int d1 = nq - nk, d2 = nq - nk2;
        const bool ok1 = (d1 <= 64) && (d1 >= -64) && (nk >= 0) && (nk < it.N);
        const bool ok2 = (d2 <= 64) && (d2 >= -64) && (nk2 >= 0) && (nk2 < it.N);
        p0[i] = ok1 ? p0[i] : -INFINITY; p1[i] = ok2 ? p1[i] : -INFINITY;
      }
    }
    if (MODE == 2) {
      const int rq = 8 * it.nrb + (qi >> 4), cq = 16 * it.ncb + (qi & 15);
      const int rs_ = min(max(rq - 4, 0), 120), cs_ = min(max(cq - 8, 0), 48);
      const int kr = it.kr0 + 2 * t;
      const bool okr0 = (kr >= rs_) && (kr < rs_ + 8), okr1 = (kr + 1 >= rs_) && (kr + 1 < rs_ + 8);
      const int bi0 = (kr - rq + 7) * 31 - cq + 15;
#pragma unroll
      for (int i = 0; i < 16; ++i) {
        const int kc = it.kc0 + crow(i, hi);
        const bool okc = (kc >= cs_) && (kc < cs_ + 16);
        const bool ok0 = okc && okr0, ok1 = okc && okr1;
        const float b0 = bias_s[ok0 ? bi0 + kc : 0], b1 = bias_s[ok1 ? bi0 + 31 + kc : 0];
        p0[i] = ok0 ? p0[i] + b0 : -INFINITY; p1[i] = ok1 ? p1[i] + b1 : -INFINITY;
      }
    }
    float pmax = p0[0];
#pragma unroll
    for (int i = 1; i < 16; ++i) pmax = fmaxf(pmax, p0[i]);
#pragma unroll
    for (int i = 0; i < 16; ++i) pmax = fmaxf(pmax, p1[i]);
    pmax = swap_max(pmax);
    const float mn = fmaxf(m_run, pmax);
    const float alpha = __builtin_amdgcn_exp2f(m_run - mn);
    m_run = mn;
    float ps = 0.f;
#pragma unroll
    for (int i = 0; i < 16; ++i) { p0[i] = __builtin_amdgcn_exp2f(p0[i] - mn); ps += p0[i]; }
#pragma unroll
    for (int i = 0; i < 16; ++i) { p1[i] = __builtin_amdgcn_exp2f(p1[i] - mn); ps += p1[i]; }
    ps = swap_sum(ps);
    l_run = l_run * alpha + ps;
#pragma unroll
    for (int i = 0; i < 16; ++i) { o[0][i] *= alpha; o[1][i] *= alpha; }
    bf16x8 pb[4];
#pragma unroll
    for (int s = 0; s < 2; ++s) {
      u32x4 a = {cvtpk(p0[8 * s], p0[8 * s + 1]), cvtpk(p0[8 * s + 2], p0[8 * s + 3]), cvtpk(p0[8 * s + 4], p0[8 * s + 5]), cvtpk(p0[8 * s + 6], p0[8 * s + 7])};
      u32x4 b = {cvtpk(p1[8 * s], p1[8 * s + 1]), cvtpk(p1[8 * s + 2], p1[8 * s + 3]), cvtpk(p1[8 * s + 4], p1[8 * s + 5]), cvtpk(p1[8 * s + 6], p1[8 * s + 7])};
      pb[s] = __builtin_bit_cast(bf16x8, a); pb[2 + s] = __builtin_bit_cast(bf16x8, b);
    }
#pragma unroll
    for (int db = 0; db < 2; ++db)
#pragma unroll
      for (int s = 0; s < 4; ++s) {
        const s16x4 lo = __builtin_amdgcn_ds_read_tr16_b64_v4i16((lds_s16x4*)(Vs + db * 4096 + (16 * s) * 64 + vrd));
        const s16x4 hh = __builtin_amdgcn_ds_read_tr16_b64_v4i16((lds_s16x4*)(Vs + db * 4096 + (16 * s + 8) * 64 + vrd));
        const bf16x8 a = {lo[0], lo[1], lo[2], lo[3], hh[0], hh[1], hh[2], hh[3]};
        o[db] = MFMA32(a, pb[s], o[db]);
      }
  }
  const float inv = 1.f / l_run;
  const int bq = qpos;
  bf16_t* orow = it.out + (size_t)bq * it.ldo;
#pragma unroll
  for (int db = 0; db < 2; ++db)
#pragma unroll
    for (int g = 0; g < 4; ++g) {
      u32x2 v = {cvtpk(o[db][4 * g] * inv, o[db][4 * g + 1] * inv), cvtpk(o[db][4 * g + 2] * inv, o[db][4 * g + 3] * inv)};
      *(u32x2*)(orow + db * 32 + 8 * g + 4 * hi) = v;
    }
  if (MODE == 1) { if (hi == 0) it.lse[(size_t)bq * 6] = m_run + __builtin_amdgcn_logf(l_run); }
}

DI void attn_dense_skew(const bf16_t* __restrict__ Q, const bf16_t* __restrict__ K, const bf16_t* __restrict__ V, int q0, bf16_t* __restrict__ out,
                        char* smem, const int tid512, const int grp) {
  constexpr int DQ = 96, CPR = 12, KST = 208, NT = SEQ / 64, KB = 64 * KST, VOFF = 2 * KB;
  const int lane = tid512 & 63, w = (tid512 >> 6) & 3, r32 = lane & 31, hi = lane >> 5;
  const int qpos = q0 + w * 32 + r32;
  bf16x8 qr[DQ / 16];
#pragma unroll
  for (int d0 = 0; d0 < DQ / 16; ++d0) qr[d0] = *(const bf16x8*)(Q + (size_t)qpos * DQ + d0 * 16 + hi * 8);
  f32x16 o[2];
#pragma unroll
  for (int i = 0; i < 16; ++i) { o[0][i] = 0.f; o[1][i] = 0.f; }
  float m_run = -1e30f, l_run = 0.f;
  const int kr0 = tid512 / CPR, kc0 = tid512 - kr0 * CPR, c1 = tid512 + 512, kr1 = c1 / CPR, kc1 = c1 - kr1 * CPR, vr = tid512 >> 3, vc = tid512 & 7;
  const bool two = tid512 < 256;
  const bf16_t* Kp0 = K + (size_t)kr0 * DQ + kc0 * 8; const bf16_t* Kp1 = K + (size_t)kr1 * DQ + kc1 * 8; const bf16_t* Vp = V + (size_t)vr * 64 + vc * 8;
  const int ks0 = kr0 * KST + kc0 * 16, ks1 = kr1 * KST + kc1 * 16, vs0 = VOFF + (vc >> 2) * 4096 + vr * 64 + (vc & 3) * 16;
  u32x4 rk0, rk1 = u32x4{0u, 0u, 0u, 0u}, rv;
  auto load = [&](int t) {
    const size_t ro = (size_t)t * 64;
    rk0 = *(const u32x4*)(Kp0 + ro * DQ); if (two) rk1 = *(const u32x4*)(Kp1 + ro * DQ); rv = *(const u32x4*)(Vp + ro * 64);
  };
  auto store = [&](int kb, int vb) {
    char* kbp = smem + kb * KB;
    *(u32x4*)(kbp + ks0) = rk0; if (two) *(u32x4*)(kbp + ks1) = rk1; *(u32x4*)(smem + vb * 8192 + vs0) = rv;
  };
  const int vrd = ((lane >> 5) * 4 + ((lane & 15) >> 2)) * 64 + ((lane >> 4) & 1) * 32 + (lane & 3) * 8;
  __syncthreads();
  load(0); store(0, 0); load(1);
  __syncthreads();
  if (grp == 1) __syncthreads();
  int vcur = 0;
  for (int t = 0; t < NT; ++t) {
    const int vnext = vcur == 2 ? 0 : vcur + 1;
    const char* Ks = smem + (t & 1) * KB; const char* Vs = smem + VOFF + vcur * 8192;
    if (t + 1 < NT) store((t + 1) & 1, vnext);
    if (t + 2 < NT) load(t + 2);
    f32x16 p0, p1;
#pragma unroll
    for (int i = 0; i < 16; ++i) { p0[i] = 0.f; p1[i] = 0.f; }
    {
      const char* kp = Ks + r32 * KST + hi * 16;
      bf16x8 ka[2][2];
      ka[0][0] = *(const bf16x8*)(kp); ka[0][1] = *(const bf16x8*)(kp + 32 * KST);
      ka[1][0] = *(const bf16x8*)(kp + 32); ka[1][1] = *(const bf16x8*)(kp + 32 * KST + 32);
#pragma unroll
      for (int d0 = 0; d0 < DQ / 16; ++d0) {
        p0 = MFMA32(ka[d0 & 1][0], qr[d0], p0); p1 = MFMA32(ka[d0 & 1][1], qr[d0], p1);
        if (d0 + 2 < DQ / 16) { ka[d0 & 1][0] = *(const bf16x8*)(kp + (d0 + 2) * 32); ka[d0 & 1][1] = *(const bf16x8*)(kp + 32 * KST + (d0 + 2) * 32); }
      }
    }
    float pmax = p0[0];
#pragma unroll
    for (int i = 1; i < 16; ++i) pmax = fmaxf(pmax, p0[i]);
#pragma unroll
    for (int i = 0; i < 16; ++i) pmax = fmaxf(pmax, p1[i]);
    pmax = swap_max(pmax);
    {
      const float mn = fmaxf(m_run, pmax);
      const float alpha = __builtin_amdgcn_exp2f(m_run - mn);
      m_run = mn; l_run *= alpha;
#pragma unroll
      for (int i = 0; i < 16; ++i) { o[0][i] *= alpha; o[1][i] *= alpha; }
    }
    asm volatile("" : "+v"(p0), "+v"(p1), "+v"(o[0]), "+v"(o[1]), "+v"(m_run));
    __syncthreads();
    asm volatile("" : "+v"(p0), "+v"(p1), "+v"(o[0]), "+v"(o[1]), "+v"(m_run));
    s16x4 vlo[4], vhi[4];
#pragma unroll
    for (int s2 = 0; s2 < 4; ++s2) {
      vlo[s2] = __builtin_amdgcn_ds_read_tr16_b64_v4i16((lds_s16x4*)(Vs + (16 * s2) * 64 + vrd));
      vhi[s2] = __builtin_amdgcn_ds_read_tr16_b64_v4i16((lds_s16x4*)(Vs + (16 * s2 + 8) * 64 + vrd));
    }
    float ps = 0.f;
#pragma unroll
    for (int i = 0; i < 16; ++i) { p0[i] = __builtin_amdgcn_exp2f(p0[i] - m_run); ps += p0[i]; }
#pragma unroll
    for (int i = 0; i < 16; ++i) { p1[i] = __builtin_amdgcn_exp2f(p1[i] - m_run); ps += p1[i]; }
    l_run += swap_sum(ps);
    bf16x8 pb[4];
#pragma unroll
    for (int s = 0; s < 2; ++s) {
      u32x4 a = {cvtpk(p0[8 * s], p0[8 * s + 1]), cvtpk(p0[8 * s + 2], p0[8 * s + 3]), cvtpk(p0[8 * s + 4], p0[8 * s + 5]), cvtpk(p0[8 * s + 6], p0[8 * s + 7])};
      u32x4 b = {cvtpk(p1[8 * s], p1[8 * s + 1]), cvtpk(p1[8 * s + 2], p1[8 * s + 3]), cvtpk(p1[8 * s + 4], p1[8 * s + 5]), cvtpk(p1[8 * s + 6], p1[8 * s + 7])};
      pb[s] = __builtin_bit_cast(bf16x8, a); pb[2 + s] = __builtin_bit_cast(bf16x8, b);
    }
    {
      s16x4 wlo[4], whi[4];
#pragma unroll
      for (int s2 = 0; s2 < 4; ++s2) {
        wlo[s2] = __builtin_amdgcn_ds_read_tr16_b64_v4i16((lds_s16x4*)(Vs + 4096 + (16 * s2) * 64 + vrd));
        whi[s2] = __builtin_amdgcn_ds_read_tr16_b64_v4i16((lds_s16x4*)(Vs + 4096 + (16 * s2 + 8) * 64 + vrd));
      }
#pragma unroll
      for (int s2 = 0; s2 < 4; ++s2) { const bf16x8 a = {vlo[s2][0], vlo[s2][1], vlo[s2][2], vlo[s2][3], vhi[s2][0], vhi[s2][1], vhi[s2][2], vhi[s2][3]}; o[0] = MFMA32(a, pb[s2], o[0]); }
#pragma unroll
      for (int s2 = 0; s2 < 4; ++s2) { const bf16x8 a = {wlo[s2][0], wlo[s2][1], wlo[s2][2], wlo[s2][3], whi[s2][0], whi[s2][1], whi[s2][2], whi[s2][3]}; o[1] = MFMA32(a, pb[s2], o[1]); }
    }
    asm volatile("" : "+v"(o[0]), "+v"(o[1]));
    __syncthreads();
    asm volatile("" : "+v"(o[0]), "+v"(o[1]));
    vcur = vnext;
  }
  if (grp == 0) __syncthreads();
  const float inv = 1.f / l_run;
  bf16_t* orow = out + (size_t)qpos * 384;
#pragma unroll
  for (int db = 0; db < 2; ++db)
#pragma unroll
    for (int g = 0; g < 4; ++g) {
      u32x2 v = {cvtpk(o[db][4 * g] * inv, o[db][4 * g + 1] * inv), cvtpk(o[db][4 * g + 2] * inv, o[db][4 * g + 3] * inv)};
      *(u32x2*)(orow + db * 32 + 8 * g + 4 * hi) = v;
    }
}

DI float wave_sum(float v) {
  v += __shfl_xor(v, 32); v += __shfl_xor(v, 16); v += __shfl_xor(v, 8); v += __shfl_xor(v, 4); v += __shfl_xor(v, 2); v += __shfl_xor(v, 1); return v;
}
DI float gain_of(const Params& p, int kind, int l, int k) {
  switch (kind) {
    case 0: return p.g_mix[l * 1024 + k];
    case 1: return p.q_norm[l * 256 + k];
    case 2: return p.kv_norm[l * 128 + k];
    case 3: return k < 384 ? p.on_a[l * 384 + k] : (k < 768 ? p.on_b[l * 384 + k - 384] : p.on_c[l * 256 + k - 768]);
    case 4: return p.g_mlp[l * 1024 + k];
    default: return 1.f;
  }
}
DI int map_col(int kind, int n) {
  if (kind == 0) {
    if (n < 384) return n;
    if (n < 448) { const int wv = n - 384, c = wv & 31, sub = wv >> 5; return c < 16 ? 384 + sub * 16 + c : -1; }
    if (n < 1600) return 416 + (n - 448);
    if (n < 2368) return 1568 + (n - 1600);
    return -1;
  }
  if (kind == 1) {
    if (n < 384) return (n >> 6) * 96 + (n & 63);
    if (n < 576) { const int wv = n - 384, g = wv >> 6, wi = wv & 63, sub = wi >> 5, c = wi & 31, hd = 2 * g + (c >> 4), fi = c & 15; return hd * 96 + 64 + sub * 16 + fi; }
    return -1;
  }
  return n;
}
DI void wtile(const Params& p, const float* src, int Nsrc, bf16_t* dst, int K, int kt, int nt, int kind, int l, char* smem, const int tid) {
  float* tile = (float*)smem;
  const int lane = tid & 63, wv = tid >> 6;
  __syncthreads();
  const int n = nt * 64 + lane, sc = map_col(kind, n);
#pragma unroll 4
  for (int r = 0; r < 8; ++r) {
    const int kl = r * 8 + wv, kd = kt * 64 + kl;
    const int k = kind == 5 ? ((kd & ~63) | ((kd & 1) << 5) | ((kd & 63) >> 1)) : kd;
    float v = 0.f;
    if (sc >= 0) v = src[(size_t)k * Nsrc + sc] * gain_of(p, kind, l, k);
    tile[kl * 65 + lane] = v;
  }
  __syncthreads();
#pragma unroll 4
  for (int r = 0; r < 8; ++r) {
    const int nl = r * 8 + wv;
    dst[(size_t)(nt * 64 + nl) * K + kt * 64 + lane] = f2bf(tile[lane * 65 + nl]);
  }
}

NI void phase_prep() {
  const Params& p = kparams(); char* smem = g_smem; const int tid = otid(), bid = obid();
  char* ws = p.ws;
  constexpr int T_WIN = (N_IN_PAD / 64) * 16, T_WUQ = (N_UQ_PAD / 64) * 4, T_WUKV = (N_UKV / 64) * 2, T_WOUT = 16 * 16, T_W1 = 64 * 16, T_W2 = 16 * 64;
  constexpr int T_L = T_WIN + T_WUQ + T_WUKV + T_WOUT + T_W1 + T_W2;
  for (int j = bid; j < NLAYER * T_L; j += gridDim.x) {
    const int l = j / T_L; int r = j - l * T_L;
    char* lw = ws + OFF_W + (size_t)l * LW_SIZE;
    if (r < T_WIN) { wtile(p, p.w_in + (size_t)l * 1024 * 2336, 2336, (bf16_t*)(lw + LW_WIN), 1024, r & 15, r >> 4, 0, l, smem, tid); continue; }
    r -= T_WIN;
    if (r < T_WUQ) { wtile(p, p.w_uq + (size_t)l * 256 * 576, 576, (bf16_t*)(lw + LW_WUQ), 256, r & 3, r >> 2, 1, l, smem, tid); continue; }
    r -= T_WUQ;
    if (r < T_WUKV) { wtile(p, p.w_ukv + (size_t)l * 128 * 768, 768, (bf16_t*)(lw + LW_WUKV), 128, r & 1, r >> 1, 2, l, smem, tid); continue; }
    r -= T_WUKV;
    if (r < T_WOUT) { wtile(p, p.w_out + (size_t)l * 1024 * 1024, 1024, (bf16_t*)(lw + LW_WOUT), 1024, r & 15, r >> 4, 3, l, smem, tid); continue; }
    r -= T_WOUT;
    if (r < T_W1) { wtile(p, p.w_mlp_in + (size_t)l * 1024 * 4096, 4096, (bf16_t*)(lw + LW_W1), 1024, r & 15, r >> 4, 4, l, smem, tid); continue; }
    r -= T_W1;
    wtile(p, p.w_mlp_out + (size_t)l * 4096 * 1024, 1024, (bf16_t*)(lw + LW_W2), 4096, r & 63, r >> 6, 5, l, smem, tid);
  }
  const size_t gtid = (size_t)bid * NTHR + tid, gsz = (size_t)gridDim.x * NTHR;
  bf16_t* xb = (bf16_t*)(ws + OFF_XB);
  {
    const int lane = tid & 63, gw = bid * (NTHR / 64) + (tid >> 6), nw = gridDim.x * (NTHR / 64);
    float* px1 = (float*)(ws + OFF_PX1);
    for (int row = gw; row < NTOK; row += nw) {
      float ss = 0.f;
#pragma unroll
      for (int j = 0; j < 4; ++j) {
        const f32x4 a = *(const f32x4*)(p.x + (size_t)row * DM + j * 256 + lane * 4);
        ss += a[0] * a[0] + a[1] * a[1] + a[2] * a[2] + a[3] * a[3];
        u32x2 o = {cvtpk(a[0], a[1]), cvtpk(a[2], a[3])};
        *(u32x2*)(xb + (size_t)row * DM + j * 256 + lane * 4) = o;
      }
      ss = wave_sum(ss);
      if (lane < 16) px1[(size_t)row * 16 + lane] = lane == 0 ? ss : 0.f;
    }
  }
  float* c32 = (float*)(ws + OFF_COS32); float* s32 = (float*)(ws + OFF_SIN32); float* c16 = (float*)(ws + OFF_COS16); float* s16 = (float*)(ws + OFF_SIN16);
  for (size_t i = gtid; i < (size_t)SEQ * 48; i += gsz) {
    int pos, fi; float invf; float *cd, *sd;
    if (i < (size_t)SEQ * 32) { pos = (int)(i >> 5); fi = (int)(i & 31); invf = __builtin_amdgcn_exp2f(-(float)fi * (13.287712379549449f / 32.f)); cd = c32 + i; sd = s32 + i; }
    else { const size_t j = i - (size_t)SEQ * 32; pos = (int)(j >> 4); fi = (int)(j & 15); invf = __builtin_amdgcn_exp2f(-(float)fi * (13.287712379549449f / 16.f)); cd = c16 + j; sd = s16 + j; }
    const float ang = (float)pos * invf;
    const double rev = (double)ang * 0.15915494309189535;
    const float fr = (float)(rev - rint(rev));
    *cd = __builtin_amdgcn_cosf(fr); *sd = __builtin_amdgcn_sinf(fr);
  }
}

NI void phase_g1(int l_) {
  const Params& p = kparams(); char* smem = g_smem; const int l = __builtin_amdgcn_readfirstlane(l_); const int tid = otid(), bid = obid(); (void)tid; (void)bid;
  char* ws = p.ws;
  EpiG1 e;
  e.cqkv = (bf16_t*)(ws + OFF_CQKV); e.KA = (bf16_t*)(ws + OFF_KA); e.qB = (bf16_t*)(ws + OFF_QB); e.qC = (bf16_t*)(ws + OFF_QC);
  e.cos32 = (const float*)(ws + OFF_COS32); e.sin32 = (const float*)(ws + OFF_SIN32); e.cos16 = (const float*)(ws + OFF_COS16); e.sin16 = (const float*)(ws + OFF_SIN16);
  e.qs = p.qscaleB; e.pq = (float*)(ws + OFF_PQ); e.pkv = (float*)(ws + OFF_PKV);
  const bf16_t* A = (const bf16_t*)(ws + OFF_XB);
  const bf16_t* Bt = (const bf16_t*)(ws + OFF_W + (size_t)l * LW_SIZE + LW_WIN);
  constexpr int NNT = N_IN_PAD / 256;
  FOR_TILES(NNT, mt, nt, gemm_tile<16>(A, 1024, Bt, 1024, 1024, mt * 256, nt * 256, e, tid, (const float*)(ws + OFF_PX1));)
}
NI void phase_g2(int l_) {
  const Params& p = kparams(); char* smem = g_smem; const int l = __builtin_amdgcn_readfirstlane(l_); const int tid = otid(), bid = obid(); (void)tid; (void)bid;
  char* ws = p.ws;
  const bf16_t* A = (const bf16_t*)(ws + OFF_CQKV);
  EpiUQ eq; eq.QA = (bf16_t*)(ws + OFF_QA); eq.cos16 = (const float*)(ws + OFF_COS16); eq.sin16 = (const float*)(ws + OFF_SIN16); eq.qs = p.qscaleA;
  EpiUKV ek; ek.KA = (bf16_t*)(ws + OFF_KA); ek.VA = (bf16_t*)(ws + OFF_VA);
  const bf16_t* Wq = (const bf16_t*)(ws + OFF_W + (size_t)l * LW_SIZE + LW_WUQ);
  const bf16_t* Wkv = (const bf16_t*)(ws + OFF_W + (size_t)l * LW_SIZE + LW_WUKV);
  FOR_TILES(3, mt, nt, gemm_tile<4>(A, 384, Wq, 256, 256, mt * 256, nt * 256, eq, tid, (const float*)(ws + OFF_PQ));)
  FOR_TILES(3, mt, nt, gemm_tile<2>(A + 256, 384, Wkv, 128, 128, mt * 256, nt * 256, ek, tid, (const float*)(ws + OFF_PKV));)
}
NI void phase_attn(int l_) {
  const Params& p = kparams(); char* smem = g_smem; const int l = __builtin_amdgcn_readfirstlane(l_); const int tid = otid(), bid = obid(); (void)tid; (void)bid;
  char* ws = p.ws;
  constexpr int NA = 1536, NBI = 4608, NC = 1024;
  const int grp = tid >> 8, t256 = tid & 255; char* gsm = smem + grp * ATT_LDS;
  for (int i0 = bid * 2; i0 < NA; i0 += gridDim.x * 2) {
    const int i = i0 + grp, xcd = (i >> 1) & 7, j = ((i >> 4) << 1) | (i & 1);
    const int bh = (j >> 6) * 8 + xcd, qb = j & 63, b = bh / 6, h = bh - b * 6;
    attn_dense_skew((const bf16_t*)(ws + OFF_QA) + (size_t)bh * SEQ * 96, (const bf16_t*)(ws + OFF_KA) + (size_t)bh * SEQ * 96, (const bf16_t*)(ws + OFF_VA) + (size_t)bh * SEQ * 64,
                    qb * 128, (bf16_t*)(ws + OFF_OA) + (size_t)b * SEQ * 384 + h * 64, smem, tid, grp);
  }
  for (int i0 = bid * 2; i0 < NBI; i0 += gridDim.x * 2) {
    AttnItem it{};
    const int i = i0 + grp, xcd = (i >> 1) & 7, j = ((i >> 4) << 1) | (i & 1);
    const int g = (j >> 6) * 8 + xcd, c = j & 63, br = g / 24, bh = g - br * 24, b = bh / 6, h = bh - b * 6;
    const int dil = br == 0 ? 1 : (br == 1 ? 4 : 16), cpr = 64 / dil;
    it.Q = (const bf16_t*)(ws + OFF_QB) + (size_t)bh * SEQ * 64; it.K = (const bf16_t*)(ws + OFF_KB) + (size_t)bh * SEQ * 64; it.V = (const bf16_t*)(ws + OFF_VB) + (size_t)bh * SEQ * 64;
    it.dil = dil; it.res = c / cpr; it.n0 = (c - it.res * cpr) * 128; it.N = SEQ / dil;
    it.out = (bf16_t*)(ws + OFF_OB) + (size_t)br * NTOK * 384 + (size_t)b * SEQ * 384 + h * 64; it.ldo = 384;
    it.lse = (float*)(ws + OFF_LSEB) + (size_t)br * NTOK * 6 + (size_t)b * SEQ * 6 + h;
    attn_block<64, 1>(it, gsm, t256);
  }
  for (int i0 = bid * 2; i0 < NC; i0 += gridDim.x * 2) {
    AttnItem it{};
    const int i = i0 + grp, xcd = (i >> 1) & 7, j = ((i >> 4) << 1) | (i & 1);
    const int bh = (j >> 6) * 8 + xcd, blk = j & 63, b = bh >> 2, h = bh & 3;
    it.Q = (const bf16_t*)(ws + OFF_QC) + (size_t)bh * SEQ * 64; it.K = (const bf16_t*)(ws + OFF_KC) + (size_t)bh * SEQ * 64; it.V = (const bf16_t*)(ws + OFF_VC) + (size_t)bh * SEQ * 64;
    it.nrb = blk >> 2; it.ncb = blk & 3;
    it.kr0 = min(max(8 * it.nrb - 4, 0), 112); it.kc0 = min(max(16 * it.ncb - 8, 0), 32);
    it.out = (bf16_t*)(ws + OFF_OC) + (size_t)b * SEQ * 256 + h * 64; it.ldo = 256;
    it.rpb = p.rpb + ((size_t)l * 4 + h) * 465;
    attn_block<64, 2>(it, gsm, t256);
  }
}
NI void phase_mix() {
  const Params& p = kparams(); const int tid = otid(), bid = obid();
  char* ws = p.ws;
  const int lane = tid & 63, gw = bid * (NTHR / 64) + (tid >> 6), nw = gridDim.x * (NTHR / 64);
  const bf16_t* oA = (const bf16_t*)(ws + OFF_OA); const bf16_t* oB = (const bf16_t*)(ws + OFF_OB); const bf16_t* oC = (const bf16_t*)(ws + OFF_OC);
  const float* lse = (const float*)(ws + OFF_LSEB);
  bf16_t* mixed = (bf16_t*)(ws + OFF_MIXED);
  for (int tok = gw; tok < NTOK; tok += nw) {
    float v[16];
    if (lane < 24 || lane >= 48) {
      const bf16_t* src = lane < 24 ? oA + (size_t)tok * 384 + lane * 16 : oC + (size_t)tok * 256 + (lane - 48) * 16;
      const u32x4 a = *(const u32x4*)src, b = *(const u32x4*)(src + 8);
#pragma unroll
      for (int j = 0; j < 4; ++j) { v[2 * j] = bf2f(a[j] & 0xffffu); v[2 * j + 1] = bf2f(a[j] >> 16); v[8 + 2 * j] = bf2f(b[j] & 0xffffu); v[8 + 2 * j + 1] = bf2f(b[j] >> 16); }
    } else {
      const int col = (lane - 24) * 16, hd = col >> 6;
      const float l0 = lse[(size_t)tok * 6 + hd], l1 = lse[(size_t)NTOK * 6 + (size_t)tok * 6 + hd], l2 = lse[(size_t)2 * NTOK * 6 + (size_t)tok * 6 + hd];
      const float mx = fmaxf(l0, fmaxf(l1, l2));
      float w0 = __builtin_amdgcn_exp2f(l0 - mx), w1 = __builtin_amdgcn_exp2f(l1 - mx), w2 = __builtin_amdgcn_exp2f(l2 - mx);
      const float wi = 1.f / (w0 + w1 + w2); w0 *= wi; w1 *= wi; w2 *= wi;
#pragma unroll
      for (int j = 0; j < 16; ++j) v[j] = 0.f;
#pragma unroll
      for (int br = 0; br < 3; ++br) {
        const float wb = br == 0 ? w0 : (br == 1 ? w1 : w2);
        const bf16_t* src = oB + (size_t)br * NTOK * 384 + (size_t)tok * 384 + col;
        const u32x4 a = *(const u32x4*)src, b = *(const u32x4*)(src + 8);
#pragma unroll
        for (int j = 0; j < 4; ++j) { v[2 * j] += wb * bf2f(a[j] & 0xffffu); v[2 * j + 1] += wb * bf2f(a[j] >> 16); v[8 + 2 * j] += wb * bf2f(b[j] & 0xffffu); v[8 + 2 * j + 1] += wb * bf2f(b[j] >> 16); }
      }
    }
    float ss = 0.f;
#pragma unroll
    for (int j = 0; j < 16; ++j) ss += v[j] * v[j];
    const float sa = wave_sum(lane < 24 ? ss : 0.f), sb = wave_sum((lane >= 24 && lane < 48) ? ss : 0.f), sc = wave_sum(lane >= 48 ? ss : 0.f);
    const float rs = lane < 24 ? rsqrtf(sa * (1.f / 384.f) + 1e-6f) : (lane < 48 ? rsqrtf(sb * (1.f / 384.f) + 1e-6f) : rsqrtf(sc * (1.f / 256.f) + 1e-6f));
    u32x4 oa, ob;
#pragma unroll
    for (int j = 0; j < 4; ++j) { oa[j] = cvtpk(v[2 * j] * rs, v[2 * j + 1] * rs); ob[j] = cvtpk(v[8 + 2 * j] * rs, v[8 + 2 * j + 1] * rs); }
    bf16_t* dst = mixed + (size_t)tok * 1024 + lane * 16;
    *(u32x4*)dst = oa; *(u32x4*)(dst + 8) = ob;
  }
}
NI void phase_wout(int l_) {
  const Params& p = kparams(); char* smem = g_smem; const int l = __builtin_amdgcn_readfirstlane(l_); const int tid = otid(), bid = obid(); (void)tid; (void)bid;
  char* ws = p.ws;
  EpiRes e; e.xb = (bf16_t*)(ws + OFF_XB); e.pout = (float*)(ws + OFF_PX2);
  const bf16_t* A = (const bf16_t*)(ws + OFF_MIXED);
  const bf16_t* Bt = (const bf16_t*)(ws + OFF_W + (size_t)l * LW_SIZE + LW_WOUT);
  FOR_TILES(4, mt, nt, gemm_tile<0>(A, 1024, Bt, 1024, 1024, mt * 256, nt * 256, e, tid, nullptr);)
}
NI void phase_mlp1(int l_) {
  const Params& p = kparams(); char* smem = g_smem; const int l = __builtin_amdgcn_readfirstlane(l_); const int tid = otid(), bid = obid(); (void)tid; (void)bid;
  char* ws = p.ws;
  EpiMlp1 e; e.hid = (bf16_t*)(ws + OFF_HID);
  const bf16_t* A = (const bf16_t*)(ws + OFF_XB);
  const bf16_t* Bt = (const bf16_t*)(ws + OFF_W + (size_t)l * LW_SIZE + LW_W1);
  FOR_TILES(16, mt, nt, gemm_tile<16>(A, 1024, Bt, 1024, 1024, mt * 256, nt * 256, e, tid, (const float*)(ws + OFF_PX2));)
}
NI void phase_mlp2(int l_) {
  const Params& p = kparams(); char* smem = g_smem; const int l = __builtin_amdgcn_readfirstlane(l_); const int tid = otid(), bid = obid(); (void)tid; (void)bid;
  char* ws = p.ws;
  EpiRes e; e.xb = (bf16_t*)(ws + OFF_XB); e.pout = (float*)(ws + OFF_PX1);
  const bf16_t* A = (const bf16_t*)(ws + OFF_HID);
  const bf16_t* Bt = (const bf16_t*)(ws + OFF_W + (size_t)l * LW_SIZE + LW_W2);
  FOR_TILES(4, mt, nt, gemm_tile<0>(A, DFF, Bt, DFF, DFF, mt * 256, nt * 256, e, tid, nullptr);)
}
NI void phase_final() {
  const Params& p = kparams(); const int tid = otid(), bid = obid();
  const int lane = tid & 63, gw = bid * (NTHR / 64) + (tid >> 6), nw = gridDim.x * (NTHR / 64);
  const bf16_t* xb = (const bf16_t*)(p.ws + OFF_XB);
  for (int tok = gw; tok < NTOK; tok += nw) {
    float* row = p.out + (size_t)tok * DM;
    f32x4 v[4]; float ss = 0.f;
#pragma unroll
    for (int j = 0; j < 4; ++j) {
      const u32x2 r = *(const u32x2*)(xb + (size_t)tok * DM + j * 256 + lane * 4);
      v[j] = f32x4{bf2f(r[0] & 0xffffu), bf2f(r[0] >> 16), bf2f(r[1] & 0xffffu), bf2f(r[1] >> 16)};
      ss += v[j][0] * v[j][0] + v[j][1] * v[j][1] + v[j][2] * v[j][2] + v[j][3] * v[j][3];
    }
    ss = wave_sum(ss);
    const float rs = rsqrtf(ss * (1.f / 1024.f) + 1e-6f);
#pragma unroll
    for (int j = 0; j < 4; ++j) { const f32x4 g = *(const f32x4*)(p.g_final + j * 256 + lane * 4); f32x4 o = {v[j][0] * rs * g[0], v[j][1] * rs * g[1], v[j][2] * rs * g[2], v[j][3] * rs * g[3]}; *(f32x4*)(row + j * 256 + lane * 4) = o; }
  }
}

DI void grid_barrier(unsigned* ctr, unsigned target) {
  __syncthreads();
  if (threadIdx.x == 0) {
    __builtin_amdgcn_fence(__ATOMIC_RELEASE, "agent");
    __hip_atomic_fetch_add(ctr, 1u, __ATOMIC_RELAXED, __HIP_MEMORY_SCOPE_AGENT);
    while (__hip_atomic_load(ctr, __ATOMIC_RELAXED, __HIP_MEMORY_SCOPE_AGENT) < target) __builtin_amdgcn_s_sleep(1);
    __builtin_amdgcn_fence(__ATOMIC_ACQUIRE, "agent");
    asm volatile("s_waitcnt vmcnt(0)" ::: "memory");
  }
  __syncthreads();
}

constexpr int NPHASE = 2 + 7 * NLAYER;
DI void run_phase(int ph) {
  if (ph == 0) { phase_prep(); return; }
  if (ph == NPHASE - 1) { phase_final(); return; }
  const int l = (ph - 1) / 7, st = (ph - 1) - l * 7;
  switch (st) {
    case 0: phase_g1(l); break;
    case 1: phase_g2(l); break;
    case 2: phase_attn(l); break;
    case 3: phase_mix(); break;
    case 4: phase_wout(l); break;
    case 5: phase_mlp1(l); break;
    default: phase_mlp2(l); break;
  }
}

__global__ void __launch_bounds__(512) mega(Params p, int ph_lo, int ph_hi) {
  cg::grid_group grid = cg::this_grid();
  unsigned* bar = (unsigned*)(p.ws + OFF_BAR);
  for (int ph = ph_lo; ph < ph_hi; ++ph) {
    run_phase(ph);
    if (ph + 1 < ph_hi) {
      if (ph == ph_lo) grid.sync();
      else grid_barrier(bar, (unsigned)(ph - ph_lo) * gridDim.x);
    }
  }
}

extern "C" void kernel_launch(void* const* d_in, const int* in_sizes, int n_in, void* d_out, int out_size, void* d_ws, size_t ws_size, hipStream_t stream) {
  static int grid_blocks = 0;
  if (!grid_blocks) {
    int dev = 0, cus = 0, per_cu = 0;
    (void)hipGetDevice(&dev);
    (void)hipDeviceGetAttribute(&cus, hipDeviceAttributeMultiprocessorCount, dev);
    (void)hipOccupancyMaxActiveBlocksPerMultiprocessor(&per_cu, mega, NTHR, 0);
    if (per_cu > 1) per_cu = 1;
    grid_blocks = cus * per_cu;
    if (ws_size < OFF_END) fprintf(stderr, "kernel_launch: workspace too small: %zu < %zu\n", ws_size, (size_t)OFF_END);
  }
  Params p;
  memset(&p, 0, sizeof(p));
  p.x = (const float*)d_in[0]; p.g_mix = (const float*)d_in[1]; p.w_in = (const float*)d_in[2]; p.q_norm = (const float*)d_in[3];
  p.w_uq = (const float*)d_in[4]; p.kv_norm = (const float*)d_in[5]; p.w_ukv = (const float*)d_in[6]; p.rpb = (const float*)d_in[7];
  p.on_a = (const float*)d_in[8]; p.on_b = (const float*)d_in[9]; p.on_c = (const float*)d_in[10]; p.w_out = (const float*)d_in[11];
  p.g_mlp = (const float*)d_in[12]; p.w_mlp_in = (const float*)d_in[13]; p.w_mlp_out = (const float*)d_in[14]; p.g_final = (const float*)d_in[15];
  p.out = (float*)d_out; p.ws = (char*)d_ws;
  p.qscaleA = (float)(1.4426950408889634 / std::sqrt(96.0));
  p.qscaleB = (float)(1.4426950408889634 * 0.125);
#if ONE_LAUNCH
  (void)hipMemsetAsync((char*)d_ws + OFF_BAR, 0, 256, stream);
  int lo = 0, hi = NPHASE;
  void* args[] = {&p, &lo, &hi};
  hipError_t e = hipLaunchCooperativeKernel((void*)mega, dim3(grid_blocks), dim3(NTHR), args, 0, stream);
  if (e != hipSuccess) fprintf(stderr, "cooperative launch failed: %s (grid %d)\n", hipGetErrorString(e), grid_blocks);
#else
  for (int ph = 0; ph < NPHASE; ++ph) hipLaunchKernelGGL(mega, dim3(grid_blocks), dim3(NTHR), 0, stream, p, ph, ph + 1);
#endif
}
```

```cpp
#include <hip/hip_runtime.h>
#include <hip/hip_cooperative_groups.h>
#include <cstdio>
#include <cmath>
#include <cstring>
namespace cg = cooperative_groups;

#ifndef ONE_LAUNCH
#define ONE_LAUNCH 1
#endif

#define DI __device__ __forceinline__
typedef unsigned short bf16_t;
typedef short bf16x8 __attribute__((ext_vector_type(8)));
typedef short s16x4 __attribute__((ext_vector_type(4)));
typedef float f32x16 __attribute__((ext_vector_type(16)));
typedef float f32x2 __attribute__((ext_vector_type(2)));
typedef float f32x4 __attribute__((ext_vector_type(4)));
typedef __bf16 bf2_t __attribute__((ext_vector_type(2)));
typedef unsigned u32x4 __attribute__((ext_vector_type(4)));
typedef unsigned u32x2 __attribute__((ext_vector_type(2)));
typedef __attribute__((address_space(3))) s16x4 lds_s16x4;

constexpr int SEQ = 8192, NB = 4, NTOK = NB * SEQ, DM = 1024, NLAYER = 4;
constexpr int N_IN_PAD = 2560, N_UQ_PAD = 768, N_UKV = 768, DFF = 4096;
constexpr int NTHR = 512;

constexpr size_t SZ_XB = (size_t)NTOK * DM * 2;
constexpr size_t SZ_WIN = (size_t)N_IN_PAD * 1024 * 2, SZ_WUQ = (size_t)N_UQ_PAD * 256 * 2, SZ_WUKV = (size_t)N_UKV * 128 * 2,
                 SZ_WOUT = (size_t)1024 * 1024 * 2, SZ_W1 = (size_t)DFF * 1024 * 2, SZ_W2 = (size_t)1024 * DFF * 2;
constexpr size_t LW_WIN = 0, LW_WUQ = LW_WIN + SZ_WIN, LW_WUKV = LW_WUQ + SZ_WUQ, LW_WOUT = LW_WUKV + SZ_WUKV, LW_W1 = LW_WOUT + SZ_WOUT,
                 LW_W2 = LW_W1 + SZ_W1, LW_SIZE = LW_W2 + SZ_W2;
constexpr size_t OFF_XB = 0, OFF_W = OFF_XB + SZ_XB, OFF_TAB = OFF_W + NLAYER * LW_SIZE;
constexpr size_t OFF_COS32 = OFF_TAB, OFF_SIN32 = OFF_COS32 + (size_t)SEQ * 32 * 4, OFF_COS16 = OFF_SIN32 + (size_t)SEQ * 32 * 4,
                 OFF_SIN16 = OFF_COS16 + (size_t)SEQ * 16 * 4, OFF_ATT = OFF_SIN16 + (size_t)SEQ * 16 * 4;
constexpr size_t SZ_T384 = (size_t)NTOK * 384 * 2, SZ_QA = (size_t)NB * 6 * SEQ * 96 * 2, SZ_H6 = (size_t)NB * 6 * SEQ * 64 * 2,
                 SZ_H4 = (size_t)NB * 4 * SEQ * 64 * 2;
constexpr size_t OFF_CQKV = OFF_ATT;
constexpr size_t OFF_OA = OFF_CQKV;
constexpr size_t OFF_QA = OFF_CQKV + SZ_T384, OFF_KA = OFF_QA + SZ_QA, OFF_VA = OFF_KA + SZ_QA;
constexpr size_t OFF_QB = OFF_VA + SZ_H6, OFF_KB = OFF_QB + SZ_H6, OFF_VB = OFF_KB + SZ_H6;
constexpr size_t OFF_QC = OFF_VB + SZ_H6, OFF_KC = OFF_QC + SZ_H4, OFF_VC = OFF_KC + SZ_H4;
constexpr size_t OFF_OB = OFF_VC + SZ_H4, OFF_LSEB = OFF_OB + 3 * SZ_T384, OFF_OC = OFF_LSEB + (size_t)3 * NTOK * 6 * 4;
constexpr size_t OFF_SSQ = OFF_OC + (size_t)NTOK * 256 * 2;
constexpr size_t OFF_PX1 = OFF_SSQ, OFF_PX2 = OFF_PX1 + (size_t)NTOK * 16 * 4, OFF_PQ = OFF_PX2 + (size_t)NTOK * 16 * 4, OFF_PKV = OFF_PQ + (size_t)NTOK * 4 * 4;
constexpr size_t OFF_BAR = OFF_PKV + (size_t)NTOK * 2 * 4;
constexpr size_t OFF_END = OFF_BAR + 16384;
constexpr size_t OFF_MIXED = OFF_QA;
constexpr size_t OFF_HID = OFF_ATT;
static_assert(OFF_HID + (size_t)NTOK * DFF * 2 <= OFF_SSQ, "hid fits");
static_assert(OFF_MIXED + (size_t)NTOK * DM * 2 <= OFF_VA, "mixed fits");

struct Params {
  const float *x, *g_mix, *w_in, *q_norm, *w_uq, *kv_norm, *w_ukv, *rpb, *on_a, *on_b, *on_c, *w_out, *g_mlp, *w_mlp_in, *w_mlp_out, *g_final;
  float* out; char* ws;
  float qscaleA, qscaleB;
};
__shared__ __attribute__((aligned(1024))) char g_smem[131072];
#define NI __device__ __forceinline__
DI const Params& kparams() { return *(const Params*)__builtin_amdgcn_kernarg_segment_ptr(); }

DI unsigned cvtpk(float lo, float hi) { f32x2 v = {lo, hi}; bf2_t b = __builtin_convertvector(v, bf2_t); return __builtin_bit_cast(unsigned, b); }
DI bf16_t f2bf(float x) { return (bf16_t)(cvtpk(x, 0.f) & 0xffffu); }
DI float bf2f(unsigned h) { return __uint_as_float(h << 16); }
DI int crow(int i, int h) { return (i & 3) + 8 * (i >> 2) + 4 * h; }
#define MFMA32(a, b, c) __builtin_amdgcn_mfma_f32_32x32x16_bf16((a), (b), (c), 0, 0, 0)
DI float fdot2bf(unsigned a, float c) { bf2_t v = __builtin_bit_cast(bf2_t, a); return __builtin_amdgcn_fdot2_f32_bf16(v, v, c, false); }
DI float swap_max(float v) { auto rr = __builtin_amdgcn_permlane32_swap(__float_as_uint(v), __float_as_uint(v), false, false); return fmaxf(__uint_as_float(rr[0]), __uint_as_float(rr[1])); }
DI float swap_sum(float v) { auto rr = __builtin_amdgcn_permlane32_swap(__float_as_uint(v), __float_as_uint(v), false, false); return __uint_as_float(rr[0]) + __uint_as_float(rr[1]); }

constexpr int ATT_LDS = 53248;
#define FOR_TILES(NN, MT, NT, BODY) { const bool xm_ = gridDim.x == 256; const int st_ = xm_ ? (bid >> 3) : bid, sp_ = xm_ ? 32 : (int)gridDim.x, cn_ = xm_ ? 16 * (NN) : (NTOK / 256) * (NN); \
  for (int j_ = st_; j_ < cn_; j_ += sp_) { int MT = j_ / (NN); const int NT = j_ - MT * (NN); if (xm_) MT += (bid & 7) * 16; BODY } }
DI int otid() { int t = threadIdx.x; asm volatile("" : "+v"(t)); return t; }
DI int obid() { int t = blockIdx.x; asm volatile("" : "+s"(t)); return t; }

template <int NSLOT, class Epi>
DI void gemm_tile(const bf16_t* __restrict__ A, int lda, const bf16_t* __restrict__ Bt, int ldb, int K, int m0, int n0, const Epi& epi, const int tid, const float* pin) {
  const int lane = tid & 63, w = tid >> 6, wm = w >> 2, wn = w & 3, r32 = lane & 31, hi = lane >> 5;
  char* smem = g_smem;
  const int lrow = lane >> 3;
  const int c0 = (lane & 7) ^ (lane >> 4), c1 = (lane & 7) ^ ((lane >> 4) | 4);
  const char* Ab = (const char*)(A + (size_t)m0 * lda);
  const char* Bb = (const char*)(Bt + (size_t)n0 * ldb);
  const unsigned oa0 = (unsigned)(((w * 32 + lrow) * lda + c0 * 8) * 2), oa1 = (unsigned)(((w * 32 + lrow) * lda + c1 * 8) * 2);
  const unsigned ob0 = (unsigned)(((w * 32 + lrow) * ldb + c0 * 8) * 2), ob1 = (unsigned)(((w * 32 + lrow) * ldb + c1 * 8) * 2);
  const int dma_off = (w * 32) * 128 + lane * 16;
  f32x16 acc[4][2];
#pragma unroll
  for (int mi = 0; mi < 4; ++mi)
#pragma unroll
    for (int nj = 0; nj < 2; ++nj)
#pragma unroll
      for (int i = 0; i < 16; ++i) acc[mi][nj][i] = 0.f;
  const int nk = K >> 6;
  const int sw = (r32 >> 1) & 7, sh = sw >> 1, lo16 = 16 * (hi ^ (sw & 1));
  const int a_off = (wm * 128 + r32) * 128 + lo16;
  const int b_off = 32768 + (wn * 64 + r32) * 128 + lo16;
  __syncthreads();
  {
    char* sa = smem + dma_off;
#pragma unroll
    for (int j = 0; j < 4; ++j) {
      __builtin_amdgcn_global_load_lds((const unsigned*)(Ab + (size_t)(j * 8 * lda) * 2 + ((j & 1) ? oa1 : oa0)), (unsigned*)(sa + j * 1024), 16, 0, 0);
      __builtin_amdgcn_global_load_lds((const unsigned*)(Bb + (size_t)(j * 8 * ldb) * 2 + ((j & 1) ? ob1 : ob0)), (unsigned*)(sa + 32768 + j * 1024), 16, 0, 0);
    }
  }
  for (int kt = 0; kt < nk; ++kt) {
    __syncthreads();
    if (kt + 1 < nk) {
      char* sa = smem + ((kt + 1) & 1) * 65536 + dma_off;
      const int k0 = (kt + 1) * 64;
#pragma unroll
      for (int j = 0; j < 4; ++j) {
        __builtin_amdgcn_global_load_lds((const unsigned*)(Ab + (size_t)(j * 8 * lda + k0) * 2 + ((j & 1) ? oa1 : oa0)), (unsigned*)(sa + j * 1024), 16, 0, 0);
        __builtin_amdgcn_global_load_lds((const unsigned*)(Bb + (size_t)(j * 8 * ldb + k0) * 2 + ((j & 1) ? ob1 : ob0)), (unsigned*)(sa + 32768 + j * 1024), 16, 0, 0);
      }
    }
    const char* sb = smem + (kt & 1) * 65536;
#pragma unroll
    for (int ks = 0; ks < 4; ++ks) {
      const int koff = 32 * (ks ^ sh);
      bf16x8 af[4], bfr[2];
#pragma unroll
      for (int mi = 0; mi < 4; ++mi) af[mi] = *(const bf16x8*)(sb + a_off + mi * 4096 + koff);
#pragma unroll
      for (int nj = 0; nj < 2; ++nj) bfr[nj] = *(const bf16x8*)(sb + b_off + nj * 4096 + koff);
#pragma unroll
      for (int mi = 0; mi < 4; ++mi)
#pragma unroll
        for (int nj = 0; nj < 2; ++nj) acc[mi][nj] = MFMA32(af[mi], bfr[nj], acc[mi][nj]);
    }
  }
  float* rstd_s = (float*)smem;
  if (NSLOT > 0) {
    __syncthreads();
    if (tid < 256) {
      const float* pr = pin + (size_t)(m0 + tid) * NSLOT;
      float sacc = 0.f;
      if (NSLOT >= 4) {
#pragma unroll
        for (int q = 0; q < NSLOT / 4; ++q) { const f32x4 v = *(const f32x4*)(pr + 4 * q); sacc += (v[0] + v[1]) + (v[2] + v[3]); }
      } else {
#pragma unroll
        for (int q = 0; q < NSLOT; ++q) sacc += pr[q];
      }
      rstd_s[tid] = rsqrtf(sacc / (float)K + 1e-6f);
    }
    __syncthreads();
  }
  int lane2 = lane, w2 = w; asm volatile("" : "+v"(lane2), "+v"(w2));
  epi(acc, m0, (w2 >> 2) * 128, n0 + (w2 & 3) * 64, lane2, rstd_s);
}
DI void row_ssq_put(float v, float* dst, int lane) {
  v += __shfl_xor(v, 1); v += __shfl_xor(v, 2); v += __shfl_xor(v, 4); v += __shfl_xor(v, 8); v += __shfl_xor(v, 16);
  if ((lane & 31) == 0) *dst = v;
}

struct EpiG1 {
  bf16_t *cqkv, *KA, *qB, *qC; const float *cos32, *sin32, *cos16, *sin16; float qs; float *pq, *pkv;
  DI void operator()(f32x16 (&acc)[4][2], int m0, int lr0, int col0, int lane, const float* rstd_s) const {
    const int c = lane & 31, h = lane >> 5, cb = col0 >> 6;
    if (cb >= 37) return;
#define G1_ROW const int lr = lr0 + mi * 32 + crow(i, h), tok = m0 + lr, b = tok >> 13, s = tok & 8191; (void)b; (void)s; \
               const float rs = rstd_s[lr]; float v0 = acc[mi][0][i] * rs, v1 = acc[mi][1][i] * rs;
    if (cb < 6) {
#pragma unroll
      for (int mi = 0; mi < 4; ++mi)
#pragma unroll
        for (int i = 0; i < 16; ++i) {
        if ((i & 3) == 0) __builtin_amdgcn_sched_barrier(0);
          G1_ROW
          bf16_t* d = cqkv + (size_t)tok * 384 + cb * 64 + c; d[0] = f2bf(v0); d[32] = f2bf(v1);
          row_ssq_put(v0 * v0 + v1 * v1, cb < 4 ? pq + (size_t)tok * 4 + cb : pkv + (size_t)tok * 2 + (cb - 4), lane);
        }
    } else if (cb == 6) {
#pragma unroll
      for (int mi = 0; mi < 4; ++mi)
#pragma unroll
        for (int i = 0; i < 16; ++i) {
        if ((i & 3) == 0) __builtin_amdgcn_sched_barrier(0);
          G1_ROW
          if (c < 16) {
            const float cs = cos16[s * 16 + c], sn = sin16[s * 16 + c];
            const bf16_t o1 = f2bf(v0 * cs - v1 * sn), o2 = f2bf(v0 * sn + v1 * cs);
#pragma unroll
            for (int hd = 0; hd < 6; ++hd) { bf16_t* d = KA + ((size_t)(b * 6 + hd) * SEQ + s) * 96 + 64 + c; d[0] = o1; d[16] = o2; }
          }
        }
    } else if (cb < 25) {
      const int idx = cb - 7, which = idx / 6, hd = idx - which * 6;
      bf16_t* base = qB + (size_t)which * (SZ_H6 / 2) + (size_t)hd * SEQ * 64 + c;
      const float sc = which == 0 ? qs : 1.f;
      if (which < 2) {
#pragma unroll
        for (int mi = 0; mi < 4; ++mi)
#pragma unroll
          for (int i = 0; i < 16; ++i) {
        if ((i & 3) == 0) __builtin_amdgcn_sched_barrier(0);
            G1_ROW
            const float cs = cos32[s * 32 + c] * sc, sn = sin32[s * 32 + c] * sc;
            bf16_t* d = base + ((size_t)(b * 6) * SEQ + s) * 64;
            d[0] = f2bf(v0 * cs - v1 * sn); d[32] = f2bf(v0 * sn + v1 * cs);
          }
      } else {
#pragma unroll
        for (int mi = 0; mi < 4; ++mi)
#pragma unroll
          for (int i = 0; i < 16; ++i) {
        if ((i & 3) == 0) __builtin_amdgcn_sched_barrier(0);
            G1_ROW
            bf16_t* d = base + ((size_t)(b * 6) * SEQ + s) * 64;
            d[0] = f2bf(v0); d[32] = f2bf(v1);
          }
      }
    } else {
      const int idx = cb - 25, which = idx >> 2, hd = idx & 3;
      bf16_t* base = qC + (size_t)which * (SZ_H4 / 2) + (size_t)hd * SEQ * 64 + c;
      const float sc = which == 0 ? qs : 1.f;
#pragma unroll
      for (int mi = 0; mi < 4; ++mi)
#pragma unroll
        for (int i = 0; i < 16; ++i) {
        if ((i & 3) == 0) __builtin_amdgcn_sched_barrier(0);
          G1_ROW
          bf16_t* d = base + ((size_t)(b * 4) * SEQ + s) * 64;
          d[0] = f2bf(v0 * sc); d[32] = f2bf(v1 * sc);
        }
    }
#undef G1_ROW
  }
};
struct EpiUQ {
  bf16_t* QA; const float *cos16, *sin16; float qs;
  DI void operator()(f32x16 (&acc)[4][2], int m0, int lr0, int col0, int lane, const float* rstd_s) const {
    const int c = lane & 31, h = lane >> 5, cb = col0 >> 6;
    if (cb >= 9) return;
#pragma unroll
    for (int mi = 0; mi < 4; ++mi)
#pragma unroll
      for (int i = 0; i < 16; ++i) {
        if ((i & 3) == 0) __builtin_amdgcn_sched_barrier(0);
        const int lr = lr0 + mi * 32 + crow(i, h), tok = m0 + lr, b = tok >> 13, s = tok & 8191;
        const float rs = rstd_s[lr] * qs;
        const float v0 = acc[mi][0][i] * rs, v1 = acc[mi][1][i] * rs;
        if (cb < 6) {
          bf16_t* d = QA + ((size_t)(b * 6 + cb) * SEQ + s) * 96 + c; d[0] = f2bf(v0); d[32] = f2bf(v1);
        } else {
          const int hd = 2 * (cb - 6) + (c >> 4), fi = c & 15;
          const float cs = cos16[s * 16 + fi], sn = sin16[s * 16 + fi];
          bf16_t* d = QA + ((size_t)(b * 6 + hd) * SEQ + s) * 96 + 64 + fi;
          d[0] = f2bf(v0 * cs - v1 * sn); d[16] = f2bf(v0 * sn + v1 * cs);
        }
      }
  }
};
struct EpiUKV {
  bf16_t *KA, *VA;
  DI void operator()(f32x16 (&acc)[4][2], int m0, int lr0, int col0, int lane, const float* rstd_s) const {
    const int c = lane & 31, h = lane >> 5, cb = col0 >> 6, hd = cb >> 1, isv = cb & 1;
#pragma unroll
    for (int mi = 0; mi < 4; ++mi)
#pragma unroll
      for (int i = 0; i < 16; ++i) {
        if ((i & 3) == 0) __builtin_amdgcn_sched_barrier(0);
        const int lr = lr0 + mi * 32 + crow(i, h), tok = m0 + lr, b = tok >> 13, s = tok & 8191;
        const float rs = rstd_s[lr];
        const float v0 = acc[mi][0][i] * rs, v1 = acc[mi][1][i] * rs;
        bf16_t* d = isv ? VA + ((size_t)(b * 6 + hd) * SEQ + s) * 64 + c : KA + ((size_t)(b * 6 + hd) * SEQ + s) * 96 + c;
        d[0] = f2bf(v0); d[32] = f2bf(v1);
      }
  }
};
struct EpiRes {
  bf16_t* xb; float* pout;
  DI void operator()(f32x16 (&acc)[4][2], int m0, int lr0, int col0, int lane, const float* rstd_s) const {
    const int c = lane & 31, h = lane >> 5;
#pragma unroll
    for (int mi = 0; mi < 4; ++mi)
#pragma unroll
      for (int i = 0; i < 16; ++i) {
        if ((i & 3) == 0) __builtin_amdgcn_sched_barrier(0);
        const int row = m0 + lr0 + mi * 32 + crow(i, h);
        const size_t o = (size_t)row * DM + col0 + c;
        const float v0 = bf2f(xb[o]) + acc[mi][0][i], v1 = bf2f(xb[o + 32]) + acc[mi][1][i];
        xb[o] = f2bf(v0); xb[o + 32] = f2bf(v1);
        row_ssq_put(v0 * v0 + v1 * v1, pout + (size_t)row * 16 + (col0 >> 6), lane);
      }
  }
};
struct EpiMlp1 {
  bf16_t* hid;
  DI void operator()(f32x16 (&acc)[4][2], int m0, int lr0, int col0, int lane, const float* rstd_s) const {
    const int c = lane & 31, h = lane >> 5;
#pragma unroll
    for (int mi = 0; mi < 4; ++mi)
#pragma unroll
      for (int i = 0; i < 16; ++i) {
        if ((i & 3) == 0) __builtin_amdgcn_sched_barrier(0);
        const int lr = lr0 + mi * 32 + crow(i, h);
        const float rs = rstd_s[lr];
        const float v0 = fmaxf(acc[mi][0][i] * rs, 0.f), v1 = fmaxf(acc[mi][1][i] * rs, 0.f);
        *(unsigned*)(hid + (size_t)(m0 + lr) * DFF + col0 + 2 * c) = cvtpk(v0 * v0, v1 * v1);
      }
  }
};

struct AttnItem {
  const bf16_t *Q, *K, *V;
  int q0;
  int n0, dil, res, N;
  int nrb, ncb, kr0, kc0;
  bf16_t* out; int ldo;
  float* lse;
  const float* rpb;
};

template <int DQ, int MODE>
DI void attn_block(const AttnItem& it, char* smem, const int tid) {
  constexpr int CPR = DQ / 8, KST = DQ * 2 + 16, KCH = (64 * CPR) / 256, NT = MODE == 0 ? SEQ / 64 : MODE == 1 ? 4 : 8;
  const int lane = tid & 63, w = tid >> 6, r32 = lane & 31, hi = lane >> 5;
  char* Ks = smem; char* Vs = smem + 64 * KST; float* bias_s = (float*)(smem + 64 * KST + 8192);
  const int qi = w * 32 + r32;
  int qpos;
  if (MODE == 0) qpos = it.q0 + qi;
  else if (MODE == 1) qpos = (it.n0 + qi) * it.dil + it.res;
  else qpos = (8 * it.nrb + (qi >> 4)) * 64 + 16 * it.ncb + (qi & 15);
  __syncthreads();
  if (MODE == 2) { for (int i = tid; i < 465; i += 256) bias_s[i] = it.rpb[i] * 1.4426950408889634f; }
  bf16x8 qr[DQ / 16];
#pragma unroll
  for (int d0 = 0; d0 < DQ / 16; ++d0) qr[d0] = *(const bf16x8*)(it.Q + (size_t)qpos * DQ + d0 * 16 + hi * 8);
  f32x16 o[2];
#pragma unroll
  for (int i = 0; i < 16; ++i) { o[0][i] = 0.f; o[1][i] = 0.f; }
  float m_run = -1e30f, l_run = 0.f;
  u32x4 rk[KCH], rv[2];
  auto kpos = [&](int t, int row) -> int {
    if (MODE == 0) return t * 64 + row;
    if (MODE == 1) { int n = it.n0 - 64 + 64 * t + row; n = n < 0 ? 0 : (n > it.N - 1 ? it.N - 1 : n); return n * it.dil + it.res; }
    return (it.kr0 + 2 * t + (row >> 5)) * 64 + it.kc0 + (row & 31);
  };
  auto load = [&](int t) {
#pragma unroll
    for (int i = 0; i < KCH; ++i) { const int c = tid + 256 * i, row = c / CPR, kc = c - row * CPR; rk[i] = *(const u32x4*)(it.K + (size_t)kpos(t, row) * DQ + kc * 8); }
#pragma unroll
    for (int i = 0; i < 2; ++i) { const int c = tid + 256 * i, row = c >> 3, kc = c & 7; rv[i] = *(const u32x4*)(it.V + (size_t)kpos(t, row) * 64 + kc * 8); }
  };
  const int vrd = ((lane >> 5) * 4 + ((lane & 15) >> 2)) * 64 + ((lane >> 4) & 1) * 32 + (lane & 3) * 8;
  load(0);
  for (int t = 0; t < NT; ++t) {
    __syncthreads();
#pragma unroll
    for (int i = 0; i < KCH; ++i) { const int c = tid + 256 * i, row = c / CPR, kc = c - row * CPR; *(u32x4*)(Ks + row * KST + kc * 16) = rk[i]; }
#pragma unroll
    for (int i = 0; i < 2; ++i) { const int c = tid + 256 * i, row = c >> 3, kc = c & 7; *(u32x4*)(Vs + (kc >> 2) * 4096 + row * 64 + (kc & 3) * 16) = rv[i]; }
    __syncthreads();
    if (t + 1 < NT) load(t + 1);
    bool skip = false;
    if (MODE == 1) skip = (w < 2) ? (t == 3) : (t == 0);
    if (MODE == 2) {
      const int rq_lo = 8 * it.nrb + 2 * w, rq_hi = rq_lo + 1;
      const int rs_lo = min(max(rq_lo - 4, 0), 120), rs_hi = min(max(rq_hi - 4, 0), 120) + 7;
      const int kr = it.kr0 + 2 * t;
      skip = (kr + 1 < rs_lo) || (kr > rs_hi);
    }
    if (skip) continue;
    f32x16 p0, p1;
#pragma unroll
    for (int i = 0; i < 16; ++i) { p0[i] = 0.f; p1[i] = 0.f; }
#pragma unroll
    for (int d0 = 0; d0 < DQ / 16; ++d0) {
      const bf16x8 k0 = *(const bf16x8*)(Ks + r32 * KST + d0 * 32 + hi * 16);
      const bf16x8 k1 = *(const bf16x8*)(Ks + (32 + r32) * KST + d0 * 32 + hi * 16);
      p0 = MFMA32(k0, qr[d0], p0); p1 = MFMA32(k1, qr[d0], p1);
    }
    if (MODE == 1) {
      const int nq = it.n0 + qi, kb = it.n0 - 64 + 64 * t;
#pragma unroll
      for (int i = 0; i < 16; ++i) {
        const int nk = kb + crow(i, hi), nk2 = nk + 32;
        const int d1 = nq - nk, d2 = nq - nk2;
        const bool ok1 = (d1 <= 64) && (d1 >= -64) && (nk >= 0) && (nk < it.N);
        const bool ok2 = (d2 <= 64) && (d2 >= -64) && (nk2 >= 0) && (nk2 < it.N);
        p0[i] = ok1 ? p0[i] : -INFINITY; p1[i] = ok2 ? p1[i] : -INFINITY;
      }
    }
    if (MODE == 2) {
      const int rq = 8 * it.nrb + (qi >> 4), cq = 16 * it.ncb + (qi & 15);
      const int rs_ = min(max(rq - 4, 0), 120), cs_ = min(max(cq - 8, 0), 48);
      const int kr = it.kr0 + 2 * t;
      const bool okr0 = (kr >= rs_) && (kr < rs_ + 8), okr1 = (kr + 1 >= rs_) && (kr + 1 < rs_ + 8);
      const int bi0 = (kr - rq + 7) * 31 - cq + 15;
#pragma unroll
      for (int i = 0; i < 16; ++i) {
        const int kc = it.kc0 + crow(i, hi);
        const bool okc = (kc >= cs_) && (kc < cs_ + 16);
        const bool ok0 = okc && okr0, ok1 = okc && okr1;
        const float b0 = bias_s[ok0 ? bi0 + kc : 0], b1 = bias_s[ok1 ? bi0 + 31 + kc : 0];
        p0[i] = ok0 ? p0[i] + b0 : -INFINITY; p1[i] = ok1 ? p1[i] + b1 : -INFINITY;
      }
    }
    float pmax = p0[0];
#pragma unroll
    for (int i = 1; i < 16; ++i) pmax = fmaxf(pmax, p0[i]);
#pragma unroll
    for (int i = 0; i < 16; ++i) pmax = fmaxf(pmax, p1[i]);
    pmax = swap_max(pmax);
    const float mn = fmaxf(m_run, pmax);
    const float alpha = __builtin_amdgcn_exp2f(m_run - mn);
    m_run = mn;
    float ps = 0.f;
#pragma unroll
    for (int i = 0; i < 16; ++i) { p0[i] = __builtin_amdgcn_exp2f(p0[i] - mn); ps += p0[i]; }
#pragma unroll
    for (int i = 0; i < 16; ++i) { p1[i] = __builtin_amdgcn_exp2f(p1[i] - mn); ps += p1[i]; }
    ps = swap_sum(ps);
    l_run = l_run * alpha + ps;
#pragma unroll
    for (int i = 0; i < 16; ++i) { o[0][i] *= alpha; o[1][i] *= alpha; }
    bf16x8 pb[4];
#pragma unroll
    for (int s = 0; s < 2; ++s) {
      u32x4 a = {cvtpk(p0[8 * s], p0[8 * s + 1]), cvtpk(p0[8 * s + 2], p0[8 * s + 3]), cvtpk(p0[8 * s + 4], p0[8 * s + 5]), cvtpk(p0[8 * s + 6], p0[8 * s + 7])};
      u32x4 b = {cvtpk(p1[8 * s], p1[8 * s + 1]), cvtpk(p1[8 * s + 2], p1[8 * s + 3]), cvtpk(p1[8 * s + 4], p1[8 * s + 5]), cvtpk(p1[8 * s + 6], p1[8 * s + 7])};
      pb[s] = __builtin_bit_cast(bf16x8, a); pb[2 + s] = __builtin_bit_cast(bf16x8, b);
    }
#pragma unroll
    for (int db = 0; db < 2; ++db)
#pragma unroll
      for (int s = 0; s < 4; ++s) {
        const s16x4 lo = __builtin_amdgcn_ds_read_tr16_b64_v4i16((lds_s16x4*)(Vs + db * 4096 + (16 * s) * 64 + vrd));
        const s16x4 hh = __builtin_amdgcn_ds_read_tr16_b64_v4i16((lds_s16x4*)(Vs + db * 4096 + (16 * s + 8) * 64 + vrd));
        const bf16x8 a = {lo[0], lo[1], lo[2], lo[3], hh[0], hh[1], hh[2], hh[3]};
        o[db] = MFMA32(a, pb[s], o[db]);
      }
  }
  const float inv = 1.f / l_run;
  const int bq = qpos;
  bf16_t* orow = it.out + (size_t)bq * it.ldo;
#pragma unroll
  for (int db = 0; db < 2; ++db)
#pragma unroll
    for (int g = 0; g < 4; ++g) {
      u32x2 v = {cvtpk(o[db][4 * g] * inv, o[db][4 * g + 1] * inv), cvtpk(o[db][4 * g + 2] * inv, o[db][4 * g + 3] * inv)};
      *(u32x2*)(orow + db * 32 + 8 * g + 4 * hi) = v;
    }
  if (MODE == 1) { if (hi == 0) it.lse[(size_t)bq * 6] = m_run + __builtin_amdgcn_logf(l_run); }
}

DI void attn_dense_skew(const bf16_t* __restrict__ Q, const bf16_t* __restrict__ K, const bf16_t* __restrict__ V, int q0, bf16_t* __restrict__ out,
                        char* smem, const int tid512, const int grp) {
  constexpr int DQ = 96, CPR = 12, KST = 208, NT = SEQ / 64, KB = 64 * KST, VOFF = 2 * KB;
  const int lane = tid512 & 63, w = (tid512 >> 6) & 3, r32 = lane & 31, hi = lane >> 5;
  const int qpos = q0 + w * 32 + r32;
  bf16x8 qr[DQ / 16];
#pragma unroll
  for (int d0 = 0; d0 < DQ / 16; ++d0) qr[d0] = *(const bf16x8*)(Q + (size_t)qpos * DQ + d0 * 16 + hi * 8);
  f32x16 o[2];
#pragma unroll
  for (int i = 0; i < 16; ++i) { o[0][i] = 0.f; o[1][i] = 0.f; }
  float m_run = -1e30f, l_run = 0.f;
  const int kr0 = tid512 / CPR, kc0 = tid512 - kr0 * CPR, c1 = tid512 + 512, kr1 = c1 / CPR, kc1 = c1 - kr1 * CPR, vr = tid512 >> 3, vc = tid512 & 7;
  const bool two = tid512 < 256;
  const bf16_t* Kp0 = K + (size_t)kr0 * DQ + kc0 * 8; const bf16_t* Kp1 = K + (size_t)kr1 * DQ + kc1 * 8; const bf16_t* Vp = V + (size_t)vr * 64 + vc * 8;
  const int ks0 = kr0 * KST + kc0 * 16, ks1 = kr1 * KST + kc1 * 16, vs0 = VOFF + (vc >> 2) * 4096 + vr * 64 + (vc & 3) * 16;
  u32x4 rk0, rk1 = u32x4{0u, 0u, 0u, 0u}, rv;
  auto load = [&](int t) {
    const size_t ro = (size_t)t * 64;
    rk0 = *(const u32x4*)(Kp0 + ro * DQ); if (two) rk1 = *(const u32x4*)(Kp1 + ro * DQ); rv = *(const u32x4*)(Vp + ro * 64);
  };
  auto store = [&](int kb, int vb) {
    char* kbp = smem + kb * KB;
    *(u32x4*)(kbp + ks0) = rk0; if (two) *(u32x4*)(kbp + ks1) = rk1; *(u32x4*)(smem + vb * 8192 + vs0) = rv;
  };
  const int vrd = ((lane >> 5) * 4 + ((lane & 15) >> 2)) * 64 + ((lane >> 4) & 1) * 32 + (lane & 3) * 8;
  __syncthreads();
  load(0); store(0, 0); load(1);
  __syncthreads();
  if (grp == 1) __syncthreads();
  int vcur = 0;
  for (int t = 0; t < NT; ++t) {
    const int vnext = vcur == 2 ? 0 : vcur + 1;
    const char* Ks = smem + (t & 1) * KB; const char* Vs = smem + VOFF + vcur * 8192;
    if (t + 1 < NT) store((t + 1) & 1, vnext);
    if (t + 2 < NT) load(t + 2);
    f32x16 p0, p1;
#pragma unroll
    for (int i = 0; i < 16; ++i) { p0[i] = 0.f; p1[i] = 0.f; }
    {
      const char* kp = Ks + r32 * KST + hi * 16;
      bf16x8 ka[2][2];
      ka[0][0] = *(const bf16x8*)(kp); ka[0][1] = *(const bf16x8*)(kp + 32 * KST);
      ka[1][0] = *(const bf16x8*)(kp + 32); ka[1][1] = *(const bf16x8*)(kp + 32 * KST + 32);
#pragma unroll
      for (int d0 = 0; d0 < DQ / 16; ++d0) {
        p0 = MFMA32(ka[d0 & 1][0], qr[d0], p0); p1 = MFMA32(ka[d0 & 1][1], qr[d0], p1);
        if (d0 + 2 < DQ / 16) { ka[d0 & 1][0] = *(const bf16x8*)(kp + (d0 + 2) * 32); ka[d0 & 1][1] = *(const bf16x8*)(kp + 32 * KST + (d0 + 2) * 32); }
      }
    }
    float pmax = p0[0];
#pragma unroll
    for (int i = 1; i < 16; ++i) pmax = fmaxf(pmax, p0[i]);
#pragma unroll
    for (int i = 0; i < 16; ++i) pmax = fmaxf(pmax, p1[i]);
    pmax = swap_max(pmax);
    {
      const float mn = fmaxf(m_run, pmax);
      const float alpha = __builtin_amdgcn_exp2f(m_run - mn);
      m_run = mn; l_run *= alpha;
#pragma unroll
      for (int i = 0; i < 16; ++i) { o[0][i] *= alpha; o[1][i] *= alpha; }
    }
    asm volatile("" : "+v"(p0), "+v"(p1), "+v"(o[0]), "+v"(o[1]), "+v"(m_run));
    __syncthreads();
    asm volatile("" : "+v"(p0), "+v"(p1), "+v"(o[0]), "+v"(o[1]), "+v"(m_run));
    s16x4 vlo[4], vhi[4];
#pragma unroll
    for (int s2 = 0; s2 < 4; ++s2) {
      vlo[s2] = __builtin_amdgcn_ds_read_tr16_b64_v4i16((lds_s16x4*)(Vs + (16 * s2) * 64 + vrd));
      vhi[s2] = __builtin_amdgcn_ds_read_tr16_b64_v4i16((lds_s16x4*)(Vs + (16 * s2 + 8) * 64 + vrd));
    }
    float ps = 0.f;
#pragma unroll
    for (int i = 0; i < 16; ++i) { p0[i] = __builtin_amdgcn_exp2f(p0[i] - m_run); ps += p0[i]; }
#pragma unroll
    for (int i = 0; i < 16; ++i) { p1[i] = __builtin_amdgcn_exp2f(p1[i] - m_run); ps += p1[i]; }
    l_run += swap_sum(ps);
    bf16x8 pb[4];
#pragma unroll
    for (int s = 0; s < 2; ++s) {
      u32x4 a = {cvtpk(p0[8 * s], p0[8 * s + 1]), cvtpk(p0[8 * s + 2], p0[8 * s + 3]), cvtpk(p0[8 * s + 4], p0[8 * s + 5]), cvtpk(p0[8 * s + 6], p0[8 * s + 7])};
      u32x4 b = {cvtpk(p1[8 * s], p1[8 * s + 1]), cvtpk(p1[8 * s + 2], p1[8 * s + 3]), cvtpk(p1[8 * s + 4], p1[8 * s + 5]), cvtpk(p1[8 * s + 6], p1[8 * s + 7])};
      pb[s] = __builtin_bit_cast(bf16x8, a); pb[2 + s] = __builtin_bit_cast(bf16x8, b);
    }
    {
      s16x4 wlo[4], whi[4];
#pragma unroll
      for (int s2 = 0; s2 < 4; ++s2) {
        wlo[s2] = __builtin_amdgcn_ds_read_tr16_b64_v4i16((lds_s16x4*)(Vs + 4096 + (16 * s2) * 64 + vrd));
        whi[s2] = __builtin_amdgcn_ds_read_tr16_b64_v4i16((lds_s16x4*)(Vs + 4096 + (16 * s2 + 8) * 64 + vrd));
      }
#pragma unroll
      for (int s2 = 0; s2 < 4; ++s2) { const bf16x8 a = {vlo[s2][0], vlo[s2][1], vlo[s2][2], vlo[s2][3], vhi[s2][0], vhi[s2][1], vhi[s2][2], vhi[s2][3]}; o[0] = MFMA32(a, pb[s2], o[0]); }
#pragma unroll
      for (int s2 = 0; s2 < 4; ++s2) { const bf16x8 a = {wlo[s2][0], wlo[s2][1], wlo[s2][2], wlo[s2][3], whi[s2][0], whi[s2][1], whi[s2][2], whi[s2][3]}; o[1] = MFMA32(a, pb[s2], o[1]); }
    }
    asm volatile("" : "+v"(o[0]), "+v"(o[1]));
    __syncthreads();
    asm volatile("" : "+v"(o[0]), "+v"(o[1]));
    vcur = vnext;
  }
  if (grp == 0) __syncthreads();
  const float inv = 1.f / l_run;
  bf16_t* orow = out + (size_t)qpos * 384;
#pragma unroll
  for (int db = 0; db < 2; ++db)
#pragma unroll
    for (int g = 0; g < 4; ++g) {
      u32x2 v = {cvtpk(o[db][4 * g] * inv, o[db][4 * g + 1] * inv), cvtpk(o[db][4 * g + 2] * inv, o[db][4 * g + 3] * inv)};
      *(u32x2*)(orow + db * 32 + 8 * g + 4 * hi) = v;
    }
}

DI float wave_sum(float v) {
  v += __shfl_xor(v, 32); v += __shfl_xor(v, 16); v += __shfl_xor(v, 8); v += __shfl_xor(v, 4); v += __shfl_xor(v, 2); v += __shfl_xor(v, 1); return v;
}
DI float gain_of(const Params& p, int kind, int l, int k) {
  switch (kind) {
    case 0: return p.g_mix[l * 1024 + k];
    case 1: return p.q_norm[l * 256 + k];
    case 2: return p.kv_norm[l * 128 + k];
    case 3: return k < 384 ? p.on_a[l * 384 + k] : (k < 768 ? p.on_b[l * 384 + k - 384] : p.on_c[l * 256 + k - 768]);
    case 4: return p.g_mlp[l * 1024 + k];
    default: return 1.f;
  }
}
DI int map_col(int kind, int n) {
  if (kind == 0) {
    if (n < 384) return n;
    if (n < 448) { const int wv = n - 384, c = wv & 31, sub = wv >> 5; return c < 16 ? 384 + sub * 16 + c : -1; }
    if (n < 1600) return 416 + (n - 448);
    if (n < 2368) return 1568 + (n - 1600);
    return -1;
  }
  if (kind == 1) {
    if (n < 384) return (n >> 6) * 96 + (n & 63);
    if (n < 576) { const int wv = n - 384, g = wv >> 6, wi = wv & 63, sub = wi >> 5, c = wi & 31, hd = 2 * g + (c >> 4), fi = c & 15; return hd * 96 + 64 + sub * 16 + fi; }
    return -1;
  }
  return n;
}
DI void wtile(const Params& p, const float* src, int Nsrc, bf16_t* dst, int K, int kt, int nt, int kind, int l, char* smem, const int tid) {
  float* tile = (float*)smem;
  const int lane = tid & 63, wv = tid >> 6;
  __syncthreads();
  const int n = nt * 64 + lane, sc = map_col(kind, n);
#pragma unroll 4
  for (int r = 0; r < 8; ++r) {
    const int kl = r * 8 + wv, kd = kt * 64 + kl;
    const int k = kind == 5 ? ((kd & ~63) | ((kd & 1) << 5) | ((kd & 63) >> 1)) : kd;
    float v = 0.f;
    if (sc >= 0) v = src[(size_t)k * Nsrc + sc] * gain_of(p, kind, l, k);
    tile[kl * 65 + lane] = v;
  }
  __syncthreads();
#pragma unroll 4
  for (int r = 0; r < 8; ++r) {
    const int nl = r * 8 + wv;
    dst[(size_t)(nt * 64 + nl) * K + kt * 64 + lane] = f2bf(tile[lane * 65 + nl]);
  }
}

NI void phase_prep() {
  const Params& p = kparams(); char* smem = g_smem; const int tid = otid(), bid = obid();
  char* ws = p.ws;
  constexpr int T_WIN = (N_IN_PAD / 64) * 16, T_WUQ = (N_UQ_PAD / 64) * 4, T_WUKV = (N_UKV / 64) * 2, T_WOUT = 16 * 16, T_W1 = 64 * 16, T_W2 = 16 * 64;
  constexpr int T_L = T_WIN + T_WUQ + T_WUKV + T_WOUT + T_W1 + T_W2;
  for (int j = bid; j < NLAYER * T_L; j += gridDim.x) {
    const int l = j / T_L; int r = j - l * T_L;
    char* lw = ws + OFF_W + (size_t)l * LW_SIZE;
    if (r < T_WIN) { wtile(p, p.w_in + (size_t)l * 1024 * 2336, 2336, (bf16_t*)(lw + LW_WIN), 1024, r & 15, r >> 4, 0, l, smem, tid); continue; }
    r -= T_WIN;
    if (r < T_WUQ) { wtile(p, p.w_uq + (size_t)l * 256 * 576, 576, (bf16_t*)(lw + LW_WUQ), 256, r & 3, r >> 2, 1, l, smem, tid); continue; }
    r -= T_WUQ;
    if (r < T_WUKV) { wtile(p, p.w_ukv + (size_t)l * 128 * 768, 768, (bf16_t*)(lw + LW_WUKV), 128, r & 1, r >> 1, 2, l, smem, tid); continue; }
    r -= T_WUKV;
    if (r < T_WOUT) { wtile(p, p.w_out + (size_t)l * 1024 * 1024, 1024, (bf16_t*)(lw + LW_WOUT), 1024, r & 15, r >> 4, 3, l, smem, tid); continue; }
    r -= T_WOUT;
    if (r < T_W1) { wtile(p, p.w_mlp_in + (size_t)l * 1024 * 4096, 4096, (bf16_t*)(lw + LW_W1), 1024, r & 15, r >> 4, 4, l, smem, tid); continue; }
    r -= T_W1;
    wtile(p, p.w_mlp_out + (size_t)l * 4096 * 1024, 1024, (bf16_t*)(lw + LW_W2), 4096, r & 63, r >> 6, 5, l, smem, tid);
  }
  const size_t gtid = (size_t)bid * NTHR + tid, gsz = (size_t)gridDim.x * NTHR;
  bf16_t* xb = (bf16_t*)(ws + OFF_XB);
  {
    const int lane = tid & 63, gw = bid * (NTHR / 64) + (tid >> 6), nw = gridDim.x * (NTHR / 64);
    float* px1 = (float*)(ws + OFF_PX1);
    for (int row = gw; row < NTOK; row += nw) {
      float ss = 0.f;
#pragma unroll
      for (int j = 0; j < 4; ++j) {
        const f32x4 a = *(const f32x4*)(p.x + (size_t)row * DM + j * 256 + lane * 4);
        ss += a[0] * a[0] + a[1] * a[1] + a[2] * a[2] + a[3] * a[3];
        u32x2 o = {cvtpk(a[0], a[1]), cvtpk(a[2], a[3])};
        *(u32x2*)(xb + (size_t)row * DM + j * 256 + lane * 4) = o;
      }
      ss = wave_sum(ss);
      if (lane < 16) px1[(size_t)row * 16 + lane] = lane == 0 ? ss : 0.f;
    }
  }
  float* c32 = (float*)(ws + OFF_COS32); float* s32 = (float*)(ws + OFF_SIN32); float* c16 = (float*)(ws + OFF_COS16); float* s16 = (float*)(ws + OFF_SIN16);
  for (size_t i = gtid; i < (size_t)SEQ * 48; i += gsz) {
    int pos, fi; float invf; float *cd, *sd;
    if (i < (size_t)SEQ * 32) { pos = (int)(i >> 5); fi = (int)(i & 31); invf = __builtin_amdgcn_exp2f(-(float)fi * (13.287712379549449f / 32.f)); cd = c32 + i; sd = s32 + i; }
    else { const size_t j = i - (size_t)SEQ * 32; pos = (int)(j >> 4); fi = (int)(j & 15); invf = __builtin_amdgcn_exp2f(-(float)fi * (13.287712379549449f / 16.f)); cd = c16 + j; sd = s16 + j; }
    const float ang = (float)pos * invf;
    const double rev = (double)ang * 0.15915494309189535;
    const float fr = (float)(rev - rint(rev));
    *cd = __builtin_amdgcn_cosf(fr); *sd = __builtin_amdgcn_sinf(fr);
  }
}

NI void phase_g1(int l_) {
  const Params& p = kparams(); char* smem = g_smem; const int l = __builtin_amdgcn_readfirstlane(l_); const int tid = otid(), bid = obid(); (void)tid; (void)bid;
  char* ws = p.ws;
  EpiG1 e;
  e.cqkv = (bf16_t*)(ws + OFF_CQKV); e.KA = (bf16_t*)(ws + OFF_KA); e.qB = (bf16_t*)(ws + OFF_QB); e.qC = (bf16_t*)(ws + OFF_QC);
  e.cos32 = (const float*)(ws + OFF_COS32); e.sin32 = (const float*)(ws + OFF_SIN32); e.cos16 = (const float*)(ws + OFF_COS16); e.sin16 = (const float*)(ws + OFF_SIN16);
  e.qs = p.qscaleB; e.pq = (float*)(ws + OFF_PQ); e.pkv = (float*)(ws + OFF_PKV);
  const bf16_t* A = (const bf16_t*)(ws + OFF_XB);
  const bf16_t* Bt = (const bf16_t*)(ws + OFF_W + (size_t)l * LW_SIZE + LW_WIN);
  constexpr int NNT = N_IN_PAD / 256;
  FOR_TILES(NNT, mt, nt, gemm_tile<16>(A, 1024, Bt, 1024, 1024, mt * 256, nt * 256, e, tid, (const float*)(ws + OFF_PX1));)
}
NI void phase_g2(int l_) {
  const Params& p = kparams(); char* smem = g_smem; const int l = __builtin_amdgcn_readfirstlane(l_); const int tid = otid(), bid = obid(); (void)tid; (void)bid;
  char* ws = p.ws;
  const bf16_t* A = (const bf16_t*)(ws + OFF_CQKV);
  EpiUQ eq; eq.QA = (bf16_t*)(ws + OFF_QA); eq.cos16 = (const float*)(ws + OFF_COS16); eq.sin16 = (const float*)(ws + OFF_SIN16); eq.qs = p.qscaleA;
  EpiUKV ek; ek.KA = (bf16_t*)(ws + OFF_KA); ek.VA = (bf16_t*)(ws + OFF_VA);
  const bf16_t* Wq = (const bf16_t*)(ws + OFF_W + (size_t)l * LW_SIZE + LW_WUQ);
  const bf16_t* Wkv = (const bf16_t*)(ws + OFF_W + (size_t)l * LW_SIZE + LW_WUKV);
  FOR_TILES(3, mt, nt, gemm_tile<4>(A, 384, Wq, 256, 256, mt * 256, nt * 256, eq, tid, (const float*)(ws + OFF_PQ));)
  FOR_TILES(3, mt, nt, gemm_tile<2>(A + 256, 384, Wkv, 128, 128, mt * 256, nt * 256, ek, tid, (const float*)(ws + OFF_PKV));)
}
NI void phase_attn(int l_) {
  const Params& p = kparams(); char* smem = g_smem; const int l = __builtin_amdgcn_readfirstlane(l_); const int tid = otid(), bid = obid(); (void)tid; (void)bid;
  char* ws = p.ws;
  constexpr int NA = 1536, NBI = 4608, NC = 1024;
  const int grp = tid >> 8, t256 = tid & 255; char* gsm = smem + grp * ATT_LDS;
  for (int i0 = bid * 2; i0 < NA; i0 += gridDim.x * 2) {
    const int i = i0 + grp, xcd = (i >> 1) & 7, j = ((i >> 4) << 1) | (i & 1);
    const int bh = (j >> 6) * 8 + xcd, qb = j & 63, b = bh / 6, h = bh - b * 6;
    attn_dense_skew((const bf16_t*)(ws + OFF_QA) + (size_t)bh * SEQ * 96, (const bf16_t*)(ws + OFF_KA) + (size_t)bh * SEQ * 96, (const bf16_t*)(ws + OFF_VA) + (size_t)bh * SEQ * 64,
                    qb * 128, (bf16_t*)(ws + OFF_OA) + (size_t)b * SEQ * 384 + h * 64, smem, tid, grp);
  }
  for (int i0 = bid * 2; i0 < NBI; i0 += gridDim.x * 2) {
    AttnItem it{};
    const int i = i0 + grp, xcd = (i >> 1) & 7, j = ((i >> 4) << 1) | (i & 1);
    const int g = (j >> 6) * 8 + xcd, c = j & 63, br = g / 24, bh = g - br * 24, b = bh / 6, h = bh - b * 6;
    const int dil = br == 0 ? 1 : (br == 1 ? 4 : 16), cpr = 64 / dil;
    it.Q = (const bf16_t*)(ws + OFF_QB) + (size_t)bh * SEQ * 64; it.K = (const bf16_t*)(ws + OFF_KB) + (size_t)bh * SEQ * 64; it.V = (const bf16_t*)(ws + OFF_VB) + (size_t)bh * SEQ * 64;
    it.dil = dil; it.res = c / cpr; it.n0 = (c - it.res * cpr) * 128; it.N = SEQ / dil;
    it.out = (bf16_t*)(ws + OFF_OB) + (size_t)br * NTOK * 384 + (size_t)b * SEQ * 384 + h * 64; it.ldo = 384;
    it.lse = (float*)(ws + OFF_LSEB) + (size_t)br * NTOK * 6 + (size_t)b * SEQ * 6 + h;
    attn_block<64, 1>(it, gsm, t256);
  }
  for (int i0 = bid * 2; i0 < NC; i0 += gridDim.x * 2) {
    AttnItem it{};
    const int i = i0 + grp, xcd = (i >> 1) & 7, j = ((i >> 4) << 1) | (i & 1);
    const int bh = (j >> 6) * 8 + xcd, blk = j & 63, b = bh >> 2, h = bh & 3;
    it.Q = (const bf16_t*)(ws + OFF_QC) + (size_t)bh * SEQ * 64; it.K = (const bf16_t*)(ws + OFF_KC) + (size_t)bh * SEQ * 64; it.V = (const bf16_t*)(ws + OFF_VC) + (size_t)bh * SEQ * 64;
    it.nrb = blk >> 2; it.ncb = blk & 3;
    it.kr0 = min(max(8 * it.nrb - 4, 0), 112); it.kc0 = min(max(16 * it.ncb - 8, 0), 32);
    it.out = (bf16_t*)(ws + OFF_OC) + (size_t)b * SEQ * 256 + h * 64; it.ldo = 256;
    it.rpb = p.rpb + ((size_t)l * 4 + h) * 465;
    attn_block<64, 2>(it, gsm, t256);
  }
}
NI void phase_mix() {
  const Params& p = kparams(); const int tid = otid(), bid = obid();
  char* ws = p.ws;
  const int lane = tid & 63, gw = bid * (NTHR / 64) + (tid >> 6), nw = gridDim.x * (NTHR / 64);
  const bf16_t* oA = (const bf16_t*)(ws + OFF_OA); const bf16_t* oB = (const bf16_t*)(ws + OFF_OB); const bf16_t* oC = (const bf16_t*)(ws + OFF_OC);
  const float* lse = (const float*)(ws + OFF_LSEB);
  bf16_t* mixed = (bf16_t*)(ws + OFF_MIXED);
  for (int tok = gw; tok < NTOK; tok += nw) {
    float v[16];
    if (lane < 24 || lane >= 48) {
      const bf16_t* src = lane < 24 ? oA + (size_t)tok * 384 + lane * 16 : oC + (size_t)tok * 256 + (lane - 48) * 16;
      const u32x4 a = *(const u32x4*)src, b = *(const u32x4*)(src + 8);
#pragma unroll
      for (int j = 0; j < 4; ++j) { v[2 * j] = bf2f(a[j] & 0xffffu); v[2 * j + 1] = bf2f(a[j] >> 16); v[8 + 2 * j] = bf2f(b[j] & 0xffffu); v[8 + 2 * j + 1] = bf2f(b[j] >> 16); }
    } else {
      const int col = (lane - 24) * 16, hd = col >> 6;
      const float l0 = lse[(size_t)tok * 6 + hd], l1 = lse[(size_t)NTOK * 6 + (size_t)tok * 6 + hd], l2 = lse[(size_t)2 * NTOK * 6 + (size_t)tok * 6 + hd];
      const float mx = fmaxf(l0, fmaxf(l1, l2));
      float w0 = __builtin_amdgcn_exp2f(l0 - mx), w1 = __builtin_amdgcn_exp2f(l1 - mx), w2 = __builtin_amdgcn_exp2f(l2 - mx);
      const float wi = 1.f / (w0 + w1 + w2); w0 *= wi; w1 *= wi; w2 *= wi;
#pragma unroll
      for (int j = 0; j < 16; ++j) v[j] = 0.f;
#pragma unroll
      for (int br = 0; br < 3; ++br) {
        const float wb = br == 0 ? w0 : (br == 1 ? w1 : w2);
        const bf16_t* src = oB + (size_t)br * NTOK * 384 + (size_t)tok * 384 + col;
        const u32x4 a = *(const u32x4*)src, b = *(const u32x4*)(src + 8);
#pragma unroll
        for (int j = 0; j < 4; ++j) { v[2 * j] += wb * bf2f(a[j] & 0xffffu); v[2 * j + 1] += wb * bf2f(a[j] >> 16); v[8 + 2 * j] += wb * bf2f(b[j] & 0xffffu); v[8 + 2 * j + 1] += wb * bf2f(b[j] >> 16); }
      }
    }
    float ss = 0.f;
#pragma unroll
    for (int j = 0; j < 16; ++j) ss += v[j] * v[j];
    const float sa = wave_sum(lane < 24 ? ss : 0.f), sb = wave_sum((lane >= 24 && lane < 48) ? ss : 0.f), sc = wave_sum(lane >= 48 ? ss : 0.f);
    const float rs = lane < 24 ? rsqrtf(sa * (1.f / 384.f) + 1e-6f) : (lane < 48 ? rsqrtf(sb * (1.f / 384.f) + 1e-6f) : rsqrtf(sc * (1.f / 256.f) + 1e-6f));
    u32x4 oa, ob;
#pragma unroll
    for (int j = 0; j < 4; ++j) { oa[j] = cvtpk(v[2 * j] * rs, v[2 * j + 1] * rs); ob[j] = cvtpk(v[8 + 2 * j] * rs, v[8 + 2 * j + 1] * rs); }
    bf16_t* dst = mixed + (size_t)tok * 1024 + lane * 16;
    *(u32x4*)dst = oa; *(u32x4*)(dst + 8) = ob;
  }
}
NI void phase_wout(int l_) {
  const Params& p = kparams(); char* smem = g_smem; const int l = __builtin_amdgcn_readfirstlane(l_); const int tid = otid(), bid = obid(); (void)tid; (void)bid;
  char* ws = p.ws;
  EpiRes e; e.xb = (bf16_t*)(ws + OFF_XB); e.pout = (float*)(ws + OFF_PX2);
  const bf16_t* A = (const bf16_t*)(ws + OFF_MIXED);
  const bf16_t* Bt = (const bf16_t*)(ws + OFF_W + (size_t)l * LW_SIZE + LW_WOUT);
  FOR_TILES(4, mt, nt, gemm_tile<0>(A, 1024, Bt, 1024, 1024, mt * 256, nt * 256, e, tid, nullptr);)
}
NI void phase_mlp1(int l_) {
  const Params& p = kparams(); char* smem = g_smem; const int l = __builtin_amdgcn_readfirstlane(l_); const int tid = otid(), bid = obid(); (void)tid; (void)bid;
  char* ws = p.ws;
  EpiMlp1 e; e.hid = (bf16_t*)(ws + OFF_HID);
  const bf16_t* A = (const bf16_t*)(ws + OFF_XB);
  const bf16_t* Bt = (const bf16_t*)(ws + OFF_W + (size_t)l * LW_SIZE + LW_W1);
  FOR_TILES(16, mt, nt, gemm_tile<16>(A, 1024, Bt, 1024, 1024, mt * 256, nt * 256, e, tid, (const float*)(ws + OFF_PX2));)
}
NI void phase_mlp2(int l_) {
  const Params& p = kparams(); char* smem = g_smem; const int l = __builtin_amdgcn_readfirstlane(l_); const int tid = otid(), bid = obid(); (void)tid; (void)bid;
  char* ws = p.ws;
  EpiRes e; e.xb = (bf16_t*)(ws + OFF_XB); e.pout = (float*)(ws + OFF_PX1);
  const bf16_t* A = (const bf16_t*)(ws + OFF_HID);
  const bf16_t* Bt = (const bf16_t*)(ws + OFF_W + (size_t)l * LW_SIZE + LW_W2);
  FOR_TILES(4, mt, nt, gemm_tile<0>(A, DFF, Bt, DFF, DFF, mt * 256, nt * 256, e, tid, nullptr);)
}
NI void phase_final() {
  const Params& p = kparams(); const int tid = otid(), bid = obid();
  const int lane = tid & 63, gw = bid * (NTHR / 64) + (tid >> 6), nw = gridDim.x * (NTHR / 64);
  const bf16_t* xb = (const bf16_t*)(p.ws + OFF_XB);
  for (int tok = gw; tok < NTOK; tok += nw) {
    float* row = p.out + (size_t)tok * DM;
    f32x4 v[4]; float ss = 0.f;
#pragma unroll
    for (int j = 0; j < 4; ++j) {
      const u32x2 r = *(const u32x2*)(xb + (size_t)tok * DM + j * 256 + lane * 4);
      v[j] = f32x4{bf2f(r[0] & 0xffffu), bf2f(r[0] >> 16), bf2f(r[1] & 0xffffu), bf2f(r[1] >> 16)};
      ss += v[j][0] * v[j][0] + v[j][1] * v[j][1] + v[j][2] * v[j][2] + v[j][3] * v[j][3];
    }
    ss = wave_sum(ss);
    const float rs = rsqrtf(ss * (1.f / 1024.f) + 1e-6f);
#pragma unroll
    for (int j = 0; j < 4; ++j) { const f32x4 g = *(const f32x4*)(p.g_final + j * 256 + lane * 4); f32x4 o = {v[j][0] * rs * g[0], v[j][1] * rs * g[1], v[j][2] * rs * g[2], v[j][3] * rs * g[3]}; *(f32x4*)(row + j * 256 + lane * 4) = o; }
  }
}

DI unsigned xcc_id() { return (unsigned)__builtin_amdgcn_s_getreg((3 << 11) | 20) & 0xFu; }
DI void grid_barrier(unsigned* base, unsigned k, unsigned xcc, unsigned n_x, unsigned nxcd) {
  __syncthreads();
  if (threadIdx.x == 0) {
    unsigned* arr = base + 64 * (16 + xcc);
    unsigned* garr = base + 64 * 32;
    const unsigned a = __hip_atomic_fetch_add(arr, 1u, __ATOMIC_RELAXED, __HIP_MEMORY_SCOPE_AGENT);
    if (a + 1 == n_x * k) {
      __builtin_amdgcn_fence(__ATOMIC_RELEASE, "agent");
      asm volatile("s_waitcnt vmcnt(0)" ::: "memory");
      __hip_atomic_fetch_add(garr, 1u, __ATOMIC_RELAXED, __HIP_MEMORY_SCOPE_AGENT);
    }
    while (__hip_atomic_load(garr, __ATOMIC_RELAXED, __HIP_MEMORY_SCOPE_AGENT) < nxcd * k) __builtin_amdgcn_s_sleep(1);
    __builtin_amdgcn_fence(__ATOMIC_ACQUIRE, "agent");
    asm volatile("s_waitcnt vmcnt(0)" ::: "memory");
  }
  __syncthreads();
}

constexpr int NPHASE = 2 + 7 * NLAYER;
DI void run_phase(int ph) {
  if (ph == 0) { phase_prep(); return; }
  if (ph == NPHASE - 1) { phase_final(); return; }
  const int l = (ph - 1) / 7, st = (ph - 1) - l * 7;
  switch (st) {
    case 0: phase_g1(l); break;
    case 1: phase_g2(l); break;
    case 2: phase_attn(l); break;
    case 3: phase_mix(); break;
    case 4: phase_wout(l); break;
    case 5: phase_mlp1(l); break;
    default: phase_mlp2(l); break;
  }
}

__global__ void __launch_bounds__(512) mega(Params p, int ph_lo, int ph_hi) {
  cg::grid_group grid = cg::this_grid();
  unsigned* bar = (unsigned*)(p.ws + OFF_BAR);
  const unsigned xcc = xcc_id();
  unsigned n_x = 0, nxcd = 0;
  if (threadIdx.x == 0) __hip_atomic_fetch_add(bar + 64 * xcc, 1u, __ATOMIC_RELAXED, __HIP_MEMORY_SCOPE_AGENT);
  for (int ph = ph_lo; ph < ph_hi; ++ph) {
    run_phase(ph);
    if (ph + 1 < ph_hi) {
      if (ph == ph_lo) {
        grid.sync();
        if (threadIdx.x == 0) {
          n_x = __hip_atomic_load(bar + 64 * xcc, __ATOMIC_RELAXED, __HIP_MEMORY_SCOPE_AGENT);
          for (int x = 0; x < 16; ++x) nxcd += __hip_atomic_load(bar + 64 * x, __ATOMIC_RELAXED, __HIP_MEMORY_SCOPE_AGENT) != 0u;
        }
      } else grid_barrier(bar, (unsigned)(ph - ph_lo), xcc, n_x, nxcd);
    }
  }
}

extern "C" void kernel_launch(void* const* d_in, const int* in_sizes, int n_in, void* d_out, int out_size, void* d_ws, size_t ws_size, hipStream_t stream) {
  static int grid_blocks = 0;
  if (!grid_blocks) {
    int dev = 0, cus = 0, per_cu = 0;
    (void)hipGetDevice(&dev);
    (void)hipDeviceGetAttribute(&cus, hipDeviceAttributeMultiprocessorCount, dev);
    (void)hipOccupancyMaxActiveBlocksPerMultiprocessor(&per_cu, mega, NTHR, 0);
    if (per_cu > 1) per_cu = 1;
    grid_blocks = cus * per_cu;
    if (ws_size < OFF_END) fprintf(stderr, "kernel_launch: workspace too small: %zu < %zu\n", ws_size, (size_t)OFF_END);
  }
  Params p;
  memset(&p, 0, sizeof(p));
  p.x = (const float*)d_in[0]; p.g_mix = (const float*)d_in[1]; p.w_in = (const float*)d_in[2]; p.q_norm = (const float*)d_in[3];
  p.w_uq = (const float*)d_in[4]; p.kv_norm = (const float*)d_in[5]; p.w_ukv = (const float*)d_in[6]; p.rpb = (const float*)d_in[7];
  p.on_a = (const float*)d_in[8]; p.on_b = (const float*)d_in[9]; p.on_c = (const float*)d_in[10]; p.w_out = (const float*)d_in[11];
  p.g_mlp = (const float*)d_in[12]; p.w_mlp_in = (const float*)d_in[13]; p.w_mlp_out = (const float*)d_in[14]; p.g_final = (const float*)d_in[15];
  p.out = (float*)d_out; p.ws = (char*)d_ws;
  p.qscaleA = (float)(1.4426950408889634 / std::sqrt(96.0));
  p.qscaleB = (float)(1.4426950408889634 * 0.125);
#if ONE_LAUNCH
  (void)hipMemsetAsync((char*)d_ws + OFF_BAR, 0, 16384, stream);
  int lo = 0, hi = NPHASE;
  void* args[] = {&p, &lo, &hi};
  hipError_t e = hipLaunchCooperativeKernel((void*)mega, dim3(grid_blocks), dim3(NTHR), args, 0, stream);
  if (e != hipSuccess) fprintf(stderr, "cooperative launch failed: %s (grid %d)\n", hipGetErrorString(e), grid_blocks);
#else
  for (int ph = 0; ph < NPHASE; ++ph) hipLaunchKernelGGL(mega, dim3(grid_blocks), dim3(NTHR), 0, stream, p, ph, ph + 1);
#endif
}
```

```cpp
#include <hip/hip_runtime.h>
#include <hip/hip_cooperative_groups.h>
#include <cstdio>
#include <cmath>
#include <cstring>
namespace cg = cooperative_groups;

#ifndef ONE_LAUNCH
#define ONE_LAUNCH 1
#endif

#define DI __device__ __forceinline__
typedef unsigned short bf16_t;
typedef short bf16x8 __attribute__((ext_vector_type(8)));
typedef short s16x4 __attribute__((ext_vector_type(4)));
typedef float f32x16 __attribute__((ext_vector_type(16)));
typedef float f32x2 __attribute__((ext_vector_type(2)));
typedef float f32x4 __attribute__((ext_vector_type(4)));
typedef __bf16 bf2_t __attribute__((ext_vector_type(2)));
typedef unsigned u32x4 __attribute__((ext_vector_type(4)));
typedef unsigned u32x2 __attribute__((ext_vector_type(2)));
typedef __attribute__((address_space(3))) s16x4 lds_s16x4;

constexpr int SEQ = 8192, NB = 4, NTOK = NB * SEQ, DM = 1024, NLAYER = 4;
constexpr int N_IN_PAD = 2560, N_UQ_PAD = 768, N_UKV = 768, DFF = 4096;
constexpr int NTHR = 512;

constexpr size_t SZ_XB = (size_t)NTOK * DM * 2;
constexpr size_t SZ_WIN = (size_t)N_IN_PAD * 1024 * 2, SZ_WUQ = (size_t)N_UQ_PAD * 256 * 2, SZ_WUKV = (size_t)N_UKV * 128 * 2,
                 SZ_WOUT = (size_t)1024 * 1024 * 2, SZ_W1 = (size_t)DFF * 1024 * 2, SZ_W2 = (size_t)1024 * DFF * 2;
constexpr size_t LW_WIN = 0, LW_WUQ = LW_WIN + SZ_WIN, LW_WUKV = LW_WUQ + SZ_WUQ, LW_WOUT = LW_WUKV + SZ_WUKV, LW_W1 = LW_WOUT + SZ_WOUT,
                 LW_W2 = LW_W1 + SZ_W1, LW_SIZE = LW_W2 + SZ_W2;
constexpr size_t OFF_XB = 0, OFF_W = OFF_XB + SZ_XB, OFF_TAB = OFF_W + NLAYER * LW_SIZE;
constexpr size_t OFF_COS32 = OFF_TAB, OFF_SIN32 = OFF_COS32 + (size_t)SEQ * 32 * 4, OFF_COS16 = OFF_SIN32 + (size_t)SEQ * 32 * 4,
                 OFF_SIN16 = OFF_COS16 + (size_t)SEQ * 16 * 4, OFF_ATT = OFF_SIN16 + (size_t)SEQ * 16 * 4;
constexpr size_t SZ_T384 = (size_t)NTOK * 384 * 2, SZ_QA = (size_t)NB * 6 * SEQ * 96 * 2, SZ_H6 = (size_t)NB * 6 * SEQ * 64 * 2,
                 SZ_H4 = (size_t)NB * 4 * SEQ * 64 * 2;
constexpr size_t OFF_CQKV = OFF_ATT;
constexpr size_t OFF_OA = OFF_CQKV;
constexpr size_t OFF_QA = OFF_CQKV + SZ_T384, OFF_KA = OFF_QA + SZ_QA, OFF_VA = OFF_KA + SZ_QA;
constexpr size_t OFF_QB = OFF_VA + SZ_H6, OFF_KB = OFF_QB + SZ_H6, OFF_VB = OFF_KB + SZ_H6;
constexpr size_t OFF_QC = OFF_VB + SZ_H6, OFF_KC = OFF_QC + SZ_H4, OFF_VC = OFF_KC + SZ_H4;
constexpr size_t OFF_OB = OFF_VC + SZ_H4, OFF_LSEB = OFF_OB + 3 * SZ_T384, OFF_OC = OFF_LSEB + (size_t)3 * NTOK * 6 * 4;
constexpr size_t OFF_SSQ = OFF_OC + (size_t)NTOK * 256 * 2;
constexpr size_t OFF_PX1 = OFF_SSQ, OFF_PX2 = OFF_PX1 + (size_t)NTOK * 16 * 4, OFF_PQ = OFF_PX2 + (size_t)NTOK * 16 * 4, OFF_PKV = OFF_PQ + (size_t)NTOK * 4 * 4;
constexpr size_t OFF_BAR = OFF_PKV + (size_t)NTOK * 2 * 4;
constexpr size_t OFF_END = OFF_BAR + 16384;
constexpr size_t OFF_MIXED = OFF_QA;
constexpr size_t OFF_HID = OFF_ATT;
static_assert(OFF_HID + (size_t)NTOK * DFF * 2 <= OFF_SSQ, "hid fits");
static_assert(OFF_MIXED + (size_t)NTOK * DM * 2 <= OFF_VA, "mixed fits");

struct Params {
  const float *x, *g_mix, *w_in, *q_norm, *w_uq, *kv_norm, *w_ukv, *rpb, *on_a, *on_b, *on_c, *w_out, *g_mlp, *w_mlp_in, *w_mlp_out, *g_final;
  float* out; char* ws;
  float qscaleA, qscaleB;
};
__shared__ __attribute__((aligned(1024))) char g_smem[131072];
#define NI __device__ __forceinline__
DI const Params& kparams() { return *(const Params*)__builtin_amdgcn_kernarg_segment_ptr(); }

DI unsigned cvtpk(float lo, float hi) { f32x2 v = {lo, hi}; bf2_t b = __builtin_convertvector(v, bf2_t); return __builtin_bit_cast(unsigned, b); }
DI bf16_t f2bf(float x) { return (bf16_t)(cvtpk(x, 0.f) & 0xffffu); }
DI float bf2f(unsigned h) { return __uint_as_float(h << 16); }
DI int crow(int i, int h) { return (i & 3) + 8 * (i >> 2) + 4 * h; }
#define MFMA32(a, b, c) __builtin_amdgcn_mfma_f32_32x32x16_bf16((a), (b), (c), 0, 0, 0)
DI float fdot2bf(unsigned a, float c) { bf2_t v = __builtin_bit_cast(bf2_t, a); return __builtin_amdgcn_fdot2_f32_bf16(v, v, c, false); }
DI float swap_max(float v) { auto rr = __builtin_amdgcn_permlane32_swap(__float_as_uint(v), __float_as_uint(v), false, false); return fmaxf(__uint_as_float(rr[0]), __uint_as_float(rr[1])); }
DI float swap_sum(float v) { auto rr = __builtin_amdgcn_permlane32_swap(__float_as_uint(v), __float_as_uint(v), false, false); return __uint_as_float(rr[0]) + __uint_as_float(rr[1]); }

constexpr int ATT_LDS = 53248;
#define FOR_TILES(NN, MT, NT, BODY) { const bool xm_ = gridDim.x == 256; const int st_ = xm_ ? (bid >> 3) : bid, sp_ = xm_ ? 32 : (int)gridDim.x, cn_ = xm_ ? 16 * (NN) : (NTOK / 256) * (NN); \
  for (int j_ = st_; j_ < cn_; j_ += sp_) { int MT = j_ / (NN); const int NT = j_ - MT * (NN); if (xm_) MT += (bid & 7) * 16; BODY } }
DI int otid() { int t = threadIdx.x; asm volatile("" : "+v"(t)); return t; }
DI int obid() { int t = blockIdx.x; asm volatile("" : "+s"(t)); return t; }

template <int NSLOT, class Epi>
DI void gemm_tile(const bf16_t* __restrict__ A, int lda, const bf16_t* __restrict__ Bt, int ldb, int K, int m0, int n0, const Epi& epi, const int tid, const float* pin) {
  const int lane = tid & 63, w = tid >> 6, wm = w >> 2, wn = w & 3, r32 = lane & 31, hi = lane >> 5;
  char* smem = g_smem;
  const int lrow = lane >> 3;
  const int c0 = (lane & 7) ^ (lane >> 4), c1 = (lane & 7) ^ ((lane >> 4) | 4);
  const char* Ab = (const char*)(A + (size_t)m0 * lda);
  const char* Bb = (const char*)(Bt + (size_t)n0 * ldb);
  const unsigned oa0 = (unsigned)(((w * 32 + lrow) * lda + c0 * 8) * 2), oa1 = (unsigned)(((w * 32 + lrow) * lda + c1 * 8) * 2);
  const unsigned ob0 = (unsigned)(((w * 32 + lrow) * ldb + c0 * 8) * 2), ob1 = (unsigned)(((w * 32 + lrow) * ldb + c1 * 8) * 2);
  const int dma_off = (w * 32) * 128 + lane * 16;
  f32x16 acc[4][2];
#pragma unroll
  for (int mi = 0; mi < 4; ++mi)
#pragma unroll
    for (int nj = 0; nj < 2; ++nj)
#pragma unroll
      for (int i = 0; i < 16; ++i) acc[mi][nj][i] = 0.f;
  const int nk = K >> 6;
  const int sw = (r32 >> 1) & 7, sh = sw >> 1, lo16 = 16 * (hi ^ (sw & 1));
  const int a_off = (wm * 128 + r32) * 128 + lo16;
  const int b_off = 32768 + (wn * 64 + r32) * 128 + lo16;
  __syncthreads();
  {
    char* sa = smem + dma_off;
#pragma unroll
    for (int j = 0; j < 4; ++j) {
      __builtin_amdgcn_global_load_lds((const unsigned*)(Ab + (size_t)(j * 8 * lda) * 2 + ((j & 1) ? oa1 : oa0)), (unsigned*)(sa + j * 1024), 16, 0, 0);
      __builtin_amdgcn_global_load_lds((const unsigned*)(Bb + (size_t)(j * 8 * ldb) * 2 + ((j & 1) ? ob1 : ob0)), (unsigned*)(sa + 32768 + j * 1024), 16, 0, 0);
    }
  }
  for (int kt = 0; kt < nk; ++kt) {
    __syncthreads();
    if (kt + 1 < nk) {
      char* sa = smem + ((kt + 1) & 1) * 65536 + dma_off;
      const int k0 = (kt + 1) * 64;
#pragma unroll
      for (int j = 0; j < 4; ++j) {
        __builtin_amdgcn_global_load_lds((const unsigned*)(Ab + (size_t)(j * 8 * lda + k0) * 2 + ((j & 1) ? oa1 : oa0)), (unsigned*)(sa + j * 1024), 16, 0, 0);
        __builtin_amdgcn_global_load_lds((const unsigned*)(Bb + (size_t)(j * 8 * ldb + k0) * 2 + ((j & 1) ? ob1 : ob0)), (unsigned*)(sa + 32768 + j * 1024), 16, 0, 0);
      }
    }
    const char* sb = smem + (kt & 1) * 65536;
#pragma unroll
    for (int ks = 0; ks < 4; ++ks) {
      const int koff = 32 * (ks ^ sh);
      bf16x8 af[4], bfr[2];
#pragma unroll
      for (int mi = 0; mi < 4; ++mi) af[mi] = *(const bf16x8*)(sb + a_off + mi * 4096 + koff);
#pragma unroll
      for (int nj = 0; nj < 2; ++nj) bfr[nj] = *(const bf16x8*)(sb + b_off + nj * 4096 + koff);
#pragma unroll
      for (int mi = 0; mi < 4; ++mi)
#pragma unroll
        for (int nj = 0; nj < 2; ++nj) acc[mi][nj] = MFMA32(af[mi], bfr[nj], acc[mi][nj]);
    }
  }
  float* rstd_s = (float*)smem;
  if (NSLOT > 0) {
    __syncthreads();
    if (tid < 256) {
      const float* pr = pin + (size_t)(m0 + tid) * NSLOT;
      float sacc = 0.f;
      if (NSLOT >= 4) {
#pragma unroll
        for (int q = 0; q < NSLOT / 4; ++q) { const f32x4 v = *(const f32x4*)(pr + 4 * q); sacc += (v[0] + v[1]) + (v[2] + v[3]); }
      } else {
#pragma unroll
        for (int q = 0; q < NSLOT; ++q) sacc += pr[q];
      }
      rstd_s[tid] = rsqrtf(sacc / (float)K + 1e-6f);
    }
    __syncthreads();
  }
  int lane2 = lane, w2 = w; asm volatile("" : "+v"(lane2), "+v"(w2));
  epi(acc, m0, (w2 >> 2) * 128, n0 + (w2 & 3) * 64, lane2, rstd_s);
}
DI void row_ssq_put(float v, float* dst, int lane) {
  v += __shfl_xor(v, 1); v += __shfl_xor(v, 2); v += __shfl_xor(v, 4); v += __shfl_xor(v, 8); v += __shfl_xor(v, 16);
  if ((lane & 31) == 0) *dst = v;
}

struct EpiG1 {
  bf16_t *cqkv, *KA, *qB, *qC; const float *cos32, *sin32, *cos16, *sin16; float qs; float *pq, *pkv;
  DI void operator()(f32x16 (&acc)[4][2], int m0, int lr0, int col0, int lane, const float* rstd_s) const {
    const int c = lane & 31, h = lane >> 5, cb = col0 >> 6;
    if (cb >= 37) return;
#define G1_ROW const int lr = lr0 + mi * 32 + crow(i, h), tok = m0 + lr, b = tok >> 13, s = tok & 8191; (void)b; (void)s; \
               const float rs = rstd_s[lr]; float v0 = acc[mi][0][i] * rs, v1 = acc[mi][1][i] * rs;
    if (cb < 6) {
#pragma unroll
      for (int mi = 0; mi < 4; ++mi)
#pragma unroll
        for (int i = 0; i < 16; ++i) {
        if ((i & 3) == 0) __builtin_amdgcn_sched_barrier(0);
          G1_ROW
          bf16_t* d = cqkv + (size_t)tok * 384 + cb * 64 + c; d[0] = f2bf(v0); d[32] = f2bf(v1);
          row_ssq_put(v0 * v0 + v1 * v1, cb < 4 ? pq + (size_t)tok * 4 + cb : pkv + (size_t)tok * 2 + (cb - 4), lane);
        }
    } else if (cb == 6) {
#pragma unroll
      for (int mi = 0; mi < 4; ++mi)
#pragma unroll
        for (int i = 0; i < 16; ++i) {
        if ((i & 3) == 0) __builtin_amdgcn_sched_barrier(0);
          G1_ROW
          if (c < 16) {
            const float cs = cos16[s * 16 + c], sn = sin16[s * 16 + c];
            const bf16_t o1 = f2bf(v0 * cs - v1 * sn), o2 = f2bf(v0 * sn + v1 * cs);
#pragma unroll
            for (int hd = 0; hd < 6; ++hd) { bf16_t* d = KA + ((size_t)(b * 6 + hd) * SEQ + s) * 96 + 64 + c; d[0] = o1; d[16] = o2; }
          }
        }
    } else if (cb < 25) {
      const int idx = cb - 7, which = idx / 6, hd = idx - which * 6;
      bf16_t* base = qB + (size_t)which * (SZ_H6 / 2) + (size_t)hd * SEQ * 64 + c;
      const float sc = which == 0 ? qs : 1.f;
      if (which < 2) {
#pragma unroll
        for (int mi = 0; mi < 4; ++mi)
#pragma unroll
          for (int i = 0; i < 16; ++i) {
        if ((i & 3) == 0) __builtin_amdgcn_sched_barrier(0);
            G1_ROW
            const float cs = cos32[s * 32 + c] * sc, sn = sin32[s * 32 + c] * sc;
            bf16_t* d = base + ((size_t)(b * 6) * SEQ + s) * 64;
            d[0] = f2bf(v0 * cs - v1 * sn); d[32] = f2bf(v0 * sn + v1 * cs);
          }
      } else {
#pragma unroll
        for (int mi = 0; mi < 4; ++mi)
#pragma unroll
          for (int i = 0; i < 16; ++i) {
        if ((i & 3) == 0) __builtin_amdgcn_sched_barrier(0);
            G1_ROW
            bf16_t* d = base + ((size_t)(b * 6) * SEQ + s) * 64;
            d[0] = f2bf(v0); d[32] = f2bf(v1);
          }
      }
    } else {
      const int idx = cb - 25, which = idx >> 2, hd = idx & 3;
      bf16_t* base = qC + (size_t)which * (SZ_H4 / 2) + (size_t)hd * SEQ * 64 + c;
      const float sc = which == 0 ? qs : 1.f;
#pragma unroll
      for (int mi = 0; mi < 4; ++mi)
#pragma unroll
        for (int i = 0; i < 16; ++i) {
        if ((i & 3) == 0) __builtin_amdgcn_sched_barrier(0);
          G1_ROW
          bf16_t* d = base + ((size_t)(b * 4) * SEQ + s) * 64;
          d[0] = f2bf(v0 * sc); d[32] = f2bf(v1 * sc);
        }
    }
#undef G1_ROW
  }
};
struct EpiUQ {
  bf16_t* QA; const float *cos16, *sin16; float qs;
  DI void operator()(f32x16 (&acc)[4][2], int m0, int lr0, int col0, int lane, const float* rstd_s) const {
    const int c = lane & 31, h = lane >> 5, cb = col0 >> 6;
    if (cb >= 9) return;
#pragma unroll
    for (int mi = 0; mi < 4; ++mi)
#pragma unroll
      for (int i = 0; i < 16; ++i) {
        if ((i & 3) == 0) __builtin_amdgcn_sched_barrier(0);
        const int lr = lr0 + mi * 32 + crow(i, h), tok = m0 + lr, b = tok >> 13, s = tok & 8191;
        const float rs = rstd_s[lr] * qs;
        const float v0 = acc[mi][0][i] * rs, v1 = acc[mi][1][i] * rs;
        if (cb < 6) {
          bf16_t* d = QA + ((size_t)(b * 6 + cb) * SEQ + s) * 96 + c; d[0] = f2bf(v0); d[32] = f2bf(v1);
        } else {
          const int hd = 2 * (cb - 6) + (c >> 4), fi = c & 15;
          const float cs = cos16[s * 16 + fi], sn = sin16[s * 16 + fi];
          bf16_t* d = QA + ((size_t)(b * 6 + hd) * SEQ + s) * 96 + 64 + fi;
          d[0] = f2bf(v0 * cs - v1 * sn); d[16] = f2bf(v0 * sn + v1 * cs);
        }
      }
  }
};
struct EpiUKV {
  bf16_t *KA, *VA;
  DI void operator()(f32x16 (&acc)[4][2], int m0, int lr0, int col0, int lane, const float* rstd_s) const {
    const int c = lane & 31, h = lane >> 5, cb = col0 >> 6, hd = cb >> 1, isv = cb & 1;
#pragma unroll
    for (int mi = 0; mi < 4; ++mi)
#pragma unroll
      for (int i = 0; i < 16; ++i) {
        if ((i & 3) == 0) __builtin_amdgcn_sched_barrier(0);
        const int lr = lr0 + mi * 32 + crow(i, h), tok = m0 + lr, b = tok >> 13, s = tok & 8191;
        const float rs = rstd_s[lr];
        const float v0 = acc[mi][0][i] * rs, v1 = acc[mi][1][i] * rs;
        bf16_t* d = isv ? VA + ((size_t)(b * 6 + hd) * SEQ + s) * 64 + c : KA + ((size_t)(b * 6 + hd) * SEQ + s) * 96 + c;
        d[0] = f2bf(v0); d[32] = f2bf(v1);
      }
  }
};
struct EpiRes {
  bf16_t* xb; float* pout;
  DI void operator()(f32x16 (&acc)[4][2], int m0, int lr0, int col0, int lane, const float* rstd_s) const {
    const int c = lane & 31, h = lane >> 5;
#pragma unroll
    for (int mi = 0; mi < 4; ++mi)
#pragma unroll
      for (int i = 0; i < 16; ++i) {
        if ((i & 3) == 0) __builtin_amdgcn_sched_barrier(0);
        const int row = m0 + lr0 + mi * 32 + crow(i, h);
        const size_t o = (size_t)row * DM + col0 + c;
        const float v0 = bf2f(xb[o]) + acc[mi][0][i], v1 = bf2f(xb[o + 32]) + acc[mi][1][i];
        xb[o] = f2bf(v0); xb[o + 32] = f2bf(v1);
        row_ssq_put(v0 * v0 + v1 * v1, pout + (size_t)row * 16 + (col0 >> 6), lane);
      }
  }
};
struct EpiMlp1 {
  bf16_t* hid;
  DI void operator()(f32x16 (&acc)[4][2], int m0, int lr0, int col0, int lane, const float* rstd_s) const {
    const int c = lane & 31, h = lane >> 5;
#pragma unroll
    for (int mi = 0; mi < 4; ++mi)
#pragma unroll
      for (int i = 0; i < 16; ++i) {
        if ((i & 3) == 0) __builtin_amdgcn_sched_barrier(0);
        const int lr = lr0 + mi * 32 + crow(i, h);
        const float rs = rstd_s[lr];
        const float v0 = fmaxf(acc[mi][0][i] * rs, 0.f), v1 = fmaxf(acc[mi][1][i] * rs, 0.f);
        *(unsigned*)(hid + (size_t)(m0 + lr) * DFF + col0 + 2 * c) = cvtpk(v0 * v0, v1 * v1);
      }
  }
};

struct AttnItem {
  const bf16_t *Q, *K, *V;
  int q0;
  int n0, dil, res, N;
  int nrb, ncb, kr0, kc0;
  bf16_t* out; int ldo;
  float* lse;
  const float* rpb;
};

template <int DQ, int MODE>
DI void attn_block(const AttnItem& it, char* smem, const int tid) {
  constexpr int CPR = DQ / 8, KST = DQ * 2 + 16, KCH = (64 * CPR) / 256, NT = MODE == 0 ? SEQ / 64 : MODE == 1 ? 4 : 8;
  const int lane = tid & 63, w = tid >> 6, r32 = lane & 31, hi = lane >> 5;
  char* Ks = smem; char* Vs = smem + 64 * KST; float* bias_s = (float*)(smem + 64 * KST + 8192);
  const int qi = w * 32 + r32;
  int qpos;
  if (MODE == 0) qpos = it.q0 + qi;
  else if (MODE == 1) qpos = (it.n0 + qi) * it.dil + it.res;
  else qpos = (8 * it.nrb + (qi >> 4)) * 64 + 16 * it.ncb + (qi & 15);
  __syncthreads();
  if (MODE == 2) { for (int i = tid; i < 465; i += 256) bias_s[i] = it.rpb[i] * 1.4426950408889634f; }
  bf16x8 qr[DQ / 16];
#pragma unroll
  for (int d0 = 0; d0 < DQ / 16; ++d0) qr[d0] = *(const bf16x8*)(it.Q + (size_t)qpos * DQ + d0 * 16 + hi * 8);
  f32x16 o[2];
#pragma unroll
  for (int i = 0; i < 16; ++i) { o[0][i] = 0.f; o[1][i] = 0.f; }
  float m_run = -1e30f, l_run = 0.f;
  u32x4 rk[KCH], rv[2];
  auto kpos = [&](int t, int row) -> int {
    if (MODE == 0) return t * 64 + row;
    if (MODE == 1) { int n = it.n0 - 64 + 64 * t + row; n = n < 0 ? 0 : (n > it.N - 1 ? it.N - 1 : n); return n * it.dil + it.res; }
    return (it.kr0 + 2 * t + (row >> 5)) * 64 + it.kc0 + (row & 31);
  };
  auto load = [&](int t) {
#pragma unroll
    for (int i = 0; i < KCH; ++i) { const int c = tid + 256 * i, row = c / CPR, kc = c - row * CPR; rk[i] = *(const u32x4*)(it.K + (size_t)kpos(t, row) * DQ + kc * 8); }
#pragma unroll
    for (int i = 0; i < 2; ++i) { const int c = tid + 256 * i, row = c >> 3, kc = c & 7; rv[i] = *(const u32x4*)(it.V + (size_t)kpos(t, row) * 64 + kc * 8); }
  };
  const int vrd = ((lane >> 5) * 4 + ((lane & 15) >> 2)) * 64 + ((lane >> 4) & 1) * 32 + (lane & 3) * 8;
  load(0);
  for (int t = 0; t < NT; ++t) {
    __syncthreads();
#pragma unroll
    for (int i = 0; i < KCH; ++i) { const int c = tid + 256 * i, row = c / CPR, kc = c - row * CPR; *(u32x4*)(Ks + row * KST + kc * 16) = rk[i]; }
#pragma unroll
    for (int i = 0; i < 2; ++i) { const int c = tid + 256 * i, row = c >> 3, kc = c & 7; *(u32x4*)(Vs + (kc >> 2) * 4096 + row * 64 + (kc & 3) * 16) = rv[i]; }
    __syncthreads();
    if (t + 1 < NT) load(t + 1);
    bool skip = false;
    if (MODE == 1) skip = (w < 2) ? (t == 3) : (t == 0);
    if (MODE == 2) {
      const int rq_lo = 8 * it.nrb + 2 * w, rq_hi = rq_lo + 1;
      const int rs_lo = min(max(rq_lo - 4, 0), 120), rs_hi = min(max(rq_hi - 4, 0), 120) + 7;
      const int kr = it.kr0 + 2 * t;
      skip = (kr + 1 < rs_lo) || (kr > rs_hi);
    }
    if (skip) continue;
    f32x16 p0, p1;
#pragma unroll
    for (int i = 0; i < 16; ++i) { p0[i] = 0.f; p1[i] = 0.f; }
#pragma unroll
    for (int d0 = 0; d0 < DQ / 16; ++d0) {
      const bf16x8 k0 = *(const bf16x8*)(Ks + r32 * KST + d0 * 32 + hi * 16);
      const bf16x8 k1 = *(const bf16x8*)(Ks + (32 + r32) * KST + d0 * 32 + hi * 16);
      p0 = MFMA32(k0, qr[d0], p0); p1 = MFMA32(k1, qr[d0], p1);
    }
    if (MODE == 1) {
      const int nq = it.n0 + qi, kb = it.n0 - 64 + 64 * t;
#pragma unroll
      for (int i = 0; i < 16; ++i) {
        const int nk = kb + crow(i, hi), nk2 = nk + 32;
        const int d1 = nq - nk, d2 = nq - nk2;
        const bool ok1 = (d1 <= 64) && (d1 >= -64) && (nk >= 0) && (nk < it.N);
        const bool ok2 = (d2 <= 64) && (d2 >= -64) && (nk2 >= 0) && (nk2 < it.N);
        p0[i] = ok1 ? p0[i] : -INFINITY; p1[i] = ok2 ? p1[i] : -INFINITY;
      }
    }
    if (MODE == 2) {
      const int rq = 8 * it.nrb + (qi >> 4), cq = 16 * it.ncb + (qi & 15);
      const int rs_ = min(max(rq - 4, 0), 120), cs_ = min(max(cq - 8, 0), 48);
      const int kr = it.kr0 + 2 * t;
      const bool okr0 = (kr >= rs_) && (kr < rs_ + 8), okr1 = (kr + 1 >= rs_) && (kr + 1 < rs_ + 8);
      const int bi0 = (kr - rq + 7) * 31 - cq + 15;
#pragma unroll
      for (int i = 0; i < 16; ++i) {
        const int kc = it.kc0 + crow(i, hi);
        const bool okc = (kc >= cs_) && (kc < cs_ + 16);
        const bool ok0 = okc && okr0, ok1 = okc && okr1;
        const float b0 = bias_s[ok0 ? bi0 + kc : 0], b1 = bias_s[ok1 ? bi0 + 31 + kc : 0];
        p0[i] = ok0 ? p0[i] + b0 : -INFINITY; p1[i] = ok1 ? p1[i] + b1 : -INFINITY;
      }
    }
    float pmax = p0[0];
#pragma unroll
    for (int i = 1; i < 16; ++i) pmax = fmaxf(pmax, p0[i]);
#pragma unroll
    for (int i = 0; i < 16; ++i) pmax = fmaxf(pmax, p1[i]);
    pmax = swap_max(pmax);
    const float mn = fmaxf(m_run, pmax);
    const float alpha = __builtin_amdgcn_exp2f(m_run - mn);
    m_run = mn;
    float ps = 0.f;
#pragma unroll
    for (int i = 0; i < 16; ++i) { p0[i] = __builtin_amdgcn_exp2f(p0[i] - mn); ps += p0[i]; }
#pragma unroll
    for (int i = 0; i < 16; ++i) { p1[i] = __builtin_amdgcn_exp2f(p1[i] - mn); ps += p1[i]; }
    ps = swap_sum(ps);
    l_run = l_run * alpha + ps;
#pragma unroll
    for (int i = 0; i < 16; ++i) { o[0][i] *= alpha; o[1][i] *= alpha; }
    bf16x8 pb[4];
#pragma unroll
    for (int s = 0; s < 2; ++s) {
      u32x4 a = {cvtpk(p0[8 * s], p0[8 * s + 1]), cvtpk(p0[8 * s + 2], p0[8 * s + 3]), cvtpk(p0[8 * s + 4], p0[8 * s + 5]), cvtpk(p0[8 * s + 6], p0[8 * s + 7])};
      u32x4 b = {cvtpk(p1[8 * s], p1[8 * s + 1]), cvtpk(p1[8 * s + 2], p1[8 * s + 3]), cvtpk(p1[8 * s + 4], p1[8 * s + 5]), cvtpk(p1[8 * s + 6], p1[8 * s + 7])};
      pb[s] = __builtin_bit_cast(bf16x8, a); pb[2 + s] = __builtin_bit_cast(bf16x8, b);
    }
#pragma unroll
    for (int db = 0; db < 2; ++db)
#pragma unroll
      for (int s = 0; s < 4; ++s) {
        const s16x4 lo = __builtin_amdgcn_ds_read_tr16_b64_v4i16((lds_s16x4*)(Vs + db * 4096 + (16 * s) * 64 + vrd));
        const s16x4 hh = __builtin_amdgcn_ds_read_tr16_b64_v4i16((lds_s16x4*)(Vs + db * 4096 + (16 * s + 8) * 64 + vrd));
        const bf16x8 a = {lo[0], lo[1], lo[2], lo[3], hh[0], hh[1], hh[2], hh[3]};
        o[db] = MFMA32(a, pb[s], o[db]);
      }
  }
  const float inv = 1.f / l_run;
  const int bq = qpos;
  bf16_t* orow = it.out + (size_t)bq * it.ldo;
#pragma unroll
  for (int db = 0; db < 2; ++db)
#pragma unroll
    for (int g = 0; g < 4; ++g) {
      u32x2 v = {cvtpk(o[db][4 * g] * inv, o[db][4 * g + 1] * inv), cvtpk(o[db][4 * g + 2] * inv, o[db][4 * g + 3] * inv)};
      *(u32x2*)(orow + db * 32 + 8 * g + 4 * hi) = v;
    }
  if (MODE == 1) { if (hi == 0) it.lse[(size_t)bq * 6] = m_run + __builtin_amdgcn_logf(l_run); }
}

DI void attn_dense_skew(const bf16_t* __restrict__ Q, const bf16_t* __restrict__ K, const bf16_t* __restrict__ V, int q0, bf16_t* __restrict__ out,
                        char* smem, const int tid512, const int grp) {
  constexpr int DQ = 96, CPR = 12, KST = 208, NT = SEQ / 64, KB = 64 * KST, VOFF = 2 * KB;
  const int lane = tid512 & 63, w = (tid512 >> 6) & 3, r32 = lane & 31, hi = lane >> 5;
  const int qpos = q0 + w * 32 + r32;
  bf16x8 qr[DQ / 16];
#pragma unroll
  for (int d0 = 0; d0 < DQ / 16; ++d0) qr[d0] = *(const bf16x8*)(Q + (size_t)qpos * DQ + d0 * 16 + hi * 8);
  f32x16 o[2];
#pragma unroll
  for (int i = 0; i < 16; ++i) { o[0][i] = 0.f; o[1][i] = 0.f; }
  float m_run = -1e30f, l_run = 0.f;
  const int kr0 = tid512 / CPR, kc0 = tid512 - kr0 * CPR, c1 = tid512 + 512, kr1 = c1 / CPR, kc1 = c1 - kr1 * CPR, vr = tid512 >> 3, vc = tid512 & 7;
  const bool two = tid512 < 256;
  const bf16_t* Kp0 = K + (size_t)kr0 * DQ + kc0 * 8; const bf16_t* Kp1 = K + (size_t)kr1 * DQ + kc1 * 8; const bf16_t* Vp = V + (size_t)vr * 64 + vc * 8;
  const int ks0 = kr0 * KST + kc0 * 16, ks1 = kr1 * KST + kc1 * 16, vs0 = VOFF + (vc >> 2) * 4096 + vr * 64 + (vc & 3) * 16;
  u32x4 rk0, rk1 = u32x4{0u, 0u, 0u, 0u}, rv;
  auto load = [&](int t) {
    const size_t ro = (size_t)t * 64;
    rk0 = *(const u32x4*)(Kp0 + ro * DQ); if (two) rk1 = *(const u32x4*)(Kp1 + ro * DQ); rv = *(const u32x4*)(Vp + ro * 64);
  };
  auto store = [&](int kb, int vb) {
    char* kbp = smem + kb * KB;
    *(u32x4*)(kbp + ks0) = rk0; if (two) *(u32x4*)(kbp + ks1) = rk1; *(u32x4*)(smem + vb * 8192 + vs0) = rv;
  };
  const int vrd = ((lane >> 5) * 4 + ((lane & 15) >> 2)) * 64 + ((lane >> 4) & 1) * 32 + (lane & 3) * 8;
  __syncthreads();
  load(0); store(0, 0); load(1);
  __syncthreads();
  if (grp == 1) __syncthreads();
  int vcur = 0;
  for (int t = 0; t < NT; ++t) {
    const int vnext = vcur == 2 ? 0 : vcur + 1;
    const char* Ks = smem + (t & 1) * KB; const char* Vs = smem + VOFF + vcur * 8192;
    if (t + 1 < NT) store((t + 1) & 1, vnext);
    if (t + 2 < NT) load(t + 2);
    f32x16 p0, p1;
#pragma unroll
    for (int i = 0; i < 16; ++i) { p0[i] = 0.f; p1[i] = 0.f; }
    {
      const char* kp = Ks + r32 * KST + hi * 16;
      bf16x8 ka[2][2];
      ka[0][0] = *(const bf16x8*)(kp); ka[0][1] = *(const bf16x8*)(kp + 32 * KST);
      ka[1][0] = *(const bf16x8*)(kp + 32); ka[1][1] = *(const bf16x8*)(kp + 32 * KST + 32);
#pragma unroll
      for (int d0 = 0; d0 < DQ / 16; ++d0) {
        p0 = MFMA32(ka[d0 & 1][0], qr[d0], p0); p1 = MFMA32(ka[d0 & 1][1], qr[d0], p1);
        if (d0 + 2 < DQ / 16) { ka[d0 & 1][0] = *(const bf16x8*)(kp + (d0 + 2) * 32); ka[d0 & 1][1] = *(const bf16x8*)(kp + 32 * KST + (d0 + 2) * 32); }
      }
    }
    float pmax = p0[0];
#pragma unroll
    for (int i = 1; i < 16; ++i) pmax = fmaxf(pmax, p0[i]);
#pragma unroll
    for (int i = 0; i < 16; ++i) pmax = fmaxf(pmax, p1[i]);
    pmax = swap_max(pmax);
    {
      const float mn = fmaxf(m_run, pmax);
      const float alpha = __builtin_amdgcn_exp2f(m_run - mn);
      m_run = mn; l_run *= alpha;
#pragma unroll
      for (int i = 0; i < 16; ++i) { o[0][i] *= alpha; o[1][i] *= alpha; }
    }
    asm volatile("" : "+v"(p0), "+v"(p1), "+v"(o[0]), "+v"(o[1]), "+v"(m_run));
    __syncthreads();
    asm volatile("" : "+v"(p0), "+v"(p1), "+v"(o[0]), "+v"(o[1]), "+v"(m_run));
    s16x4 vlo[4], vhi[4];
#pragma unroll
    for (int s2 = 0; s2 < 4; ++s2) {
      vlo[s2] = __builtin_amdgcn_ds_read_tr16_b64_v4i16((lds_s16x4*)(Vs + (16 * s2) * 64 + vrd));
      vhi[s2] = __builtin_amdgcn_ds_read_tr16_b64_v4i16((lds_s16x4*)(Vs + (16 * s2 + 8) * 64 + vrd));
    }
    float ps = 0.f;
#pragma unroll
    for (int i = 0; i < 16; ++i) { p0[i] = __builtin_amdgcn_exp2f(p0[i] - m_run); ps += p0[i]; }
#pragma unroll
    for (int i = 0; i < 16; ++i) { p1[i] = __builtin_amdgcn_exp2f(p1[i] - m_run); ps += p1[i]; }
    l_run += swap_sum(ps);
    bf16x8 pb[4];
#pragma unroll
    for (int s = 0; s < 2; ++s) {
      u32x4 a = {cvtpk(p0[8 * s], p0[8 * s + 1]), cvtpk(p0[8 * s + 2], p0[8 * s + 3]), cvtpk(p0[8 * s + 4], p0[8 * s + 5]), cvtpk(p0[8 * s + 6], p0[8 * s + 7])};
      u32x4 b = {cvtpk(p1[8 * s], p1[8 * s + 1]), cvtpk(p1[8 * s + 2], p1[8 * s + 3]), cvtpk(p1[8 * s + 4], p1[8 * s + 5]), cvtpk(p1[8 * s + 6], p1[8 * s + 7])};
      pb[s] = __builtin_bit_cast(bf16x8, a); pb[2 + s] = __builtin_bit_cast(bf16x8, b);
    }
    {
      s16x4 wlo[4], whi[4];
#pragma unroll
      for (int s2 = 0; s2 < 4; ++s2) {
        wlo[s2] = __builtin_amdgcn_ds_read_tr16_b64_v4i16((lds_s16x4*)(Vs + 4096 + (16 * s2) * 64 + vrd));
        whi[s2] = __builtin_amdgcn_ds_read_tr16_b64_v4i16((lds_s16x4*)(Vs + 4096 + (16 * s2 + 8) * 64 + vrd));
      }
#pragma unroll
      for (int s2 = 0; s2 < 4; ++s2) { const bf16x8 a = {vlo[s2][0], vlo[s2][1], vlo[s2][2], vlo[s2][3], vhi[s2][0], vhi[s2][1], vhi[s2][2], vhi[s2][3]}; o[0] = MFMA32(a, pb[s2], o[0]); }
#pragma unroll
      for (int s2 = 0; s2 < 4; ++s2) { const bf16x8 a = {wlo[s2][0], wlo[s2][1], wlo[s2][2], wlo[s2][3], whi[s2][0], whi[s2][1], whi[s2][2], whi[s2][3]}; o[1] = MFMA32(a, pb[s2], o[1]); }
    }
    asm volatile("" : "+v"(o[0]), "+v"(o[1]));
    __syncthreads();
    asm volatile("" : "+v"(o[0]), "+v"(o[1]));
    vcur = vnext;
  }
  if (grp == 0) __syncthreads();
  const float inv = 1.f / l_run;
  bf16_t* orow = out + (size_t)qpos * 384;
#pragma unroll
  for (int db = 0; db < 2; ++db)
#pragma unroll
    for (int g = 0; g < 4; ++g) {
      u32x2 v = {cvtpk(o[db][4 * g] * inv, o[db][4 * g + 1] * inv), cvtpk(o[db][4 * g + 2] * inv, o[db][4 * g + 3] * inv)};
      *(u32x2*)(orow + db * 32 + 8 * g + 4 * hi) = v;
    }
}

DI float wave_sum(float v) {
  v += __shfl_xor(v, 32); v += __shfl_xor(v, 16); v += __shfl_xor(v, 8); v += __shfl_xor(v, 4); v += __shfl_xor(v, 2); v += __shfl_xor(v, 1); return v;
}
DI float gain_of(const Params& p, int kind, int l, int k) {
  switch (kind) {
    case 0: return p.g_mix[l * 1024 + k];
    case 1: return p.q_norm[l * 256 + k];
    case 2: return p.kv_norm[l * 128 + k];
    case 3: return k < 384 ? p.on_a[l * 384 + k] : (k < 768 ? p.on_b[l * 384 + k - 384] : p.on_c[l * 256 + k - 768]);
    case 4: return p.g_mlp[l * 1024 + k];
    default: return 1.f;
  }
}
DI int map_col(int kind, int n) {
  if (kind == 0) {
    if (n < 384) return n;
    if (n < 448) { const int wv = n - 384, c = wv & 31, sub = wv >> 5; return c < 16 ? 384 + sub * 16 + c : -1; }
    if (n < 1600) return 416 + (n - 448);
    if (n < 2368) return 1568 + (n - 1600);
    return -1;
  }
  if (kind == 1) {
    if (n < 384) return (n >> 6) * 96 + (n & 63);
    if (n < 576) { const int wv = n - 384, g = wv >> 6, wi = wv & 63, sub = wi >> 5, c = wi & 31, hd = 2 * g + (c >> 4), fi = c & 15; return hd * 96 + 64 + sub * 16 + fi; }
    return -1;
  }
  return n;
}
DI void wtile(const Params& p, const float* src, int Nsrc, bf16_t* dst, int K, int kt, int nt, int kind, int l, char* smem, const int tid) {
  float* tile = (float*)smem;
  const int lane = tid & 63, wv = tid >> 6;
  __syncthreads();
  const int n = nt * 64 + lane, sc = map_col(kind, n);
#pragma unroll 4
  for (int r = 0; r < 8; ++r) {
    const int kl = r * 8 + wv, kd = kt * 64 + kl;
    const int k = kind == 5 ? ((kd & ~63) | ((kd & 1) << 5) | ((kd & 63) >> 1)) : kd;
    float v = 0.f;
    if (sc >= 0) v = src[(size_t)k * Nsrc + sc] * gain_of(p, kind, l, k);
    tile[kl * 65 + lane] = v;
  }
  __syncthreads();
#pragma unroll 4
  for (int r = 0; r < 8; ++r) {
    const int nl = r * 8 + wv;
    dst[(size_t)(nt * 64 + nl) * K + kt * 64 + lane] = f2bf(tile[lane * 65 + nl]);
  }
}

NI void phase_prep() {
  const Params& p = kparams(); char* smem = g_smem; const int tid = otid(), bid = obid();
  char* ws = p.ws;
  constexpr int T_WIN = (N_IN_PAD / 64) * 16, T_WUQ = (N_UQ_PAD / 64) * 4, T_WUKV = (N_UKV / 64) * 2, T_WOUT = 16 * 16, T_W1 = 64 * 16, T_W2 = 16 * 64;
  constexpr int T_L = T_WIN + T_WUQ + T_WUKV + T_WOUT + T_W1 + T_W2;
  for (int j = bid; j < NLAYER * T_L; j += gridDim.x) {
    const int l = j / T_L; int r = j - l * T_L;
    char* lw = ws + OFF_W + (size_t)l * LW_SIZE;
    if (r < T_WIN) { wtile(p, p.w_in + (size_t)l * 1024 * 2336, 2336, (bf16_t*)(lw + LW_WIN), 1024, r & 15, r >> 4, 0, l, smem, tid); continue; }
    r -= T_WIN;
    if (r < T_WUQ) { wtile(p, p.w_uq + (size_t)l * 256 * 576, 576, (bf16_t*)(lw + LW_WUQ), 256, r & 3, r >> 2, 1, l, smem, tid); continue; }
    r -= T_WUQ;
    if (r < T_WUKV) { wtile(p, p.w_ukv + (size_t)l * 128 * 768, 768, (bf16_t*)(lw + LW_WUKV), 128, r & 1, r >> 1, 2, l, smem, tid); continue; }
    r -= T_WUKV;
    if (r < T_WOUT) { wtile(p, p.w_out + (size_t)l * 1024 * 1024, 1024, (bf16_t*)(lw + LW_WOUT), 1024, r & 15, r >> 4, 3, l, smem, tid); continue; }
    r -= T_WOUT;
    if (r < T_W1) { wtile(p, p.w_mlp_in + (size_t)l * 1024 * 4096, 4096, (bf16_t*)(lw + LW_W1), 1024, r & 15, r >> 4, 4, l, smem, tid); continue; }
    r -= T_W1;
    wtile(p, p.w_mlp_out + (size_t)l * 4096 * 1024, 1024, (bf16_t*)(lw + LW_W2), 4096, r & 63, r >> 6, 5, l, smem, tid);
  }
  const size_t gtid = (size_t)bid * NTHR + tid, gsz = (size_t)gridDim.x * NTHR;
  bf16_t* xb = (bf16_t*)(ws + OFF_XB);
  {
    const int lane = tid & 63, gw = bid * (NTHR / 64) + (tid >> 6), nw = gridDim.x * (NTHR / 64);
    float* px1 = (float*)(ws + OFF_PX1);
    for (int row = gw; row < NTOK; row += nw) {
      float ss = 0.f;
#pragma unroll
      for (int j = 0; j < 4; ++j) {
        const f32x4 a = *(const f32x4*)(p.x + (size_t)row * DM + j * 256 + lane * 4);
        ss += a[0] * a[0] + a[1] * a[1] + a[2] * a[2] + a[3] * a[3];
        u32x2 o = {cvtpk(a[0], a[1]), cvtpk(a[2], a[3])};
        *(u32x2*)(xb + (size_t)row * DM + j * 256 + lane * 4) = o;
      }
      ss = wave_sum(ss);
      if (lane < 16) px1[(size_t)row * 16 + lane] = lane == 0 ? ss : 0.f;
    }
  }
  float* c32 = (float*)(ws + OFF_COS32); float* s32 = (float*)(ws + OFF_SIN32); float* c16 = (float*)(ws + OFF_COS16); float* s16 = (float*)(ws + OFF_SIN16);
  for (size_t i = gtid; i < (size_t)SEQ * 48; i += gsz) {
    int pos, fi; float invf; float *cd, *sd;
    if (i < (size_t)SEQ * 32) { pos = (int)(i >> 5); fi = (int)(i & 31); invf = __builtin_amdgcn_exp2f(-(float)fi * (13.287712379549449f / 32.f)); cd = c32 + i; sd = s32 + i; }
    else { const size_t j = i - (size_t)SEQ * 32; pos = (int)(j >> 4); fi = (int)(j & 15); invf = __builtin_amdgcn_exp2f(-(float)fi * (13.287712379549449f / 16.f)); cd = c16 + j; sd = s16 + j; }
    const float ang = (float)pos * invf;
    const double rev = (double)ang * 0.15915494309189535;
    const float fr = (float)(rev - rint(rev));
    *cd = __builtin_amdgcn_cosf(fr); *sd = __builtin_amdgcn_sinf(fr);
  }
}

NI void phase_g1(int l_) {
  const Params& p = kparams(); char* smem = g_smem; const int l = __builtin_amdgcn_readfirstlane(l_); const int tid = otid(), bid = obid(); (void)tid; (void)bid;
  char* ws = p.ws;
  EpiG1 e;
  e.cqkv = (bf16_t*)(ws + OFF_CQKV); e.KA = (bf16_t*)(ws + OFF_KA); e.qB = (bf16_t*)(ws + OFF_QB); e.qC = (bf16_t*)(ws + OFF_QC);
  e.cos32 = (const float*)(ws + OFF_COS32); e.sin32 = (const float*)(ws + OFF_SIN32); e.cos16 = (const float*)(ws + OFF_COS16); e.sin16 = (const float*)(ws + OFF_SIN16);
  e.qs = p.qscaleB; e.pq = (float*)(ws + OFF_PQ); e.pkv = (float*)(ws + OFF_PKV);
  const bf16_t* A = (const bf16_t*)(ws + OFF_XB);
  const bf16_t* Bt = (const bf16_t*)(ws + OFF_W + (size_t)l * LW_SIZE + LW_WIN);
  constexpr int NNT = N_IN_PAD / 256;
  FOR_TILES(NNT, mt, nt, gemm_tile<16>(A, 1024, Bt, 1024, 1024, mt * 256, nt * 256, e, tid, (const float*)(ws + OFF_PX1));)
}
NI void phase_g2(int l_) {
  const Params& p = kparams(); char* smem = g_smem; const int l = __builtin_amdgcn_readfirstlane(l_); const int tid = otid(), bid = obid(); (void)tid; (void)bid;
  char* ws = p.ws;
  const bf16_t* A = (const bf16_t*)(ws + OFF_CQKV);
  EpiUQ eq; eq.QA = (bf16_t*)(ws + OFF_QA); eq.cos16 = (const float*)(ws + OFF_COS16); eq.sin16 = (const float*)(ws + OFF_SIN16); eq.qs = p.qscaleA;
  EpiUKV ek; ek.KA = (bf16_t*)(ws + OFF_KA); ek.VA = (bf16_t*)(ws + OFF_VA);
  const bf16_t* Wq = (const bf16_t*)(ws + OFF_W + (size_t)l * LW_SIZE + LW_WUQ);
  const bf16_t* Wkv = (const bf16_t*)(ws + OFF_W + (size_t)l * LW_SIZE + LW_WUKV);
  FOR_TILES(6, mt, nt,
    if (nt < 3) gemm_tile<4>(A, 384, Wq, 256, 256, mt * 256, nt * 256, eq, tid, (const float*)(ws + OFF_PQ));
    else gemm_tile<2>(A + 256, 384, Wkv, 128, 128, mt * 256, (nt - 3) * 256, ek, tid, (const float*)(ws + OFF_PKV));)
}
NI void phase_attn(int l_) {
  const Params& p = kparams(); char* smem = g_smem; const int l = __builtin_amdgcn_readfirstlane(l_); const int tid = otid(), bid = obid(); (void)tid; (void)bid;
  char* ws = p.ws;
  constexpr int NA = 1536, NBI = 4608, NC = 1024;
  const int grp = tid >> 8, t256 = tid & 255; char* gsm = smem + grp * ATT_LDS;
  for (int i0 = bid * 2; i0 < NA; i0 += gridDim.x * 2) {
    const int i = i0 + grp, xcd = (i >> 1) & 7, j = ((i >> 4) << 1) | (i & 1);
    const int bh = (j >> 6) * 8 + xcd, qb = j & 63, b = bh / 6, h = bh - b * 6;
    attn_dense_skew((const bf16_t*)(ws + OFF_QA) + (size_t)bh * SEQ * 96, (const bf16_t*)(ws + OFF_KA) + (size_t)bh * SEQ * 96, (const bf16_t*)(ws + OFF_VA) + (size_t)bh * SEQ * 64,
                    qb * 128, (bf16_t*)(ws + OFF_OA) + (size_t)b * SEQ * 384 + h * 64, smem, tid, grp);
  }
  for (int i0 = bid * 2; i0 < NBI; i0 += gridDim.x * 2) {
    AttnItem it{};
    const int i = i0 + grp, xcd = (i >> 1) & 7, j = ((i >> 4) << 1) | (i & 1);
    const int g = (j >> 6) * 8 + xcd, c = j & 63, br = g / 24, bh = g - br * 24, b = bh / 6, h = bh - b * 6;
    const int dil = br == 0 ? 1 : (br == 1 ? 4 : 16), cpr = 64 / dil;
    it.Q = (const bf16_t*)(ws + OFF_QB) + (size_t)bh * SEQ * 64; it.K = (const bf16_t*)(ws + OFF_KB) + (size_t)bh * SEQ * 64; it.V = (const bf16_t*)(ws + OFF_VB) + (size_t)bh * SEQ * 64;
    it.dil = dil; it.res = c / cpr; it.n0 = (c - it.res * cpr) * 128; it.N = SEQ / dil;
    it.out = (bf16_t*)(ws + OFF_OB) + (size_t)br * NTOK * 384 + (size_t)b * SEQ * 384 + h * 64; it.ldo = 384;
    it.lse = (float*)(ws + OFF_LSEB) + (size_t)br * NTOK * 6 + (size_t)b * SEQ * 6 + h;
    attn_block<64, 1>(it, gsm, t256);
  }
  for (int i0 = bid * 2; i0 < NC; i0 += gridDim.x * 2) {
    AttnItem it{};
    const int i = i0 + grp, xcd = (i >> 1) & 7, j = ((i >> 4) << 1) | (i & 1);
    const int bh = (j >> 6) * 8 + xcd, blk = j & 63, b = bh >> 2, h = bh & 3;
    it.Q = (const bf16_t*)(ws + OFF_QC) + (size_t)bh * SEQ * 64; it.K = (const bf16_t*)(ws + OFF_KC) + (size_t)bh * SEQ * 64; it.V = (const bf16_t*)(ws + OFF_VC) + (size_t)bh * SEQ * 64;
    it.nrb = blk >> 2; it.ncb = blk & 3;
    it.kr0 = min(max(8 * it.nrb - 4, 0), 112); it.kc0 = min(max(16 * it.ncb - 8, 0), 32);
    it.out = (bf16_t*)(ws + OFF_OC) + (size_t)b * SEQ * 256 + h * 64; it.ldo = 256;
    it.rpb = p.rpb + ((size_t)l * 4 + h) * 465;
    attn_block<64, 2>(it, gsm, t256);
  }
}
NI void phase_mix() {
  const Params& p = kparams(); const int tid = otid(), bid = obid();
  char* ws = p.ws;
  const int lane = tid & 63, gw = bid * (NTHR / 64) + (tid >> 6), nw = gridDim.x * (NTHR / 64);
  const bf16_t* oA = (const bf16_t*)(ws + OFF_OA); const bf16_t* oB = (const bf16_t*)(ws + OFF_OB); const bf16_t* oC = (const bf16_t*)(ws + OFF_OC);
  const float* lse = (const float*)(ws + OFF_LSEB);
  bf16_t* mixed = (bf16_t*)(ws + OFF_MIXED);
  for (int tok = gw; tok < NTOK; tok += nw) {
    float v[16];
    if (lane < 24 || lane >= 48) {
      const bf16_t* src = lane < 24 ? oA + (size_t)tok * 384 + lane * 16 : oC + (size_t)tok * 256 + (lane - 48) * 16;
      const u32x4 a = *(const u32x4*)src, b = *(const u32x4*)(src + 8);
#pragma unroll
      for (int j = 0; j < 4; ++j) { v[2 * j] = bf2f(a[j] & 0xffffu); v[2 * j + 1] = bf2f(a[j] >> 16); v[8 + 2 * j] = bf2f(b[j] & 0xffffu); v[8 + 2 * j + 1] = bf2f(b[j] >> 16); }
    } else {
      const int col = (lane - 24) * 16, hd = col >> 6;
      const float l0 = lse[(size_t)tok * 6 + hd], l1 = lse[(size_t)NTOK * 6 + (size_t)tok * 6 + hd], l2 = lse[(size_t)2 * NTOK * 6 + (size_t)tok * 6 + hd];
      const float mx = fmaxf(l0, fmaxf(l1, l2));
      float w0 = __builtin_amdgcn_exp2f(l0 - mx), w1 = __builtin_amdgcn_exp2f(l1 - mx), w2 = __builtin_amdgcn_exp2f(l2 - mx);
      const float wi = 1.f / (w0 + w1 + w2); w0 *= wi; w1 *= wi; w2 *= wi;
#pragma unroll
      for (int j = 0; j < 16; ++j) v[j] = 0.f;
#pragma unroll
      for (int br = 0; br < 3; ++br) {
        const float wb = br == 0 ? w0 : (br == 1 ? w1 : w2);
        const bf16_t* src = oB + (size_t)br * NTOK * 384 + (size_t)tok * 384 + col;
        const u32x4 a = *(const u32x4*)src, b = *(const u32x4*)(src + 8);
#pragma unroll
        for (int j = 0; j < 4; ++j) { v[2 * j] += wb * bf2f(a[j] & 0xffffu); v[2 * j + 1] += wb * bf2f(a[j] >> 16); v[8 + 2 * j] += wb * bf2f(b[j] & 0xffffu); v[8 + 2 * j + 1] += wb * bf2f(b[j] >> 16); }
      }
    }
    float ss = 0.f;
#pragma unroll
    for (int j = 0; j < 16; ++j) ss += v[j] * v[j];
    const float sa = wave_sum(lane < 24 ? ss : 0.f), sb = wave_sum((lane >= 24 && lane < 48) ? ss : 0.f), sc = wave_sum(lane >= 48 ? ss : 0.f);
    const float rs = lane < 24 ? rsqrtf(sa * (1.f / 384.f) + 1e-6f) : (lane < 48 ? rsqrtf(sb * (1.f / 384.f) + 1e-6f) : rsqrtf(sc * (1.f / 256.f) + 1e-6f));
    u32x4 oa, ob;
#pragma unroll
    for (int j = 0; j < 4; ++j) { oa[j] = cvtpk(v[2 * j] * rs, v[2 * j + 1] * rs); ob[j] = cvtpk(v[8 + 2 * j] * rs, v[8 + 2 * j + 1] * rs); }
    bf16_t* dst = mixed + (size_t)tok * 1024 + lane * 16;
    *(u32x4*)dst = oa; *(u32x4*)(dst + 8) = ob;
  }
}
NI void phase_wout(int l_) {
  const Params& p = kparams(); char* smem = g_smem; const int l = __builtin_amdgcn_readfirstlane(l_); const int tid = otid(), bid = obid(); (void)tid; (void)bid;
  char* ws = p.ws;
  EpiRes e; e.xb = (bf16_t*)(ws + OFF_XB); e.pout = (float*)(ws + OFF_PX2);
  const bf16_t* A = (const bf16_t*)(ws + OFF_MIXED);
  const bf16_t* Bt = (const bf16_t*)(ws + OFF_W + (size_t)l * LW_SIZE + LW_WOUT);
  FOR_TILES(4, mt, nt, gemm_tile<0>(A, 1024, Bt, 1024, 1024, mt * 256, nt * 256, e, tid, nullptr);)
}
NI void phase_mlp1(int l_) {
  const Params& p = kparams(); char* smem = g_smem; const int l = __builtin_amdgcn_readfirstlane(l_); const int tid = otid(), bid = obid(); (void)tid; (void)bid;
  char* ws = p.ws;
  EpiMlp1 e; e.hid = (bf16_t*)(ws + OFF_HID);
  const bf16_t* A = (const bf16_t*)(ws + OFF_XB);
  const bf16_t* Bt = (const bf16_t*)(ws + OFF_W + (size_t)l * LW_SIZE + LW_W1);
  FOR_TILES(16, mt, nt, gemm_tile<16>(A, 1024, Bt, 1024, 1024, mt * 256, nt * 256, e, tid, (const float*)(ws + OFF_PX2));)
}
NI void phase_mlp2(int l_) {
  const Params& p = kparams(); char* smem = g_smem; const int l = __builtin_amdgcn_readfirstlane(l_); const int tid = otid(), bid = obid(); (void)tid; (void)bid;
  char* ws = p.ws;
  EpiRes e; e.xb = (bf16_t*)(ws + OFF_XB); e.pout = (float*)(ws + OFF_PX1);
  const bf16_t* A = (const bf16_t*)(ws + OFF_HID);
  const bf16_t* Bt = (const bf16_t*)(ws + OFF_W + (size_t)l * LW_SIZE + LW_W2);
  FOR_TILES(4, mt, nt, gemm_tile<0>(A, DFF, Bt, DFF, DFF, mt * 256, nt * 256, e, tid, nullptr);)
}
NI void phase_final() {
  const Params& p = kparams(); const int tid = otid(), bid = obid();
  const int lane = tid & 63, gw = bid * (NTHR / 64) + (tid >> 6), nw = gridDim.x * (NTHR / 64);
  const bf16_t* xb = (const bf16_t*)(p.ws + OFF_XB);
  for (int tok = gw; tok < NTOK; tok += nw) {
    float* row = p.out + (size_t)tok * DM;
    f32x4 v[4]; float ss = 0.f;
#pragma unroll
    for (int j = 0; j < 4; ++j) {
      const u32x2 r = *(const u32x2*)(xb + (size_t)tok * DM + j * 256 + lane * 4);
      v[j] = f32x4{bf2f(r[0] & 0xffffu), bf2f(r[0] >> 16), bf2f(r[1] & 0xffffu), bf2f(r[1] >> 16)};
      ss += v[j][0] * v[j][0] + v[j][1] * v[j][1] + v[j][2] * v[j][2] + v[j][3] * v[j][3];
    }
    ss = wave_sum(ss);
    const float rs = rsqrtf(ss * (1.f / 1024.f) + 1e-6f);
#pragma unroll
    for (int j = 0; j < 4; ++j) { const f32x4 g = *(const f32x4*)(p.g_final + j * 256 + lane * 4); f32x4 o = {v[j][0] * rs * g[0], v[j][1] * rs * g[1], v[j][2] * rs * g[2], v[j][3] * rs * g[3]}; *(f32x4*)(row + j * 256 + lane * 4) = o; }
  }
}

DI unsigned xcc_id() { return (unsigned)__builtin_amdgcn_s_getreg((3 << 11) | 20) & 0xFu; }
DI void grid_barrier(unsigned* base, unsigned k, unsigned xcc, unsigned n_x, unsigned nxcd) {
  __syncthreads();
  if (threadIdx.x == 0) {
    unsigned* arr = base + 64 * (16 + xcc);
    unsigned* garr = base + 64 * 32;
    const unsigned a = __hip_atomic_fetch_add(arr, 1u, __ATOMIC_RELAXED, __HIP_MEMORY_SCOPE_AGENT);
    if (a + 1 == n_x * k) {
      __builtin_amdgcn_fence(__ATOMIC_RELEASE, "agent");
      asm volatile("s_waitcnt vmcnt(0)" ::: "memory");
      __hip_atomic_fetch_add(garr, 1u, __ATOMIC_RELAXED, __HIP_MEMORY_SCOPE_AGENT);
    }
    while (__hip_atomic_load(garr, __ATOMIC_RELAXED, __HIP_MEMORY_SCOPE_AGENT) < nxcd * k) __builtin_amdgcn_s_sleep(1);
    __builtin_amdgcn_fence(__ATOMIC_ACQUIRE, "agent");
    asm volatile("s_waitcnt vmcnt(0)" ::: "memory");
  }
  __syncthreads();
}

constexpr int NPHASE = 2 + 7 * NLAYER;
DI void run_phase(int ph) {
  if (ph == 0) { phase_prep(); return; }
  if (ph == NPHASE - 1) { phase_final(); return; }
  const int l = (ph - 1) / 7, st = (ph - 1) - l * 7;
  switch (st) {
    case 0: phase_g1(l); break;
    case 1: phase_g2(l); break;
    case 2: phase_attn(l); break;
    case 3: phase_mix(); break;
    case 4: phase_wout(l); break;
    case 5: phase_mlp1(l); break;
    default: phase_mlp2(l); break;
  }
}

__global__ void __launch_bounds__(512) mega(Params p, int ph_lo, int ph_hi) {
  cg::grid_group grid = cg::this_grid();
  unsigned* bar = (unsigned*)(p.ws + OFF_BAR);
  const unsigned xcc = xcc_id();
  unsigned n_x = 0, nxcd = 0;
  if (threadIdx.x == 0) __hip_atomic_fetch_add(bar + 64 * xcc, 1u, __ATOMIC_RELAXED, __HIP_MEMORY_SCOPE_AGENT);
  for (int ph = ph_lo; ph < ph_hi; ++ph) {
    run_phase(ph);
    if (ph + 1 < ph_hi) {
      if (ph == ph_lo) {
        grid.sync();
        if (threadIdx.x == 0) {
          n_x = __hip_atomic_load(bar + 64 * xcc, __ATOMIC_RELAXED, __HIP_MEMORY_SCOPE_AGENT);
          for (int x = 0; x < 16; ++x) nxcd += __hip_atomic_load(bar + 64 * x, __ATOMIC_RELAXED, __HIP_MEMORY_SCOPE_AGENT) != 0u;
        }
      } else grid_barrier(bar, (unsigned)(ph - ph_lo), xcc, n_x, nxcd);
    }
  }
}

extern "C" void kernel_launch(void* const* d_in, const int* in_sizes, int n_in, void* d_out, int out_size, void* d_ws, size_t ws_size, hipStream_t stream) {
  static int grid_blocks = 0;
  if (!grid_blocks) {
    int dev = 0, cus = 0, per_cu = 0;
    (void)hipGetDevice(&dev);
    (void)hipDeviceGetAttribute(&cus, hipDeviceAttributeMultiprocessorCount, dev);
    (void)hipOccupancyMaxActiveBlocksPerMultiprocessor(&per_cu, mega, NTHR, 0);
    if (per_cu > 1) per_cu = 1;
    grid_blocks = cus * per_cu;
    if (ws_size < OFF_END) fprintf(stderr, "kernel_launch: workspace too small: %zu < %zu\n", ws_size, (size_t)OFF_END);
  }
  Params p;
  memset(&p, 0, sizeof(p));
  p.x = (const float*)d_in[0]; p.g_mix = (const float*)d_in[1]; p.w_in = (const float*)d_in[2]; p.q_norm = (const float*)d_in[3];
  p.w_uq = (const float*)d_in[4]; p.kv_norm = (const float*)d_in[5]; p.w_ukv = (const float*)d_in[6]; p.rpb = (const float*)d_in[7];
  p.on_a = (const float*)d_in[8]; p.on_b = (const float*)d_in[9]; p.on_c = (const float*)d_in[10]; p.w_out = (const float*)d_in[11];
  p.g_mlp = (const float*)d_in[12]; p.w_mlp_in = (const float*)d_in[13]; p.w_mlp_out = (const float*)d_in[14]; p.g_final = (const float*)d_in[15];
  p.out = (float*)d_out; p.ws = (char*)d_ws;
  p.qscaleA = (float)(1.4426950408889634 / std::sqrt(96.0));
  p.qscaleB = (float)(1.4426950408889634 * 0.125);
#if ONE_LAUNCH
  (void)hipMemsetAsync((char*)d_ws + OFF_BAR, 0, 16384, stream);
  int lo = 0, hi = NPHASE;
  void* args[] = {&p, &lo, &hi};
  hipError_t e = hipLaunchCooperativeKernel((void*)mega, dim3(grid_blocks), dim3(NTHR), args, 0, stream);
  if (e != hipSuccess) fprintf(stderr, "cooperative launch failed: %s (grid %d)\n", hipGetErrorString(e), grid_blocks);
#else
  for (int ph = 0; ph < NPHASE; ++ph) hipLaunchKernelGGL(mega, dim3(grid_blocks), dim3(NTHR), 0, stream, p, ph, ph + 1);
#endif
}
```

```cpp
#include <hip/hip_runtime.h>
#include <hip/hip_cooperative_groups.h>
#include <cstdio>
#include <cmath>
#include <cstring>
namespace cg = cooperative_groups;

#ifndef ONE_LAUNCH
#define ONE_LAUNCH 1
#endif

#define DI __device__ __forceinline__
typedef unsigned short bf16_t;
typedef short bf16x8 __attribute__((ext_vector_type(8)));
typedef short s16x4 __attribute__((ext_vector_type(4)));
typedef float f32x16 __attribute__((ext_vector_type(16)));
typedef float f32x2 __attribute__((ext_vector_type(2)));
typedef float f32x4 __attribute__((ext_vector_type(4)));
typedef __bf16 bf2_t __attribute__((ext_vector_type(2)));
typedef unsigned u32x4 __attribute__((ext_vector_type(4)));
typedef unsigned u32x2 __attribute__((ext_vector_type(2)));
typedef __attribute__((address_space(3))) s16x4 lds_s16x4;

constexpr int SEQ = 8192, NB = 4, NTOK = NB * SEQ, DM = 1024, NLAYER = 4;
constexpr int N_IN_PAD = 2560, N_UQ_PAD = 768, N_UKV = 768, DFF = 4096;
constexpr int NTHR = 512;

constexpr size_t SZ_XB = (size_t)NTOK * DM * 2;
constexpr size_t SZ_WIN = (size_t)N_IN_PAD * 1024 * 2, SZ_WUQ = (size_t)N_UQ_PAD * 256 * 2, SZ_WUKV = (size_t)N_UKV * 128 * 2,
                 SZ_WOUT = (size_t)1024 * 1024 * 2, SZ_W1 = (size_t)DFF * 1024 * 2, SZ_W2 = (size_t)1024 * DFF * 2;
constexpr size_t LW_WIN = 0, LW_WUQ = LW_WIN + SZ_WIN, LW_WUKV = LW_WUQ + SZ_WUQ, LW_WOUT = LW_WUKV + SZ_WUKV, LW_W1 = LW_WOUT + SZ_WOUT,
                 LW_W2 = LW_W1 + SZ_W1, LW_SIZE = LW_W2 + SZ_W2;
constexpr size_t OFF_XB = 0, OFF_W = OFF_XB + SZ_XB, OFF_TAB = OFF_W + NLAYER * LW_SIZE;
constexpr size_t OFF_COS32 = OFF_TAB, OFF_SIN32 = OFF_COS32 + (size_t)SEQ * 32 * 4, OFF_COS16 = OFF_SIN32 + (size_t)SEQ * 32 * 4,
                 OFF_SIN16 = OFF_COS16 + (size_t)SEQ * 16 * 4, OFF_ATT = OFF_SIN16 + (size_t)SEQ * 16 * 4;
constexpr size_t SZ_T384 = (size_t)NTOK * 384 * 2, SZ_QA = (size_t)NB * 6 * SEQ * 96 * 2, SZ_H6 = (size_t)NB * 6 * SEQ * 64 * 2,
                 SZ_H4 = (size_t)NB * 4 * SEQ * 64 * 2;
constexpr size_t OFF_CQKV = OFF_ATT;
constexpr size_t OFF_OA = OFF_CQKV;
constexpr size_t OFF_QA = OFF_CQKV + SZ_T384, OFF_KA = OFF_QA + SZ_QA, OFF_VA = OFF_KA + SZ_QA;
constexpr size_t OFF_QB = OFF_VA + SZ_H6, OFF_KB = OFF_QB + SZ_H6, OFF_VB = OFF_KB + SZ_H6;
constexpr size_t OFF_QC = OFF_VB + SZ_H6, OFF_KC = OFF_QC + SZ_H4, OFF_VC = OFF_KC + SZ_H4;
constexpr size_t OFF_OB = OFF_VC + SZ_H4, OFF_LSEB = OFF_OB + 3 * SZ_T384, OFF_OC = OFF_LSEB + (size_t)3 * NTOK * 6 * 4;
constexpr size_t OFF_SSQ = OFF_OC + (size_t)NTOK * 256 * 2;
constexpr size_t OFF_PX1 = OFF_SSQ, OFF_PX2 = OFF_PX1 + (size_t)NTOK * 16 * 4, OFF_PQ = OFF_PX2 + (size_t)NTOK * 16 * 4, OFF_PKV = OFF_PQ + (size_t)NTOK * 4 * 4;
constexpr size_t OFF_BAR = OFF_PKV + (size_t)NTOK * 2 * 4;
constexpr size_t OFF_END = OFF_BAR + 16384;
constexpr size_t OFF_MIXED = OFF_QA;
constexpr size_t OFF_HID = OFF_ATT;
static_assert(OFF_HID + (size_t)NTOK * DFF * 2 <= OFF_SSQ, "hid fits");
static_assert(OFF_MIXED + (size_t)NTOK * DM * 2 <= OFF_VA, "mixed fits");

struct Params {
  const float *x, *g_mix, *w_in, *q_norm, *w_uq, *kv_norm, *w_ukv, *rpb, *on_a, *on_b, *on_c, *w_out, *g_mlp, *w_mlp_in, *w_mlp_out, *g_final;
  float* out; char* ws;
  float qscaleA, qscaleB;
};
__shared__ __attribute__((aligned(1024))) char g_smem[131072];
#define NI __device__ __forceinline__
DI const Params& kparams() { return *(const Params*)__builtin_amdgcn_kernarg_segment_ptr(); }

DI unsigned cvtpk(float lo, float hi) { f32x2 v = {lo, hi}; bf2_t b = __builtin_convertvector(v, bf2_t); return __builtin_bit_cast(unsigned, b); }
DI bf16_t f2bf(float x) { return (bf16_t)(cvtpk(x, 0.f) & 0xffffu); }
DI float bf2f(unsigned h) { return __uint_as_float(h << 16); }
DI int crow(int i, int h) { return (i & 3) + 8 * (i >> 2) + 4 * h; }
#define MFMA32(a, b, c) __builtin_amdgcn_mfma_f32_32x32x16_bf16((a), (b), (c), 0, 0, 0)
DI float fdot2bf(unsigned a, float c) { bf2_t v = __builtin_bit_cast(bf2_t, a); return __builtin_amdgcn_fdot2_f32_bf16(v, v, c, false); }
DI float swap_max(float v) { auto rr = __builtin_amdgcn_permlane32_swap(__float_as_uint(v), __float_as_uint(v), false, false); return fmaxf(__uint_as_float(rr[0]), __uint_as_float(rr[1])); }
DI float swap_sum(float v) { auto rr = __builtin_amdgcn_permlane32_swap(__float_as_uint(v), __float_as_uint(v), false, false); return __uint_as_float(rr[0]) + __uint_as_float(rr[1]); }

constexpr int ATT_LDS = 53248;
#define FOR_TILES(NN, MT, NT, BODY) { const bool xm_ = gridDim.x == 256; const int st_ = xm_ ? (bid >> 3) : bid, sp_ = xm_ ? 32 : (int)gridDim.x, cn_ = xm_ ? 16 * (NN) : (NTOK / 256) * (NN); \
  for (int j_ = st_; j_ < cn_; j_ += sp_) { int MT = j_ / (NN); const int NT = j_ - MT * (NN); if (xm_) MT += (bid & 7) * 16; BODY } }
DI int otid() { int t = threadIdx.x; asm volatile("" : "+v"(t)); return t; }
DI int obid() { int t = blockIdx.x; asm volatile("" : "+s"(t)); return t; }

template <int NSLOT, class Epi>
DI void gemm_tile(const bf16_t* __restrict__ A, int lda, const bf16_t* __restrict__ Bt, int ldb, int K, int m0, int n0, const Epi& epi, const int tid, const float* pin) {
  const int lane = tid & 63, w = tid >> 6, wm = w >> 2, wn = w & 3, r32 = lane & 31, hi = lane >> 5;
  char* smem = g_smem;
  const int lrow = lane >> 3;
  const int c0 = (lane & 7) ^ (lane >> 4), c1 = (lane & 7) ^ ((lane >> 4) | 4);
  const char* Ab = (const char*)(A + (size_t)m0 * lda);
  const char* Bb = (const char*)(Bt + (size_t)n0 * ldb);
  const unsigned oa0 = (unsigned)(((w * 32 + lrow) * lda + c0 * 8) * 2), oa1 = (unsigned)(((w * 32 + lrow) * lda + c1 * 8) * 2);
  const unsigned ob0 = (unsigned)(((w * 32 + lrow) * ldb + c0 * 8) * 2), ob1 = (unsigned)(((w * 32 + lrow) * ldb + c1 * 8) * 2);
  const int dma_off = (w * 32) * 128 + lane * 16;
  f32x16 acc[4][2];
#pragma unroll
  for (int mi = 0; mi < 4; ++mi)
#pragma unroll
    for (int nj = 0; nj < 2; ++nj)
#pragma unroll
      for (int i = 0; i < 16; ++i) acc[mi][nj][i] = 0.f;
  const int nk = K >> 6;
  const int sw = (r32 >> 1) & 7, sh = sw >> 1, lo16 = 16 * (hi ^ (sw & 1));
  const int a_off = (wm * 128 + r32) * 128 + lo16;
  const int b_off = 32768 + (wn * 64 + r32) * 128 + lo16;
  __syncthreads();
  {
    char* sa = smem + dma_off;
#pragma unroll
    for (int j = 0; j < 4; ++j) {
      __builtin_amdgcn_global_load_lds((const unsigned*)(Ab + (size_t)(j * 8 * lda) * 2 + ((j & 1) ? oa1 : oa0)), (unsigned*)(sa + j * 1024), 16, 0, 0);
      __builtin_amdgcn_global_load_lds((const unsigned*)(Bb + (size_t)(j * 8 * ldb) * 2 + ((j & 1) ? ob1 : ob0)), (unsigned*)(sa + 32768 + j * 1024), 16, 0, 0);
    }
  }
  for (int kt = 0; kt < nk; ++kt) {
    __syncthreads();
    if (kt + 1 < nk) {
      char* sa = smem + ((kt + 1) & 1) * 65536 + dma_off;
      const int k0 = (kt + 1) * 64;
#pragma unroll
      for (int j = 0; j < 4; ++j) {
        __builtin_amdgcn_global_load_lds((const unsigned*)(Ab + (size_t)(j * 8 * lda + k0) * 2 + ((j & 1) ? oa1 : oa0)), (unsigned*)(sa + j * 1024), 16, 0, 0);
        __builtin_amdgcn_global_load_lds((const unsigned*)(Bb + (size_t)(j * 8 * ldb + k0) * 2 + ((j & 1) ? ob1 : ob0)), (unsigned*)(sa + 32768 + j * 1024), 16, 0, 0);
      }
    }
    const char* sb = smem + (kt & 1) * 65536;
#pragma unroll
    for (int ks = 0; ks < 4; ++ks) {
      const int koff = 32 * (ks ^ sh);
      bf16x8 af[4], bfr[2];
#pragma unroll
      for (int mi = 0; mi < 4; ++mi) af[mi] = *(const bf16x8*)(sb + a_off + mi * 4096 + koff);
#pragma unroll
      for (int nj = 0; nj < 2; ++nj) bfr[nj] = *(const bf16x8*)(sb + b_off + nj * 4096 + koff);
#pragma unroll
      for (int mi = 0; mi < 4; ++mi)
#pragma unroll
        for (int nj = 0; nj < 2; ++nj) acc[mi][nj] = MFMA32(af[mi], bfr[nj], acc[mi][nj]);
    }
  }
  float* rstd_s = (float*)smem;
  if (NSLOT > 0) {
    __syncthreads();
    if (tid < 256) {
      const float* pr = pin + (size_t)(m0 + tid) * NSLOT;
      float sacc = 0.f;
      if (NSLOT >= 4) {
#pragma unroll
        for (int q = 0; q < NSLOT / 4; ++q) { const f32x4 v = *(const f32x4*)(pr + 4 * q); sacc += (v[0] + v[1]) + (v[2] + v[3]); }
      } else {
#pragma unroll
        for (int q = 0; q < NSLOT; ++q) sacc += pr[q];
      }
      rstd_s[tid] = rsqrtf(sacc / (float)K + 1e-6f);
    }
    __syncthreads();
  }
  int lane2 = lane, w2 = w; asm volatile("" : "+v"(lane2), "+v"(w2));
  epi(acc, m0, (w2 >> 2) * 128, n0 + (w2 & 3) * 64, lane2, rstd_s);
}
DI void row_ssq_put(float v, float* dst, int lane) {
  v += __shfl_xor(v, 1); v += __shfl_xor(v, 2); v += __shfl_xor(v, 4); v += __shfl_xor(v, 8); v += __shfl_xor(v, 16);
  if ((lane & 31) == 0) *dst = v;
}

struct EpiG1 {
  bf16_t *cqkv, *KA, *qB, *qC; const float *cos32, *sin32, *cos16, *sin16; float qs; float *pq, *pkv;
  DI void operator()(f32x16 (&acc)[4][2], int m0, int lr0, int col0, int lane, const float* rstd_s) const {
    const int c = lane & 31, h = lane >> 5, cb = col0 >> 6;
    if (cb >= 37) return;
#define G1_ROW const int lr = lr0 + mi * 32 + crow(i, h), tok = m0 + lr, b = tok >> 13, s = tok & 8191; (void)b; (void)s; \
               const float rs = rstd_s[lr]; float v0 = acc[mi][0][i] * rs, v1 = acc[mi][1][i] * rs;
    if (cb < 6) {
#pragma unroll
      for (int mi = 0; mi < 4; ++mi)
#pragma unroll
        for (int i = 0; i < 16; ++i) {
        if ((i & 3) == 0) __builtin_amdgcn_sched_barrier(0);
          G1_ROW
          bf16_t* d = cqkv + (size_t)tok * 384 + cb * 64 + c; d[0] = f2bf(v0); d[32] = f2bf(v1);
          row_ssq_put(v0 * v0 + v1 * v1, cb < 4 ? pq + (size_t)tok * 4 + cb : pkv + (size_t)tok * 2 + (cb - 4), lane);
        }
    } else if (cb == 6) {
#pragma unroll
      for (int mi = 0; mi < 4; ++mi)
#pragma unroll
        for (int i = 0; i < 16; ++i) {
        if ((i & 3) == 0) __builtin_amdgcn_sched_barrier(0);
          G1_ROW
          if (c < 16) {
            const float cs = cos16[s * 16 + c], sn = sin16[s * 16 + c];
            const bf16_t o1 = f2bf(v0 * cs - v1 * sn), o2 = f2bf(v0 * sn + v1 * cs);
#pragma unroll
            for (int hd = 0; hd < 6; ++hd) { bf16_t* d = KA + ((size_t)(b * 6 + hd) * SEQ + s) * 96 + 64 + c; d[0] = o1; d[16] = o2; }
          }
        }
    } else if (cb < 25) {
      const int idx = cb - 7, which = idx / 6, hd = idx - which * 6;
      bf16_t* base = qB + (size_t)which * (SZ_H6 / 2) + (size_t)hd * SEQ * 64 + c;
      const float sc = which == 0 ? qs : 1.f;
      if (which < 2) {
#pragma unroll
        for (int mi = 0; mi < 4; ++mi)
#pragma unroll
          for (int i = 0; i < 16; ++i) {
        if ((i & 3) == 0) __builtin_amdgcn_sched_barrier(0);
            G1_ROW
            const float cs = cos32[s * 32 + c] * sc, sn = sin32[s * 32 + c] * sc;
            bf16_t* d = base + ((size_t)(b * 6) * SEQ + s) * 64;
            d[0] = f2bf(v0 * cs - v1 * sn); d[32] = f2bf(v0 * sn + v1 * cs);
          }
      } else {
#pragma unroll
        for (int mi = 0; mi < 4; ++mi)
#pragma unroll
          for (int i = 0; i < 16; ++i) {
        if ((i & 3) == 0) __builtin_amdgcn_sched_barrier(0);
            G1_ROW
            bf16_t* d = base + ((size_t)(b * 6) * SEQ + s) * 64;
            d[0] = f2bf(v0); d[32] = f2bf(v1);
          }
      }
    } else {
      const int idx = cb - 25, which = idx >> 2, hd = idx & 3;
      bf16_t* base = qC + (size_t)which * (SZ_H4 / 2) + (size_t)hd * SEQ * 64 + c;
      const float sc = which == 0 ? qs : 1.f;
#pragma unroll
      for (int mi = 0; mi < 4; ++mi)
#pragma unroll
        for (int i = 0; i < 16; ++i) {
        if ((i & 3) == 0) __builtin_amdgcn_sched_barrier(0);
          G1_ROW
          bf16_t* d = base + ((size_t)(b * 4) * SEQ + s) * 64;
          d[0] = f2bf(v0 * sc); d[32] = f2bf(v1 * sc);
        }
    }
#undef G1_ROW
  }
};
struct EpiUQ {
  bf16_t* QA; const float *cos16, *sin16; float qs;
  DI void operator()(f32x16 (&acc)[4][2], int m0, int lr0, int col0, int lane, const float* rstd_s) const {
    const int c = lane & 31, h = lane >> 5, cb = col0 >> 6;
    if (cb >= 9) return;
#pragma unroll
    for (int mi = 0; mi < 4; ++mi)
#pragma unroll
      for (int i = 0; i < 16; ++i) {
        if ((i & 3) == 0) __builtin_amdgcn_sched_barrier(0);
        const int lr = lr0 + mi * 32 + crow(i, h), tok = m0 + lr, b = tok >> 13, s = tok & 8191;
        const float rs = rstd_s[lr] * qs;
        const float v0 = acc[mi][0][i] * rs, v1 = acc[mi][1][i] * rs;
        if (cb < 6) {
          bf16_t* d = QA + ((size_t)(b * 6 + cb) * SEQ + s) * 96 + c; d[0] = f2bf(v0); d[32] = f2bf(v1);
        } else {
          const int hd = 2 * (cb - 6) + (c >> 4), fi = c & 15;
          const float cs = cos16[s * 16 + fi], sn = sin16[s * 16 + fi];
          bf16_t* d = QA + ((size_t)(b * 6 + hd) * SEQ + s) * 96 + 64 + fi;
          d[0] = f2bf(v0 * cs - v1 * sn); d[16] = f2bf(v0 * sn + v1 * cs);
        }
      }
  }
};
struct EpiUKV {
  bf16_t *KA, *VA;
  DI void operator()(f32x16 (&acc)[4][2], int m0, int lr0, int col0, int lane, const float* rstd_s) const {
    const int c = lane & 31, h = lane >> 5, cb = col0 >> 6, hd = cb >> 1, isv = cb & 1;
#pragma unroll
    for (int mi = 0; mi < 4; ++mi)
#pragma unroll
      for (int i = 0; i < 16; ++i) {
        if ((i & 3) == 0) __builtin_amdgcn_sched_barrier(0);
        const int lr = lr0 + mi * 32 + crow(i, h), tok = m0 + lr, b = tok >> 13, s = tok & 8191;
        const float rs = rstd_s[lr];
        const float v0 = acc[mi][0][i] * rs, v1 = acc[mi][1][i] * rs;
        bf16_t* d = isv ? VA + ((size_t)(b * 6 + hd) * SEQ + s) * 64 + c : KA + ((size_t)(b * 6 + hd) * SEQ + s) * 96 + c;
        d[0] = f2bf(v0); d[32] = f2bf(v1);
      }
  }
};
struct EpiRes {
  bf16_t* xb; float* pout;
  DI void operator()(f32x16 (&acc)[4][2], int m0, int lr0, int col0, int lane, const float* rstd_s) const {
    const int c = lane & 31, h = lane >> 5;
#pragma unroll
    for (int mi = 0; mi < 4; ++mi)
#pragma unroll
      for (int i = 0; i < 16; ++i) {
        if ((i & 3) == 0) __builtin_amdgcn_sched_barrier(0);
        const int row = m0 + lr0 + mi * 32 + crow(i, h);
        const size_t o = (size_t)row * DM + col0 + c;
        const float v0 = bf2f(xb[o]) + acc[mi][0][i], v1 = bf2f(xb[o + 32]) + acc[mi][1][i];
        xb[o] = f2bf(v0); xb[o + 32] = f2bf(v1);
        row_ssq_put(v0 * v0 + v1 * v1, pout + (size_t)row * 16 + (col0 >> 6), lane);
      }
  }
};
struct EpiMlp1 {
  bf16_t* hid;
  DI void operator()(f32x16 (&acc)[4][2], int m0, int lr0, int col0, int lane, const float* rstd_s) const {
    const int c = lane & 31, h = lane >> 5;
#pragma unroll
    for (int mi = 0; mi < 4; ++mi)
#pragma unroll
      for (int i = 0; i < 16; ++i) {
        if ((i & 3) == 0) __builtin_amdgcn_sched_barrier(0);
        const int lr = lr0 + mi * 32 + crow(i, h);
        const float rs = rstd_s[lr];
        const float v0 = fmaxf(acc[mi][0][i] * rs, 0.f), v1 = fmaxf(acc[mi][1][i] * rs, 0.f);
        __builtin_nontemporal_store(cvtpk(v0 * v0, v1 * v1), (unsigned*)(hid + (size_t)(m0 + lr) * DFF + col0 + 2 * c));
      }
  }
};

struct AttnItem {
  const bf16_t *Q, *K, *V;
  int q0;
  int n0, dil, res, N;
  int nrb, ncb, kr0, kc0;
  bf16_t* out; int ldo;
  float* lse;
  const float* rpb;
};

template <int DQ, int MODE>
DI void attn_block(const AttnItem& it, char* smem, const int tid) {
  constexpr int CPR = DQ / 8, KST = DQ * 2 + 16, KCH = (64 * CPR) / 256, NT = MODE == 0 ? SEQ / 64 : MODE == 1 ? 4 : 8;
  const int lane = tid & 63, w = tid >> 6, r32 = lane & 31, hi = lane >> 5;
  char* Ks = smem; char* Vs = smem + 64 * KST; float* bias_s = (float*)(smem + 64 * KST + 8192);
  const int qi = w * 32 + r32;
  int qpos;
  if (MODE == 0) qpos = it.q0 + qi;
  else if (MODE == 1) qpos = (it.n0 + qi) * it.dil + it.res;
  else qpos = (8 * it.nrb + (qi >> 4)) * 64 + 16 * it.ncb + (qi & 15);
  __syncthreads();
  if (MODE == 2) { for (int i = tid; i < 465; i += 256) bias_s[i] = it.rpb[i] * 1.4426950408889634f; }
  bf16x8 qr[DQ / 16];
#pragma unroll
  for (int d0 = 0; d0 < DQ / 16; ++d0) qr[d0] = *(const bf16x8*)(it.Q + (size_t)qpos * DQ + d0 * 16 + hi * 8);
  f32x16 o[2];
#pragma unroll
  for (int i = 0; i < 16; ++i) { o[0][i] = 0.f; o[1][i] = 0.f; }
  float m_run = -1e30f, l_run = 0.f;
  u32x4 rk[KCH], rv[2];
  auto kpos = [&](int t, int row) -> int {
    if (MODE == 0) return t * 64 + row;
    if (MODE == 1) { int n = it.n0 - 64 + 64 * t + row; n = n < 0 ? 0 : (n > it.N - 1 ? it.N - 1 : n); return n * it.dil + it.res; }
    return (it.kr0 + 2 * t + (row >> 5)) * 64 + it.kc0 + (row & 31);
  };
  auto load = [&](int t) {
#pragma unroll
    for (int i = 0; i < KCH; ++i) { const int c = tid + 256 * i, row = c / CPR, kc = c - row * CPR; rk[i] = *(const u32x4*)(it.K + (size_t)kpos(t, row) * DQ + kc * 8); }
#pragma unroll
    for (int i = 0; i < 2; ++i) { const int c = tid + 256 * i, row = c >> 3, kc = c & 7; rv[i] = *(const u32x4*)(it.V + (size_t)kpos(t, row) * 64 + kc * 8); }
  };
  const int vrd = ((lane >> 5) * 4 + ((lane & 15) >> 2)) * 64 + ((lane >> 4) & 1) * 32 + (lane & 3) * 8;
  load(0);
  for (int t = 0; t < NT; ++t) {
    __syncthreads();
#pragma unroll
    for (int i = 0; i < KCH; ++i) { const int c = tid + 256 * i, row = c / CPR, kc = c - row * CPR; *(u32x4*)(Ks + row * KST + kc * 16) = rk[i]; }
#pragma unroll
    for (int i = 0; i < 2; ++i) { const int c = tid + 256 * i, row = c >> 3, kc = c & 7; *(u32x4*)(Vs + (kc >> 2) * 4096 + row * 64 + (kc & 3) * 16) = rv[i]; }
    __syncthreads();
    if (t + 1 < NT) load(t + 1);
    bool skip = false;
    if (MODE == 1) skip = (w < 2) ? (t == 3) : (t == 0);
    if (MODE == 2) {
      const int rq_lo = 8 * it.nrb + 2 * w, rq_hi = rq_lo + 1;
      const int rs_lo = min(max(rq_lo - 4, 0), 120), rs_hi = min(max(rq_hi - 4, 0), 120) + 7;
      const int kr = it.kr0 + 2 * t;
      skip = (kr + 1 < rs_lo) || (kr > rs_hi);
    }
    if (skip) continue;
    f32x16 p0, p1;
#pragma unroll
    for (int i = 0; i < 16; ++i) { p0[i] = 0.f; p1[i] = 0.f; }
#pragma unroll
    for (int d0 = 0; d0 < DQ / 16; ++d0) {
      const bf16x8 k0 = *(const bf16x8*)(Ks + r32 * KST + d0 * 32 + hi * 16);
      const bf16x8 k1 = *(const bf16x8*)(Ks + (32 + r32) * KST + d0 * 32 + hi * 16);
      p0 = MFMA32(k0, qr[d0], p0); p1 = MFMA32(k1, qr[d0], p1);
    }
    if (MODE == 1) {
      const int nq = it.n0 + qi, kb = it.n0 - 64 + 64 * t;
#pragma unroll
      for (int i = 0; i < 16; ++i) {
        const int nk = kb + crow(i, hi), nk2 = nk + 32;
        const int d1 = nq - nk, d2 = nq - nk2;
        const bool ok1 = (d1 <= 64) && (d1 >= -64) && (nk >= 0) && (nk < it.N);
        const bool ok2 = (d2 <= 64) && (d2 >= -64) && (nk2 >= 0) && (nk2 < it.N);
        p0[i] = ok1 ? p0[i] : -INFINITY; p1[i] = ok2 ? p1[i] : -INFINITY;
      }
    }
    if (MODE == 2) {
      const int rq = 8 * it.nrb + (qi >> 4), cq = 16 * it.ncb + (qi & 15);
      const int rs_ = min(max(rq - 4, 0), 120), cs_ = min(max(cq - 8, 0), 48);
      const int kr = it.kr0 + 2 * t;
      const bool okr0 = (kr >= rs_) && (kr < rs_ + 8), okr1 = (kr + 1 >= rs_) && (kr + 1 < rs_ + 8);
      const int bi0 = (kr - rq + 7) * 31 - cq + 15;
#pragma unroll
      for (int i = 0; i < 16; ++i) {
        const int kc = it.kc0 + crow(i, hi);
        const bool okc = (kc >= cs_) && (kc < cs_ + 16);
        const bool ok0 = okc && okr0, ok1 = okc && okr1;
        const float b0 = bias_s[ok0 ? bi0 + kc : 0], b1 = bias_s[ok1 ? bi0 + 31 + kc : 0];
        p0[i] = ok0 ? p0[i] + b0 : -INFINITY; p1[i] = ok1 ? p1[i] + b1 : -INFINITY;
      }
    }
    float pmax = p0[0];
#pragma unroll
    for (int i = 1; i < 16; ++i) pmax = fmaxf(pmax, p0[i]);
#pragma unroll
    for (int i = 0; i < 16; ++i) pmax = fmaxf(pmax, p1[i]);
    pmax = swap_max(pmax);
    const float mn = fmaxf(m_run, pmax);
    const float alpha = __builtin_amdgcn_exp2f(m_run - mn);
    m_run = mn;
    float ps = 0.f;
#pragma unroll
    for (int i = 0; i < 16; ++i) { p0[i] = __builtin_amdgcn_exp2f(p0[i] - mn); ps += p0[i]; }
#pragma unroll
    for (int i = 0; i < 16; ++i) { p1[i] = __builtin_amdgcn_exp2f(p1[i] - mn); ps += p1[i]; }
    ps = swap_sum(ps);
    l_run = l_run * alpha + ps;
#pragma unroll
    for (int i = 0; i < 16; ++i) { o[0][i] *= alpha; o[1][i] *= alpha; }
    bf16x8 pb[4];
#pragma unroll
    for (int s = 0; s < 2; ++s) {
      u32x4 a = {cvtpk(p0[8 * s], p0[8 * s + 1]), cvtpk(p0[8 * s + 2], p0[8 * s + 3]), cvtpk(p0[8 * s + 4], p0[8 * s + 5]), cvtpk(p0[8 * s + 6], p0[8 * s + 7])};
      u32x4 b = {cvtpk(p1[8 * s], p1[8 * s + 1]), cvtpk(p1[8 * s + 2], p1[8 * s + 3]), cvtpk(p1[8 * s + 4], p1[8 * s + 5]), cvtpk(p1[8 * s + 6], p1[8 * s + 7])};
      pb[s] = __builtin_bit_cast(bf16x8, a); pb[2 + s] = __builtin_bit_cast(bf16x8, b);
    }
#pragma unroll
    for (int db = 0; db < 2; ++db)
#pragma unroll
      for (int s = 0; s < 4; ++s) {
        const s16x4 lo = __builtin_amdgcn_ds_read_tr16_b64_v4i16((lds_s16x4*)(Vs + db * 4096 + (16 * s) * 64 + vrd));
        const s16x4 hh = __builtin_amdgcn_ds_read_tr16_b64_v4i16((lds_s16x4*)(Vs + db * 4096 + (16 * s + 8) * 64 + vrd));
        const bf16x8 a = {lo[0], lo[1], lo[2], lo[3], hh[0], hh[1], hh[2], hh[3]};
        o[db] = MFMA32(a, pb[s], o[db]);
      }
  }
  const float inv = 1.f / l_run;
  const int bq = qpos;
  bf16_t* orow = it.out + (size_t)bq * it.ldo;
#pragma unroll
  for (int db = 0; db < 2; ++db)
#pragma unroll
    for (int g = 0; g < 4; ++g) {
      u32x2 v = {cvtpk(o[db][4 * g] * inv, o[db][4 * g + 1] * inv), cvtpk(o[db][4 * g + 2] * inv, o[db][4 * g + 3] * inv)};
      *(u32x2*)(orow + db * 32 + 8 * g + 4 * hi) = v;
    }
  if (MODE == 1) { if (hi == 0) it.lse[(size_t)bq * 6] = m_run + __builtin_amdgcn_logf(l_run); }
}

DI void attn_dense_skew(const bf16_t* __restrict__ Q, const bf16_t* __restrict__ K, const bf16_t* __restrict__ V, int q0, bf16_t* __restrict__ out,
                        char* smem, const int tid512, const int grp) {
  constexpr int DQ = 96, CPR = 12, KST = 208, NT = SEQ / 64, KB = 64 * KST, VOFF = 2 * KB;
  const int lane = tid512 & 63, w = (tid512 >> 6) & 3, r32 = lane & 31, hi = lane >> 5;
  const int qpos = q0 + w * 32 + r32;
  bf16x8 qr[DQ / 16];
#pragma unroll
  for (int d0 = 0; d0 < DQ / 16; ++d0) qr[d0] = *(const bf16x8*)(Q + (size_t)qpos * DQ + d0 * 16 + hi * 8);
  f32x16 o[2];
#pragma unroll
  for (int i = 0; i < 16; ++i) { o[0][i] = 0.f; o[1][i] = 0.f; }
  float m_run = -1e30f, l_run = 0.f;
  const int kr0 = tid512 / CPR, kc0 = tid512 - kr0 * CPR, c1 = tid512 + 512, kr1 = c1 / CPR, kc1 = c1 - kr1 * CPR, vr = tid512 >> 3, vc = tid512 & 7;
  const bool two = tid512 < 256;
  const bf16_t* Kp0 = K + (size_t)kr0 * DQ + kc0 * 8; const bf16_t* Kp1 = K + (size_t)kr1 * DQ + kc1 * 8; const bf16_t* Vp = V + (size_t)vr * 64 + vc * 8;
  const int ks0 = kr0 * KST + kc0 * 16, ks1 = kr1 * KST + kc1 * 16, vs0 = VOFF + (vc >> 2) * 4096 + vr * 64 + (vc & 3) * 16;
  u32x4 rk0, rk1 = u32x4{0u, 0u, 0u, 0u}, rv;
  auto load = [&](int t) {
    const size_t ro = (size_t)t * 64;
    rk0 = *(const u32x4*)(Kp0 + ro * DQ); if (two) rk1 = *(const u32x4*)(Kp1 + ro * DQ); rv = *(const u32x4*)(Vp + ro * 64);
  };
  auto store = [&](int kb, int vb) {
    char* kbp = smem + kb * KB;
    *(u32x4*)(kbp + ks0) = rk0; if (two) *(u32x4*)(kbp + ks1) = rk1; *(u32x4*)(smem + vb * 8192 + vs0) = rv;
  };
  const int vrd = ((lane >> 5) * 4 + ((lane & 15) >> 2)) * 64 + ((lane >> 4) & 1) * 32 + (lane & 3) * 8;
  __syncthreads();
  load(0); store(0, 0); load(1);
  __syncthreads();
  if (grp == 1) __syncthreads();
  int vcur = 0;
  for (int t = 0; t < NT; ++t) {
    const int vnext = vcur == 2 ? 0 : vcur + 1;
    const char* Ks = smem + (t & 1) * KB; const char* Vs = smem + VOFF + vcur * 8192;
    if (t + 1 < NT) store((t + 1) & 1, vnext);
    if (t + 2 < NT) load(t + 2);
    f32x16 p0, p1;
#pragma unroll
    for (int i = 0; i < 16; ++i) { p0[i] = 0.f; p1[i] = 0.f; }
    {
      const char* kp = Ks + r32 * KST + hi * 16;
      bf16x8 ka[2][2];
      ka[0][0] = *(const bf16x8*)(kp); ka[0][1] = *(const bf16x8*)(kp + 32 * KST);
      ka[1][0] = *(const bf16x8*)(kp + 32); ka[1][1] = *(const bf16x8*)(kp + 32 * KST + 32);
#pragma unroll
      for (int d0 = 0; d0 < DQ / 16; ++d0) {
        p0 = MFMA32(ka[d0 & 1][0], qr[d0], p0); p1 = MFMA32(ka[d0 & 1][1], qr[d0], p1);
        if (d0 + 2 < DQ / 16) { ka[d0 & 1][0] = *(const bf16x8*)(kp + (d0 + 2) * 32); ka[d0 & 1][1] = *(const bf16x8*)(kp + 32 * KST + (d0 + 2) * 32); }
      }
    }
    float pmax = p0[0];
#pragma unroll
    for (int i = 1; i < 16; ++i) pmax = fmaxf(pmax, p0[i]);
#pragma unroll
    for (int i = 0; i < 16; ++i) pmax = fmaxf(pmax, p1[i]);
    pmax = swap_max(pmax);
    {
      const float mn = fmaxf(m_run, pmax);
      const float alpha = __builtin_amdgcn_exp2f(m_run - mn);
      m_run = mn; l_run *= alpha;
#pragma unroll
      for (int i = 0; i < 16; ++i) { o[0][i] *= alpha; o[1][i] *= alpha; }
    }
    asm volatile("" : "+v"(p0), "+v"(p1), "+v"(o[0]), "+v"(o[1]), "+v"(m_run));
    __syncthreads();
    asm volatile("" : "+v"(p0), "+v"(p1), "+v"(o[0]), "+v"(o[1]), "+v"(m_run));
    s16x4 vlo[4], vhi[4];
#pragma unroll
    for (int s2 = 0; s2 < 4; ++s2) {
      vlo[s2] = __builtin_amdgcn_ds_read_tr16_b64_v4i16((lds_s16x4*)(Vs + (16 * s2) * 64 + vrd));
      vhi[s2] = __builtin_amdgcn_ds_read_tr16_b64_v4i16((lds_s16x4*)(Vs + (16 * s2 + 8) * 64 + vrd));
    }
    float ps = 0.f;
#pragma unroll
    for (int i = 0; i < 16; ++i) { p0[i] = __builtin_amdgcn_exp2f(p0[i] - m_run); ps += p0[i]; }
#pragma unroll
    for (int i = 0; i < 16; ++i) { p1[i] = __builtin_amdgcn_exp2f(p1[i] - m_run); ps += p1[i]; }
    l_run += swap_sum(ps);
    bf16x8 pb[4];
#pragma unroll
    for (int s = 0; s < 2; ++s) {
      u32x4 a = {cvtpk(p0[8 * s], p0[8 * s + 1]), cvtpk(p0[8 * s + 2], p0[8 * s + 3]), cvtpk(p0[8 * s + 4], p0[8 * s + 5]), cvtpk(p0[8 * s + 6], p0[8 * s + 7])};
      u32x4 b = {cvtpk(p1[8 * s], p1[8 * s + 1]), cvtpk(p1[8 * s + 2], p1[8 * s + 3]), cvtpk(p1[8 * s + 4], p1[8 * s + 5]), cvtpk(p1[8 * s + 6], p1[8 * s + 7])};
      pb[s] = __builtin_bit_cast(bf16x8, a); pb[2 + s] = __builtin_bit_cast(bf16x8, b);
    }
    {
      s16x4 wlo[4], whi[4];
#pragma unroll
      for (int s2 = 0; s2 < 4; ++s2) {
        wlo[s2] = __builtin_amdgcn_ds_read_tr16_b64_v4i16((lds_s16x4*)(Vs + 4096 + (16 * s2) * 64 + vrd));
        whi[s2] = __builtin_amdgcn_ds_read_tr16_b64_v4i16((lds_s16x4*)(Vs + 4096 + (16 * s2 + 8) * 64 + vrd));
      }
#pragma unroll
      for (int s2 = 0; s2 < 4; ++s2) { const bf16x8 a = {vlo[s2][0], vlo[s2][1], vlo[s2][2], vlo[s2][3], vhi[s2][0], vhi[s2][1], vhi[s2][2], vhi[s2][3]}; o[0] = MFMA32(a, pb[s2], o[0]); }
#pragma unroll
      for (int s2 = 0; s2 < 4; ++s2) { const bf16x8 a = {wlo[s2][0], wlo[s2][1], wlo[s2][2], wlo[s2][3], whi[s2][0], whi[s2][1], whi[s2][2], whi[s2][3]}; o[1] = MFMA32(a, pb[s2], o[1]); }
    }
    asm volatile("" : "+v"(o[0]), "+v"(o[1]));
    __syncthreads();
    asm volatile("" : "+v"(o[0]), "+v"(o[1]));
    vcur = vnext;
  }
  if (grp == 0) __syncthreads();
  const float inv = 1.f / l_run;
  bf16_t* orow = out + (size_t)qpos * 384;
#pragma unroll
  for (int db = 0; db < 2; ++db)
#pragma unroll
    for (int g = 0; g < 4; ++g) {
      u32x2 v = {cvtpk(o[db][4 * g] * inv, o[db][4 * g + 1] * inv), cvtpk(o[db][4 * g + 2] * inv, o[db][4 * g + 3] * inv)};
      *(u32x2*)(orow + db * 32 + 8 * g + 4 * hi) = v;
    }
}

DI float wave_sum(float v) {
  v += __shfl_xor(v, 32); v += __shfl_xor(v, 16); v += __shfl_xor(v, 8); v += __shfl_xor(v, 4); v += __shfl_xor(v, 2); v += __shfl_xor(v, 1); return v;
}
DI float gain_of(const Params& p, int kind, int l, int k) {
  switch (kind) {
    case 0: return p.g_mix[l * 1024 + k];
    case 1: return p.q_norm[l * 256 + k];
    case 2: return p.kv_norm[l * 128 + k];
    case 3: return k < 384 ? p.on_a[l * 384 + k] : (k < 768 ? p.on_b[l * 384 + k - 384] : p.on_c[l * 256 + k - 768]);
    case 4: return p.g_mlp[l * 1024 + k];
    default: return 1.f;
  }
}
DI int map_col(int kind, int n) {
  if (kind == 0) {
    if (n < 384) return n;
    if (n < 448) { const int wv = n - 384, c = wv & 31, sub = wv >> 5; return c < 16 ? 384 + sub * 16 + c : -1; }
    if (n < 1600) return 416 + (n - 448);
    if (n < 2368) return 1568 + (n - 1600);
    return -1;
  }
  if (kind == 1) {
    if (n < 384) return (n >> 6) * 96 + (n & 63);
    if (n < 576) { const int wv = n - 384, g = wv >> 6, wi = wv & 63, sub = wi >> 5, c = wi & 31, hd = 2 * g + (c >> 4), fi = c & 15; return hd * 96 + 64 + sub * 16 + fi; }
    return -1;
  }
  return n;
}
DI void wtile(const Params& p, const float* src, int Nsrc, bf16_t* dst, int K, int kt, int nt, int kind, int l, char* smem, const int tid) {
  float* tile = (float*)smem;
  const int lane = tid & 63, wv = tid >> 6;
  __syncthreads();
  const int n = nt * 64 + lane, sc = map_col(kind, n);
#pragma unroll 4
  for (int r = 0; r < 8; ++r) {
    const int kl = r * 8 + wv, kd = kt * 64 + kl;
    const int k = kind == 5 ? ((kd & ~63) | ((kd & 1) << 5) | ((kd & 63) >> 1)) : kd;
    float v = 0.f;
    if (sc >= 0) v = src[(size_t)k * Nsrc + sc] * gain_of(p, kind, l, k);
    tile[kl * 65 + lane] = v;
  }
  __syncthreads();
#pragma unroll 4
  for (int r = 0; r < 8; ++r) {
    const int nl = r * 8 + wv;
    dst[(size_t)(nt * 64 + nl) * K + kt * 64 + lane] = f2bf(tile[lane * 65 + nl]);
  }
}

NI void phase_prep() {
  const Params& p = kparams(); char* smem = g_smem; const int tid = otid(), bid = obid();
  char* ws = p.ws;
  constexpr int T_WIN = (N_IN_PAD / 64) * 16, T_WUQ = (N_UQ_PAD / 64) * 4, T_WUKV = (N_UKV / 64) * 2, T_WOUT = 16 * 16, T_W1 = 64 * 16, T_W2 = 16 * 64;
  constexpr int T_L = T_WIN + T_WUQ + T_WUKV + T_WOUT + T_W1 + T_W2;
  for (int j = bid; j < NLAYER * T_L; j += gridDim.x) {
    const int l = j / T_L; int r = j - l * T_L;
    char* lw = ws + OFF_W + (size_t)l * LW_SIZE;
    if (r < T_WIN) { wtile(p, p.w_in + (size_t)l * 1024 * 2336, 2336, (bf16_t*)(lw + LW_WIN), 1024, r & 15, r >> 4, 0, l, smem, tid); continue; }
    r -= T_WIN;
    if (r < T_WUQ) { wtile(p, p.w_uq + (size_t)l * 256 * 576, 576, (bf16_t*)(lw + LW_WUQ), 256, r & 3, r >> 2, 1, l, smem, tid); continue; }
    r -= T_WUQ;
    if (r < T_WUKV) { wtile(p, p.w_ukv + (size_t)l * 128 * 768, 768, (bf16_t*)(lw + LW_WUKV), 128, r & 1, r >> 1, 2, l, smem, tid); continue; }
    r -= T_WUKV;
    if (r < T_WOUT) { wtile(p, p.w_out + (size_t)l * 1024 * 1024, 1024, (bf16_t*)(lw + LW_WOUT), 1024, r & 15, r >> 4, 3, l, smem, tid); continue; }
    r -= T_WOUT;
    if (r < T_W1) { wtile(p, p.w_mlp_in + (size_t)l * 1024 * 4096, 4096, (bf16_t*)(lw + LW_W1), 1024, r & 15, r >> 4, 4, l, smem, tid); continue; }
    r -= T_W1;
    wtile(p, p.w_mlp_out + (size_t)l * 4096 * 1024, 1024, (bf16_t*)(lw + LW_W2), 4096, r & 63, r >> 6, 5, l, smem, tid);
  }
  const size_t gtid = (size_t)bid * NTHR + tid, gsz = (size_t)gridDim.x * NTHR;
  bf16_t* xb = (bf16_t*)(ws + OFF_XB);
  {
    const int lane = tid & 63, gw = bid * (NTHR / 64) + (tid >> 6), nw = gridDim.x * (NTHR / 64);
    float* px1 = (float*)(ws + OFF_PX1);
    for (int row = gw; row < NTOK; row += nw) {
      float ss = 0.f;
#pragma unroll
      for (int j = 0; j < 4; ++j) {
        const f32x4 a = *(const f32x4*)(p.x + (size_t)row * DM + j * 256 + lane * 4);
        ss += a[0] * a[0] + a[1] * a[1] + a[2] * a[2] + a[3] * a[3];
        u32x2 o = {cvtpk(a[0], a[1]), cvtpk(a[2], a[3])};
        *(u32x2*)(xb + (size_t)row * DM + j * 256 + lane * 4) = o;
      }
      ss = wave_sum(ss);
      if (lane < 16) px1[(size_t)row * 16 + lane] = lane == 0 ? ss : 0.f;
    }
  }
  float* c32 = (float*)(ws + OFF_COS32); float* s32 = (float*)(ws + OFF_SIN32); float* c16 = (float*)(ws + OFF_COS16); float* s16 = (float*)(ws + OFF_SIN16);
  for (size_t i = gtid; i < (size_t)SEQ * 48; i += gsz) {
    int pos, fi; float invf; float *cd, *sd;
    if (i < (size_t)SEQ * 32) { pos = (int)(i >> 5); fi = (int)(i & 31); invf = __builtin_amdgcn_exp2f(-(float)fi * (13.287712379549449f / 32.f)); cd = c32 + i; sd = s32 + i; }
    else { const size_t j = i - (size_t)SEQ * 32; pos = (int)(j >> 4); fi = (int)(j & 15); invf = __builtin_amdgcn_exp2f(-(float)fi * (13.287712379549449f / 16.f)); cd = c16 + j; sd = s16 + j; }
    const float ang = (float)pos * invf;
    const double rev = (double)ang * 0.15915494309189535;
    const float fr = (float)(rev - rint(rev));
    *cd = __builtin_amdgcn_cosf(fr); *sd = __builtin_amdgcn_sinf(fr);
  }
}

NI void phase_g1(int l_) {
  const Params& p = kparams(); char* smem = g_smem; const int l = __builtin_amdgcn_readfirstlane(l_); const int tid = otid(), bid = obid(); (void)tid; (void)bid;
  char* ws = p.ws;
  EpiG1 e;
  e.cqkv = (bf16_t*)(ws + OFF_CQKV); e.KA = (bf16_t*)(ws + OFF_KA); e.qB = (bf16_t*)(ws + OFF_QB); e.qC = (bf16_t*)(ws + OFF_QC);
  e.cos32 = (const float*)(ws + OFF_COS32); e.sin32 = (const float*)(ws + OFF_SIN32); e.cos16 = (const float*)(ws + OFF_COS16); e.sin16 = (const float*)(ws + OFF_SIN16);
  e.qs = p.qscaleB; e.pq = (float*)(ws + OFF_PQ); e.pkv = (float*)(ws + OFF_PKV);
  const bf16_t* A = (const bf16_t*)(ws + OFF_XB);
  const bf16_t* Bt = (const bf16_t*)(ws + OFF_W + (size_t)l * LW_SIZE + LW_WIN);
  constexpr int NNT = N_IN_PAD / 256;
  FOR_TILES(NNT, mt, nt, gemm_tile<16>(A, 1024, Bt, 1024, 1024, mt * 256, nt * 256, e, tid, (const float*)(ws + OFF_PX1));)
}
NI void phase_g2(int l_) {
  const Params& p = kparams(); char* smem = g_smem; const int l = __builtin_amdgcn_readfirstlane(l_); const int tid = otid(), bid = obid(); (void)tid; (void)bid;
  char* ws = p.ws;
  const bf16_t* A = (const bf16_t*)(ws + OFF_CQKV);
  EpiUQ eq; eq.QA = (bf16_t*)(ws + OFF_QA); eq.cos16 = (const float*)(ws + OFF_COS16); eq.sin16 = (const float*)(ws + OFF_SIN16); eq.qs = p.qscaleA;
  EpiUKV ek; ek.KA = (bf16_t*)(ws + OFF_KA); ek.VA = (bf16_t*)(ws + OFF_VA);
  const bf16_t* Wq = (const bf16_t*)(ws + OFF_W + (size_t)l * LW_SIZE + LW_WUQ);
  const bf16_t* Wkv = (const bf16_t*)(ws + OFF_W + (size_t)l * LW_SIZE + LW_WUKV);
  FOR_TILES(6, mt, nt,
    if (nt < 3) gemm_tile<4>(A, 384, Wq, 256, 256, mt * 256, nt * 256, eq, tid, (const float*)(ws + OFF_PQ));
    else gemm_tile<2>(A + 256, 384, Wkv, 128, 128, mt * 256, (nt - 3) * 256, ek, tid, (const float*)(ws + OFF_PKV));)
}
NI void phase_attn(int l_) {
  const Params& p = kparams(); char* smem = g_smem; const int l = __builtin_amdgcn_readfirstlane(l_); const int tid = otid(), bid = obid(); (void)tid; (void)bid;
  char* ws = p.ws;
  constexpr int NA = 1536, NBI = 4608, NC = 1024;
  const int grp = tid >> 8, t256 = tid & 255; char* gsm = smem + grp * ATT_LDS;
  for (int i0 = bid * 2; i0 < NA; i0 += gridDim.x * 2) {
    const int i = i0 + grp, xcd = (i >> 1) & 7, j = ((i >> 4) << 1) | (i & 1);
    const int bh = (j >> 6) * 8 + xcd, qb = j & 63, b = bh / 6, h = bh - b * 6;
    attn_dense_skew((const bf16_t*)(ws + OFF_QA) + (size_t)bh * SEQ * 96, (const bf16_t*)(ws + OFF_KA) + (size_t)bh * SEQ * 96, (const bf16_t*)(ws + OFF_VA) + (size_t)bh * SEQ * 64,
                    qb * 128, (bf16_t*)(ws + OFF_OA) + (size_t)b * SEQ * 384 + h * 64, smem, tid, grp);
  }
  for (int i0 = bid * 2; i0 < NBI; i0 += gridDim.x * 2) {
    AttnItem it{};
    const int i = i0 + grp, xcd = (i >> 1) & 7, j = ((i >> 4) << 1) | (i & 1);
    const int g = (j >> 6) * 8 + xcd, c = j & 63, br = g / 24, bh = g - br * 24, b = bh / 6, h = bh - b * 6;
    const int dil = br == 0 ? 1 : (br == 1 ? 4 : 16), cpr = 64 / dil;
    it.Q = (const bf16_t*)(ws + OFF_QB) + (size_t)bh * SEQ * 64; it.K = (const bf16_t*)(ws + OFF_KB) + (size_t)bh * SEQ * 64; it.V = (const bf16_t*)(ws + OFF_VB) + (size_t)bh * SEQ * 64;
    it.dil = dil; it.res = c / cpr; it.n0 = (c - it.res * cpr) * 128; it.N = SEQ / dil;
    it.out = (bf16_t*)(ws + OFF_OB) + (size_t)br * NTOK * 384 + (size_t)b * SEQ * 384 + h * 64; it.ldo = 384;
    it.lse = (float*)(ws + OFF_LSEB) + (size_t)br * NTOK * 6 + (size_t)b * SEQ * 6 + h;
    attn_block<64, 1>(it, gsm, t256);
  }
  for (int i0 = bid * 2; i0 < NC; i0 += gridDim.x * 2) {
    AttnItem it{};
    const int i = i0 + grp, xcd = (i >> 1) & 7, j = ((i >> 4) << 1) | (i & 1);
    const int bh = (j >> 6) * 8 + xcd, blk = j & 63, b = bh >> 2, h = bh & 3;
    it.Q = (const bf16_t*)(ws + OFF_QC) + (size_t)bh * SEQ * 64; it.K = (const bf16_t*)(ws + OFF_KC) + (size_t)bh * SEQ * 64; it.V = (const bf16_t*)(ws + OFF_VC) + (size_t)bh * SEQ * 64;
    it.nrb = blk >> 2; it.ncb = blk & 3;
    it.kr0 = min(max(8 * it.nrb - 4, 0), 112); it.kc0 = min(max(16 * it.ncb - 8, 0), 32);
    it.out = (bf16_t*)(ws + OFF_OC) + (size_t)b * SEQ * 256 + h * 64; it.ldo = 256;
    it.rpb = p.rpb + ((size_t)l * 4 + h) * 465;
    attn_block<64, 2>(it, gsm, t256);
  }
}
NI void phase_mix() {
  const Params& p = kparams(); const int tid = otid(), bid = obid();
  char* ws = p.ws;
  const int lane = tid & 63, gw = bid * (NTHR / 64) + (tid >> 6), nw = gridDim.x * (NTHR / 64);
  const bf16_t* oA = (const bf16_t*)(ws + OFF_OA); const bf16_t* oB = (const bf16_t*)(ws + OFF_OB); const bf16_t* oC = (const bf16_t*)(ws + OFF_OC);
  const float* lse = (const float*)(ws + OFF_LSEB);
  bf16_t* mixed = (bf16_t*)(ws + OFF_MIXED);
  for (int tok = gw; tok < NTOK; tok += nw) {
    float v[16];
    if (lane < 24 || lane >= 48) {
      const bf16_t* src = lane < 24 ? oA + (size_t)tok * 384 + lane * 16 : oC + (size_t)tok * 256 + (lane - 48) * 16;
      const u32x4 a = *(const u32x4*)src, b = *(const u32x4*)(src + 8);
#pragma unroll
      for (int j = 0; j < 4; ++j) { v[2 * j] = bf2f(a[j] & 0xffffu); v[2 * j + 1] = bf2f(a[j] >> 16); v[8 + 2 * j] = bf2f(b[j] & 0xffffu); v[8 + 2 * j + 1] = bf2f(b[j] >> 16); }
    } else {
      const int col = (lane - 24) * 16, hd = col >> 6;
      const float l0 = lse[(size_t)tok * 6 + hd], l1 = lse[(size_t)NTOK * 6 + (size_t)tok * 6 + hd], l2 = lse[(size_t)2 * NTOK * 6 + (size_t)tok * 6 + hd];
      const float mx = fmaxf(l0, fmaxf(l1, l2));
      float w0 = __builtin_amdgcn_exp2f(l0 - mx), w1 = __builtin_amdgcn_exp2f(l1 - mx), w2 = __builtin_amdgcn_exp2f(l2 - mx);
      const float wi = 1.f / (w0 + w1 + w2); w0 *= wi; w1 *= wi; w2 *= wi;
#pragma unroll
      for (int j = 0; j < 16; ++j) v[j] = 0.f;
#pragma unroll
      for (int br = 0; br < 3; ++br) {
        const float wb = br == 0 ? w0 : (br == 1 ? w1 : w2);
        const bf16_t* src = oB + (size_t)br * NTOK * 384 + (size_t)tok * 384 + col;
        const u32x4 a = *(const u32x4*)src, b = *(const u32x4*)(src + 8);
#pragma unroll
        for (int j = 0; j < 4; ++j) { v[2 * j] += wb * bf2f(a[j] & 0xffffu); v[2 * j + 1] += wb * bf2f(a[j] >> 16); v[8 + 2 * j] += wb * bf2f(b[j] & 0xffffu); v[8 + 2 * j + 1] += wb * bf2f(b[j] >> 16); }
      }
    }
    float ss = 0.f;
#pragma unroll
    for (int j = 0; j < 16; ++j) ss += v[j] * v[j];
    const float sa = wave_sum(lane < 24 ? ss : 0.f), sb = wave_sum((lane >= 24 && lane < 48) ? ss : 0.f), sc = wave_sum(lane >= 48 ? ss : 0.f);
    const float rs = lane < 24 ? rsqrtf(sa * (1.f / 384.f) + 1e-6f) : (lane < 48 ? rsqrtf(sb * (1.f / 384.f) + 1e-6f) : rsqrtf(sc * (1.f / 256.f) + 1e-6f));
    u32x4 oa, ob;
#pragma unroll
    for (int j = 0; j < 4; ++j) { oa[j] = cvtpk(v[2 * j] * rs, v[2 * j + 1] * rs); ob[j] = cvtpk(v[8 + 2 * j] * rs, v[8 + 2 * j + 1] * rs); }
    bf16_t* dst = mixed + (size_t)tok * 1024 + lane * 16;
    *(u32x4*)dst = oa; *(u32x4*)(dst + 8) = ob;
  }
}
NI void phase_wout(int l_) {
  const Params& p = kparams(); char* smem = g_smem; const int l = __builtin_amdgcn_readfirstlane(l_); const int tid = otid(), bid = obid(); (void)tid; (void)bid;
  char* ws = p.ws;
  EpiRes e; e.xb = (bf16_t*)(ws + OFF_XB); e.pout = (float*)(ws + OFF_PX2);
  const bf16_t* A = (const bf16_t*)(ws + OFF_MIXED);
  const bf16_t* Bt = (const bf16_t*)(ws + OFF_W + (size_t)l * LW_SIZE + LW_WOUT);
  FOR_TILES(4, mt, nt, gemm_tile<0>(A, 1024, Bt, 1024, 1024, mt * 256, nt * 256, e, tid, nullptr);)
}
NI void phase_mlp1(int l_) {
  const Params& p = kparams(); char* smem = g_smem; const int l = __builtin_amdgcn_readfirstlane(l_); const int tid = otid(), bid = obid(); (void)tid; (void)bid;
  char* ws = p.ws;
  EpiMlp1 e; e.hid = (bf16_t*)(ws + OFF_HID);
  const bf16_t* A = (const bf16_t*)(ws + OFF_XB);
  const bf16_t* Bt = (const bf16_t*)(ws + OFF_W + (size_t)l * LW_SIZE + LW_W1);
  FOR_TILES(16, mt, nt, gemm_tile<16>(A, 1024, Bt, 1024, 1024, mt * 256, nt * 256, e, tid, (const float*)(ws + OFF_PX2));)
}
NI void phase_mlp2(int l_) {
  const Params& p = kparams(); char* smem = g_smem; const int l = __builtin_amdgcn_readfirstlane(l_); const int tid = otid(), bid = obid(); (void)tid; (void)bid;
  char* ws = p.ws;
  EpiRes e; e.xb = (bf16_t*)(ws + OFF_XB); e.pout = (float*)(ws + OFF_PX1);
  const bf16_t* A = (const bf16_t*)(ws + OFF_HID);
  const bf16_t* Bt = (const bf16_t*)(ws + OFF_W + (size_t)l * LW_SIZE + LW_W2);
  FOR_TILES(4, mt, nt, gemm_tile<0>(A, DFF, Bt, DFF, DFF, mt * 256, nt * 256, e, tid, nullptr);)
}
NI void phase_final() {
  const Params& p = kparams(); const int tid = otid(), bid = obid();
  const int lane = tid & 63, gw = bid * (NTHR / 64) + (tid >> 6), nw = gridDim.x * (NTHR / 64);
  const bf16_t* xb = (const bf16_t*)(p.ws + OFF_XB);
  for (int tok = gw; tok < NTOK; tok += nw) {
    float* row = p.out + (size_t)tok * DM;
    f32x4 v[4]; float ss = 0.f;
#pragma unroll
    for (int j = 0; j < 4; ++j) {
      const u32x2 r = *(const u32x2*)(xb + (size_t)tok * DM + j * 256 + lane * 4);
      v[j] = f32x4{bf2f(r[0] & 0xffffu), bf2f(r[0] >> 16), bf2f(r[1] & 0xffffu), bf2f(r[1] >> 16)};
      ss += v[j][0] * v[j][0] + v[j][1] * v[j][1] + v[j][2] * v[j][2] + v[j][3] * v[j][3];
    }
    ss = wave_sum(ss);
    const float rs = rsqrtf(ss * (1.f / 1024.f) + 1e-6f);
#pragma unroll
    for (int j = 0; j < 4; ++j) { const f32x4 g = *(const f32x4*)(p.g_final + j * 256 + lane * 4); f32x4 o = {v[j][0] * rs * g[0], v[j][1] * rs * g[1], v[j][2] * rs * g[2], v[j][3] * rs * g[3]}; __builtin_nontemporal_store(o, (f32x4*)(row + j * 256 + lane * 4)); }
  }
}

DI unsigned xcc_id() { return (unsigned)__builtin_amdgcn_s_getreg((3 << 11) | 20) & 0xFu; }
DI void grid_barrier(unsigned* base, unsigned k, unsigned xcc, unsigned n_x, unsigned nxcd) {
  __syncthreads();
  if (threadIdx.x == 0) {
    unsigned* arr = base + 64 * (16 + xcc);
    unsigned* garr = base + 64 * 32;
    const unsigned a = __hip_atomic_fetch_add(arr, 1u, __ATOMIC_RELAXED, __HIP_MEMORY_SCOPE_AGENT);
    if (a + 1 == n_x * k) {
      __builtin_amdgcn_fence(__ATOMIC_RELEASE, "agent");
      asm volatile("s_waitcnt vmcnt(0)" ::: "memory");
      __hip_atomic_fetch_add(garr, 1u, __ATOMIC_RELAXED, __HIP_MEMORY_SCOPE_AGENT);
    }
    while (__hip_atomic_load(garr, __ATOMIC_RELAXED, __HIP_MEMORY_SCOPE_AGENT) < nxcd * k) __builtin_amdgcn_s_sleep(1);
    __builtin_amdgcn_fence(__ATOMIC_ACQUIRE, "agent");
    asm volatile("s_waitcnt vmcnt(0)" ::: "memory");
  }
  __syncthreads();
}

constexpr int NPHASE = 2 + 7 * NLAYER;
DI void run_phase(int ph) {
  if (ph == 0) { phase_prep(); return; }
  if (ph == NPHASE - 1) { phase_final(); return; }
  const int l = (ph - 1) / 7, st = (ph - 1) - l * 7;
  switch (st) {
    case 0: phase_g1(l); break;
    case 1: phase_g2(l); break;
    case 2: phase_attn(l); break;
    case 3: phase_mix(); break;
    case 4: phase_wout(l); break;
    case 5: phase_mlp1(l); break;
    default: phase_mlp2(l); break;
  }
}

__global__ void __launch_bounds__(512) mega(Params p, int ph_lo, int ph_hi) {
  cg::grid_group grid = cg::this_grid();
  unsigned* bar = (unsigned*)(p.ws + OFF_BAR);
  const unsigned xcc = xcc_id();
  unsigned n_x = 0, nxcd = 0;
  if (threadIdx.x == 0) __hip_atomic_fetch_add(bar + 64 * xcc, 1u, __ATOMIC_RELAXED, __HIP_MEMORY_SCOPE_AGENT);
  for (int ph = ph_lo; ph < ph_hi; ++ph) {
    run_phase(ph);
    if (ph + 1 < ph_hi) {
      if (ph == ph_lo) {
        grid.sync();
        if (threadIdx.x == 0) {
          n_x = __hip_atomic_load(bar + 64 * xcc, __ATOMIC_RELAXED, __HIP_MEMORY_SCOPE_AGENT);
          for (int x = 0; x < 16; ++x) nxcd += __hip_atomic_load(bar + 64 * x, __ATOMIC_RELAXED, __HIP_MEMORY_SCOPE_AGENT) != 0u;
        }
      } else grid_barrier(bar, (unsigned)(ph - ph_lo), xcc, n_x, nxcd);
    }
  }
}

extern "C" void kernel_launch(void* const* d_in, const int* in_sizes, int n_in, void* d_out, int out_size, void* d_ws, size_t ws_size, hipStream_t stream) {
  static int grid_blocks = 0;
  if (!grid_blocks) {
    int dev = 0, cus = 0, per_cu = 0;
    (void)hipGetDevice(&dev);
    (void)hipDeviceGetAttribute(&cus, hipDeviceAttributeMultiprocessorCount, dev);
    (void)hipOccupancyMaxActiveBlocksPerMultiprocessor(&per_cu, mega, NTHR, 0);
    if (per_cu > 1) per_cu = 1;
    grid_blocks = cus * per_cu;
    if (ws_size < OFF_END) fprintf(stderr, "kernel_launch: workspace too small: %zu < %zu\n", ws_size, (size_t)OFF_END);
  }
  Params p;
  memset(&p, 0, sizeof(p));
  p.x = (const float*)d_in[0]; p.g_mix = (const float*)d_in[1]; p.w_in = (const float*)d_in[2]; p.q_norm = (const float*)d_in[3];
  p.w_uq = (const float*)d_in[4]; p.kv_norm = (const float*)d_in[5]; p.w_ukv = (const float*)d_in[6]; p.rpb = (const float*)d_in[7];
  p.on_a = (const float*)d_in[8]; p.on_b = (const float*)d_in[9]; p.on_c = (const float*)d_in[10]; p.w_out = (const float*)d_in[11];
  p.g_mlp = (const float*)d_in[12]; p.w_mlp_in = (const float*)d_in[13]; p.w_mlp_out = (const float*)d_in[14]; p.g_final = (const float*)d_in[15];
  p.out = (float*)d_out; p.ws = (char*)d_ws;
  p.qscaleA = (float)(1.4426950408889634 / std::sqrt(96.0));
  p.qscaleB = (float)(1.4426950408889634 * 0.125);
#if ONE_LAUNCH
  (void)hipMemsetAsync((char*)d_ws + OFF_BAR, 0, 16384, stream);
  int lo = 0, hi = NPHASE;
  void* args[] = {&p, &lo, &hi};
  hipError_t e = hipLaunchCooperativeKernel((void*)mega, dim3(grid_blocks), dim3(NTHR), args, 0, stream);
  if (e != hipSuccess) fprintf(stderr, "cooperative launch failed: %s (grid %d)\n", hipGetErrorString(e), grid_blocks);
#else
  for (int ph = 0; ph < NPHASE; ++ph) hipLaunchKernelGGL(mega, dim3(grid_blocks), dim3(NTHR), 0, stream, p, ph, ph + 1);
#endif
}
```

```cpp
#include <hip/hip_runtime.h>
#include <hip/hip_cooperative_groups.h>
#include <cstdio>
#include <cmath>
#include <cstring>
namespace cg = cooperative_groups;

#ifndef ONE_LAUNCH
#define ONE_LAUNCH 1
#endif

#define DI __device__ __forceinline__
typedef unsigned short bf16_t;
typedef short bf16x8 __attribute__((ext_vector_type(8)));
typedef short s16x4 __attribute__((ext_vector_type(4)));
typedef float f32x16 __attribute__((ext_vector_type(16)));
typedef float f32x2 __attribute__((ext_vector_type(2)));
typedef float f32x4 __attribute__((ext_vector_type(4)));
typedef __bf16 bf2_t __attribute__((ext_vector_type(2)));
typedef unsigned u32x4 __attribute__((ext_vector_type(4)));
typedef unsigned u32x2 __attribute__((ext_vector_type(2)));
typedef __attribute__((address_space(3))) s16x4 lds_s16x4;

constexpr int SEQ = 8192, NB = 4, NTOK = NB * SEQ, DM = 1024, NLAYER = 4;
constexpr int N_IN_PAD = 2560, N_UQ_PAD = 768, N_UKV = 768, DFF = 4096;
constexpr int NTHR = 512;

constexpr size_t SZ_XB = (size_t)NTOK * DM * 2;
constexpr size_t SZ_WIN = (size_t)N_IN_PAD * 1024 * 2, SZ_WUQ = (size_t)N_UQ_PAD * 256 * 2, SZ_WUKV = (size_t)N_UKV * 128 * 2,
                 SZ_WOUT = (size_t)1024 * 1024 * 2, SZ_W1 = (size_t)DFF * 1024 * 2, SZ_W2 = (size_t)1024 * DFF * 2;
constexpr size_t LW_WIN = 0, LW_WUQ = LW_WIN + SZ_WIN, LW_WUKV = LW_WUQ + SZ_WUQ, LW_WOUT = LW_WUKV + SZ_WUKV, LW_W1 = LW_WOUT + SZ_WOUT,
                 LW_W2 = LW_W1 + SZ_W1, LW_SIZE = LW_W2 + SZ_W2;
constexpr size_t OFF_XB = 0, OFF_W = OFF_XB + SZ_XB, OFF_TAB = OFF_W + NLAYER * LW_SIZE;
constexpr size_t OFF_COS32 = OFF_TAB, OFF_SIN32 = OFF_COS32 + (size_t)SEQ * 32 * 4, OFF_COS16 = OFF_SIN32 + (size_t)SEQ * 32 * 4,
                 OFF_SIN16 = OFF_COS16 + (size_t)SEQ * 16 * 4, OFF_ATT = OFF_SIN16 + (size_t)SEQ * 16 * 4;
constexpr size_t SZ_T384 = (size_t)NTOK * 384 * 2, SZ_QA = (size_t)NB * 6 * SEQ * 96 * 2, SZ_H6 = (size_t)NB * 6 * SEQ * 64 * 2,
                 SZ_H4 = (size_t)NB * 4 * SEQ * 64 * 2;
constexpr size_t OFF_CQKV = OFF_ATT;
constexpr size_t OFF_OA = OFF_CQKV;
constexpr size_t OFF_QA = OFF_CQKV + SZ_T384, OFF_KA = OFF_QA + SZ_QA, OFF_VA = OFF_KA + SZ_QA;
constexpr size_t OFF_QB = OFF_VA + SZ_H6, OFF_KB = OFF_QB + SZ_H6, OFF_VB = OFF_KB + SZ_H6;
constexpr size_t OFF_QC = OFF_VB + SZ_H6, OFF_KC = OFF_QC + SZ_H4, OFF_VC = OFF_KC + SZ_H4;
constexpr size_t OFF_OB = OFF_VC + SZ_H4, OFF_LSEB = OFF_OB + 3 * SZ_T384, OFF_OC = OFF_LSEB + (size_t)3 * NTOK * 6 * 4;
constexpr size_t OFF_SSQ = OFF_OC + (size_t)NTOK * 256 * 2;
constexpr size_t OFF_PX1 = OFF_SSQ, OFF_PX2 = OFF_PX1 + (size_t)NTOK * 16 * 4, OFF_PQ = OFF_PX2 + (size_t)NTOK * 16 * 4, OFF_PKV = OFF_PQ + (size_t)NTOK * 4 * 4;
constexpr size_t OFF_BAR = OFF_PKV + (size_t)NTOK * 2 * 4;
constexpr size_t OFF_END = OFF_BAR + 16384;
constexpr size_t OFF_MIXED = OFF_QA;
constexpr size_t OFF_HID = OFF_ATT;
static_assert(OFF_HID + (size_t)NTOK * DFF * 2 <= OFF_SSQ, "hid fits");
static_assert(OFF_MIXED + (size_t)NTOK * DM * 2 <= OFF_VA, "mixed fits");

struct Params {
  const float *x, *g_mix, *w_in, *q_norm, *w_uq, *kv_norm, *w_ukv, *rpb, *on_a, *on_b, *on_c, *w_out, *g_mlp, *w_mlp_in, *w_mlp_out, *g_final;
  float* out; char* ws;
  float qscaleA, qscaleB;
};
__shared__ __attribute__((aligned(1024))) char g_smem[131072];
#define NI __device__ __forceinline__
DI const Params& kparams() { return *(const Params*)__builtin_amdgcn_kernarg_segment_ptr(); }

DI unsigned cvtpk(float lo, float hi) { f32x2 v = {lo, hi}; bf2_t b = __builtin_convertvector(v, bf2_t); return __builtin_bit_cast(unsigned, b); }
DI bf16_t f2bf(float x) { return (bf16_t)(cvtpk(x, 0.f) & 0xffffu); }
DI float bf2f(unsigned h) { return __uint_as_float(h << 16); }
DI int crow(int i, int h) { return (i & 3) + 8 * (i >> 2) + 4 * h; }
#define MFMA32(a, b, c) __builtin_amdgcn_mfma_f32_32x32x16_bf16((a), (b), (c), 0, 0, 0)
DI float fdot2bf(unsigned a, float c) { bf2_t v = __builtin_bit_cast(bf2_t, a); return __builtin_amdgcn_fdot2_f32_bf16(v, v, c, false); }
DI float swap_max(float v) { auto rr = __builtin_amdgcn_permlane32_swap(__float_as_uint(v), __float_as_uint(v), false, false); return fmaxf(__uint_as_float(rr[0]), __uint_as_float(rr[1])); }
DI float swap_sum(float v) { auto rr = __builtin_amdgcn_permlane32_swap(__float_as_uint(v), __float_as_uint(v), false, false); return __uint_as_float(rr[0]) + __uint_as_float(rr[1]); }

constexpr int ATT_LDS = 53248;
#define FOR_TILES(NN, MT, NT, BODY) { const bool xm_ = gridDim.x == 256; const int st_ = xm_ ? (bid >> 3) : bid, sp_ = xm_ ? 32 : (int)gridDim.x, cn_ = xm_ ? 16 * (NN) : (NTOK / 256) * (NN); \
  for (int j_ = st_; j_ < cn_; j_ += sp_) { int MT = j_ / (NN); const int NT = j_ - MT * (NN); if (xm_) MT += (bid & 7) * 16; BODY } }
DI int otid() { int t = threadIdx.x; asm volatile("" : "+v"(t)); return t; }
DI int obid() { int t = blockIdx.x; asm volatile("" : "+s"(t)); return t; }

template <int NSLOT, class Epi>
DI void gemm_tile(const bf16_t* __restrict__ A, int lda, const bf16_t* __restrict__ Bt, int ldb, int K, int m0, int n0, const Epi& epi, const int tid, const float* pin) {
  const int lane = tid & 63, w = tid >> 6, wm = w >> 2, wn = w & 3, r32 = lane & 31, hi = lane >> 5;
  char* smem = g_smem;
  const int lrow = lane >> 3;
  const int c0 = (lane & 7) ^ (lane >> 4), c1 = (lane & 7) ^ ((lane >> 4) | 4);
  const char* Ab = (const char*)(A + (size_t)m0 * lda);
  const char* Bb = (const char*)(Bt + (size_t)n0 * ldb);
  const unsigned oa0 = (unsigned)(((w * 32 + lrow) * lda + c0 * 8) * 2), oa1 = (unsigned)(((w * 32 + lrow) * lda + c1 * 8) * 2);
  const unsigned ob0 = (unsigned)(((w * 32 + lrow) * ldb + c0 * 8) * 2), ob1 = (unsigned)(((w * 32 + lrow) * ldb + c1 * 8) * 2);
  const int dma_off = (w * 32) * 128 + lane * 16;
  f32x16 acc[4][2];
#pragma unroll
  for (int mi = 0; mi < 4; ++mi)
#pragma unroll
    for (int nj = 0; nj < 2; ++nj)
#pragma unroll
      for (int i = 0; i < 16; ++i) acc[mi][nj][i] = 0.f;
  const int nk = K >> 6;
  const int sw = (r32 >> 1) & 7, sh = sw >> 1, lo16 = 16 * (hi ^ (sw & 1));
  const int a_off = (wm * 128 + r32) * 128 + lo16;
  const int b_off = 32768 + (wn * 64 + r32) * 128 + lo16;
  __syncthreads();
  {
    char* sa = smem + dma_off;
#pragma unroll
    for (int j = 0; j < 4; ++j) {
      __builtin_amdgcn_global_load_lds((const unsigned*)(Ab + (size_t)(j * 8 * lda) * 2 + ((j & 1) ? oa1 : oa0)), (unsigned*)(sa + j * 1024), 16, 0, 0);
      __builtin_amdgcn_global_load_lds((const unsigned*)(Bb + (size_t)(j * 8 * ldb) * 2 + ((j & 1) ? ob1 : ob0)), (unsigned*)(sa + 32768 + j * 1024), 16, 0, 0);
    }
  }
  for (int kt = 0; kt < nk; ++kt) {
    __syncthreads();
    if (kt + 1 < nk) {
      char* sa = smem + ((kt + 1) & 1) * 65536 + dma_off;
      const int k0 = (kt + 1) * 64;
#pragma unroll
      for (int j = 0; j < 4; ++j) {
        __builtin_amdgcn_global_load_lds((const unsigned*)(Ab + (size_t)(j * 8 * lda + k0) * 2 + ((j & 1) ? oa1 : oa0)), (unsigned*)(sa + j * 1024), 16, 0, 0);
        __builtin_amdgcn_global_load_lds((const unsigned*)(Bb + (size_t)(j * 8 * ldb + k0) * 2 + ((j & 1) ? ob1 : ob0)), (unsigned*)(sa + 32768 + j * 1024), 16, 0, 0);
      }
    }
    const char* sb = smem + (kt & 1) * 65536;
#pragma unroll
    for (int ks = 0; ks < 4; ++ks) {
      const int koff = 32 * (ks ^ sh);
      bf16x8 af[4], bfr[2];
#pragma unroll
      for (int mi = 0; mi < 4; ++mi) af[mi] = *(const bf16x8*)(sb + a_off + mi * 4096 + koff);
#pragma unroll
      for (int nj = 0; nj < 2; ++nj) bfr[nj] = *(const bf16x8*)(sb + b_off + nj * 4096 + koff);
#pragma unroll
      for (int mi = 0; mi < 4; ++mi)
#pragma unroll
        for (int nj = 0; nj < 2; ++nj) acc[mi][nj] = MFMA32(af[mi], bfr[nj], acc[mi][nj]);
    }
  }
  float* rstd_s = (float*)smem;
  if (NSLOT > 0) {
    __syncthreads();
    if (tid < 256) {
      const float* pr = pin + (size_t)(m0 + tid) * NSLOT;
      float sacc = 0.f;
      if (NSLOT >= 4) {
#pragma unroll
        for (int q = 0; q < NSLOT / 4; ++q) { const f32x4 v = *(const f32x4*)(pr + 4 * q); sacc += (v[0] + v[1]) + (v[2] + v[3]); }
      } else {
#pragma unroll
        for (int q = 0; q < NSLOT; ++q) sacc += pr[q];
      }
      rstd_s[tid] = rsqrtf(sacc / (float)K + 1e-6f);
    }
    __syncthreads();
  }
  int lane2 = lane, w2 = w; asm volatile("" : "+v"(lane2), "+v"(w2));
  epi(acc, m0, (w2 >> 2) * 128, n0 + (w2 & 3) * 64, lane2, rstd_s);
}
DI void row_ssq_put(float v, float* dst, int lane) {
  v += __shfl_xor(v, 1); v += __shfl_xor(v, 2); v += __shfl_xor(v, 4); v += __shfl_xor(v, 8); v += __shfl_xor(v, 16);
  if ((lane & 31) == 0) *dst = v;
}

struct EpiG1 {
  bf16_t *cqkv, *KA, *qB, *qC; const float *cos32, *sin32, *cos16, *sin16; float qs; float *pq, *pkv;
  DI void operator()(f32x16 (&acc)[4][2], int m0, int lr0, int col0, int lane, const float* rstd_s) const {
    const int c = lane & 31, h = lane >> 5, cb = col0 >> 6;
    if (cb >= 37) return;
#define G1_ROW const int lr = lr0 + mi * 32 + crow(i, h), tok = m0 + lr, b = tok >> 13, s = tok & 8191; (void)b; (void)s; \
               const float rs = rstd_s[lr]; float v0 = acc[mi][0][i] * rs, v1 = acc[mi][1][i] * rs;
    if (cb < 6) {
#pragma unroll
      for (int mi = 0; mi < 4; ++mi)
#pragma unroll
        for (int i = 0; i < 16; ++i) {
        if ((i & 3) == 0) __builtin_amdgcn_sched_barrier(0);
          G1_ROW
          bf16_t* d = cqkv + (size_t)tok * 384 + cb * 64 + c; d[0] = f2bf(v0); d[32] = f2bf(v1);
          row_ssq_put(v0 * v0 + v1 * v1, cb < 4 ? pq + (size_t)tok * 4 + cb : pkv + (size_t)tok * 2 + (cb - 4), lane);
        }
    } else if (cb == 6) {
#pragma unroll
      for (int mi = 0; mi < 4; ++mi)
#pragma unroll
        for (int i = 0; i < 16; ++i) {
        if ((i & 3) == 0) __builtin_amdgcn_sched_barrier(0);
          G1_ROW
          if (c < 16) {
            const float cs = cos16[s * 16 + c], sn = sin16[s * 16 + c];
            const bf16_t o1 = f2bf(v0 * cs - v1 * sn), o2 = f2bf(v0 * sn + v1 * cs);
#pragma unroll
            for (int hd = 0; hd < 6; ++hd) { bf16_t* d = KA + ((size_t)(b * 6 + hd) * SEQ + s) * 96 + 64 + c; d[0] = o1; d[16] = o2; }
          }
        }
    } else if (cb < 25) {
      const int idx = cb - 7, which = idx / 6, hd = idx - which * 6;
      bf16_t* base = qB + (size_t)which * (SZ_H6 / 2) + (size_t)hd * SEQ * 64 + 2 * c;
      const float sc = which == 0 ? qs : 1.f;
      if (which < 2) {
#pragma unroll
        for (int mi = 0; mi < 4; ++mi)
#pragma unroll
          for (int i = 0; i < 16; ++i) {
        if ((i & 3) == 0) __builtin_amdgcn_sched_barrier(0);
            G1_ROW
            const float cs = cos32[s * 32 + c] * sc, sn = sin32[s * 32 + c] * sc;
            bf16_t* d = base + ((size_t)(b * 6) * SEQ + s) * 64;
            *(unsigned*)d = cvtpk(v0 * cs - v1 * sn, v0 * sn + v1 * cs);
          }
      } else {
#pragma unroll
        for (int mi = 0; mi < 4; ++mi)
#pragma unroll
          for (int i = 0; i < 16; ++i) {
        if ((i & 3) == 0) __builtin_amdgcn_sched_barrier(0);
            G1_ROW
            bf16_t* d = base + ((size_t)(b * 6) * SEQ + s) * 64;
            *(unsigned*)d = cvtpk(v0, v1);
          }
      }
    } else {
      const int idx = cb - 25, which = idx >> 2, hd = idx & 3;
      bf16_t* base = qC + (size_t)which * (SZ_H4 / 2) + (size_t)hd * SEQ * 64 + 2 * c;
      const float sc = which == 0 ? qs : 1.f;
#pragma unroll
      for (int mi = 0; mi < 4; ++mi)
#pragma unroll
        for (int i = 0; i < 16; ++i) {
        if ((i & 3) == 0) __builtin_amdgcn_sched_barrier(0);
          G1_ROW
          bf16_t* d = base + ((size_t)(b * 4) * SEQ + s) * 64;
          *(unsigned*)d = cvtpk(v0 * sc, v1 * sc);
        }
    }
#undef G1_ROW
  }
};
struct EpiUQ {
  bf16_t* QA; const float *cos16, *sin16; float qs;
  DI void operator()(f32x16 (&acc)[4][2], int m0, int lr0, int col0, int lane, const float* rstd_s) const {
    const int c = lane & 31, h = lane >> 5, cb = col0 >> 6;
    if (cb >= 9) return;
#pragma unroll
    for (int mi = 0; mi < 4; ++mi)
#pragma unroll
      for (int i = 0; i < 16; ++i) {
        if ((i & 3) == 0) __builtin_amdgcn_sched_barrier(0);
        const int lr = lr0 + mi * 32 + crow(i, h), tok = m0 + lr, b = tok >> 13, s = tok & 8191;
        const float rs = rstd_s[lr] * qs;
        const float v0 = acc[mi][0][i] * rs, v1 = acc[mi][1][i] * rs;
        if (cb < 6) {
          bf16_t* d = QA + ((size_t)(b * 6 + cb) * SEQ + s) * 96 + c; d[0] = f2bf(v0); d[32] = f2bf(v1);
        } else {
          const int hd = 2 * (cb - 6) + (c >> 4), fi = c & 15;
          const float cs = cos16[s * 16 + fi], sn = sin16[s * 16 + fi];
          bf16_t* d = QA + ((size_t)(b * 6 + hd) * SEQ + s) * 96 + 64 + fi;
          d[0] = f2bf(v0 * cs - v1 * sn); d[16] = f2bf(v0 * sn + v1 * cs);
        }
      }
  }
};
struct EpiUKV {
  bf16_t *KA, *VA;
  DI void operator()(f32x16 (&acc)[4][2], int m0, int lr0, int col0, int lane, const float* rstd_s) const {
    const int c = lane & 31, h = lane >> 5, cb = col0 >> 6, hd = cb >> 1, isv = cb & 1;
#pragma unroll
    for (int mi = 0; mi < 4; ++mi)
#pragma unroll
      for (int i = 0; i < 16; ++i) {
        if ((i & 3) == 0) __builtin_amdgcn_sched_barrier(0);
        const int lr = lr0 + mi * 32 + crow(i, h), tok = m0 + lr, b = tok >> 13, s = tok & 8191;
        const float rs = rstd_s[lr];
        const float v0 = acc[mi][0][i] * rs, v1 = acc[mi][1][i] * rs;
        bf16_t* d = isv ? VA + ((size_t)(b * 6 + hd) * SEQ + s) * 64 + c : KA + ((size_t)(b * 6 + hd) * SEQ + s) * 96 + c;
        d[0] = f2bf(v0); d[32] = f2bf(v1);
      }
  }
};
struct EpiRes {
  bf16_t* xb; float* pout;
  DI void operator()(f32x16 (&acc)[4][2], int m0, int lr0, int col0, int lane, const float* rstd_s) const {
    const int c = lane & 31, h = lane >> 5;
#pragma unroll
    for (int mi = 0; mi < 4; ++mi)
#pragma unroll
      for (int i = 0; i < 16; ++i) {
        if ((i & 3) == 0) __builtin_amdgcn_sched_barrier(0);
        const int row = m0 + lr0 + mi * 32 + crow(i, h);
        const size_t o = (size_t)row * DM + col0 + c;
        const float v0 = bf2f(xb[o]) + acc[mi][0][i], v1 = bf2f(xb[o + 32]) + acc[mi][1][i];
        xb[o] = f2bf(v0); xb[o + 32] = f2bf(v1);
        row_ssq_put(v0 * v0 + v1 * v1, pout + (size_t)row * 16 + (col0 >> 6), lane);
      }
  }
};
struct EpiMlp1 {
  bf16_t* hid;
  DI void operator()(f32x16 (&acc)[4][2], int m0, int lr0, int col0, int lane, const float* rstd_s) const {
    const int c = lane & 31, h = lane >> 5;
#pragma unroll
    for (int mi = 0; mi < 4; ++mi)
#pragma unroll
      for (int i = 0; i < 16; ++i) {
        if ((i & 3) == 0) __builtin_amdgcn_sched_barrier(0);
        const int lr = lr0 + mi * 32 + crow(i, h);
        const float rs = rstd_s[lr];
        const float v0 = fmaxf(acc[mi][0][i] * rs, 0.f), v1 = fmaxf(acc[mi][1][i] * rs, 0.f);
        __builtin_nontemporal_store(cvtpk(v0 * v0, v1 * v1), (unsigned*)(hid + (size_t)(m0 + lr) * DFF + col0 + 2 * c));
      }
  }
};

struct AttnItem {
  const bf16_t *Q, *K, *V;
  int q0;
  int n0, dil, res, N;
  int nrb, ncb, kr0, kc0;
  bf16_t* out; int ldo;
  float* lse;
  const float* rpb;
};

template <int DQ, int MODE>
DI void attn_block(const AttnItem& it, char* smem, const int tid) {
  constexpr int CPR = DQ / 8, KST = DQ * 2 + 16, KCH = (64 * CPR) / 256, NT = MODE == 0 ? SEQ / 64 : MODE == 1 ? 4 : 8;
  const int lane = tid & 63, w = tid >> 6, r32 = lane & 31, hi = lane >> 5;
  char* Ks = smem; char* Vs = smem + 64 * KST; float* bias_s = (float*)(smem + 64 * KST + 8192);
  const int qi = w * 32 + r32;
  int qpos;
  if (MODE == 0) qpos = it.q0 + qi;
  else if (MODE == 1) qpos = (it.n0 + qi) * it.dil + it.res;
  else qpos = (8 * it.nrb + (qi >> 4)) * 64 + 16 * it.ncb + (qi & 15);
  __syncthreads();
  if (MODE == 2) { for (int i = tid; i < 465; i += 256) bias_s[i] = it.rpb[i] * 1.4426950408889634f; }
  bf16x8 qr[DQ / 16];
#pragma unroll
  for (int d0 = 0; d0 < DQ / 16; ++d0) qr[d0] = *(const bf16x8*)(it.Q + (size_t)qpos * DQ + d0 * 16 + hi * 8);
  f32x16 o[2];
#pragma unroll
  for (int i = 0; i < 16; ++i) { o[0][i] = 0.f; o[1][i] = 0.f; }
  float m_run = -1e30f, l_run = 0.f;
  u32x4 rk[KCH], rv[2];
  auto kpos = [&](int t, int row) -> int {
    if (MODE == 0) return t * 64 + row;
    if (MODE == 1) { int n = it.n0 - 64 + 64 * t + row; n = n < 0 ? 0 : (n > it.N - 1 ? it.N - 1 : n); return n * it.dil + it.res; }
    return (it.kr0 + 2 * t + (row >> 5)) * 64 + it.kc0 + (row & 31);
  };
  auto load = [&](int t) {
#pragma unroll
    for (int i = 0; i < KCH; ++i) { const int c = tid + 256 * i, row = c / CPR, kc = c - row * CPR; rk[i] = *(const u32x4*)(it.K + (size_t)kpos(t, row) * DQ + kc * 8); }
#pragma unroll
    for (int i = 0; i < 2; ++i) { const int c = tid + 256 * i, row = c >> 3, kc = c & 7; rv[i] = *(const u32x4*)(it.V + (size_t)kpos(t, row) * 64 + kc * 8); }
  };
  const int vrd = ((lane >> 5) * 4 + ((lane & 15) >> 2)) * 64 + ((lane >> 4) & 1) * 32 + (lane & 3) * 8;
  load(0);
  for (int t = 0; t < NT; ++t) {
    __syncthreads();
#pragma unroll
    for (int i = 0; i < KCH; ++i) { const int c = tid + 256 * i, row = c / CPR, kc = c - row * CPR; *(u32x4*)(Ks + row * KST + kc * 16) = rk[i]; }
#pragma unroll
    for (int i = 0; i < 2; ++i) { const int c = tid + 256 * i, row = c >> 3, kc = c & 7; *(u32x4*)(Vs + (kc >> 2) * 4096 + row * 64 + (kc & 3) * 16) = rv[i]; }
    __syncthreads();
    if (t + 1 < NT) load(t + 1);
    bool skip = false;
    if (MODE == 1) skip = (w < 2) ? (t == 3) : (t == 0);
    if (MODE == 2) {
      const int rq_lo = 8 * it.nrb + 2 * w, rq_hi = rq_lo + 1;
      const int rs_lo = min(max(rq_lo - 4, 0), 120), rs_hi = min(max(rq_hi - 4, 0), 120) + 7;
      const int kr = it.kr0 + 2 * t;
      skip = (kr + 1 < rs_lo) || (kr > rs_hi);
    }
    if (skip) continue;
    f32x16 p0, p1;
#pragma unroll
    for (int i = 0; i < 16; ++i) { p0[i] = 0.f; p1[i] = 0.f; }
#pragma unroll
    for (int d0 = 0; d0 < DQ / 16; ++d0) {
      const bf16x8 k0 = *(const bf16x8*)(Ks + r32 * KST + d0 * 32 + hi * 16);
      const bf16x8 k1 = *(const bf16x8*)(Ks + (32 + r32) * KST + d0 * 32 + hi * 16);
      p0 = MFMA32(k0, qr[d0], p0); p1 = MFMA32(k1, qr[d0], p1);
    }
    if (MODE == 1) {
      const int nq = it.n0 + qi, kb = it.n0 - 64 + 64 * t;
#pragma unroll
      for (int i = 0; i < 16; ++i) {
        const int nk = kb + crow(i, hi), nk2 = nk + 32;
        const int d1 = nq - nk, d2 = nq - nk2;
        const bool ok1 = (d1 <= 64) && (d1 >= -64) && (nk >= 0) && (nk < it.N);
        const bool ok2 = (d2 <= 64) && (d2 >= -64) && (nk2 >= 0) && (nk2 < it.N);
        p0[i] = ok1 ? p0[i] : -INFINITY; p1[i] = ok2 ? p1[i] : -INFINITY;
      }
    }
    if (MODE == 2) {
      const int rq = 8 * it.nrb + (qi >> 4), cq = 16 * it.ncb + (qi & 15);
      const int rs_ = min(max(rq - 4, 0), 120), cs_ = min(max(cq - 8, 0), 48);
      const int kr = it.kr0 + 2 * t;
      const bool okr0 = (kr >= rs_) && (kr < rs_ + 8), okr1 = (kr + 1 >= rs_) && (kr + 1 < rs_ + 8);
      const int bi0 = (kr - rq + 7) * 31 - cq + 15;
#pragma unroll
      for (int i = 0; i < 16; ++i) {
        const int kc = it.kc0 + crow(i, hi);
        const bool okc = (kc >= cs_) && (kc < cs_ + 16);
        const bool ok0 = okc && okr0, ok1 = okc && okr1;
        const float b0 = bias_s[ok0 ? bi0 + kc : 0], b1 = bias_s[ok1 ? bi0 + 31 + kc : 0];
        p0[i] = ok0 ? p0[i] + b0 : -INFINITY; p1[i] = ok1 ? p1[i] + b1 : -INFINITY;
      }
    }
    float pmax = p0[0];
#pragma unroll
    for (int i = 1; i < 16; ++i) pmax = fmaxf(pmax, p0[i]);
#pragma unroll
    for (int i = 0; i < 16; ++i) pmax = fmaxf(pmax, p1[i]);
    pmax = swap_max(pmax);
    const float mn = fmaxf(m_run, pmax);
    const float alpha = __builtin_amdgcn_exp2f(m_run - mn);
    m_run = mn;
    float ps = 0.f;
#pragma unroll
    for (int i = 0; i < 16; ++i) { p0[i] = __builtin_amdgcn_exp2f(p0[i] - mn); ps += p0[i]; }
#pragma unroll
    for (int i = 0; i < 16; ++i) { p1[i] = __builtin_amdgcn_exp2f(p1[i] - mn); ps += p1[i]; }
    ps = swap_sum(ps);
    l_run = l_run * alpha + ps;
#pragma unroll
    for (int i = 0; i < 16; ++i) { o[0][i] *= alpha; o[1][i] *= alpha; }
    bf16x8 pb[4];
#pragma unroll
    for (int s = 0; s < 2; ++s) {
      u32x4 a = {cvtpk(p0[8 * s], p0[8 * s + 1]), cvtpk(p0[8 * s + 2], p0[8 * s + 3]), cvtpk(p0[8 * s + 4], p0[8 * s + 5]), cvtpk(p0[8 * s + 6], p0[8 * s + 7])};
      u32x4 b = {cvtpk(p1[8 * s], p1[8 * s + 1]), cvtpk(p1[8 * s + 2], p1[8 * s + 3]), cvtpk(p1[8 * s + 4], p1[8 * s + 5]), cvtpk(p1[8 * s + 6], p1[8 * s + 7])};
      pb[s] = __builtin_bit_cast(bf16x8, a); pb[2 + s] = __builtin_bit_cast(bf16x8, b);
    }
#pragma unroll
    for (int db = 0; db < 2; ++db)
#pragma unroll
      for (int s = 0; s < 4; ++s) {
        const s16x4 lo = __builtin_amdgcn_ds_read_tr16_b64_v4i16((lds_s16x4*)(Vs + db * 4096 + (16 * s) * 64 + vrd));
        const s16x4 hh = __builtin_amdgcn_ds_read_tr16_b64_v4i16((lds_s16x4*)(Vs + db * 4096 + (16 * s + 8) * 64 + vrd));
        const bf16x8 a = {lo[0], lo[1], lo[2], lo[3], hh[0], hh[1], hh[2], hh[3]};
        o[db] = MFMA32(a, pb[s], o[db]);
      }
  }
  const float inv = 1.f / l_run;
  const int bq = qpos;
  bf16_t* orow = it.out + (size_t)bq * it.ldo;
#pragma unroll
  for (int db = 0; db < 2; ++db)
#pragma unroll
    for (int g = 0; g < 4; ++g) {
      u32x2 v = {cvtpk(o[db][4 * g] * inv, o[db][4 * g + 1] * inv), cvtpk(o[db][4 * g + 2] * inv, o[db][4 * g + 3] * inv)};
      *(u32x2*)(orow + db * 32 + 8 * g + 4 * hi) = v;
    }
  if (MODE == 1) { if (hi == 0) it.lse[(size_t)bq * 6] = m_run + __builtin_amdgcn_logf(l_run); }
}

DI void attn_dense_skew(const bf16_t* __restrict__ Q, const bf16_t* __restrict__ K, const bf16_t* __restrict__ V, int q0, bf16_t* __restrict__ out,
                        char* smem, const int tid512, const int grp) {
  constexpr int DQ = 96, CPR = 12, KST = 208, NT = SEQ / 64, KB = 64 * KST, VOFF = 2 * KB;
  const int lane = tid512 & 63, w = (tid512 >> 6) & 3, r32 = lane & 31, hi = lane >> 5;
  const int qpos = q0 + w * 32 + r32;
  bf16x8 qr[DQ / 16];
#pragma unroll
  for (int d0 = 0; d0 < DQ / 16; ++d0) qr[d0] = *(const bf16x8*)(Q + (size_t)qpos * DQ + d0 * 16 + hi * 8);
  f32x16 o[2];
#pragma unroll
  for (int i = 0; i < 16; ++i) { o[0][i] = 0.f; o[1][i] = 0.f; }
  float m_run = -1e30f, l_run = 0.f;
  const int kr0 = tid512 / CPR, kc0 = tid512 - kr0 * CPR, c1 = tid512 + 512, kr1 = c1 / CPR, kc1 = c1 - kr1 * CPR, vr = tid512 >> 3, vc = tid512 & 7;
  const bool two = tid512 < 256;
  const bf16_t* Kp0 = K + (size_t)kr0 * DQ + kc0 * 8; const bf16_t* Kp1 = K + (size_t)kr1 * DQ + kc1 * 8; const bf16_t* Vp = V + (size_t)vr * 64 + vc * 8;
  const int ks0 = kr0 * KST + kc0 * 16, ks1 = kr1 * KST + kc1 * 16, vs0 = VOFF + (vc >> 2) * 4096 + vr * 64 + (vc & 3) * 16;
  u32x4 rk0, rk1 = u32x4{0u, 0u, 0u, 0u}, rv;
  auto load = [&](int t) {
    const size_t ro = (size_t)t * 64;
    rk0 = *(const u32x4*)(Kp0 + ro * DQ); if (two) rk1 = *(const u32x4*)(Kp1 + ro * DQ); rv = *(const u32x4*)(Vp + ro * 64);
  };
  auto store = [&](int kb, int vb) {
    char* kbp = smem + kb * KB;
    *(u32x4*)(kbp + ks0) = rk0; if (two) *(u32x4*)(kbp + ks1) = rk1; *(u32x4*)(smem + vb * 8192 + vs0) = rv;
  };
  const int vrd = ((lane >> 5) * 4 + ((lane & 15) >> 2)) * 64 + ((lane >> 4) & 1) * 32 + (lane & 3) * 8;
  __syncthreads();
  load(0); store(0, 0); load(1);
  __syncthreads();
  if (grp == 1) __syncthreads();
  int vcur = 0;
  for (int t = 0; t < NT; ++t) {
    const int vnext = vcur == 2 ? 0 : vcur + 1;
    const char* Ks = smem + (t & 1) * KB; const char* Vs = smem + VOFF + vcur * 8192;
    if (t + 1 < NT) store((t + 1) & 1, vnext);
    if (t + 2 < NT) load(t + 2);
    f32x16 p0, p1;
#pragma unroll
    for (int i = 0; i < 16; ++i) { p0[i] = 0.f; p1[i] = 0.f; }
    {
      const char* kp = Ks + r32 * KST + hi * 16;
      bf16x8 ka[2][2];
      ka[0][0] = *(const bf16x8*)(kp); ka[0][1] = *(const bf16x8*)(kp + 32 * KST);
      ka[1][0] = *(const bf16x8*)(kp + 32); ka[1][1] = *(const bf16x8*)(kp + 32 * KST + 32);
#pragma unroll
      for (int d0 = 0; d0 < DQ / 16; ++d0) {
        p0 = MFMA32(ka[d0 & 1][0], qr[d0], p0); p1 = MFMA32(ka[d0 & 1][1], qr[d0], p1);
        if (d0 + 2 < DQ / 16) { ka[d0 & 1][0] = *(const bf16x8*)(kp + (d0 + 2) * 32); ka[d0 & 1][1] = *(const bf16x8*)(kp + 32 * KST + (d0 + 2) * 32); }
      }
    }
    float pmax = p0[0];
#pragma unroll
    for (int i = 1; i < 16; ++i) pmax = fmaxf(pmax, p0[i]);
#pragma unroll
    for (int i = 0; i < 16; ++i) pmax = fmaxf(pmax, p1[i]);
    pmax = swap_max(pmax);
    {
      const float mn = fmaxf(m_run, pmax);
      const float alpha = __builtin_amdgcn_exp2f(m_run - mn);
      m_run = mn; l_run *= alpha;
#pragma unroll
      for (int i = 0; i < 16; ++i) { o[0][i] *= alpha; o[1][i] *= alpha; }
    }
    asm volatile("" : "+v"(p0), "+v"(p1), "+v"(o[0]), "+v"(o[1]), "+v"(m_run));
    __syncthreads();
    asm volatile("" : "+v"(p0), "+v"(p1), "+v"(o[0]), "+v"(o[1]), "+v"(m_run));
    s16x4 vlo[4], vhi[4];
#pragma unroll
    for (int s2 = 0; s2 < 4; ++s2) {
      vlo[s2] = __builtin_amdgcn_ds_read_tr16_b64_v4i16((lds_s16x4*)(Vs + (16 * s2) * 64 + vrd));
      vhi[s2] = __builtin_amdgcn_ds_read_tr16_b64_v4i16((lds_s16x4*)(Vs + (16 * s2 + 8) * 64 + vrd));
    }
    float ps = 0.f;
#pragma unroll
    for (int i = 0; i < 16; ++i) { p0[i] = __builtin_amdgcn_exp2f(p0[i] - m_run); ps += p0[i]; }
#pragma unroll
    for (int i = 0; i < 16; ++i) { p1[i] = __builtin_amdgcn_exp2f(p1[i] - m_run); ps += p1[i]; }
    l_run += swap_sum(ps);
    bf16x8 pb[4];
#pragma unroll
    for (int s = 0; s < 2; ++s) {
      u32x4 a = {cvtpk(p0[8 * s], p0[8 * s + 1]), cvtpk(p0[8 * s + 2], p0[8 * s + 3]), cvtpk(p0[8 * s + 4], p0[8 * s + 5]), cvtpk(p0[8 * s + 6], p0[8 * s + 7])};
      u32x4 b = {cvtpk(p1[8 * s], p1[8 * s + 1]), cvtpk(p1[8 * s + 2], p1[8 * s + 3]), cvtpk(p1[8 * s + 4], p1[8 * s + 5]), cvtpk(p1[8 * s + 6], p1[8 * s + 7])};
      pb[s] = __builtin_bit_cast(bf16x8, a); pb[2 + s] = __builtin_bit_cast(bf16x8, b);
    }
    {
      s16x4 wlo[4], whi[4];
#pragma unroll
      for (int s2 = 0; s2 < 4; ++s2) {
        wlo[s2] = __builtin_amdgcn_ds_read_tr16_b64_v4i16((lds_s16x4*)(Vs + 4096 + (16 * s2) * 64 + vrd));
        whi[s2] = __builtin_amdgcn_ds_read_tr16_b64_v4i16((lds_s16x4*)(Vs + 4096 + (16 * s2 + 8) * 64 + vrd));
      }
#pragma unroll
      for (int s2 = 0; s2 < 4; ++s2) { const bf16x8 a = {vlo[s2][0], vlo[s2][1], vlo[s2][2], vlo[s2][3], vhi[s2][0], vhi[s2][1], vhi[s2][2], vhi[s2][3]}; o[0] = MFMA32(a, pb[s2], o[0]); }
#pragma unroll
      for (int s2 = 0; s2 < 4; ++s2) { const bf16x8 a = {wlo[s2][0], wlo[s2][1], wlo[s2][2], wlo[s2][3], whi[s2][0], whi[s2][1], whi[s2][2], whi[s2][3]}; o[1] = MFMA32(a, pb[s2], o[1]); }
    }
    asm volatile("" : "+v"(o[0]), "+v"(o[1]));
    __syncthreads();
    asm volatile("" : "+v"(o[0]), "+v"(o[1]));
    vcur = vnext;
  }
  if (grp == 0) __syncthreads();
  const float inv = 1.f / l_run;
  bf16_t* orow = out + (size_t)qpos * 384;
#pragma unroll
  for (int db = 0; db < 2; ++db)
#pragma unroll
    for (int g = 0; g < 4; ++g) {
      u32x2 v = {cvtpk(o[db][4 * g] * inv, o[db][4 * g + 1] * inv), cvtpk(o[db][4 * g + 2] * inv, o[db][4 * g + 3] * inv)};
      *(u32x2*)(orow + db * 32 + 8 * g + 4 * hi) = v;
    }
}

DI float wave_sum(float v) {
  v += __shfl_xor(v, 32); v += __shfl_xor(v, 16); v += __shfl_xor(v, 8); v += __shfl_xor(v, 4); v += __shfl_xor(v, 2); v += __shfl_xor(v, 1); return v;
}
DI float gain_of(const Params& p, int kind, int l, int k) {
  switch (kind) {
    case 0: return p.g_mix[l * 1024 + k];
    case 1: return p.q_norm[l * 256 + k];
    case 2: return p.kv_norm[l * 128 + k];
    case 3: return k < 384 ? p.on_a[l * 384 + k] : (k < 768 ? p.on_b[l * 384 + k - 384] : p.on_c[l * 256 + k - 768]);
    case 4: return p.g_mlp[l * 1024 + k];
    default: return 1.f;
  }
}
DI int map_col(int kind, int n) {
  if (kind == 0) {
    if (n < 384) return n;
    if (n < 448) { const int wv = n - 384, c = wv & 31, sub = wv >> 5; return c < 16 ? 384 + sub * 16 + c : -1; }
    if (n < 1600) return 416 + (n - 448);
    if (n < 2368) return 1568 + (n - 1600);
    return -1;
  }
  if (kind == 1) {
    if (n < 384) return (n >> 6) * 96 + (n & 63);
    if (n < 576) { const int wv = n - 384, g = wv >> 6, wi = wv & 63, sub = wi >> 5, c = wi & 31, hd = 2 * g + (c >> 4), fi = c & 15; return hd * 96 + 64 + sub * 16 + fi; }
    return -1;
  }
  return n;
}
DI void wtile(const Params& p, const float* src, int Nsrc, bf16_t* dst, int K, int kt, int nt, int kind, int l, char* smem, const int tid) {
  float* tile = (float*)smem;
  const int lane = tid & 63, wv = tid >> 6;
  __syncthreads();
  const int n = nt * 64 + lane, sc = map_col(kind, n);
#pragma unroll 4
  for (int r = 0; r < 8; ++r) {
    const int kl = r * 8 + wv, kd = kt * 64 + kl;
    const bool perm = kind == 5 || (kind == 3 && kd >= 384);
    const int k = perm ? ((kd & ~63) | ((kd & 1) << 5) | ((kd & 63) >> 1)) : kd;
    float v = 0.f;
    if (sc >= 0) v = src[(size_t)k * Nsrc + sc] * gain_of(p, kind, l, k);
    tile[kl * 65 + lane] = v;
  }
  __syncthreads();
#pragma unroll 4
  for (int r = 0; r < 8; ++r) {
    const int nl = r * 8 + wv;
    dst[(size_t)(nt * 64 + nl) * K + kt * 64 + lane] = f2bf(tile[lane * 65 + nl]);
  }
}

NI void phase_prep() {
  const Params& p = kparams(); char* smem = g_smem; const int tid = otid(), bid = obid();
  char* ws = p.ws;
  constexpr int T_WIN = (N_IN_PAD / 64) * 16, T_WUQ = (N_UQ_PAD / 64) * 4, T_WUKV = (N_UKV / 64) * 2, T_WOUT = 16 * 16, T_W1 = 64 * 16, T_W2 = 16 * 64;
  constexpr int T_L = T_WIN + T_WUQ + T_WUKV + T_WOUT + T_W1 + T_W2;
  for (int j = bid; j < NLAYER * T_L; j += gridDim.x) {
    const int l = j / T_L; int r = j - l * T_L;
    char* lw = ws + OFF_W + (size_t)l * LW_SIZE;
    if (r < T_WIN) { wtile(p, p.w_in + (size_t)l * 1024 * 2336, 2336, (bf16_t*)(lw + LW_WIN), 1024, r & 15, r >> 4, 0, l, smem, tid); continue; }
    r -= T_WIN;
    if (r < T_WUQ) { wtile(p, p.w_uq + (size_t)l * 256 * 576, 576, (bf16_t*)(lw + LW_WUQ), 256, r & 3, r >> 2, 1, l, smem, tid); continue; }
    r -= T_WUQ;
    if (r < T_WUKV) { wtile(p, p.w_ukv + (size_t)l * 128 * 768, 768, (bf16_t*)(lw + LW_WUKV), 128, r & 1, r >> 1, 2, l, smem, tid); continue; }
    r -= T_WUKV;
    if (r < T_WOUT) { wtile(p, p.w_out + (size_t)l * 1024 * 1024, 1024, (bf16_t*)(lw + LW_WOUT), 1024, r & 15, r >> 4, 3, l, smem, tid); continue; }
    r -= T_WOUT;
    if (r < T_W1) { wtile(p, p.w_mlp_in + (size_t)l * 1024 * 4096, 4096, (bf16_t*)(lw + LW_W1), 1024, r & 15, r >> 4, 4, l, smem, tid); continue; }
    r -= T_W1;
    wtile(p, p.w_mlp_out + (size_t)l * 4096 * 1024, 1024, (bf16_t*)(lw + LW_W2), 4096, r & 63, r >> 6, 5, l, smem, tid);
  }
  const size_t gtid = (size_t)bid * NTHR + tid, gsz = (size_t)gridDim.x * NTHR;
  bf16_t* xb = (bf16_t*)(ws + OFF_XB);
  {
    const int lane = tid & 63, gw = bid * (NTHR / 64) + (tid >> 6), nw = gridDim.x * (NTHR / 64);
    float* px1 = (float*)(ws + OFF_PX1);
    for (int row = gw; row < NTOK; row += nw) {
      float ss = 0.f;
#pragma unroll
      for (int j = 0; j < 4; ++j) {
        const f32x4 a = *(const f32x4*)(p.x + (size_t)row * DM + j * 256 + lane * 4);
        ss += a[0] * a[0] + a[1] * a[1] + a[2] * a[2] + a[3] * a[3];
        u32x2 o = {cvtpk(a[0], a[1]), cvtpk(a[2], a[3])};
        *(u32x2*)(xb + (size_t)row * DM + j * 256 + lane * 4) = o;
      }
      ss = wave_sum(ss);
      if (lane < 16) px1[(size_t)row * 16 + lane] = lane == 0 ? ss : 0.f;
    }
  }
  float* c32 = (float*)(ws + OFF_COS32); float* s32 = (float*)(ws + OFF_SIN32); float* c16 = (float*)(ws + OFF_COS16); float* s16 = (float*)(ws + OFF_SIN16);
  for (size_t i = gtid; i < (size_t)SEQ * 48; i += gsz) {
    int pos, fi; float invf; float *cd, *sd;
    if (i < (size_t)SEQ * 32) { pos = (int)(i >> 5); fi = (int)(i & 31); invf = __builtin_amdgcn_exp2f(-(float)fi * (13.287712379549449f / 32.f)); cd = c32 + i; sd = s32 + i; }
    else { const size_t j = i - (size_t)SEQ * 32; pos = (int)(j >> 4); fi = (int)(j & 15); invf = __builtin_amdgcn_exp2f(-(float)fi * (13.287712379549449f / 16.f)); cd = c16 + j; sd = s16 + j; }
    const float ang = (float)pos * invf;
    const double rev = (double)ang * 0.15915494309189535;
    const float fr = (float)(rev - rint(rev));
    *cd = __builtin_amdgcn_cosf(fr); *sd = __builtin_amdgcn_sinf(fr);
  }
}

NI void phase_g1(int l_) {
  const Params& p = kparams(); char* smem = g_smem; const int l = __builtin_amdgcn_readfirstlane(l_); const int tid = otid(), bid = obid(); (void)tid; (void)bid;
  char* ws = p.ws;
  EpiG1 e;
  e.cqkv = (bf16_t*)(ws + OFF_CQKV); e.KA = (bf16_t*)(ws + OFF_KA); e.qB = (bf16_t*)(ws + OFF_QB); e.qC = (bf16_t*)(ws + OFF_QC);
  e.cos32 = (const float*)(ws + OFF_COS32); e.sin32 = (const float*)(ws + OFF_SIN32); e.cos16 = (const float*)(ws + OFF_COS16); e.sin16 = (const float*)(ws + OFF_SIN16);
  e.qs = p.qscaleB; e.pq = (float*)(ws + OFF_PQ); e.pkv = (float*)(ws + OFF_PKV);
  const bf16_t* A = (const bf16_t*)(ws + OFF_XB);
  const bf16_t* Bt = (const bf16_t*)(ws + OFF_W + (size_t)l * LW_SIZE + LW_WIN);
  constexpr int NNT = N_IN_PAD / 256;
  FOR_TILES(NNT, mt, nt, gemm_tile<16>(A, 1024, Bt, 1024, 1024, mt * 256, nt * 256, e, tid, (const float*)(ws + OFF_PX1));)
}
NI void phase_g2(int l_) {
  const Params& p = kparams(); char* smem = g_smem; const int l = __builtin_amdgcn_readfirstlane(l_); const int tid = otid(), bid = obid(); (void)tid; (void)bid;
  char* ws = p.ws;
  const bf16_t* A = (const bf16_t*)(ws + OFF_CQKV);
  EpiUQ eq; eq.QA = (bf16_t*)(ws + OFF_QA); eq.cos16 = (const float*)(ws + OFF_COS16); eq.sin16 = (const float*)(ws + OFF_SIN16); eq.qs = p.qscaleA;
  EpiUKV ek; ek.KA = (bf16_t*)(ws + OFF_KA); ek.VA = (bf16_t*)(ws + OFF_VA);
  const bf16_t* Wq = (const bf16_t*)(ws + OFF_W + (size_t)l * LW_SIZE + LW_WUQ);
  const bf16_t* Wkv = (const bf16_t*)(ws + OFF_W + (size_t)l * LW_SIZE + LW_WUKV);
  FOR_TILES(6, mt, nt,
    if (nt < 3) gemm_tile<4>(A, 384, Wq, 256, 256, mt * 256, nt * 256, eq, tid, (const float*)(ws + OFF_PQ));
    else gemm_tile<2>(A + 256, 384, Wkv, 128, 128, mt * 256, (nt - 3) * 256, ek, tid, (const float*)(ws + OFF_PKV));)
}
NI void phase_attn(int l_) {
  const Params& p = kparams(); char* smem = g_smem; const int l = __builtin_amdgcn_readfirstlane(l_); const int tid = otid(), bid = obid(); (void)tid; (void)bid;
  char* ws = p.ws;
  constexpr int NA = 1536, NBI = 4608, NC = 1024;
  const int grp = tid >> 8, t256 = tid & 255; char* gsm = smem + grp * ATT_LDS;
  for (int i0 = bid * 2; i0 < NA; i0 += gridDim.x * 2) {
    const int i = i0 + grp, xcd = (i >> 1) & 7, j = ((i >> 4) << 1) | (i & 1);
    const int bh = (j >> 6) * 8 + xcd, qb = j & 63, b = bh / 6, h = bh - b * 6;
    attn_dense_skew((const bf16_t*)(ws + OFF_QA) + (size_t)bh * SEQ * 96, (const bf16_t*)(ws + OFF_KA) + (size_t)bh * SEQ * 96, (const bf16_t*)(ws + OFF_VA) + (size_t)bh * SEQ * 64,
                    qb * 128, (bf16_t*)(ws + OFF_OA) + (size_t)b * SEQ * 384 + h * 64, smem, tid, grp);
  }
  for (int i0 = bid * 2; i0 < NBI; i0 += gridDim.x * 2) {
    AttnItem it{};
    const int i = i0 + grp, xcd = (i >> 1) & 7, j = ((i >> 4) << 1) | (i & 1);
    const int g = (j >> 6) * 8 + xcd, c = j & 63, br = g / 24, bh = g - br * 24, b = bh / 6, h = bh - b * 6;
    const int dil = br == 0 ? 1 : (br == 1 ? 4 : 16), cpr = 64 / dil;
    it.Q = (const bf16_t*)(ws + OFF_QB) + (size_t)bh * SEQ * 64; it.K = (const bf16_t*)(ws + OFF_KB) + (size_t)bh * SEQ * 64; it.V = (const bf16_t*)(ws + OFF_VB) + (size_t)bh * SEQ * 64;
    it.dil = dil; it.res = c / cpr; it.n0 = (c - it.res * cpr) * 128; it.N = SEQ / dil;
    it.out = (bf16_t*)(ws + OFF_OB) + (size_t)br * NTOK * 384 + (size_t)b * SEQ * 384 + h * 64; it.ldo = 384;
    it.lse = (float*)(ws + OFF_LSEB) + (size_t)br * NTOK * 6 + (size_t)b * SEQ * 6 + h;
    attn_block<64, 1>(it, gsm, t256);
  }
  for (int i0 = bid * 2; i0 < NC; i0 += gridDim.x * 2) {
    AttnItem it{};
    const int i = i0 + grp, xcd = (i >> 1) & 7, j = ((i >> 4) << 1) | (i & 1);
    const int bh = (j >> 6) * 8 + xcd, blk = j & 63, b = bh >> 2, h = bh & 3;
    it.Q = (const bf16_t*)(ws + OFF_QC) + (size_t)bh * SEQ * 64; it.K = (const bf16_t*)(ws + OFF_KC) + (size_t)bh * SEQ * 64; it.V = (const bf16_t*)(ws + OFF_VC) + (size_t)bh * SEQ * 64;
    it.nrb = blk >> 2; it.ncb = blk & 3;
    it.kr0 = min(max(8 * it.nrb - 4, 0), 112); it.kc0 = min(max(16 * it.ncb - 8, 0), 32);
    it.out = (bf16_t*)(ws + OFF_OC) + (size_t)b * SEQ * 256 + h * 64; it.ldo = 256;
    it.rpb = p.rpb + ((size_t)l * 4 + h) * 465;
    attn_block<64, 2>(it, gsm, t256);
  }
}
NI void phase_mix() {
  const Params& p = kparams(); const int tid = otid(), bid = obid();
  char* ws = p.ws;
  const int lane = tid & 63, gw = bid * (NTHR / 64) + (tid >> 6), nw = gridDim.x * (NTHR / 64);
  const bf16_t* oA = (const bf16_t*)(ws + OFF_OA); const bf16_t* oB = (const bf16_t*)(ws + OFF_OB); const bf16_t* oC = (const bf16_t*)(ws + OFF_OC);
  const float* lse = (const float*)(ws + OFF_LSEB);
  bf16_t* mixed = (bf16_t*)(ws + OFF_MIXED);
  for (int tok = gw; tok < NTOK; tok += nw) {
    float v[16];
    if (lane < 24 || lane >= 48) {
      const bf16_t* src = lane < 24 ? oA + (size_t)tok * 384 + lane * 16 : oC + (size_t)tok * 256 + (lane - 48) * 16;
      const u32x4 a = *(const u32x4*)src, b = *(const u32x4*)(src + 8);
#pragma unroll
      for (int j = 0; j < 4; ++j) { v[2 * j] = bf2f(a[j] & 0xffffu); v[2 * j + 1] = bf2f(a[j] >> 16); v[8 + 2 * j] = bf2f(b[j] & 0xffffu); v[8 + 2 * j + 1] = bf2f(b[j] >> 16); }
    } else {
      const int col = (lane - 24) * 16, hd = col >> 6;
      const float l0 = lse[(size_t)tok * 6 + hd], l1 = lse[(size_t)NTOK * 6 + (size_t)tok * 6 + hd], l2 = lse[(size_t)2 * NTOK * 6 + (size_t)tok * 6 + hd];
      const float mx = fmaxf(l0, fmaxf(l1, l2));
      float w0 = __builtin_amdgcn_exp2f(l0 - mx), w1 = __builtin_amdgcn_exp2f(l1 - mx), w2 = __builtin_amdgcn_exp2f(l2 - mx);
      const float wi = 1.f / (w0 + w1 + w2); w0 *= wi; w1 *= wi; w2 *= wi;
#pragma unroll
      for (int j = 0; j < 16; ++j) v[j] = 0.f;
#pragma unroll
      for (int br = 0; br < 3; ++br) {
        const float wb = br == 0 ? w0 : (br == 1 ? w1 : w2);
        const bf16_t* src = oB + (size_t)br * NTOK * 384 + (size_t)tok * 384 + col;
        const u32x4 a = *(const u32x4*)src, b = *(const u32x4*)(src + 8);
#pragma unroll
        for (int j = 0; j < 4; ++j) { v[2 * j] += wb * bf2f(a[j] & 0xffffu); v[2 * j + 1] += wb * bf2f(a[j] >> 16); v[8 + 2 * j] += wb * bf2f(b[j] & 0xffffu); v[8 + 2 * j + 1] += wb * bf2f(b[j] >> 16); }
      }
    }
    float ss = 0.f;
#pragma unroll
    for (int j = 0; j < 16; ++j) ss += v[j] * v[j];
    const float sa = wave_sum(lane < 24 ? ss : 0.f), sb = wave_sum((lane >= 24 && lane < 48) ? ss : 0.f), sc = wave_sum(lane >= 48 ? ss : 0.f);
    const float rs = lane < 24 ? rsqrtf(sa * (1.f / 384.f) + 1e-6f) : (lane < 48 ? rsqrtf(sb * (1.f / 384.f) + 1e-6f) : rsqrtf(sc * (1.f / 256.f) + 1e-6f));
    u32x4 oa, ob;
#pragma unroll
    for (int j = 0; j < 4; ++j) { oa[j] = cvtpk(v[2 * j] * rs, v[2 * j + 1] * rs); ob[j] = cvtpk(v[8 + 2 * j] * rs, v[8 + 2 * j + 1] * rs); }
    bf16_t* dst = mixed + (size_t)tok * 1024 + lane * 16;
    *(u32x4*)dst = oa; *(u32x4*)(dst + 8) = ob;
  }
}
NI void phase_wout(int l_) {
  const Params& p = kparams(); char* smem = g_smem; const int l = __builtin_amdgcn_readfirstlane(l_); const int tid = otid(), bid = obid(); (void)tid; (void)bid;
  char* ws = p.ws;
  EpiRes e; e.xb = (bf16_t*)(ws + OFF_XB); e.pout = (float*)(ws + OFF_PX2);
  const bf16_t* A = (const bf16_t*)(ws + OFF_MIXED);
  const bf16_t* Bt = (const bf16_t*)(ws + OFF_W + (size_t)l * LW_SIZE + LW_WOUT);
  FOR_TILES(4, mt, nt, gemm_tile<0>(A, 1024, Bt, 1024, 1024, mt * 256, nt * 256, e, tid, nullptr);)
}
NI void phase_mlp1(int l_) {
  const Params& p = kparams(); char* smem = g_smem; const int l = __builtin_amdgcn_readfirstlane(l_); const int tid = otid(), bid = obid(); (void)tid; (void)bid;
  char* ws = p.ws;
  EpiMlp1 e; e.hid = (bf16_t*)(ws + OFF_HID);
  const bf16_t* A = (const bf16_t*)(ws + OFF_XB);
  const bf16_t* Bt = (const bf16_t*)(ws + OFF_W + (size_t)l * LW_SIZE + LW_W1);
  FOR_TILES(16, mt, nt, gemm_tile<16>(A, 1024, Bt, 1024, 1024, mt * 256, nt * 256, e, tid, (const float*)(ws + OFF_PX2));)
}
NI void phase_mlp2(int l_) {
  const Params& p = kparams(); char* smem = g_smem; const int l = __builtin_amdgcn_readfirstlane(l_); const int tid = otid(), bid = obid(); (void)tid; (void)bid;
  char* ws = p.ws;
  EpiRes e; e.xb = (bf16_t*)(ws + OFF_XB); e.pout = (float*)(ws + OFF_PX1);
  const bf16_t* A = (const bf16_t*)(ws + OFF_HID);
  const bf16_t* Bt = (const bf16_t*)(ws + OFF_W + (size_t)l * LW_SIZE + LW_W2);
  FOR_TILES(4, mt, nt, gemm_tile<0>(A, DFF, Bt, DFF, DFF, mt * 256, nt * 256, e, tid, nullptr);)
}
NI void phase_final() {
  const Params& p = kparams(); const int tid = otid(), bid = obid();
  const int lane = tid & 63, gw = bid * (NTHR / 64) + (tid >> 6), nw = gridDim.x * (NTHR / 64);
  const bf16_t* xb = (const bf16_t*)(p.ws + OFF_XB);
  for (int tok = gw; tok < NTOK; tok += nw) {
    float* row = p.out + (size_t)tok * DM;
    f32x4 v[4]; float ss = 0.f;
#pragma unroll
    for (int j = 0; j < 4; ++j) {
      const u32x2 r = *(const u32x2*)(xb + (size_t)tok * DM + j * 256 + lane * 4);
      v[j] = f32x4{bf2f(r[0] & 0xffffu), bf2f(r[0] >> 16), bf2f(r[1] & 0xffffu), bf2f(r[1] >> 16)};
      ss += v[j][0] * v[j][0] + v[j][1] * v[j][1] + v[j][2] * v[j][2] + v[j][3] * v[j][3];
    }
    ss = wave_sum(ss);
    const float rs = rsqrtf(ss * (1.f / 1024.f) + 1e-6f);
#pragma unroll
    for (int j = 0; j < 4; ++j) { const f32x4 g = *(const f32x4*)(p.g_final + j * 256 + lane * 4); f32x4 o = {v[j][0] * rs * g[0], v[j][1] * rs * g[1], v[j][2] * rs * g[2], v[j][3] * rs * g[3]}; __builtin_nontemporal_store(o, (f32x4*)(row + j * 256 + lane * 4)); }
  }
}

DI unsigned xcc_id() { return (unsigned)__builtin_amdgcn_s_getreg((3 << 11) | 20) & 0xFu; }
DI void grid_barrier(unsigned* base, unsigned k, unsigned xcc, unsigned n_x, unsigned nxcd) {
  __syncthreads();
  if (threadIdx.x == 0) {
    unsigned* arr = base + 64 * (16 + xcc);
    unsigned* garr = base + 64 * 32;
    const unsigned a = __hip_atomic_fetch_add(arr, 1u, __ATOMIC_RELAXED, __HIP_MEMORY_SCOPE_AGENT);
    if (a + 1 == n_x * k) {
      __builtin_amdgcn_fence(__ATOMIC_RELEASE, "agent");
      asm volatile("s_waitcnt vmcnt(0)" ::: "memory");
      __hip_atomic_fetch_add(garr, 1u, __ATOMIC_RELAXED, __HIP_MEMORY_SCOPE_AGENT);
    }
    while (__hip_atomic_load(garr, __ATOMIC_RELAXED, __HIP_MEMORY_SCOPE_AGENT) < nxcd * k) __builtin_amdgcn_s_sleep(1);
    __builtin_amdgcn_fence(__ATOMIC_ACQUIRE, "agent");
    asm volatile("s_waitcnt vmcnt(0)" ::: "memory");
  }
  __syncthreads();
}

constexpr int NPHASE = 2 + 7 * NLAYER;
DI void run_phase(int ph) {
  if (ph == 0) { phase_prep(); return; }
  if (ph == NPHASE - 1) { phase_final(); return; }
  const int l = (ph - 1) / 7, st = (ph - 1) - l * 7;
  switch (st) {
    case 0: phase_g1(l); break;
    case 1: phase_g2(l); break;
    case 2: phase_attn(l); break;
    case 3: phase_mix(); break;
    case 4: phase_wout(l); break;
    case 5: phase_mlp1(l); break;
    default: phase_mlp2(l); break;
  }
}

__global__ void __launch_bounds__(512) mega(Params p, int ph_lo, int ph_hi) {
  cg::grid_group grid = cg::this_grid();
  unsigned* bar = (unsigned*)(p.ws + OFF_BAR);
  const unsigned xcc = xcc_id();
  unsigned n_x = 0, nxcd = 0;
  if (threadIdx.x == 0) __hip_atomic_fetch_add(bar + 64 * xcc, 1u, __ATOMIC_RELAXED, __HIP_MEMORY_SCOPE_AGENT);
  for (int ph = ph_lo; ph < ph_hi; ++ph) {
    run_phase(ph);
    if (ph + 1 < ph_hi) {
      if (ph == ph_lo) {
        grid.sync();
        if (threadIdx.x == 0) {
          n_x = __hip_atomic_load(bar + 64 * xcc, __ATOMIC_RELAXED, __HIP_MEMORY_SCOPE_AGENT);
          for (int x = 0; x < 16; ++x) nxcd += __hip_atomic_load(bar + 64 * x, __ATOMIC_RELAXED, __HIP_MEMORY_SCOPE_AGENT) != 0u;
        }
      } else grid_barrier(bar, (unsigned)(ph - ph_lo), xcc, n_x, nxcd);
    }
  }
}

extern "C" void kernel_launch(void* const* d_in, const int* in_sizes, int n_in, void* d_out, int out_size, void* d_ws, size_t ws_size, hipStream_t stream) {
  static int grid_blocks = 0;
  if (!grid_blocks) {
    int dev = 0, cus = 0, per_cu = 0;
    (void)hipGetDevice(&dev);
    (void)hipDeviceGetAttribute(&cus, hipDeviceAttributeMultiprocessorCount, dev);
    (void)hipOccupancyMaxActiveBlocksPerMultiprocessor(&per_cu, mega, NTHR, 0);
    if (per_cu > 1) per_cu = 1;
    grid_blocks = cus * per_cu;
    if (ws_size < OFF_END) fprintf(stderr, "kernel_launch: workspace too small: %zu < %zu\n", ws_size, (size_t)OFF_END);
  }
  Params p;
  memset(&p, 0, sizeof(p));
  p.x = (const float*)d_in[0]; p.g_mix = (const float*)d_in[1]; p.w_in = (const float*)d_in[2]; p.q_norm = (const float*)d_in[3];
  p.w_uq = (const float*)d_in[4]; p.kv_norm = (const float*)d_in[5]; p.w_ukv = (const float*)d_in[6]; p.rpb = (const float*)d_in[7];
  p.on_a = (const float*)d_in[8]; p.on_b = (const float*)d_in[9]; p.on_c = (const float*)d_in[10]; p.w_out = (const float*)d_in[11];
  p.g_mlp = (const float*)d_in[12]; p.w_mlp_in = (const float*)d_in[13]; p.w_mlp_out = (const float*)d_in[14]; p.g_final = (const float*)d_in[15];
  p.out = (float*)d_out; p.ws = (char*)d_ws;
  p.qscaleA = (float)(1.4426950408889634 / std::sqrt(96.0));
  p.qscaleB = (float)(1.4426950408889634 * 0.125);
#if ONE_LAUNCH
  (void)hipMemsetAsync((char*)d_ws + OFF_BAR, 0, 16384, stream);
  int lo = 0, hi = NPHASE;
  void* args[] = {&p, &lo, &hi};
  hipError_t e = hipLaunchCooperativeKernel((void*)mega, dim3(grid_blocks), dim3(NTHR), args, 0, stream);
  if (e != hipSuccess) fprintf(stderr, "cooperative launch failed: %s (grid %d)\n", hipGetErrorString(e), grid_blocks);
#else
  for (int ph = 0; ph < NPHASE; ++ph) hipLaunchKernelGGL(mega, dim3(grid_blocks), dim3(NTHR), 0, stream, p, ph, ph + 1);
#endif
}
```

```cpp
#include <hip/hip_runtime.h>
#include <hip/hip_cooperative_groups.h>
#include <cstdio>
#include <cmath>
#include <cstring>
namespace cg = cooperative_groups;

#ifndef ONE_LAUNCH
#define ONE_LAUNCH 1
#endif

#define DI __device__ __forceinline__
typedef unsigned short bf16_t;
typedef short bf16x8 __attribute__((ext_vector_type(8)));
typedef short s16x4 __attribute__((ext_vector_type(4)));
typedef float f32x16 __attribute__((ext_vector_type(16)));
typedef float f32x2 __attribute__((ext_vector_type(2)));
typedef float f32x4 __attribute__((ext_vector_type(4)));
typedef __bf16 bf2_t __attribute__((ext_vector_type(2)));
typedef unsigned u32x4 __attribute__((ext_vector_type(4)));
typedef unsigned u32x2 __attribute__((ext_vector_type(2)));
typedef __attribute__((address_space(3))) s16x4 lds_s16x4;

constexpr int SEQ = 8192, NB = 4, NTOK = NB * SEQ, DM = 1024, NLAYER = 4;
constexpr int N_IN_PAD = 2560, N_UQ_PAD = 768, N_UKV = 768, DFF = 4096;
constexpr int NTHR = 512;

constexpr size_t SZ_XB = (size_t)NTOK * DM * 2;
constexpr size_t SZ_WIN = (size_t)N_IN_PAD * 1024 * 2, SZ_WUQ = (size_t)N_UQ_PAD * 256 * 2, SZ_WUKV = (size_t)N_UKV * 128 * 2,
                 SZ_WOUT = (size_t)1024 * 1024 * 2, SZ_W1 = (size_t)DFF * 1024 * 2, SZ_W2 = (size_t)1024 * DFF * 2;
constexpr size_t LW_WIN = 0, LW_WUQ = LW_WIN + SZ_WIN, LW_WUKV = LW_WUQ + SZ_WUQ, LW_WOUT = LW_WUKV + SZ_WUKV, LW_W1 = LW_WOUT + SZ_WOUT,
                 LW_W2 = LW_W1 + SZ_W1, LW_SIZE = LW_W2 + SZ_W2;
constexpr size_t OFF_XB = 0, OFF_W = OFF_XB + SZ_XB, OFF_TAB = OFF_W + NLAYER * LW_SIZE;
constexpr size_t OFF_COS32 = OFF_TAB, OFF_SIN32 = OFF_COS32 + (size_t)SEQ * 32 * 4, OFF_COS16 = OFF_SIN32 + (size_t)SEQ * 32 * 4,
                 OFF_SIN16 = OFF_COS16 + (size_t)SEQ * 16 * 4, OFF_ATT = OFF_SIN16 + (size_t)SEQ * 16 * 4;
constexpr size_t SZ_T384 = (size_t)NTOK * 384 * 2, SZ_QA = (size_t)NB * 6 * SEQ * 96 * 2, SZ_H6 = (size_t)NB * 6 * SEQ * 64 * 2,
                 SZ_H4 = (size_t)NB * 4 * SEQ * 64 * 2;
constexpr size_t OFF_CQKV = OFF_ATT;
constexpr size_t OFF_OA = OFF_CQKV;
constexpr size_t OFF_QA = OFF_CQKV + SZ_T384, OFF_KA = OFF_QA + SZ_QA, OFF_VA = OFF_KA + SZ_QA;
constexpr size_t OFF_QB = OFF_VA + SZ_H6, OFF_KB = OFF_QB + SZ_H6, OFF_VB = OFF_KB + SZ_H6;
constexpr size_t OFF_QC = OFF_VB + SZ_H6, OFF_KC = OFF_QC + SZ_H4, OFF_VC = OFF_KC + SZ_H4;
constexpr size_t OFF_OB = OFF_VC + SZ_H4, OFF_LSEB = OFF_OB + 3 * SZ_T384, OFF_OC = OFF_LSEB + (size_t)3 * NTOK * 6 * 4;
constexpr size_t OFF_SSQ = OFF_OC + (size_t)NTOK * 256 * 2;
constexpr size_t OFF_PX1 = OFF_SSQ, OFF_PX2 = OFF_PX1 + (size_t)NTOK * 16 * 4, OFF_PQ = OFF_PX2 + (size_t)NTOK * 16 * 4, OFF_PKV = OFF_PQ + (size_t)NTOK * 4 * 4;
constexpr size_t OFF_BAR = OFF_PKV + (size_t)NTOK * 2 * 4;
constexpr size_t OFF_END = OFF_BAR + 16384;
constexpr size_t OFF_MIXED = OFF_QA;
constexpr size_t OFF_HID = OFF_ATT;
static_assert(OFF_HID + (size_t)NTOK * DFF * 2 <= OFF_SSQ, "hid fits");
static_assert(OFF_MIXED + (size_t)NTOK * DM * 2 <= OFF_VA, "mixed fits");

struct Params {
  const float *x, *g_mix, *w_in, *q_norm, *w_uq, *kv_norm, *w_ukv, *rpb, *on_a, *on_b, *on_c, *w_out, *g_mlp, *w_mlp_in, *w_mlp_out, *g_final;
  float* out; char* ws;
  float qscaleA, qscaleB;
};
__shared__ __attribute__((aligned(1024))) char g_smem[131072];
#define NI __device__ __forceinline__
DI const Params& kparams() { return *(const Params*)__builtin_amdgcn_kernarg_segment_ptr(); }

DI unsigned cvtpk(float lo, float hi) { f32x2 v = {lo, hi}; bf2_t b = __builtin_convertvector(v, bf2_t); return __builtin_bit_cast(unsigned, b); }
DI bf16_t f2bf(float x) { return (bf16_t)(cvtpk(x, 0.f) & 0xffffu); }
DI float bf2f(unsigned h) { return __uint_as_float(h << 16); }
DI int crow(int i, int h) { return (i & 3) + 8 * (i >> 2) + 4 * h; }
#define MFMA32(a, b, c) __builtin_amdgcn_mfma_f32_32x32x16_bf16((a), (b), (c), 0, 0, 0)
DI float fdot2bf(unsigned a, float c) { bf2_t v = __builtin_bit_cast(bf2_t, a); return __builtin_amdgcn_fdot2_f32_bf16(v, v, c, false); }
DI float swap_max(float v) { auto rr = __builtin_amdgcn_permlane32_swap(__float_as_uint(v), __float_as_uint(v), false, false); return fmaxf(__uint_as_float(rr[0]), __uint_as_float(rr[1])); }
DI float swap_sum(float v) { auto rr = __builtin_amdgcn_permlane32_swap(__float_as_uint(v), __float_as_uint(v), false, false); return __uint_as_float(rr[0]) + __uint_as_float(rr[1]); }

constexpr int ATT_LDS = 53248;
#define FOR_TILES(NN, MT, NT, BODY) { const bool xm_ = gridDim.x == 256; const int st_ = xm_ ? (bid >> 3) : bid, sp_ = xm_ ? 32 : (int)gridDim.x, cn_ = xm_ ? 16 * (NN) : (NTOK / 256) * (NN); \
  for (int j_ = st_; j_ < cn_; j_ += sp_) { int MT = j_ / (NN); const int NT = j_ - MT * (NN); if (xm_) MT += (bid & 7) * 16; BODY } }
DI int otid() { int t = threadIdx.x; asm volatile("" : "+v"(t)); return t; }
DI int obid() { int t = blockIdx.x; asm volatile("" : "+s"(t)); return t; }

template <int NSLOT, class Epi>
DI void gemm_tile(const bf16_t* __restrict__ A, int lda, const bf16_t* __restrict__ Bt, int ldb, int K, int m0, int n0, const Epi& epi, const int tid, const float* pin) {
  const int lane = tid & 63, w = tid >> 6, wm = w >> 2, wn = w & 3, r32 = lane & 31, hi = lane >> 5;
  char* smem = g_smem;
  const int lrow = lane >> 3;
  const int c0 = (lane & 7) ^ (lane >> 4), c1 = (lane & 7) ^ ((lane >> 4) | 4);
  const char* Ab = (const char*)(A + (size_t)m0 * lda);
  const char* Bb = (const char*)(Bt + (size_t)n0 * ldb);
  const unsigned oa0 = (unsigned)(((w * 32 + lrow) * lda + c0 * 8) * 2), oa1 = (unsigned)(((w * 32 + lrow) * lda + c1 * 8) * 2);
  const unsigned ob0 = (unsigned)(((w * 32 + lrow) * ldb + c0 * 8) * 2), ob1 = (unsigned)(((w * 32 + lrow) * ldb + c1 * 8) * 2);
  const int dma_off = (w * 32) * 128 + lane * 16;
  f32x16 acc[4][2];
#pragma unroll
  for (int mi = 0; mi < 4; ++mi)
#pragma unroll
    for (int nj = 0; nj < 2; ++nj)
#pragma unroll
      for (int i = 0; i < 16; ++i) acc[mi][nj][i] = 0.f;
  const int nk = K >> 6;
  const int sw = (r32 >> 1) & 7, sh = sw >> 1, lo16 = 16 * (hi ^ (sw & 1));
  const int a_off = (wm * 128 + r32) * 128 + lo16;
  const int b_off = 32768 + (wn * 64 + r32) * 128 + lo16;
  __syncthreads();
  {
    char* sa = smem + dma_off;
#pragma unroll
    for (int j = 0; j < 4; ++j) {
      __builtin_amdgcn_global_load_lds((const unsigned*)(Ab + (size_t)(j * 8 * lda) * 2 + ((j & 1) ? oa1 : oa0)), (unsigned*)(sa + j * 1024), 16, 0, 0);
      __builtin_amdgcn_global_load_lds((const unsigned*)(Bb + (size_t)(j * 8 * ldb) * 2 + ((j & 1) ? ob1 : ob0)), (unsigned*)(sa + 32768 + j * 1024), 16, 0, 0);
    }
  }
  for (int kt = 0; kt < nk; ++kt) {
    __syncthreads();
    if (kt + 1 < nk) {
      char* sa = smem + ((kt + 1) & 1) * 65536 + dma_off;
      const int k0 = (kt + 1) * 64;
#pragma unroll
      for (int j = 0; j < 4; ++j) {
        __builtin_amdgcn_global_load_lds((const unsigned*)(Ab + (size_t)(j * 8 * lda + k0) * 2 + ((j & 1) ? oa1 : oa0)), (unsigned*)(sa + j * 1024), 16, 0, 0);
        __builtin_amdgcn_global_load_lds((const unsigned*)(Bb + (size_t)(j * 8 * ldb + k0) * 2 + ((j & 1) ? ob1 : ob0)), (unsigned*)(sa + 32768 + j * 1024), 16, 0, 0);
      }
    }
    const char* sb = smem + (kt & 1) * 65536;
#pragma unroll
    for (int ks = 0; ks < 4; ++ks) {
      const int koff = 32 * (ks ^ sh);
      bf16x8 af[4], bfr[2];
#pragma unroll
      for (int mi = 0; mi < 4; ++mi) af[mi] = *(const bf16x8*)(sb + a_off + mi * 4096 + koff);
#pragma unroll
      for (int nj = 0; nj < 2; ++nj) bfr[nj] = *(const bf16x8*)(sb + b_off + nj * 4096 + koff);
#pragma unroll
      for (int mi = 0; mi < 4; ++mi)
#pragma unroll
        for (int nj = 0; nj < 2; ++nj) acc[mi][nj] = MFMA32(af[mi], bfr[nj], acc[mi][nj]);
    }
  }
  float* rstd_s = (float*)smem;
  if (NSLOT > 0) {
    __syncthreads();
    if (tid < 256) {
      const float* pr = pin + (size_t)(m0 + tid) * NSLOT;
      float sacc = 0.f;
      if (NSLOT >= 4) {
#pragma unroll
        for (int q = 0; q < NSLOT / 4; ++q) { const f32x4 v = *(const f32x4*)(pr + 4 * q); sacc += (v[0] + v[1]) + (v[2] + v[3]); }
      } else {
#pragma unroll
        for (int q = 0; q < NSLOT; ++q) sacc += pr[q];
      }
      rstd_s[tid] = rsqrtf(sacc / (float)K + 1e-6f);
    }
    __syncthreads();
  }
  int lane2 = lane, w2 = w; asm volatile("" : "+v"(lane2), "+v"(w2));
  epi(acc, m0, (w2 >> 2) * 128, n0 + (w2 & 3) * 64, lane2, rstd_s);
}
DI void row_ssq_put(float v, float* dst, int lane) {
  v += __shfl_xor(v, 1); v += __shfl_xor(v, 2); v += __shfl_xor(v, 4); v += __shfl_xor(v, 8); v += __shfl_xor(v, 16);
  if ((lane & 31) == 0) *dst = v;
}

struct EpiG1 {
  bf16_t *cqkv, *KA, *qB, *qC; const float *cos32, *sin32, *cos16, *sin16; float qs; float *pq, *pkv;
  DI void operator()(f32x16 (&acc)[4][2], int m0, int lr0, int col0, int lane, const float* rstd_s) const {
    const int c = lane & 31, h = lane >> 5, cb = col0 >> 6;
    if (cb >= 37) return;
#define G1_ROW const int lr = lr0 + mi * 32 + crow(i, h), tok = m0 + lr, b = tok >> 13, s = tok & 8191; (void)b; (void)s; \
               const float rs = rstd_s[lr]; float v0 = acc[mi][0][i] * rs, v1 = acc[mi][1][i] * rs;
    if (cb < 6) {
#pragma unroll
      for (int mi = 0; mi < 4; ++mi)
#pragma unroll
        for (int i = 0; i < 16; ++i) {
        if ((i & 3) == 0) __builtin_amdgcn_sched_barrier(0);
          G1_ROW
          bf16_t* d = cqkv + (size_t)tok * 384 + cb * 64 + c; d[0] = f2bf(v0); d[32] = f2bf(v1);
          row_ssq_put(v0 * v0 + v1 * v1, cb < 4 ? pq + (size_t)tok * 4 + cb : pkv + (size_t)tok * 2 + (cb - 4), lane);
        }
    } else if (cb == 6) {
#pragma unroll
      for (int mi = 0; mi < 4; ++mi)
#pragma unroll
        for (int i = 0; i < 16; ++i) {
        if ((i & 3) == 0) __builtin_amdgcn_sched_barrier(0);
          G1_ROW
          if (c < 16) {
            const float cs = cos16[s * 16 + c], sn = sin16[s * 16 + c];
            const bf16_t o1 = f2bf(v0 * cs - v1 * sn), o2 = f2bf(v0 * sn + v1 * cs);
#pragma unroll
            for (int hd = 0; hd < 6; ++hd) { bf16_t* d = KA + ((size_t)(b * 6 + hd) * SEQ + s) * 96 + 64 + c; d[0] = o1; d[16] = o2; }
          }
        }
    } else if (cb < 25) {
      const int idx = cb - 7, which = idx / 6, hd = idx - which * 6;
      bf16_t* base = qB + (size_t)which * (SZ_H6 / 2) + (size_t)hd * SEQ * 64 + 2 * c;
      const float sc = which == 0 ? qs : 1.f;
      if (which < 2) {
#pragma unroll
        for (int mi = 0; mi < 4; ++mi)
#pragma unroll
          for (int i = 0; i < 16; ++i) {
        if ((i & 3) == 0) __builtin_amdgcn_sched_barrier(0);
            G1_ROW
            const float cs = cos32[s * 32 + c] * sc, sn = sin32[s * 32 + c] * sc;
            bf16_t* d = base + ((size_t)(b * 6) * SEQ + s) * 64;
            __builtin_nontemporal_store(cvtpk(v0 * cs - v1 * sn, v0 * sn + v1 * cs), (unsigned*)d);
          }
      } else {
#pragma unroll
        for (int mi = 0; mi < 4; ++mi)
#pragma unroll
          for (int i = 0; i < 16; ++i) {
        if ((i & 3) == 0) __builtin_amdgcn_sched_barrier(0);
            G1_ROW
            bf16_t* d = base + ((size_t)(b * 6) * SEQ + s) * 64;
            __builtin_nontemporal_store(cvtpk(v0, v1), (unsigned*)d);
          }
      }
    } else {
      const int idx = cb - 25, which = idx >> 2, hd = idx & 3;
      bf16_t* base = qC + (size_t)which * (SZ_H4 / 2) + (size_t)hd * SEQ * 64 + 2 * c;
      const float sc = which == 0 ? qs : 1.f;
#pragma unroll
      for (int mi = 0; mi < 4; ++mi)
#pragma unroll
        for (int i = 0; i < 16; ++i) {
        if ((i & 3) == 0) __builtin_amdgcn_sched_barrier(0);
          G1_ROW
          bf16_t* d = base + ((size_t)(b * 4) * SEQ + s) * 64;
          __builtin_nontemporal_store(cvtpk(v0 * sc, v1 * sc), (unsigned*)d);
        }
    }
#undef G1_ROW
  }
};
struct EpiUQ {
  bf16_t* QA; const float *cos16, *sin16; float qs;
  DI void operator()(f32x16 (&acc)[4][2], int m0, int lr0, int col0, int lane, const float* rstd_s) const {
    const int c = lane & 31, h = lane >> 5, cb = col0 >> 6;
    if (cb >= 9) return;
#pragma unroll
    for (int mi = 0; mi < 4; ++mi)
#pragma unroll
      for (int i = 0; i < 16; ++i) {
        if ((i & 3) == 0) __builtin_amdgcn_sched_barrier(0);
        const int lr = lr0 + mi * 32 + crow(i, h), tok = m0 + lr, b = tok >> 13, s = tok & 8191;
        const float rs = rstd_s[lr] * qs;
        const float v0 = acc[mi][0][i] * rs, v1 = acc[mi][1][i] * rs;
        if (cb < 6) {
          bf16_t* d = QA + ((size_t)(b * 6 + cb) * SEQ + s) * 96 + c; d[0] = f2bf(v0); d[32] = f2bf(v1);
        } else {
          const int hd = 2 * (cb - 6) + (c >> 4), fi = c & 15;
          const float cs = cos16[s * 16 + fi], sn = sin16[s * 16 + fi];
          bf16_t* d = QA + ((size_t)(b * 6 + hd) * SEQ + s) * 96 + 64 + fi;
          d[0] = f2bf(v0 * cs - v1 * sn); d[16] = f2bf(v0 * sn + v1 * cs);
        }
      }
  }
};
struct EpiUKV {
  bf16_t *KA, *VA;
  DI void operator()(f32x16 (&acc)[4][2], int m0, int lr0, int col0, int lane, const float* rstd_s) const {
    const int c = lane & 31, h = lane >> 5, cb = col0 >> 6, hd = cb >> 1, isv = cb & 1;
#pragma unroll
    for (int mi = 0; mi < 4; ++mi)
#pragma unroll
      for (int i = 0; i < 16; ++i) {
        if ((i & 3) == 0) __builtin_amdgcn_sched_barrier(0);
        const int lr = lr0 + mi * 32 + crow(i, h), tok = m0 + lr, b = tok >> 13, s = tok & 8191;
        const float rs = rstd_s[lr];
        const float v0 = acc[mi][0][i] * rs, v1 = acc[mi][1][i] * rs;
        bf16_t* d = isv ? VA + ((size_t)(b * 6 + hd) * SEQ + s) * 64 + c : KA + ((size_t)(b * 6 + hd) * SEQ + s) * 96 + c;
        d[0] = f2bf(v0); d[32] = f2bf(v1);
      }
  }
};
struct EpiRes {
  bf16_t* xb; float* pout;
  DI void operator()(f32x16 (&acc)[4][2], int m0, int lr0, int col0, int lane, const float* rstd_s) const {
    const int c = lane & 31, h = lane >> 5;
#pragma unroll
    for (int mi = 0; mi < 4; ++mi)
#pragma unroll
      for (int i = 0; i < 16; ++i) {
        if ((i & 3) == 0) __builtin_amdgcn_sched_barrier(0);
        const int row = m0 + lr0 + mi * 32 + crow(i, h);
        const size_t o = (size_t)row * DM + col0 + c;
        const float v0 = bf2f(xb[o]) + acc[mi][0][i], v1 = bf2f(xb[o + 32]) + acc[mi][1][i];
        xb[o] = f2bf(v0); xb[o + 32] = f2bf(v1);
        row_ssq_put(v0 * v0 + v1 * v1, pout + (size_t)row * 16 + (col0 >> 6), lane);
      }
  }
};
struct EpiMlp1 {
  bf16_t* hid;
  DI void operator()(f32x16 (&acc)[4][2], int m0, int lr0, int col0, int lane, const float* rstd_s) const {
    const int c = lane & 31, h = lane >> 5;
#pragma unroll
    for (int mi = 0; mi < 4; ++mi)
#pragma unroll
      for (int i = 0; i < 16; ++i) {
        if ((i & 3) == 0) __builtin_amdgcn_sched_barrier(0);
        const int lr = lr0 + mi * 32 + crow(i, h);
        const float rs = rstd_s[lr];
        const float v0 = fmaxf(acc[mi][0][i] * rs, 0.f), v1 = fmaxf(acc[mi][1][i] * rs, 0.f);
        __builtin_nontemporal_store(cvtpk(v0 * v0, v1 * v1), (unsigned*)(hid + (size_t)(m0 + lr) * DFF + col0 + 2 * c));
      }
  }
};

struct AttnItem {
  const bf16_t *Q, *K, *V;
  int q0;
  int n0, dil, res, N;
  int nrb, ncb, kr0, kc0;
  bf16_t* out; int ldo;
  float* lse;
  const float* rpb;
};

template <int DQ, int MODE>
DI void attn_block(const AttnItem& it, char* smem, const int tid) {
  constexpr int CPR = DQ / 8, KST = DQ * 2 + 16, KCH = (64 * CPR) / 256, NT = MODE == 0 ? SEQ / 64 : MODE == 1 ? 4 : 8;
  const int lane = tid & 63, w = tid >> 6, r32 = lane & 31, hi = lane >> 5;
  char* Ks = smem; char* Vs = smem + 64 * KST; float* bias_s = (float*)(smem + 64 * KST + 8192);
  const int qi = w * 32 + r32;
  int qpos;
  if (MODE == 0) qpos = it.q0 + qi;
  else if (MODE == 1) qpos = (it.n0 + qi) * it.dil + it.res;
  else qpos = (8 * it.nrb + (qi >> 4)) * 64 + 16 * it.ncb + (qi & 15);
  __syncthreads();
  if (MODE == 2) { for (int i = tid; i < 465; i += 256) bias_s[i] = it.rpb[i] * 1.4426950408889634f; }
  bf16x8 qr[DQ / 16];
#pragma unroll
  for (int d0 = 0; d0 < DQ / 16; ++d0) qr[d0] = *(const bf16x8*)(it.Q + (size_t)qpos * DQ + d0 * 16 + hi * 8);
  f32x16 o[2];
#pragma unroll
  for (int i = 0; i < 16; ++i) { o[0][i] = 0.f; o[1][i] = 0.f; }
  float m_run = -1e30f, l_run = 0.f;
  u32x4 rk[KCH], rv[2];
  auto kpos = [&](int t, int row) -> int {
    if (MODE == 0) return t * 64 + row;
    if (MODE == 1) { int n = it.n0 - 64 + 64 * t + row; n = n < 0 ? 0 : (n > it.N - 1 ? it.N - 1 : n); return n * it.dil + it.res; }
    return (it.kr0 + 2 * t + (row >> 5)) * 64 + it.kc0 + (row & 31);
  };
  auto load = [&](int t) {
#pragma unroll
    for (int i = 0; i < KCH; ++i) { const int c = tid + 256 * i, row = c / CPR, kc = c - row * CPR; rk[i] = *(const u32x4*)(it.K + (size_t)kpos(t, row) * DQ + kc * 8); }
#pragma unroll
    for (int i = 0; i < 2; ++i) { const int c = tid + 256 * i, row = c >> 3, kc = c & 7; rv[i] = *(const u32x4*)(it.V + (size_t)kpos(t, row) * 64 + kc * 8); }
  };
  const int vrd = ((lane >> 5) * 4 + ((lane & 15) >> 2)) * 64 + ((lane >> 4) & 1) * 32 + (lane & 3) * 8;
  load(0);
  for (int t = 0; t < NT; ++t) {
    __syncthreads();
#pragma unroll
    for (int i = 0; i < KCH; ++i) { const int c = tid + 256 * i, row = c / CPR, kc = c - row * CPR; *(u32x4*)(Ks + row * KST + kc * 16) = rk[i]; }
#pragma unroll
    for (int i = 0; i < 2; ++i) { const int c = tid + 256 * i, row = c >> 3, kc = c & 7; *(u32x4*)(Vs + (kc >> 2) * 4096 + row * 64 + (kc & 3) * 16) = rv[i]; }
    __syncthreads();
    if (t + 1 < NT) load(t + 1);
    bool skip = false;
    if (MODE == 1) skip = (w < 2) ? (t == 3) : (t == 0);
    if (MODE == 2) {
      const int rq_lo = 8 * it.nrb + 2 * w, rq_hi = rq_lo + 1;
      const int rs_lo = min(max(rq_lo - 4, 0), 120), rs_hi = min(max(rq_hi - 4, 0), 120) + 7;
      const int kr = it.kr0 + 2 * t;
      skip = (kr + 1 < rs_lo) || (kr > rs_hi);
    }
    if (skip) continue;
    f32x16 p0, p1;
#pragma unroll
    for (int i = 0; i < 16; ++i) { p0[i] = 0.f; p1[i] = 0.f; }
#pragma unroll
    for (int d0 = 0; d0 < DQ / 16; ++d0) {
      const bf16x8 k0 = *(const bf16x8*)(Ks + r32 * KST + d0 * 32 + hi * 16);
      const bf16x8 k1 = *(const bf16x8*)(Ks + (32 + r32) * KST + d0 * 32 + hi * 16);
      p0 = MFMA32(k0, qr[d0], p0); p1 = MFMA32(k1, qr[d0], p1);
    }
    if (MODE == 1) {
      const int nq = it.n0 + qi, kb = it.n0 - 64 + 64 * t;
#pragma unroll
      for (int i = 0; i < 16; ++i) {
        const int nk = kb + crow(i, hi), nk2 = nk + 32;
        const int d1 = nq - nk, d2 = nq - nk2;
        const bool ok1 = (d1 <= 64) && (d1 >= -64) && (nk >= 0) && (nk < it.N);
        const bool ok2 = (d2 <= 64) && (d2 >= -64) && (nk2 >= 0) && (nk2 < it.N);
        p0[i] = ok1 ? p0[i] : -INFINITY; p1[i] = ok2 ? p1[i] : -INFINITY;
      }
    }
    if (MODE == 2) {
      const int rq = 8 * it.nrb + (qi >> 4), cq = 16 * it.ncb + (qi & 15);
      const int rs_ = min(max(rq - 4, 0), 120), cs_ = min(max(cq - 8, 0), 48);
      const int kr = it.kr0 + 2 * t;
      const bool okr0 = (kr >= rs_) && (kr < rs_ + 8), okr1 = (kr + 1 >= rs_) && (kr + 1 < rs_ + 8);
      const int bi0 = (kr - rq + 7) * 31 - cq + 15;
#pragma unroll
      for (int i = 0; i < 16; ++i) {
        const int kc = it.kc0 + crow(i, hi);
        const bool okc = (kc >= cs_) && (kc < cs_ + 16);
        const bool ok0 = okc && okr0, ok1 = okc && okr1;
        const float b0 = bias_s[ok0 ? bi0 + kc : 0], b1 = bias_s[ok1 ? bi0 + 31 + kc : 0];
        p0[i] = ok0 ? p0[i] + b0 : -INFINITY; p1[i] = ok1 ? p1[i] + b1 : -INFINITY;
      }
    }
    float pmax = p0[0];
#pragma unroll
    for (int i = 1; i < 16; ++i) pmax = fmaxf(pmax, p0[i]);
#pragma unroll
    for (int i = 0; i < 16; ++i) pmax = fmaxf(pmax, p1[i]);
    pmax = swap_max(pmax);
    const float mn = fmaxf(m_run, pmax);
    const float alpha = __builtin_amdgcn_exp2f(m_run - mn);
    m_run = mn;
    float ps = 0.f;
#pragma unroll
    for (int i = 0; i < 16; ++i) { p0[i] = __builtin_amdgcn_exp2f(p0[i] - mn); ps += p0[i]; }
#pragma unroll
    for (int i = 0; i < 16; ++i) { p1[i] = __builtin_amdgcn_exp2f(p1[i] - mn); ps += p1[i]; }
    ps = swap_sum(ps);
    l_run = l_run * alpha + ps;
#pragma unroll
    for (int i = 0; i < 16; ++i) { o[0][i] *= alpha; o[1][i] *= alpha; }
    bf16x8 pb[4];
#pragma unroll
    for (int s = 0; s < 2; ++s) {
      u32x4 a = {cvtpk(p0[8 * s], p0[8 * s + 1]), cvtpk(p0[8 * s + 2], p0[8 * s + 3]), cvtpk(p0[8 * s + 4], p0[8 * s + 5]), cvtpk(p0[8 * s + 6], p0[8 * s + 7])};
      u32x4 b = {cvtpk(p1[8 * s], p1[8 * s + 1]), cvtpk(p1[8 * s + 2], p1[8 * s + 3]), cvtpk(p1[8 * s + 4], p1[8 * s + 5]), cvtpk(p1[8 * s + 6], p1[8 * s + 7])};
      pb[s] = __builtin_bit_cast(bf16x8, a); pb[2 + s] = __builtin_bit_cast(bf16x8, b);
    }
#pragma unroll
    for (int db = 0; db < 2; ++db)
#pragma unroll
      for (int s = 0; s < 4; ++s) {
        const s16x4 lo = __builtin_amdgcn_ds_read_tr16_b64_v4i16((lds_s16x4*)(Vs + db * 4096 + (16 * s) * 64 + vrd));
        const s16x4 hh = __builtin_amdgcn_ds_read_tr16_b64_v4i16((lds_s16x4*)(Vs + db * 4096 + (16 * s + 8) * 64 + vrd));
        const bf16x8 a = {lo[0], lo[1], lo[2], lo[3], hh[0], hh[1], hh[2], hh[3]};
        o[db] = MFMA32(a, pb[s], o[db]);
      }
  }
  const float inv = 1.f / l_run;
  const int bq = qpos;
  bf16_t* orow = it.out + (size_t)bq * it.ldo;
#pragma unroll
  for (int db = 0; db < 2; ++db)
#pragma unroll
    for (int g = 0; g < 4; ++g) {
      u32x2 v = {cvtpk(o[db][4 * g] * inv, o[db][4 * g + 1] * inv), cvtpk(o[db][4 * g + 2] * inv, o[db][4 * g + 3] * inv)};
      *(u32x2*)(orow + db * 32 + 8 * g + 4 * hi) = v;
    }
  if (MODE == 1) { if (hi == 0) it.lse[(size_t)bq * 6] = m_run + __builtin_amdgcn_logf(l_run); }
}

DI void attn_dense_skew(const bf16_t* __restrict__ Q, const bf16_t* __restrict__ K, const bf16_t* __restrict__ V, int q0, bf16_t* __restrict__ out,
                        char* smem, const int tid512, const int grp) {
  constexpr int DQ = 96, CPR = 12, KST = 208, NT = SEQ / 64, KB = 64 * KST, VOFF = 2 * KB;
  const int lane = tid512 & 63, w = (tid512 >> 6) & 3, r32 = lane & 31, hi = lane >> 5;
  const int qpos = q0 + w * 32 + r32;
  bf16x8 qr[DQ / 16];
#pragma unroll
  for (int d0 = 0; d0 < DQ / 16; ++d0) qr[d0] = *(const bf16x8*)(Q + (size_t)qpos * DQ + d0 * 16 + hi * 8);
  f32x16 o[2];
#pragma unroll
  for (int i = 0; i < 16; ++i) { o[0][i] = 0.f; o[1][i] = 0.f; }
  float m_run = -1e30f, l_run = 0.f;
  const int kr0 = tid512 / CPR, kc0 = tid512 - kr0 * CPR, c1 = tid512 + 512, kr1 = c1 / CPR, kc1 = c1 - kr1 * CPR, vr = tid512 >> 3, vc = tid512 & 7;
  const bool two = tid512 < 256;
  const bf16_t* Kp0 = K + (size_t)kr0 * DQ + kc0 * 8; const bf16_t* Kp1 = K + (size_t)kr1 * DQ + kc1 * 8; const bf16_t* Vp = V + (size_t)vr * 64 + vc * 8;
  const int ks0 = kr0 * KST + kc0 * 16, ks1 = kr1 * KST + kc1 * 16, vs0 = VOFF + (vc >> 2) * 4096 + vr * 64 + (vc & 3) * 16;
  u32x4 rk0, rk1 = u32x4{0u, 0u, 0u, 0u}, rv;
  auto load = [&](int t) {
    const size_t ro = (size_t)t * 64;
    rk0 = *(const u32x4*)(Kp0 + ro * DQ); if (two) rk1 = *(const u32x4*)(Kp1 + ro * DQ); rv = *(const u32x4*)(Vp + ro * 64);
  };
  auto store = [&](int kb, int vb) {
    char* kbp = smem + kb * KB;
    *(u32x4*)(kbp + ks0) = rk0; if (two) *(u32x4*)(kbp + ks1) = rk1; *(u32x4*)(smem + vb * 8192 + vs0) = rv;
  };
  const int vrd = ((lane >> 5) * 4 + ((lane & 15) >> 2)) * 64 + ((lane >> 4) & 1) * 32 + (lane & 3) * 8;
  __syncthreads();
  load(0); store(0, 0); load(1);
  __syncthreads();
  if (grp == 1) __syncthreads();
  int vcur = 0;
  for (int t = 0; t < NT; ++t) {
    const int vnext = vcur == 2 ? 0 : vcur + 1;
    const char* Ks = smem + (t & 1) * KB; const char* Vs = smem + VOFF + vcur * 8192;
    if (t + 1 < NT) store((t + 1) & 1, vnext);
    if (t + 2 < NT) load(t + 2);
    f32x16 p0, p1;
#pragma unroll
    for (int i = 0; i < 16; ++i) { p0[i] = 0.f; p1[i] = 0.f; }
    {
      const char* kp = Ks + r32 * KST + hi * 16;
      bf16x8 ka[2][2];
      ka[0][0] = *(const bf16x8*)(kp); ka[0][1] = *(const bf16x8*)(kp + 32 * KST);
      ka[1][0] = *(const bf16x8*)(kp + 32); ka[1][1] = *(const bf16x8*)(kp + 32 * KST + 32);
#pragma unroll
      for (int d0 = 0; d0 < DQ / 16; ++d0) {
        p0 = MFMA32(ka[d0 & 1][0], qr[d0], p0); p1 = MFMA32(ka[d0 & 1][1], qr[d0], p1);
        if (d0 + 2 < DQ / 16) { ka[d0 & 1][0] = *(const bf16x8*)(kp + (d0 + 2) * 32); ka[d0 & 1][1] = *(const bf16x8*)(kp + 32 * KST + (d0 + 2) * 32); }
      }
    }
    float pmax = p0[0];
#pragma unroll
    for (int i = 1; i < 16; ++i) pmax = fmaxf(pmax, p0[i]);
#pragma unroll
    for (int i = 0; i < 16; ++i) pmax = fmaxf(pmax, p1[i]);
    pmax = swap_max(pmax);
    {
      const float mn = fmaxf(m_run, pmax);
      const float alpha = __builtin_amdgcn_exp2f(m_run - mn);
      m_run = mn; l_run *= alpha;
#pragma unroll
      for (int i = 0; i < 16; ++i) { o[0][i] *= alpha; o[1][i] *= alpha; }
    }
    asm volatile("" : "+v"(p0), "+v"(p1), "+v"(o[0]), "+v"(o[1]), "+v"(m_run));
    __syncthreads();
    asm volatile("" : "+v"(p0), "+v"(p1), "+v"(o[0]), "+v"(o[1]), "+v"(m_run));
    s16x4 vlo[4], vhi[4];
#pragma unroll
    for (int s2 = 0; s2 < 4; ++s2) {
      vlo[s2] = __builtin_amdgcn_ds_read_tr16_b64_v4i16((lds_s16x4*)(Vs + (16 * s2) * 64 + vrd));
      vhi[s2] = __builtin_amdgcn_ds_read_tr16_b64_v4i16((lds_s16x4*)(Vs + (16 * s2 + 8) * 64 + vrd));
    }
    float ps = 0.f;
#pragma unroll
    for (int i = 0; i < 16; ++i) { p0[i] = __builtin_amdgcn_exp2f(p0[i] - m_run); ps += p0[i]; }
#pragma unroll
    for (int i = 0; i < 16; ++i) { p1[i] = __builtin_amdgcn_exp2f(p1[i] - m_run); ps += p1[i]; }
    l_run += swap_sum(ps);
    bf16x8 pb[4];
#pragma unroll
    for (int s = 0; s < 2; ++s) {
      u32x4 a = {cvtpk(p0[8 * s], p0[8 * s + 1]), cvtpk(p0[8 * s + 2], p0[8 * s + 3]), cvtpk(p0[8 * s + 4], p0[8 * s + 5]), cvtpk(p0[8 * s + 6], p0[8 * s + 7])};
      u32x4 b = {cvtpk(p1[8 * s], p1[8 * s + 1]), cvtpk(p1[8 * s + 2], p1[8 * s + 3]), cvtpk(p1[8 * s + 4], p1[8 * s + 5]), cvtpk(p1[8 * s + 6], p1[8 * s + 7])};
      pb[s] = __builtin_bit_cast(bf16x8, a); pb[2 + s] = __builtin_bit_cast(bf16x8, b);
    }
    {
      s16x4 wlo[4], whi[4];
#pragma unroll
      for (int s2 = 0; s2 < 4; ++s2) {
        wlo[s2] = __builtin_amdgcn_ds_read_tr16_b64_v4i16((lds_s16x4*)(Vs + 4096 + (16 * s2) * 64 + vrd));
        whi[s2] = __builtin_amdgcn_ds_read_tr16_b64_v4i16((lds_s16x4*)(Vs + 4096 + (16 * s2 + 8) * 64 + vrd));
      }
#pragma unroll
      for (int s2 = 0; s2 < 4; ++s2) { const bf16x8 a = {vlo[s2][0], vlo[s2][1], vlo[s2][2], vlo[s2][3], vhi[s2][0], vhi[s2][1], vhi[s2][2], vhi[s2][3]}; o[0] = MFMA32(a, pb[s2], o[0]); }
#pragma unroll
      for (int s2 = 0; s2 < 4; ++s2) { const bf16x8 a = {wlo[s2][0], wlo[s2][1], wlo[s2][2], wlo[s2][3], whi[s2][0], whi[s2][1], whi[s2][2], whi[s2][3]}; o[1] = MFMA32(a, pb[s2], o[1]); }
    }
    asm volatile("" : "+v"(o[0]), "+v"(o[1]));
    __syncthreads();
    asm volatile("" : "+v"(o[0]), "+v"(o[1]));
    vcur = vnext;
  }
  if (grp == 0) __syncthreads();
  const float inv = 1.f / l_run;
  bf16_t* orow = out + (size_t)qpos * 384;
#pragma unroll
  for (int db = 0; db < 2; ++db)
#pragma unroll
    for (int g = 0; g < 4; ++g) {
      u32x2 v = {cvtpk(o[db][4 * g] * inv, o[db][4 * g + 1] * inv), cvtpk(o[db][4 * g + 2] * inv, o[db][4 * g + 3] * inv)};
      *(u32x2*)(orow + db * 32 + 8 * g + 4 * hi) = v;
    }
}

DI float wave_sum(float v) {
  v += __shfl_xor(v, 32); v += __shfl_xor(v, 16); v += __shfl_xor(v, 8); v += __shfl_xor(v, 4); v += __shfl_xor(v, 2); v += __shfl_xor(v, 1); return v;
}
DI float gain_of(const Params& p, int kind, int l, int k) {
  switch (kind) {
    case 0: return p.g_mix[l * 1024 + k];
    case 1: return p.q_norm[l * 256 + k];
    case 2: return p.kv_norm[l * 128 + k];
    case 3: return k < 384 ? p.on_a[l * 384 + k] : (k < 768 ? p.on_b[l * 384 + k - 384] : p.on_c[l * 256 + k - 768]);
    case 4: return p.g_mlp[l * 1024 + k];
    default: return 1.f;
  }
}
DI int map_col(int kind, int n) {
  if (kind == 0) {
    if (n < 384) return n;
    if (n < 448) { const int wv = n - 384, c = wv & 31, sub = wv >> 5; return c < 16 ? 384 + sub * 16 + c : -1; }
    if (n < 1600) return 416 + (n - 448);
    if (n < 2368) return 1568 + (n - 1600);
    return -1;
  }
  if (kind == 1) {
    if (n < 384) return (n >> 6) * 96 + (n & 63);
    if (n < 576) { const int wv = n - 384, g = wv >> 6, wi = wv & 63, sub = wi >> 5, c = wi & 31, hd = 2 * g + (c >> 4), fi = c & 15; return hd * 96 + 64 + sub * 16 + fi; }
    return -1;
  }
  return n;
}
DI void wtile(const Params& p, const float* src, int Nsrc, bf16_t* dst, int K, int kt, int nt, int kind, int l, char* smem, const int tid) {
  float* tile = (float*)smem;
  const int lane = tid & 63, wv = tid >> 6;
  __syncthreads();
  const int n = nt * 64 + lane, sc = map_col(kind, n);
#pragma unroll 4
  for (int r = 0; r < 8; ++r) {
    const int kl = r * 8 + wv, kd = kt * 64 + kl;
    const bool perm = kind == 5 || (kind == 3 && kd >= 384);
    const int k = perm ? ((kd & ~63) | ((kd & 1) << 5) | ((kd & 63) >> 1)) : kd;
    float v = 0.f;
    if (sc >= 0) v = src[(size_t)k * Nsrc + sc] * gain_of(p, kind, l, k);
    tile[kl * 65 + lane] = v;
  }
  __syncthreads();
#pragma unroll 4
  for (int r = 0; r < 8; ++r) {
    const int nl = r * 8 + wv;
    dst[(size_t)(nt * 64 + nl) * K + kt * 64 + lane] = f2bf(tile[lane * 65 + nl]);
  }
}

NI void phase_prep() {
  const Params& p = kparams(); char* smem = g_smem; const int tid = otid(), bid = obid();
  char* ws = p.ws;
  constexpr int T_WIN = (N_IN_PAD / 64) * 16, T_WUQ = (N_UQ_PAD / 64) * 4, T_WUKV = (N_UKV / 64) * 2, T_WOUT = 16 * 16, T_W1 = 64 * 16, T_W2 = 16 * 64;
  constexpr int T_L = T_WIN + T_WUQ + T_WUKV + T_WOUT + T_W1 + T_W2;
  for (int j = bid; j < NLAYER * T_L; j += gridDim.x) {
    const int l = j / T_L; int r = j - l * T_L;
    char* lw = ws + OFF_W + (size_t)l * LW_SIZE;
    if (r < T_WIN) { wtile(p, p.w_in + (size_t)l * 1024 * 2336, 2336, (bf16_t*)(lw + LW_WIN), 1024, r & 15, r >> 4, 0, l, smem, tid); continue; }
    r -= T_WIN;
    if (r < T_WUQ) { wtile(p, p.w_uq + (size_t)l * 256 * 576, 576, (bf16_t*)(lw + LW_WUQ), 256, r & 3, r >> 2, 1, l, smem, tid); continue; }
    r -= T_WUQ;
    if (r < T_WUKV) { wtile(p, p.w_ukv + (size_t)l * 128 * 768, 768, (bf16_t*)(lw + LW_WUKV), 128, r & 1, r >> 1, 2, l, smem, tid); continue; }
    r -= T_WUKV;
    if (r < T_WOUT) { wtile(p, p.w_out + (size_t)l * 1024 * 1024, 1024, (bf16_t*)(lw + LW_WOUT), 1024, r & 15, r >> 4, 3, l, smem, tid); continue; }
    r -= T_WOUT;
    if (r < T_W1) { wtile(p, p.w_mlp_in + (size_t)l * 1024 * 4096, 4096, (bf16_t*)(lw + LW_W1), 1024, r & 15, r >> 4, 4, l, smem, tid); continue; }
    r -= T_W1;
    wtile(p, p.w_mlp_out + (size_t)l * 4096 * 1024, 1024, (bf16_t*)(lw + LW_W2), 4096, r & 63, r >> 6, 5, l, smem, tid);
  }
  const size_t gtid = (size_t)bid * NTHR + tid, gsz = (size_t)gridDim.x * NTHR;
  bf16_t* xb = (bf16_t*)(ws + OFF_XB);
  {
    const int lane = tid & 63, gw = bid * (NTHR / 64) + (tid >> 6), nw = gridDim.x * (NTHR / 64);
    float* px1 = (float*)(ws + OFF_PX1);
    for (int row = gw; row < NTOK; row += nw) {
      float ss = 0.f;
#pragma unroll
      for (int j = 0; j < 4; ++j) {
        const f32x4 a = *(const f32x4*)(p.x + (size_t)row * DM + j * 256 + lane * 4);
        ss += a[0] * a[0] + a[1] * a[1] + a[2] * a[2] + a[3] * a[3];
        u32x2 o = {cvtpk(a[0], a[1]), cvtpk(a[2], a[3])};
        *(u32x2*)(xb + (size_t)row * DM + j * 256 + lane * 4) = o;
      }
      ss = wave_sum(ss);
      if (lane < 16) px1[(size_t)row * 16 + lane] = lane == 0 ? ss : 0.f;
    }
  }
  float* c32 = (float*)(ws + OFF_COS32); float* s32 = (float*)(ws + OFF_SIN32); float* c16 = (float*)(ws + OFF_COS16); float* s16 = (float*)(ws + OFF_SIN16);
  for (size_t i = gtid; i < (size_t)SEQ * 48; i += gsz) {
    int pos, fi; float invf; float *cd, *sd;
    if (i < (size_t)SEQ * 32) { pos = (int)(i >> 5); fi = (int)(i & 31); invf = __builtin_amdgcn_exp2f(-(float)fi * (13.287712379549449f / 32.f)); cd = c32 + i; sd = s32 + i; }
    else { const size_t j = i - (size_t)SEQ * 32; pos = (int)(j >> 4); fi = (int)(j & 15); invf = __builtin_amdgcn_exp2f(-(float)fi * (13.287712379549449f / 16.f)); cd = c16 + j; sd = s16 + j; }
    const float ang = (float)pos * invf;
    const double rev = (double)ang * 0.15915494309189535;
    const float fr = (float)(rev - rint(rev));
    *cd = __builtin_amdgcn_cosf(fr); *sd = __builtin_amdgcn_sinf(fr);
  }
}

NI void phase_g1(int l_) {
  const Params& p = kparams(); char* smem = g_smem; const int l = __builtin_amdgcn_readfirstlane(l_); const int tid = otid(), bid = obid(); (void)tid; (void)bid;
  char* ws = p.ws;
  EpiG1 e;
  e.cqkv = (bf16_t*)(ws + OFF_CQKV); e.KA = (bf16_t*)(ws + OFF_KA); e.qB = (bf16_t*)(ws + OFF_QB); e.qC = (bf16_t*)(ws + OFF_QC);
  e.cos32 = (const float*)(ws + OFF_COS32); e.sin32 = (const float*)(ws + OFF_SIN32); e.cos16 = (const float*)(ws + OFF_COS16); e.sin16 = (const float*)(ws + OFF_SIN16);
  e.qs = p.qscaleB; e.pq = (float*)(ws + OFF_PQ); e.pkv = (float*)(ws + OFF_PKV);
  const bf16_t* A = (const bf16_t*)(ws + OFF_XB);
  const bf16_t* Bt = (const bf16_t*)(ws + OFF_W + (size_t)l * LW_SIZE + LW_WIN);
  constexpr int NNT = N_IN_PAD / 256;
  FOR_TILES(NNT, mt, nt, gemm_tile<16>(A, 1024, Bt, 1024, 1024, mt * 256, nt * 256, e, tid, (const float*)(ws + OFF_PX1));)
}
NI void phase_g2(int l_) {
  const Params& p = kparams(); char* smem = g_smem; const int l = __builtin_amdgcn_readfirstlane(l_); const int tid = otid(), bid = obid(); (void)tid; (void)bid;
  char* ws = p.ws;
  const bf16_t* A = (const bf16_t*)(ws + OFF_CQKV);
  EpiUQ eq; eq.QA = (bf16_t*)(ws + OFF_QA); eq.cos16 = (const float*)(ws + OFF_COS16); eq.sin16 = (const float*)(ws + OFF_SIN16); eq.qs = p.qscaleA;
  EpiUKV ek; ek.KA = (bf16_t*)(ws + OFF_KA); ek.VA = (bf16_t*)(ws + OFF_VA);
  const bf16_t* Wq = (const bf16_t*)(ws + OFF_W + (size_t)l * LW_SIZE + LW_WUQ);
  const bf16_t* Wkv = (const bf16_t*)(ws + OFF_W + (size_t)l * LW_SIZE + LW_WUKV);
  FOR_TILES(6, mt, nt,
    if (nt < 3) gemm_tile<4>(A, 384, Wq, 256, 256, mt * 256, nt * 256, eq, tid, (const float*)(ws + OFF_PQ));
    else gemm_tile<2>(A + 256, 384, Wkv, 128, 128, mt * 256, (nt - 3) * 256, ek, tid, (const float*)(ws + OFF_PKV));)
}
NI void phase_attn(int l_) {
  const Params& p = kparams(); char* smem = g_smem; const int l = __builtin_amdgcn_readfirstlane(l_); const int tid = otid(), bid = obid(); (void)tid; (void)bid;
  char* ws = p.ws;
  constexpr int NA = 1536, NBI = 4608, NC = 1024;
  const int grp = tid >> 8, t256 = tid & 255; char* gsm = smem + grp * ATT_LDS;
  for (int i0 = bid * 2; i0 < NA; i0 += gridDim.x * 2) {
    const int i = i0 + grp, xcd = (i >> 1) & 7, j = ((i >> 4) << 1) | (i & 1);
    const int bh = (j >> 6) * 8 + xcd, qb = j & 63, b = bh / 6, h = bh - b * 6;
    attn_dense_skew((const bf16_t*)(ws + OFF_QA) + (size_t)bh * SEQ * 96, (const bf16_t*)(ws + OFF_KA) + (size_t)bh * SEQ * 96, (const bf16_t*)(ws + OFF_VA) + (size_t)bh * SEQ * 64,
                    qb * 128, (bf16_t*)(ws + OFF_OA) + (size_t)b * SEQ * 384 + h * 64, smem, tid, grp);
  }
  for (int i0 = bid * 2; i0 < NBI; i0 += gridDim.x * 2) {
    AttnItem it{};
    const int i = i0 + grp, xcd = (i >> 1) & 7, j = ((i >> 4) << 1) | (i & 1);
    const int g = (j >> 6) * 8 + xcd, c = j & 63, br = g / 24, bh = g - br * 24, b = bh / 6, h = bh - b * 6;
    const int dil = br == 0 ? 1 : (br == 1 ? 4 : 16), cpr = 64 / dil;
    it.Q = (const bf16_t*)(ws + OFF_QB) + (size_t)bh * SEQ * 64; it.K = (const bf16_t*)(ws + OFF_KB) + (size_t)bh * SEQ * 64; it.V = (const bf16_t*)(ws + OFF_VB) + (size_t)bh * SEQ * 64;
    it.dil = dil; it.res = c / cpr; it.n0 = (c - it.res * cpr) * 128; it.N = SEQ / dil;
    it.out = (bf16_t*)(ws + OFF_OB) + (size_t)br * NTOK * 384 + (size_t)b * SEQ * 384 + h * 64; it.ldo = 384;
    it.lse = (float*)(ws + OFF_LSEB) + (size_t)br * NTOK * 6 + (size_t)b * SEQ * 6 + h;
    attn_block<64, 1>(it, gsm, t256);
  }
  for (int i0 = bid * 2; i0 < NC; i0 += gridDim.x * 2) {
    AttnItem it{};
    const int i = i0 + grp, xcd = (i >> 1) & 7, j = ((i >> 4) << 1) | (i & 1);
    const int bh = (j >> 6) * 8 + xcd, blk = j & 63, b = bh >> 2, h = bh & 3;
    it.Q = (const bf16_t*)(ws + OFF_QC) + (size_t)bh * SEQ * 64; it.K = (const bf16_t*)(ws + OFF_KC) + (size_t)bh * SEQ * 64; it.V = (const bf16_t*)(ws + OFF_VC) + (size_t)bh * SEQ * 64;
    it.nrb = blk >> 2; it.ncb = blk & 3;
    it.kr0 = min(max(8 * it.nrb - 4, 0), 112); it.kc0 = min(max(16 * it.ncb - 8, 0), 32);
    it.out = (bf16_t*)(ws + OFF_OC) + (size_t)b * SEQ * 256 + h * 64; it.ldo = 256;
    it.rpb = p.rpb + ((size_t)l * 4 + h) * 465;
    attn_block<64, 2>(it, gsm, t256);
  }
}
NI void phase_mix() {
  const Params& p = kparams(); const int tid = otid(), bid = obid();
  char* ws = p.ws;
  const int lane = tid & 63, gw = bid * (NTHR / 64) + (tid >> 6), nw = gridDim.x * (NTHR / 64);
  const bf16_t* oA = (const bf16_t*)(ws + OFF_OA); const bf16_t* oB = (const bf16_t*)(ws + OFF_OB); const bf16_t* oC = (const bf16_t*)(ws + OFF_OC);
  const float* lse = (const float*)(ws + OFF_LSEB);
  bf16_t* mixed = (bf16_t*)(ws + OFF_MIXED);
  for (int tok = gw; tok < NTOK; tok += nw) {
    float v[16];
    if (lane < 24 || lane >= 48) {
      const bf16_t* src = lane < 24 ? oA + (size_t)tok * 384 + lane * 16 : oC + (size_t)tok * 256 + (lane - 48) * 16;
      const u32x4 a = *(const u32x4*)src, b = *(const u32x4*)(src + 8);
#pragma unroll
      for (int j = 0; j < 4; ++j) { v[2 * j] = bf2f(a[j] & 0xffffu); v[2 * j + 1] = bf2f(a[j] >> 16); v[8 + 2 * j] = bf2f(b[j] & 0xffffu); v[8 + 2 * j + 1] = bf2f(b[j] >> 16); }
    } else {
      const int col = (lane - 24) * 16, hd = col >> 6;
      const float l0 = lse[(size_t)tok * 6 + hd], l1 = lse[(size_t)NTOK * 6 + (size_t)tok * 6 + hd], l2 = lse[(size_t)2 * NTOK * 6 + (size_t)tok * 6 + hd];
      const float mx = fmaxf(l0, fmaxf(l1, l2));
      float w0 = __builtin_amdgcn_exp2f(l0 - mx), w1 = __builtin_amdgcn_exp2f(l1 - mx), w2 = __builtin_amdgcn_exp2f(l2 - mx);
      const float wi = 1.f / (w0 + w1 + w2); w0 *= wi; w1 *= wi; w2 *= wi;
#pragma unroll
      for (int j = 0; j < 16; ++j) v[j] = 0.f;
#pragma unroll
      for (int br = 0; br < 3; ++br) {
        const float wb = br == 0 ? w0 : (br == 1 ? w1 : w2);
        const bf16_t* src = oB + (size_t)br * NTOK * 384 + (size_t)tok * 384 + col;
        const u32x4 a = *(const u32x4*)src, b = *(const u32x4*)(src + 8);
#pragma unroll
        for (int j = 0; j < 4; ++j) { v[2 * j] += wb * bf2f(a[j] & 0xffffu); v[2 * j + 1] += wb * bf2f(a[j] >> 16); v[8 + 2 * j] += wb * bf2f(b[j] & 0xffffu); v[8 + 2 * j + 1] += wb * bf2f(b[j] >> 16); }
      }
    }
    float ss = 0.f;
#pragma unroll
    for (int j = 0; j < 16; ++j) ss += v[j] * v[j];
    const float sa = wave_sum(lane < 24 ? ss : 0.f), sb = wave_sum((lane >= 24 && lane < 48) ? ss : 0.f), sc = wave_sum(lane >= 48 ? ss : 0.f);
    const float rs = lane < 24 ? rsqrtf(sa * (1.f / 384.f) + 1e-6f) : (lane < 48 ? rsqrtf(sb * (1.f / 384.f) + 1e-6f) : rsqrtf(sc * (1.f / 256.f) + 1e-6f));
    u32x4 oa, ob;
#pragma unroll
    for (int j = 0; j < 4; ++j) { oa[j] = cvtpk(v[2 * j] * rs, v[2 * j + 1] * rs); ob[j] = cvtpk(v[8 + 2 * j] * rs, v[8 + 2 * j + 1] * rs); }
    bf16_t* dst = mixed + (size_t)tok * 1024 + lane * 16;
    *(u32x4*)dst = oa; *(u32x4*)(dst + 8) = ob;
  }
}
NI void phase_wout(int l_) {
  const Params& p = kparams(); char* smem = g_smem; const int l = __builtin_amdgcn_readfirstlane(l_); const int tid = otid(), bid = obid(); (void)tid; (void)bid;
  char* ws = p.ws;
  EpiRes e; e.xb = (bf16_t*)(ws + OFF_XB); e.pout = (float*)(ws + OFF_PX2);
  const bf16_t* A = (const bf16_t*)(ws + OFF_MIXED);
  const bf16_t* Bt = (const bf16_t*)(ws + OFF_W + (size_t)l * LW_SIZE + LW_WOUT);
  FOR_TILES(4, mt, nt, gemm_tile<0>(A, 1024, Bt, 1024, 1024, mt * 256, nt * 256, e, tid, nullptr);)
}
NI void phase_mlp1(int l_) {
  const Params& p = kparams(); char* smem = g_smem; const int l = __builtin_amdgcn_readfirstlane(l_); const int tid = otid(), bid = obid(); (void)tid; (void)bid;
  char* ws = p.ws;
  EpiMlp1 e; e.hid = (bf16_t*)(ws + OFF_HID);
  const bf16_t* A = (const bf16_t*)(ws + OFF_XB);
  const bf16_t* Bt = (const bf16_t*)(ws + OFF_W + (size_t)l * LW_SIZE + LW_W1);
  FOR_TILES(16, mt, nt, gemm_tile<16>(A, 1024, Bt, 1024, 1024, mt * 256, nt * 256, e, tid, (const float*)(ws + OFF_PX2));)
}
NI void phase_mlp2(int l_) {
  const Params& p = kparams(); char* smem = g_smem; const int l = __builtin_amdgcn_readfirstlane(l_); const int tid = otid(), bid = obid(); (void)tid; (void)bid;
  char* ws = p.ws;
  EpiRes e; e.xb = (bf16_t*)(ws + OFF_XB); e.pout = (float*)(ws + OFF_PX1);
  const bf16_t* A = (const bf16_t*)(ws + OFF_HID);
  const bf16_t* Bt = (const bf16_t*)(ws + OFF_W + (size_t)l * LW_SIZE + LW_W2);
  FOR_TILES(4, mt, nt, gemm_tile<0>(A, DFF, Bt, DFF, DFF, mt * 256, nt * 256, e, tid, nullptr);)
}
NI void phase_final() {
  const Params& p = kparams(); const int tid = otid(), bid = obid();
  const int lane = tid & 63, gw = bid * (NTHR / 64) + (tid >> 6), nw = gridDim.x * (NTHR / 64);
  const bf16_t* xb = (const bf16_t*)(p.ws + OFF_XB);
  for (int tok = gw; tok < NTOK; tok += nw) {
    float* row = p.out + (size_t)tok * DM;
    f32x4 v[4]; float ss = 0.f;
#pragma unroll
    for (int j = 0; j < 4; ++j) {
      const u32x2 r = *(const u32x2*)(xb + (size_t)tok * DM + j * 256 + lane * 4);
      v[j] = f32x4{bf2f(r[0] & 0xffffu), bf2f(r[0] >> 16), bf2f(r[1] & 0xffffu), bf2f(r[1] >> 16)};
      ss += v[j][0] * v[j][0] + v[j][1] * v[j][1] + v[j][2] * v[j][2] + v[j][3] * v[j][3];
    }
    ss = wave_sum(ss);
    const float rs = rsqrtf(ss * (1.f / 1024.f) + 1e-6f);
#pragma unroll
    for (int j = 0; j < 4; ++j) { const f32x4 g = *(const f32x4*)(p.g_final + j * 256 + lane * 4); f32x4 o = {v[j][0] * rs * g[0], v[j][1] * rs * g[1], v[j][2] * rs * g[2], v[j][3] * rs * g[3]}; __builtin_nontemporal_store(o, (f32x4*)(row + j * 256 + lane * 4)); }
  }
}

DI unsigned xcc_id() { return (unsigned)__builtin_amdgcn_s_getreg((3 << 11) | 20) & 0xFu; }
DI void grid_barrier(unsigned* base, unsigned k, unsigned xcc, unsigned n_x, unsigned nxcd) {
  __syncthreads();
  if (threadIdx.x == 0) {
    unsigned* arr = base + 64 * (16 + xcc);
    unsigned* garr = base + 64 * 32;
    const unsigned a = __hip_atomic_fetch_add(arr, 1u, __ATOMIC_RELAXED, __HIP_MEMORY_SCOPE_AGENT);
    if (a + 1 == n_x * k) {
      __builtin_amdgcn_fence(__ATOMIC_RELEASE, "agent");
      asm volatile("s_waitcnt vmcnt(0)" ::: "memory");
      __hip_atomic_fetch_add(garr, 1u, __ATOMIC_RELAXED, __HIP_MEMORY_SCOPE_AGENT);
    }
    while (__hip_atomic_load(garr, __ATOMIC_RELAXED, __HIP_MEMORY_SCOPE_AGENT) < nxcd * k) __builtin_amdgcn_s_sleep(1);
    __builtin_amdgcn_fence(__ATOMIC_ACQUIRE, "agent");
    asm volatile("s_waitcnt vmcnt(0)" ::: "memory");
  }
  __syncthreads();
}

constexpr int NPHASE = 2 + 7 * NLAYER;
DI void run_phase(int ph) {
  if (ph == 0) { phase_prep(); return; }
  if (ph == NPHASE - 1) { phase_final(); return; }
  const int l = (ph - 1) / 7, st = (ph - 1) - l * 7;
  switch (st) {
    case 0: phase_g1(l); break;
    case 1: phase_g2(l); break;
    case 2: phase_attn(l); break;
    case 3: phase_mix(); break;
    case 4: phase_wout(l); break;
    case 5: phase_mlp1(l); break;
    default: phase_mlp2(l); break;
  }
}

__global__ void __launch_bounds__(512) mega(Params p, int ph_lo, int ph_hi) {
  cg::grid_group grid = cg::this_grid();
  unsigned* bar = (unsigned*)(p.ws + OFF_BAR);
  const unsigned xcc = xcc_id();
  unsigned n_x = 0, nxcd = 0;
  if (threadIdx.x == 0) __hip_atomic_fetch_add(bar + 64 * xcc, 1u, __ATOMIC_RELAXED, __HIP_MEMORY_SCOPE_AGENT);
  for (int ph = ph_lo; ph < ph_hi; ++ph) {
    run_phase(ph);
    if (ph + 1 < ph_hi) {
      if (ph == ph_lo) {
        grid.sync();
        if (threadIdx.x == 0) {
          n_x = __hip_atomic_load(bar + 64 * xcc, __ATOMIC_RELAXED, __HIP_MEMORY_SCOPE_AGENT);
          for (int x = 0; x < 16; ++x) nxcd += __hip_atomic_load(bar + 64 * x, __ATOMIC_RELAXED, __HIP_MEMORY_SCOPE_AGENT) != 0u;
        }
      } else grid_barrier(bar, (unsigned)(ph - ph_lo), xcc, n_x, nxcd);
    }
  }
}

extern "C" void kernel_launch(void* const* d_in, const int* in_sizes, int n_in, void* d_out, int out_size, void* d_ws, size_t ws_size, hipStream_t stream) {
  static int grid_blocks = 0;
  if (!grid_blocks) {
    int dev = 0, cus = 0, per_cu = 0;
    (void)hipGetDevice(&dev);
    (void)hipDeviceGetAttribute(&cus, hipDeviceAttributeMultiprocessorCount, dev);
    (void)hipOccupancyMaxActiveBlocksPerMultiprocessor(&per_cu, mega, NTHR, 0);
    if (per_cu > 1) per_cu = 1;
    grid_blocks = cus * per_cu;
    if (ws_size < OFF_END) fprintf(stderr, "kernel_launch: workspace too small: %zu < %zu\n", ws_size, (size_t)OFF_END);
  }
  Params p;
  memset(&p, 0, sizeof(p));
  p.x = (const float*)d_in[0]; p.g_mix = (const float*)d_in[1]; p.w_in = (const float*)d_in[2]; p.q_norm = (const float*)d_in[3];
  p.w_uq = (const float*)d_in[4]; p.kv_norm = (const float*)d_in[5]; p.w_ukv = (const float*)d_in[6]; p.rpb = (const float*)d_in[7];
  p.on_a = (const float*)d_in[8]; p.on_b = (const float*)d_in[9]; p.on_c = (const float*)d_in[10]; p.w_out = (const float*)d_in[11];
  p.g_mlp = (const float*)d_in[12]; p.w_mlp_in = (const float*)d_in[13]; p.w_mlp_out = (const float*)d_in[14]; p.g_final = (const float*)d_in[15];
  p.out = (float*)d_out; p.ws = (char*)d_ws;
  p.qscaleA = (float)(1.4426950408889634 / std::sqrt(96.0));
  p.qscaleB = (float)(1.4426950408889634 * 0.125);
#if ONE_LAUNCH
  (void)hipMemsetAsync((char*)d_ws + OFF_BAR, 0, 16384, stream);
  int lo = 0, hi = NPHASE;
  void* args[] = {&p, &lo, &hi};
  hipError_t e = hipLaunchCooperativeKernel((void*)mega, dim3(grid_blocks), dim3(NTHR), args, 0, stream);
  if (e != hipSuccess) fprintf(stderr, "cooperative launch failed: %s (grid %d)\n", hipGetErrorString(e), grid_blocks);
#else
  for (int ph = 0; ph < NPHASE; ++ph) hipLaunchKernelGGL(mega, dim3(grid_blocks), dim3(NTHR), 0, stream, p, ph, ph + 1);
#endif
}
```
